# Optimizing an MI355X kernel written in HIP

```python
import jax, jax.numpy as jnp
from jax import lax
import numpy as np

D_MODEL = 1024
BATCH = 2
SEQ = 8192
DEPTH = 2
DEC_BATCH = 4
DEC_SEQ = 4096
PAST_LEN = 128

N_META = 16
D_FF = 2816
RMS_EPS = 1e-6
HEAD_NORM_EPS = 1e-5
RWKV_LN_EPS = 64e-5
ROPE_BASE = 10000.0
RET_HEADS = 4
RET_QK = 64
RET_V = 128
RET_CHUNK = 128
RET_W = RET_HEADS * RET_V
RWKV_HEADS = 8
RWKV_N = 64
RWKV_W = RWKV_HEADS * RWKV_N
W_RANK = 64
A_RANK = 64
G_RANK = 128
RWKV_IN = 3 * RWKV_W + W_RANK + A_RANK + G_RANK
EVEN_SPLITS = [RET_HEADS * RET_QK, 2 * RET_HEADS * RET_QK, 2 * RET_HEADS * RET_QK + RET_W, 2 * RET_HEADS * RET_QK + 2 * RET_W]
EVEN_IN = EVEN_SPLITS[-1] + RWKV_IN
RWKV_SPLITS = [RWKV_W, 2 * RWKV_W, 3 * RWKV_W, 3 * RWKV_W + W_RANK, 3 * RWKV_W + W_RANK + A_RANK]
FNET_GROUPS = 4
FNET_G = 128
FNET_W = FNET_GROUPS * FNET_G
CONV_W = 512
CONV_K = 3
ODD_SPLITS = [FNET_W, FNET_W + CONV_W, FNET_W + 2 * CONV_W]
ODD_IN = FNET_W + 3 * CONV_W
MIX_W = RET_W + RWKV_W

kernel_name = 'hybrid_bidir_retention_rwkv7_fnet_shortconv_encoder'


def _rmsnorm(x, g):
    xf = x.astype(jnp.float32)
    y = xf * lax.rsqrt(jnp.mean(xf * xf, axis=-1, keepdims=True) + RMS_EPS)
    return (y * g.astype(jnp.float32)).astype(x.dtype)


def _swiglu(x, wg, wu, wd):
    return (jax.nn.silu(x @ wg) * (x @ wu)) @ wd


def _rope(x, pos):
    half = x.shape[-1] // 2
    inv = ROPE_BASE ** (-jnp.arange(half, dtype=jnp.float32) / half)
    ang = pos[:, None] * inv[None, :]
    cos = jnp.cos(ang)[None, :, None, :]
    sin = jnp.sin(ang)[None, :, None, :]
    xf = x.astype(jnp.float32)
    x1, x2 = xf[..., :half], xf[..., half:]
    return jnp.concatenate([x1 * cos - x2 * sin, x1 * sin + x2 * cos], axis=-1)


def _retention(q, k, v):
    B, L, H, _ = q.shape
    C = RET_CHUNK
    pad = (-L) % C
    n = (L + pad) // C
    padf = lambda t: jnp.pad(t.astype(jnp.float32), ((0, 0), (pad, 0), (0, 0), (0, 0)))
    qc = padf(q).reshape(B, n, C, H, RET_QK) * (RET_QK ** -0.5)
    kc = padf(k).reshape(B, n, C, H, RET_QK)
    vc = padf(v).reshape(B, n, C, H, RET_V)
    lg = jnp.log1p(-jnp.exp2(-5.0 - jnp.arange(H, dtype=jnp.float32)))
    idx = jnp.arange(C, dtype=jnp.float32)
    dmat = jnp.exp(lg[:, None, None] * jnp.abs(idx[:, None] - idx[None, :]))
    s = jnp.einsum('bnihd,bnjhd->bnhij', qc, kc) * dmat
    intra = jnp.einsum('bnhij,bnjhe->bnihe', s, vc)
    dec = lambda e: jnp.exp(e[:, None] * lg[None, :])[None, None, :, :, None]
    kv_f = jnp.einsum('bnjhd,bnjhe->nbhde', kc * dec(C - 1.0 - idx), vc)
    kv_b = jnp.einsum('bnjhd,bnjhe->nbhde', kc * dec(idx), vc)
    g_c = jnp.exp(C * lg)[None, :, None, None]

    def step(S, kv):
        return g_c * S + kv, S

    S0 = jnp.zeros((B, H, RET_QK, RET_V), jnp.float32)
    _, s_prev = lax.scan(step, S0, kv_f)
    _, s_next = lax.scan(step, S0, kv_b, reverse=True)
    inter = (jnp.einsum('bnihd,nbhde->bnihe', qc * dec(idx + 1.0), s_prev)
             + jnp.einsum('bnihd,nbhde->bnihe', qc * dec(C - idx), s_next))
    o = (intra + inter).reshape(B, n * C, H, RET_V)[:, pad:]
    return o


def _centred_shift_mix(p, mu):
    pp = jnp.pad(p, ((0, 0), (1, 1), (0, 0)))
    nb = 0.5 * (pp[:, :-2] + pp[:, 2:])
    return p + mu * (nb - p)


def _rwkv7(p, mu, w0, w2, a0, a2, g2, k_k, k_a, r_k, ln_w, ln_b):
    B, L, _ = p.shape
    f32 = jnp.float32
    x = _centred_shift_mix(p.astype(f32), mu.astype(f32))
    r, k, v, xw, xa, xg = jnp.split(x, RWKV_SPLITS, axis=-1)
    wlog = -jax.nn.softplus(-(w0.astype(f32)[:, None, None, :]
                              + jnp.einsum('blr,drc->dblc', jnp.tanh(xw), w2.astype(f32)))) - 0.5
    decay = jnp.exp(-jnp.exp(wlog))
    a = jax.nn.sigmoid(a0.astype(f32)[:, None, None, :] + jnp.einsum('blr,drc->dblc', xa, a2.astype(f32)))
    g = jax.nn.sigmoid(xg) @ g2.astype(f32)
    hs = lambda t: t.reshape(t.shape[:-1] + (RWKV_HEADS, RWKV_N))
    kk = hs(k * k_k.astype(f32))
    kk = kk * lax.rsqrt(jnp.maximum(jnp.sum(kk * kk, axis=-1, keepdims=True), 1e-24))
    kd = k[None] * (1.0 + (a - 1.0) * k_a.astype(f32))
    per_dir = lambda t: jnp.stack([t[0], jnp.flip(t[1], axis=1)])
    both = lambda t: jnp.stack([t, jnp.flip(t, axis=1)])
    seq = lambda t: jnp.moveaxis(t, 2, 0)
    xs = (seq(both(hs(r))), seq(per_dir(hs(decay))), seq(per_dir(hs(kd))),
          seq(both(hs(v))), seq(both(kk)), seq(per_dir(hs(a))))

    def step(S, inp):
        rt, wt, kt, vt, kkt, at = inp
        sk = jnp.einsum('dbhvk,dbhk->dbhv', S, kkt)
        S = S * wt[..., None, :] - sk[..., :, None] * (kkt * at)[..., None, :] + vt[..., :, None] * kt[..., None, :]
        return S, jnp.einsum('dbhvk,dbhk->dbhv', S, rt)

    S0 = jnp.zeros((2, B, RWKV_HEADS, RWKV_N, RWKV_N), f32)
    _, o = lax.scan(step, S0, xs)
    o = jnp.moveaxis(o, 0, 2)
    o = o[0] + jnp.flip(o[1], axis=1)
    mean = jnp.mean(o, axis=-1, keepdims=True)
    var = jnp.mean(jnp.square(o - mean), axis=-1, keepdims=True)
    on = ((o - mean) * lax.rsqrt(var + RWKV_LN_EPS)).reshape(B, L, RWKV_W)
    on = on * ln_w.astype(f32) + ln_b.astype(f32)
    bonus = jnp.sum(hs(r) * hs(0.5 * (kd[0] + kd[1])) * r_k.astype(f32), axis=-1, keepdims=True) * hs(v)
    return (on + bonus.reshape(B, L, RWKV_W)) * g


def _fourier(p):
    B, L, _ = p.shape
    z = p.astype(jnp.float32).reshape(B, L, FNET_GROUPS, FNET_G)
    return jnp.fft.fft2(z, axes=(1, 3), norm='ortho').real.reshape(B, L, FNET_W)


def _gated_short_conv(pb, pc, ph, w):
    L = ph.shape[1]
    u = pc * ph
    up = jnp.pad(u, ((0, 0), (CONV_K // 2, CONV_K // 2), (0, 0)))
    y = sum(w[j] * up[:, j:j + L] for j in range(CONV_K))
    return pb * y


def _even_layer(h, pos, n1, f1g, f1u, f1d, nm, w_in, w_out, mu, w0, w2, a0, a2, g2, k_k, k_a, r_k,
                ln_w, ln_b, n2, f2g, f2u, f2d):
    h = h + 0.5 * _swiglu(_rmsnorm(h, n1), f1g, f1u, f1d)
    u = _rmsnorm(h, nm) @ w_in
    B, L, _ = u.shape
    q, k, v, gr, prw = jnp.split(u, EVEN_SPLITS, axis=-1)
    q = _rope(q.reshape(B, L, RET_HEADS, RET_QK), pos)
    k = _rope(k.reshape(B, L, RET_HEADS, RET_QK), pos)
    o = _retention(q, k, v.reshape(B, L, RET_HEADS, RET_V))
    o = o * lax.rsqrt(jnp.mean(o * o, axis=-1, keepdims=True) + HEAD_NORM_EPS)
    ret = o.reshape(B, L, RET_W) * jax.nn.silu(gr.astype(jnp.float32))
    rw = _rwkv7(prw, mu, w0, w2, a0, a2, g2, k_k, k_a, r_k, ln_w, ln_b)
    h = h + jnp.concatenate([ret, rw], axis=-1).astype(h.dtype) @ w_out
    return h + 0.5 * _swiglu(_rmsnorm(h, n2), f2g, f2u, f2d)


def _odd_layer(h, n1, f1g, f1u, f1d, nm, w_in, w_out, conv_w, n2, f2g, f2u, f2d):
    h = h + 0.5 * _swiglu(_rmsnorm(h, n1), f1g, f1u, f1d)
    u = _rmsnorm(h, nm) @ w_in
    pf, pb, pc, ph = jnp.split(u, ODD_SPLITS, axis=-1)
    fo = _fourier(pf).astype(h.dtype)
    co = _gated_short_conv(pb, pc, ph, conv_w).astype(h.dtype)
    h = h + jnp.concatenate([fo, co], axis=-1) @ w_out
    return h + 0.5 * _swiglu(_rmsnorm(h, n2), f2g, f2u, f2d)


def _encode(x, meta, even_p, odd_p, final_norm):
    B, S, _ = x.shape
    h = jnp.concatenate([jnp.broadcast_to(meta.astype(x.dtype)[None], (B, N_META, D_MODEL)), x], axis=1)
    pos = jnp.arange(S + N_META, dtype=jnp.float32)
    for i in range(DEPTH):
        if i % 2 == 0:
            h = _even_layer(h, pos, *even_p)
        else:
            h = _odd_layer(h, *odd_p)
    return _rmsnorm(h, final_norm)[:, N_META:]


def setup_inputs(seed: int = 0) -> dict:
    key = jax.random.key(seed)
    ks = iter(jax.random.split(key, 64))
    f32 = jnp.float32

    def nrm(shape, scale):
        return scale * jax.random.normal(next(ks), shape, f32)

    def gain(n):
        return 1.0 + nrm((n,), 0.01)

    def ffn(prefix, d):
        d[prefix + '_norm'] = gain(D_MODEL)
        d[prefix + '_wg'] = nrm((D_MODEL, D_FF), D_MODEL ** -0.5)
        d[prefix + '_wu'] = nrm((D_MODEL, D_FF), D_MODEL ** -0.5)
        d[prefix + '_wd'] = nrm((D_FF, D_MODEL), D_FF ** -0.5)

    d = {}
    d['x_prompt'] = nrm((BATCH, SEQ, D_MODEL), 1.0)
    d['x_sample'] = nrm((DEC_BATCH, DEC_SEQ, D_MODEL), 1.0)
    d['meta'] = nrm((N_META, D_MODEL), 1.0)
    ffn('l0_ffn1', d)
    d['l0_mix_norm'] = gain(D_MODEL)
    d['l0_w_in'] = nrm((D_MODEL, EVEN_IN), D_MODEL ** -0.5)
    d['l0_w_out'] = nrm((MIX_W, D_MODEL), MIX_W ** -0.5)
    d['l0_rwkv_mu'] = jax.random.uniform(next(ks), (RWKV_IN,), f32)
    d['l0_rwkv_w0'] = jax.random.uniform(next(ks), (2, RWKV_W), f32, -6.0, 1.0)
    d['l0_rwkv_w2'] = nrm((2, W_RANK, RWKV_W), 0.1)
    d['l0_rwkv_a0'] = nrm((2, RWKV_W), 0.5)
    d['l0_rwkv_a2'] = nrm((2, A_RANK, RWKV_W), 0.5 * A_RANK ** -0.5)
    d['l0_rwkv_g2'] = nrm((G_RANK, RWKV_W), G_RANK ** -0.5)
    d['l0_rwkv_kk'] = 0.85 + nrm((RWKV_W,), 0.1)
    d['l0_rwkv_ka'] = 1.0 + nrm((RWKV_W,), 0.1)
    d['l0_rwkv_rk'] = nrm((RWKV_HEADS, RWKV_N), 0.1)
    d['l0_rwkv_lnw'] = gain(RWKV_W)
    d['l0_rwkv_lnb'] = nrm((RWKV_W,), 0.01)
    ffn('l0_ffn2', d)
    ffn('l1_ffn1', d)
    d['l1_mix_norm'] = gain(D_MODEL)
    d['l1_w_in'] = nrm((D_MODEL, ODD_IN), D_MODEL ** -0.5)
    d['l1_w_out'] = nrm((MIX_W, D_MODEL), MIX_W ** -0.5)
    d['l1_conv_w'] = nrm((CONV_K, CONV_W), CONV_K ** -0.5)
    ffn('l1_ffn2', d)
    d['final_norm'] = gain(D_MODEL)
    return d


def reference(x_prompt, x_sample, meta,
              l0_ffn1_norm, l0_ffn1_wg, l0_ffn1_wu, l0_ffn1_wd, l0_mix_norm, l0_w_in, l0_w_out,
              l0_rwkv_mu, l0_rwkv_w0, l0_rwkv_w2, l0_rwkv_a0, l0_rwkv_a2, l0_rwkv_g2, l0_rwkv_kk,
              l0_rwkv_ka, l0_rwkv_rk, l0_rwkv_lnw, l0_rwkv_lnb,
              l0_ffn2_norm, l0_ffn2_wg, l0_ffn2_wu, l0_ffn2_wd,
              l1_ffn1_norm, l1_ffn1_wg, l1_ffn1_wu, l1_ffn1_wd, l1_mix_norm, l1_w_in, l1_w_out, l1_conv_w,
              l1_ffn2_norm, l1_ffn2_wg, l1_ffn2_wu, l1_ffn2_wd, final_norm):
    even_p = (l0_ffn1_norm, l0_ffn1_wg, l0_ffn1_wu, l0_ffn1_wd, l0_mix_norm, l0_w_in, l0_w_out,
              l0_rwkv_mu, l0_rwkv_w0, l0_rwkv_w2, l0_rwkv_a0, l0_rwkv_a2, l0_rwkv_g2, l0_rwkv_kk,
              l0_rwkv_ka, l0_rwkv_rk, l0_rwkv_lnw, l0_rwkv_lnb,
              l0_ffn2_norm, l0_ffn2_wg, l0_ffn2_wu, l0_ffn2_wd)
    odd_p = (l1_ffn1_norm, l1_ffn1_wg, l1_ffn1_wu, l1_ffn1_wd, l1_mix_norm, l1_w_in, l1_w_out, l1_conv_w,
             l1_ffn2_norm, l1_ffn2_wg, l1_ffn2_wu, l1_ffn2_wd)
    y_prompt = _encode(x_prompt, meta, even_p, odd_p, final_norm)
    y_sample = _encode(x_sample, meta, even_p, odd_p, final_norm)
    return (y_prompt, y_sample)
```

```cpp
#include <hip/hip_runtime.h>
#include <hip/hip_cooperative_groups.h>
#include <cstdio>
namespace cg = cooperative_groups;
#define LAS __attribute__((address_space(3)))
typedef unsigned short bf16_t;
typedef short bf16x8 __attribute__((ext_vector_type(8)));
typedef float f32x4 __attribute__((ext_vector_type(4)));
typedef unsigned u32x4 __attribute__((ext_vector_type(4)));
typedef unsigned u32x2 __attribute__((ext_vector_type(2)));

constexpr int DM = 1024, FF = 2816;
constexpr int LP = 8208, LS = 4112, LPP = 8320, LPS = 4224, PADR = 112;
constexpr int MROWS = 2 * LPP + 4 * LPS;
constexpr int MT = MROWS / 256;
constexpr int MT_A = 66;
static_assert(MROWS % 256 == 0, "rows");
constexpr size_t SZ_H = (size_t)MROWS * DM * 2;
constexpr size_t SZ_UP = (size_t)2 * FF * DM * 2, SZ_DN = (size_t)DM * FF * 2, SZ_SQ = (size_t)DM * DM * 2;
constexpr size_t OFF_H = 0;
constexpr size_t OFF_W0 = OFF_H + SZ_H;
constexpr size_t W0_F1UP = OFF_W0, W0_F1DN = W0_F1UP + SZ_UP, W0_INA = W0_F1DN + SZ_DN, W0_INB = W0_INA + (size_t)1536 * DM * 2,
                 W0_OUT = W0_INB + (size_t)1792 * DM * 2, W0_F2UP = W0_OUT + SZ_SQ, W0_F2DN = W0_F2UP + SZ_UP;
constexpr size_t OFF_TAB = W0_F2DN + SZ_DN;
constexpr size_t T_ROWSQ = OFF_TAB;
constexpr size_t T_ROPE = T_ROWSQ + (size_t)MROWS * 16 * 4;
constexpr size_t T_ADFTP = T_ROPE + (size_t)LP * 64 * 4;
constexpr size_t T_ADFTS = T_ADFTP + (size_t)512 * 1024 * 2;
constexpr size_t T_FT = T_ADFTS + (size_t)256 * 512 * 2;
constexpr size_t T_WTMP = T_FT + (size_t)1024 * 512 * 2;
constexpr size_t T_TWP = T_WTMP + (size_t)1024 * 512 * 2;
constexpr size_t T_TWS = T_TWP + 65792;
constexpr size_t T_TAILC = T_TWS + 33024;
constexpr size_t T_TAILV = T_TAILC + 16384;
constexpr size_t T_BONUS = T_TAILV + 131072 + 262144;
constexpr size_t T_G2T = T_BONUS + (size_t)MROWS * 16 * 4;
constexpr size_t T_PTR = T_G2T + 131072;
constexpr size_t T_CNT = T_PTR + 384;
constexpr size_t T_BAR = T_PTR + 512;
constexpr size_t OFF_R1 = T_BAR + 14336;
constexpr int LDS_RSTD = 143360 + 64;
constexpr int LDS_CTL = 143360;
constexpr size_t WS_MIN = 268435456;
constexpr size_t R1_MIX = OFF_R1;
constexpr size_t SZ_MIX = (size_t)MROWS * 1024 * 2;
constexpr size_t R1_OF = R1_MIX + SZ_MIX, R1_OB = R1_OF + (size_t)MROWS * 512 * 2;
constexpr size_t R1_U = R1_MIX + SZ_MIX;
constexpr size_t R1_BTFS = R1_U;
constexpr size_t R1_ACTA = OFF_R1;
constexpr size_t SZ_W1 = SZ_UP + SZ_DN + (size_t)2560 * DM * 2 + SZ_SQ + SZ_UP + SZ_DN;
constexpr size_t OFF_W1 = WS_MIN - SZ_W1;
constexpr size_t W1_F1UP = OFF_W1, W1_F1DN = W1_F1UP + SZ_UP, W1_IN = W1_F1DN + SZ_DN, W1_OUT = W1_IN + (size_t)2560 * DM * 2,
                 W1_F2UP = W1_OUT + SZ_SQ, W1_F2DN = W1_F2UP + SZ_UP;
static_assert(R1_OB + (size_t)MROWS * 512 * 2 <= WS_MIN, "L0 mixer region");
static_assert(R1_ACTA + (size_t)MT_A * 256 * FF * 2 <= OFF_W1, "actA vs W1");
static_assert(R1_U + (size_t)MROWS * 512 * 2 <= OFF_W1, "u vs W1");
static_assert(R1_BTFS + (size_t)16 * 2048 * 512 * 2 <= OFF_W1, "btfs vs W1");
constexpr size_t SZ_OUT = (size_t)32768 * 1024 * 4;
static_assert(((size_t)96 << 20) + (size_t)66 * 262144 <= SZ_OUT && ((size_t)96 << 20) >= (size_t)(MT - MT_A) * 256 * FF * 2, "split-K scratch");
constexpr size_t R2_SPLITK = (size_t)96 << 20;
constexpr size_t R1_QK = R1_OF;
constexpr size_t R1_KVF = R1_OB;
constexpr size_t R1_KVB = R1_KVF + (size_t)1048 * 8192 * 2;
static_assert(R1_KVB + (size_t)1048 * 8192 * 2 <= R1_OB + (size_t)MROWS * 512 * 2, "kv in o_b region");
constexpr size_t R2_PRW = 0;
constexpr size_t R2_ACTB = 0;
constexpr size_t R2_WT = 0;
constexpr size_t R2_WTS = (size_t)2 * 1024 * LP * 2;
constexpr size_t R2_BTFP = R2_WTS + (size_t)4 * 1024 * LS * 2;
static_assert(R2_PRW + (size_t)MROWS * 1792 * 2 <= SZ_OUT, "r2 b");
static_assert(R2_BTFP + (size_t)16 * 1024 * 1024 * 2 <= SZ_OUT, "r2 c");
static_assert((size_t)(MT - MT_A) * 256 * FF * 2 <= SZ_OUT, "r2 d");
constexpr int TC_CTP = 0, TC_STP = 512, TC_ARCP = 1024, TC_ARSP = 1024 + 520, TC_CTS = 2080, TC_STS = 2080 + 256, TC_ARCS = 2600, TC_ARSS = 2600 + 264;

struct Params { const float* in[38]; float* out; unsigned char* ws; };

__device__ __forceinline__ bf16_t f2bf(float f) { unsigned u = __float_as_uint(f); u += 0x7FFFu + ((u >> 16) & 1u); return (bf16_t)(u >> 16); }
__device__ __forceinline__ float bf2f(bf16_t b) { return __uint_as_float(((unsigned)b) << 16); }
typedef float f32x2_t __attribute__((ext_vector_type(2)));
typedef __bf16 bf16x2_t __attribute__((ext_vector_type(2)));
__device__ __forceinline__ unsigned pack2(float a, float b) { f32x2_t v = {a, b}; bf16x2_t r = __builtin_convertvector(v, bf16x2_t); return __builtin_bit_cast(unsigned, r); }
__device__ __forceinline__ float bflo(unsigned u) { return __uint_as_float(u << 16); }
__device__ __forceinline__ float bfhi(unsigned u) { return __uint_as_float(u & 0xffff0000u); }
__device__ __forceinline__ int seq_base(int s) { return s < 2 ? s * LPP : 2 * LPP + (s - 2) * LPS; }
__device__ __forceinline__ void row_info(int row, int& seq, int& pos, int& L) {
  if (row < 2 * LPP) { seq = row >= LPP ? 1 : 0; pos = row - seq * LPP - PADR; L = LP; }
  else { const int r = row - 2 * LPP; const int s = r / LPS; seq = 2 + s; pos = r - s * LPS - PADR; L = LS; }
}
template <int CTRL> __device__ __forceinline__ float dppf(float v) { return __int_as_float(__builtin_amdgcn_update_dpp(0, __float_as_int(v), CTRL, 0xF, 0xF, true)); }
__device__ __forceinline__ float rowsum16(float v) { v += dppf<0xB1>(v); v += dppf<0x4E>(v); v += dppf<0x141>(v); v += dppf<0x140>(v); return v; }
__device__ __forceinline__ float rcpf_(float x) { return __builtin_amdgcn_rcpf(x); }
__device__ __forceinline__ float sigmoidf_(float x) { return rcpf_(1.0f + __expf(-x)); }
__device__ __forceinline__ f32x4 mfma16(bf16x8 a, bf16x8 b, f32x4 c) { return __builtin_amdgcn_mfma_f32_16x16x32_bf16(a, b, c, 0, 0, 0); }
__device__ __forceinline__ const float* inp(const unsigned char* ws, int i) {
  const unsigned long long v = ((const unsigned long long*)(ws + T_PTR))[i];
  const unsigned lo = __builtin_amdgcn_readfirstlane((unsigned)v), hi = __builtin_amdgcn_readfirstlane((unsigned)(v >> 32));
  return (const float*)(((unsigned long long)hi << 32) | (unsigned long long)lo);
}
__device__ __forceinline__ int tidx_() { int t = threadIdx.x; asm volatile("" : "+v"(t)); return t; }
__device__ __forceinline__ int bidx_() { int b = blockIdx.x; asm volatile("" : "+s"(b)); return b; }
__device__ __forceinline__ int gdim_() { int g = __builtin_amdgcn_readfirstlane((int)gridDim.x); asm volatile("" : "+s"(g)); return g; }
__device__ __forceinline__ float shx(float v, int o, int lane) { return __int_as_float(__builtin_amdgcn_ds_bpermute(((lane ^ o) & 63) << 2, __float_as_int(v))); }
__device__ __forceinline__ unsigned xcc_id_() { return (unsigned)__builtin_amdgcn_s_getreg((3 << 11) | 20) & 0xFu; }
__device__ __forceinline__ size_t tix(int row, int col, int KB) { return ((size_t)((row >> 7) * KB + (col >> 6)) << 13) + (size_t)((row & 127) * 64 + (col & 63)); }

#define XB_TMO      128
#define XB_XCNT(j)  (256  + 64 * (j))
#define XB_XSUB(j)  (1280 + 64 * (j))
#define XB_XGEN(j)  (2304 + 64 * (j))
#define XB_TOP      3328
#define XB_TOPGEN   3392
#define XCD_BAR_WORDS 3456
#define XB_SPIN_CAP (1u << 22)
__device__ __forceinline__ unsigned xb_ld(unsigned* p)              { return __hip_atomic_load(p, __ATOMIC_RELAXED, __HIP_MEMORY_SCOPE_AGENT); }
__device__ __forceinline__ unsigned xb_add(unsigned* p, unsigned v) { return __hip_atomic_fetch_add(p, v, __ATOMIC_RELAXED, __HIP_MEMORY_SCOPE_AGENT); }
#define XB_SPIN(cond, bar) do { unsigned _sp = 0; while (cond) { __builtin_amdgcn_s_sleep(1); \
    if ((++_sp & 255u) == 0u) { if (xb_ld(&(bar)[XB_TMO])) break; if (_sp > XB_SPIN_CAP) { atomicAdd(&(bar)[XB_TMO], 1u); break; } } } } while (0)
struct XcdBarrier { unsigned* bar; unsigned x; volatile LAS unsigned* st; };
__device__ __forceinline__ void xcd_barrier_complete(unsigned* bar, unsigned x, unsigned& nloc, unsigned& nx) {
    const unsigned G = gridDim.x * gridDim.y * gridDim.z;
    unsigned sum, cnt, mine, sp = 0u;
    for (;;) {
        sum = 0u; cnt = 0u; mine = 0u;
#pragma unroll
        for (unsigned j = 0; j < 16; ++j) { const unsigned c = xb_ld(&bar[XB_XCNT(j)]); sum += c; cnt += (c > 0u) ? 1u : 0u; mine = (j == x) ? c : mine; }
        if (sum == G) break;
        __builtin_amdgcn_s_sleep(1);
        if ((++sp & 255u) == 0u) { if (xb_ld(&bar[XB_TMO])) break; if (sp > XB_SPIN_CAP) { atomicAdd(&bar[XB_TMO], 1u); break; } }
    }
    nloc = mine > 0u ? mine : 1u; nx = cnt > 0u ? cnt : 1u;
}
__device__ __forceinline__ void xcd_barrier(const XcdBarrier& b) {
    asm volatile("s_waitcnt vmcnt(0)" ::: "memory");
    __syncthreads();
    if (threadIdx.x == 0) {
        unsigned* bar = b.bar;
        __builtin_amdgcn_s_waitcnt(0);
        unsigned nloc = b.st[0], nx = b.st[1];
        if (nloc == 0u) { xcd_barrier_complete(bar, b.x, nloc, nx); b.st[0] = nloc; b.st[1] = nx; }
        const unsigned old = xb_add(&bar[XB_XSUB(b.x)], 1u);
        const unsigned gen = old / nloc;
        if (old + 1u == (gen + 1u) * nloc) {
            __builtin_amdgcn_fence(__ATOMIC_RELEASE, "agent");
            asm volatile("s_waitcnt vmcnt(0)" ::: "memory");
            const unsigned og = xb_add(&bar[XB_TOP], 1u);
            const unsigned tg = og / nx;
            if (og + 1u == (tg + 1u) * nx) xb_add(&bar[XB_TOPGEN], 1u);
            else XB_SPIN(xb_ld(&bar[XB_TOPGEN]) == tg, bar);
            __builtin_amdgcn_fence(__ATOMIC_ACQUIRE, "agent");
            xb_add(&bar[XB_XGEN(b.x)], 1u);
            asm volatile("s_waitcnt vmcnt(0)" ::: "memory");
        } else {
            XB_SPIN(xb_ld(&bar[XB_XGEN(b.x)]) == gen, bar);
            __builtin_amdgcn_fence(__ATOMIC_ACQUIRE, "agent");
            asm volatile("s_waitcnt vmcnt(0)" ::: "memory");
        }
    }
    __syncthreads();
}
__device__ __forceinline__ size_t opq0_() { size_t z = 0; asm volatile("" : "+s"(z)); return z; }
constexpr int HTB = 128 * 64 * 2;
__device__ __forceinline__ int lds_byte(int r, int c) { const int st = (r >> 4) * 2 + (c >> 5), rr = r & 15, cc = c & 31, ob = rr * 64 + cc * 2; return st * 1024 + (ob ^ (((ob >> 9) & 1) << 5)); }
__device__ __forceinline__ void stage_rc(int b, int& R, int& C) { const int st = b / 1024, sb = b % 1024, swz = sb ^ (((sb >> 9) & 1) << 5); R = (st >> 1) * 16 + swz / 64; C = (st & 1) * 32 + (swz % 64) / 2; }

__device__ __forceinline__ void gemm_core(const bf16_t* A, int lda, size_t kstepA, size_t hA, const bf16_t* Bt, int ldb, size_t kstepB, size_t hB, int K, LAS unsigned char* lds, f32x4 (&acc)[2][2][4][2]) {
  const int tid = tidx_(), wid = tid >> 6, lane = tid & 63, wr = wid >> 2, wc = wid & 3, fr = lane & 15, fq = lane >> 4;
  unsigned voffA[2], voffB[2];
#pragma unroll
  for (int i = 0; i < 2; ++i) { int R, C; stage_rc(tid * 16 + i * 8192, R, C); voffA[i] = (unsigned)(R * lda + C) * 2u; voffB[i] = (unsigned)(R * ldb + C) * 2u; }
  const unsigned ldsw = (unsigned)wid * 1024u;
  const int aoff = lds_byte(wr * 64 + fr, fq * 8), boff = lds_byte(wc * 32 + fr, fq * 8);
  const char* gA = (const char*)A; const char* gB = (const char*)Bt;
#define SA_(b, h) (((b) * 2 + (h)) * HTB)
#define SB_(b, h) ((4 + (b) * 2 + (h)) * HTB)
#define STAGE_(bufoff, gbase, voff) do { _Pragma("unroll") for (int _i = 0; _i < 2; ++_i) \
    __builtin_amdgcn_global_load_lds((const unsigned*)((gbase) + (voff)[_i]), (LAS unsigned*)(lds + (bufoff) + ldsw + _i * 8192), 16, 0, 0); } while (0)
#define STA_(b, h, kt) STAGE_(SA_(b, h), gA + (size_t)(h) * hA + (size_t)(kt) * kstepA, voffA)
#define STB_(b, h, kt) STAGE_(SB_(b, h), gB + (size_t)(h) * hB + (size_t)(kt) * kstepB, voffB)
#define LDA_(dst, b, h) do { _Pragma("unroll") for (int m = 0; m < 4; ++m) _Pragma("unroll") for (int k = 0; k < 2; ++k) dst[m][k] = *(const LAS bf16x8*)(lds + SA_(b, h) + aoff + m * 2048 + k * 1024); } while (0)
#define LDB_(dst, b, h) do { _Pragma("unroll") for (int n = 0; n < 2; ++n) _Pragma("unroll") for (int k = 0; k < 2; ++k) dst[n][k] = *(const LAS bf16x8*)(lds + SB_(b, h) + boff + n * 2048 + k * 1024); } while (0)
#define MMA_(ai, bj, At, Bx) do { __builtin_amdgcn_s_setprio(1); _Pragma("unroll") for (int m = 0; m < 4; ++m) _Pragma("unroll") for (int n = 0; n < 2; ++n) _Pragma("unroll") for (int k = 0; k < 2; ++k) \
    acc[ai][bj][m][n] = __builtin_amdgcn_mfma_f32_16x16x32_bf16(Bx[n][k], At[m][k], acc[ai][bj][m][n], 0, 0, 0); __builtin_amdgcn_s_setprio(0); } while (0)
#define WAIT_V(n) asm volatile("s_waitcnt vmcnt(" #n ")" ::: "memory")
#define WAIT_L(n) asm volatile("s_waitcnt lgkmcnt(" #n ")" ::: "memory")
#define BAR_ __builtin_amdgcn_s_barrier()
#define SCHED_ __builtin_amdgcn_sched_barrier(0)
#pragma unroll
  for (int a = 0; a < 2; ++a)
#pragma unroll
    for (int b = 0; b < 2; ++b)
#pragma unroll
      for (int m = 0; m < 4; ++m)
#pragma unroll
        for (int n = 0; n < 2; ++n) acc[a][b][m][n] = (f32x4){0.f, 0.f, 0.f, 0.f};
  bf16x8 At[4][2], B0[2][2], B1[2][2];
  const int nt = K / 64;
  STB_(0, 0, 0); STA_(0, 0, 0); STB_(0, 1, 0); STA_(0, 1, 0);
  if (wr == 1) BAR_;
  WAIT_V(4); BAR_;
  STB_(1, 0, 1); STA_(1, 0, 1); STB_(1, 1, 1);
  WAIT_V(6); BAR_;
  for (int t = 0; t < nt - 2; t += 2) {
    LDB_(B0, 0, 0); SCHED_; LDA_(At, 0, 0); STA_(1, 1, t + 1);
    WAIT_L(8); BAR_; WAIT_L(0); MMA_(0, 0, At, B0); BAR_; SCHED_;
    LDB_(B1, 0, 1); STB_(0, 0, t + 2);
    BAR_; WAIT_L(0); MMA_(0, 1, At, B1); BAR_;
    LDA_(At, 0, 1); STA_(0, 0, t + 2);
    BAR_; WAIT_L(0); MMA_(1, 0, At, B0); BAR_; SCHED_;
    STB_(0, 1, t + 2);
    WAIT_V(6); BAR_; MMA_(1, 1, At, B1); BAR_;
    LDB_(B0, 1, 0); SCHED_; LDA_(At, 1, 0); STA_(0, 1, t + 2);
    WAIT_L(8); BAR_; WAIT_L(0); MMA_(0, 0, At, B0); BAR_; SCHED_;
    LDB_(B1, 1, 1); STB_(1, 0, t + 3);
    BAR_; WAIT_L(0); MMA_(0, 1, At, B1); BAR_;
    LDA_(At, 1, 1); STA_(1, 0, t + 3);
    BAR_; WAIT_L(0); MMA_(1, 0, At, B0); BAR_; SCHED_;
    STB_(1, 1, t + 3);
    WAIT_V(6); BAR_; MMA_(1, 1, At, B1); BAR_;
  }
  { LDB_(B0, 0, 0); LDA_(At, 0, 0); STA_(1, 1, nt - 1);
    BAR_; WAIT_L(0); MMA_(0, 0, At, B0); BAR_;
    LDB_(B1, 0, 1); BAR_; WAIT_L(0); MMA_(0, 1, At, B1); BAR_;
    LDA_(At, 0, 1); WAIT_V(4); BAR_; WAIT_L(0); MMA_(1, 0, At, B0); MMA_(1, 1, At, B1); BAR_; }
  { LDB_(B0, 1, 0); LDA_(At, 1, 0); WAIT_V(2); BAR_; WAIT_L(0); MMA_(0, 0, At, B0); BAR_;
    LDB_(B1, 1, 1); WAIT_V(0); BAR_; WAIT_L(0); MMA_(0, 1, At, B1); BAR_;
    LDA_(At, 1, 1); BAR_; WAIT_L(0); MMA_(1, 0, At, B0); MMA_(1, 1, At, B1); BAR_; }
  if (wr == 0) BAR_;
}

__device__ __forceinline__ void gemm_issue(const bf16_t* A, int lda, size_t kstepA, size_t hA, const bf16_t* Bt, int ldb, size_t kstepB, size_t hB, LAS unsigned char* lds) {
  const int tid = tidx_(), wid = tid >> 6;
  unsigned voffA[2], voffB[2];
#pragma unroll
  for (int i = 0; i < 2; ++i) { int R, C; stage_rc(tid * 16 + i * 8192, R, C); voffA[i] = (unsigned)(R * lda + C) * 2u; voffB[i] = (unsigned)(R * ldb + C) * 2u; }
  const unsigned ldsw = (unsigned)wid * 1024u;
  const char* gA = (const char*)A; const char* gB = (const char*)Bt;
  STB_(0, 0, 0); STA_(0, 0, 0); STB_(0, 1, 0); STA_(0, 1, 0);
  STB_(1, 0, 1); STA_(1, 0, 1); STB_(1, 1, 1);
}
__device__ __forceinline__ void gemm_main(const bf16_t* A, int lda, size_t kstepA, size_t hA, const bf16_t* Bt, int ldb, size_t kstepB, size_t hB, int K, LAS unsigned char* lds, f32x4 (&acc)[2][2][4][2]) {
  const int tid = tidx_(), wid = tid >> 6, lane = tid & 63, wr = wid >> 2, wc = wid & 3, fr = lane & 15, fq = lane >> 4;
  unsigned voffA[2], voffB[2];
#pragma unroll
  for (int i = 0; i < 2; ++i) { int R, C; stage_rc(tid * 16 + i * 8192, R, C); voffA[i] = (unsigned)(R * lda + C) * 2u; voffB[i] = (unsigned)(R * ldb + C) * 2u; }
  const unsigned ldsw = (unsigned)wid * 1024u;
  const int aoff = lds_byte(wr * 64 + fr, fq * 8), boff = lds_byte(wc * 32 + fr, fq * 8);
  const char* gA = (const char*)A; const char* gB = (const char*)Bt;
#pragma unroll
  for (int a = 0; a < 2; ++a)
#pragma unroll
    for (int b = 0; b < 2; ++b)
#pragma unroll
      for (int m = 0; m < 4; ++m)
#pragma unroll
        for (int n = 0; n < 2; ++n) acc[a][b][m][n] = (f32x4){0.f, 0.f, 0.f, 0.f};
  bf16x8 At[4][2], B0[2][2], B1[2][2];
  const int nt = K / 64;
  if (wr == 1) BAR_;
  WAIT_V(0); BAR_;
  BAR_;
  for (int t = 0; t < nt - 2; t += 2) {
    LDB_(B0, 0, 0); SCHED_; LDA_(At, 0, 0); STA_(1, 1, t + 1);
    WAIT_L(8); BAR_; WAIT_L(0); MMA_(0, 0, At, B0); BAR_; SCHED_;
    LDB_(B1, 0, 1); STB_(0, 0, t + 2);
    BAR_; WAIT_L(0); MMA_(0, 1, At, B1); BAR_;
    LDA_(At, 0, 1); STA_(0, 0, t + 2);
    BAR_; WAIT_L(0); MMA_(1, 0, At, B0); BAR_; SCHED_;
    STB_(0, 1, t + 2);
    WAIT_V(6); BAR_; MMA_(1, 1, At, B1); BAR_;
    LDB_(B0, 1, 0); SCHED_; LDA_(At, 1, 0); STA_(0, 1, t + 2);
    WAIT_L(8); BAR_; WAIT_L(0); MMA_(0, 0, At, B0); BAR_; SCHED_;
    LDB_(B1, 1, 1); STB_(1, 0, t + 3);
    BAR_; WAIT_L(0); MMA_(0, 1, At, B1); BAR_;
    LDA_(At, 1, 1); STA_(1, 0, t + 3);
    BAR_; WAIT_L(0); MMA_(1, 0, At, B0); BAR_; SCHED_;
    STB_(1, 1, t + 3);
    WAIT_V(6); BAR_; MMA_(1, 1, At, B1); BAR_;
  }
  { LDB_(B0, 0, 0); LDA_(At, 0, 0); STA_(1, 1, nt - 1);
    BAR_; WAIT_L(0); MMA_(0, 0, At, B0); BAR_;
    LDB_(B1, 0, 1); BAR_; WAIT_L(0); MMA_(0, 1, At, B1); BAR_;
    LDA_(At, 0, 1); WAIT_V(4); BAR_; WAIT_L(0); MMA_(1, 0, At, B0); MMA_(1, 1, At, B1); BAR_; }
  { LDB_(B0, 1, 0); LDA_(At, 1, 0); WAIT_V(2); BAR_; WAIT_L(0); MMA_(0, 0, At, B0); BAR_;
    LDB_(B1, 1, 1); WAIT_V(0); BAR_; WAIT_L(0); MMA_(0, 1, At, B1); BAR_;
    LDA_(At, 1, 1); BAR_; WAIT_L(0); MMA_(1, 0, At, B0); MMA_(1, 1, At, B1); BAR_; }
  if (wr == 0) BAR_;
}


__device__ __forceinline__ bool unit_for(int it, int U, int nM, int nN, int& pm, int& pn, LAS unsigned char* lds) {
  const LAS int* ctl = (const LAS int*)(lds + LDS_CTL);
  const int x = __builtin_amdgcn_readfirstlane(ctl[0]), slot = __builtin_amdgcn_readfirstlane(ctl[1]), nx = __builtin_amdgcn_readfirstlane(ctl[2]), ok = __builtin_amdgcn_readfirstlane(ctl[3]);
  int l;
  if (ok) {
    const int q = U >> 3, r = U & 7;
    const int cnt = x < r ? q + 1 : q, start = x < r ? x * (q + 1) : r * (q + 1) + (x - r) * q;
    const int li = it * nx + slot; if (li >= cnt) return false; l = start + li;
  } else { const int G = gridDim.x, b = bidx_(); l = it * G + b; if (l >= U) return false; }
  const int nig = 8 * nN, gid = l / nig, within = l % nig, fm = gid * 8, gsz = (nM - fm) < 8 ? (nM - fm) : 8;
  pm = fm + within % gsz; pn = within / gsz; return true;
}

enum { K_UP = 0, K_DN = 1, K_WINA = 2, K_WINB = 3, K_WOUT = 4, K_WIN1 = 5, K_F3 = 6, K_FOLD = 7 };

__device__ __forceinline__ float row_rstd(const float* rowsq, int row) {
  const f32x4* q = (const f32x4*)(rowsq + (size_t)row * 16);
  const f32x4 a = q[0], b = q[1], c = q[2], d = q[3];
  const float s = ((a[0] + a[1]) + (a[2] + a[3])) + ((b[0] + b[1]) + (b[2] + b[3])) + ((c[0] + c[1]) + (c[2] + c[3])) + ((d[0] + d[1]) + (d[2] + d[3]));
  return rsqrtf(s * (1.0f / 1024.0f) + 1e-6f);
}

struct F3Info { int grp, k1, mt, nt; };
__device__ __forceinline__ void gemm_epilogue(const int kind, const int pm, const int pn, const F3Info f3, f32x4 (&acc)[2][2][4][2], unsigned char* ws, unsigned char* r2, LAS unsigned char* lds, const float* partial = nullptr) {
  const LAS float* rst = (const LAS float*)(lds + LDS_RSTD);
#define ACC_(ai, bj, m, n) (partial ? acc[ai][bj][m][n] + *(const f32x4*)(partial + (size_t)(((((ai) * 2 + (bj)) * 4 + (m)) * 2 + (n)) * 512 + tid) * 4) : acc[ai][bj][m][n])
  const int f3_grp = f3.grp, f3_k1 = f3.k1, f3_mt = f3.mt, f3_nt = f3.nt;
  {
    ws += opq0_(); r2 += opq0_();
    const int tid = tidx_(), wid = tid >> 6, lane = tid & 63, wr = wid >> 2, wc = wid & 3, fr = lane & 15, fq = lane >> 4;
    bf16_t* h = (bf16_t*)(ws + OFF_H);
    float* rowsq = (float*)(ws + T_ROWSQ);
    const int brow = pm * 256 + wr * 64 + fr;
    const int ccol = wc * 32 + fq * 4;
    if (kind == K_UP) {
      bf16_t* act = pm < MT_A ? (bf16_t*)(ws + R1_ACTA) : (bf16_t*)(r2 + R2_ACTB); const int arow0 = pm < MT_A ? 0 : MT_A * 256;
#pragma unroll
      for (int ai = 0; ai < 2; ++ai)
#pragma unroll
        for (int m = 0; m < 4; ++m) { asm volatile("" ::: "memory");
          const int row = brow + ai * 128 + m * 16; const float rs = rst[row - pm * 256];
#pragma unroll
          for (int n = 0; n < 2; ++n) {
            const f32x4 g = ACC_(ai, 0, m, n) * rs, u = ACC_(ai, 1, m, n) * rs; float o[4];
#pragma unroll
            for (int j = 0; j < 4; ++j) o[j] = g[j] * sigmoidf_(g[j]) * u[j];
            u32x2 w; w.x = pack2(o[0], o[1]); w.y = pack2(o[2], o[3]);
            *(u32x2*)(act + tix(row - arow0, pn * 128 + ccol + n * 16, 44)) = w;
          }
        }
    } else if (kind == K_DN || kind == K_WOUT) {
      const float sc = kind == K_DN ? 0.5f : 1.0f;
#pragma unroll
      for (int ai = 0; ai < 2; ++ai)
#pragma unroll
        for (int m = 0; m < 4; ++m) { asm volatile("" ::: "memory");
          const int row = brow + ai * 128 + m * 16; int seq, pos, L; row_info(row, seq, pos, L);
          float ss = 0.f;
          if (pos >= 0) {
#pragma unroll
            for (int bj = 0; bj < 2; ++bj)
#pragma unroll
              for (int n = 0; n < 2; ++n) {
                bf16_t* hp = h + tix(row, pn * 256 + bj * 128 + ccol + n * 16, 16);
                const u32x2 old = *(const u32x2*)hp; const f32x4 a = ACC_(ai, bj, m, n);
                u32x2 w; w.x = pack2(bflo(old.x) + sc * a[0], bfhi(old.x) + sc * a[1]); w.y = pack2(bflo(old.y) + sc * a[2], bfhi(old.y) + sc * a[3]);
                *(u32x2*)hp = w;
                const float v0 = bflo(w.x), v1 = bfhi(w.x), v2 = bflo(w.y), v3 = bfhi(w.y);
                ss += (v0 * v0 + v1 * v1) + (v2 * v2 + v3 * v3);
              }
          }
          ss += shx(ss, 16, lane); ss += shx(ss, 32, lane);
          if (fq == 0) rowsq[(size_t)row * 16 + pn * 4 + wc] = ss;
        }
    } else if (kind == K_WINA) {
      if (pn < 2) {
        bf16_t* qk = (bf16_t*)(ws + R1_QK);
        const float* rc = (const float*)(ws + T_ROPE); const float* rsn = rc + (size_t)LP * 32;
        const float qs = pn == 0 ? 0.125f : 1.0f;
#pragma unroll
        for (int ai = 0; ai < 2; ++ai)
#pragma unroll
          for (int m = 0; m < 4; ++m) { asm volatile("" ::: "memory");
            const int row = brow + ai * 128 + m * 16; int seq, pos, L; row_info(row, seq, pos, L);
            const float rs = rst[row - pm * 256] * qs; const int pc = pos < 0 ? 0 : pos;
#pragma unroll
            for (int bj = 0; bj < 2; ++bj) {
              const int g = bj * 4 + wc, head = g >> 1, d1 = (g & 1) * 16 + fq * 4;
              const f32x4 x1 = ACC_(ai, bj, m, 0) * rs, x2 = ACC_(ai, bj, m, 1) * rs;
              const f32x4 c = *(const f32x4*)(rc + (size_t)pc * 32 + d1), s = *(const f32x4*)(rsn + (size_t)pc * 32 + d1);
              const f32x4 o1 = x1 * c - x2 * s, o2 = x1 * s + x2 * c;
              bf16_t* dst = qk + (size_t)row * 512 + pn * 256 + head * 64 + d1;
              u32x2 w; w.x = pack2(o1[0], o1[1]); w.y = pack2(o1[2], o1[3]); *(u32x2*)dst = w;
              w.x = pack2(o2[0], o2[1]); w.y = pack2(o2[2], o2[3]); *(u32x2*)(dst + 32) = w;
            }
          }
      } else if (pn >= 6) {
        bf16_t* dst = (bf16_t*)(r2 + R2_PRW);
#pragma unroll
        for (int ai = 0; ai < 2; ++ai)
#pragma unroll
          for (int m = 0; m < 4; ++m) { asm volatile("" ::: "memory");
            const int row = brow + ai * 128 + m * 16; const float rs = rst[row - pm * 256];
#pragma unroll
            for (int bj = 0; bj < 2; ++bj)
#pragma unroll
              for (int n = 0; n < 2; ++n) { const f32x4 a = ACC_(ai, bj, m, n) * rs; u32x2 w; w.x = pack2(a[0], a[1]); w.y = pack2(a[2], a[3]);
                *(u32x2*)(dst + (size_t)row * 1792 + (pn - 6) * 256 + bj * 128 + ccol + n * 16) = w; }
          }
      } else {
        bf16_t* mix = (bf16_t*)(ws + R1_MIX);
#pragma unroll
        for (int ai = 0; ai < 2; ++ai)
#pragma unroll
          for (int m = 0; m < 4; ++m) { asm volatile("" ::: "memory");
            const int row = brow + ai * 128 + m * 16; const float rs = rst[row - pm * 256];
#pragma unroll
            for (int bj = 0; bj < 2; ++bj)
#pragma unroll
              for (int n = 0; n < 2; ++n) { const f32x4 a = ACC_(ai, bj, m, n) * rs; u32x2 w; w.x = pack2(a[0], a[1]); w.y = pack2(a[2], a[3]);
                *(u32x2*)(mix + tix(row, (pn - 2) * 256 + bj * 128 + ccol + n * 16, 16)) = w; }
          }
      }
    } else if (kind == K_WINB || kind == K_FOLD) {
      bf16_t* dst = kind == K_WINB ? (bf16_t*)(r2 + R2_PRW) : (bf16_t*)(ws + W1_IN);
      const int ldd = kind == K_WINB ? 1792 : 1024;
#pragma unroll
      for (int ai = 0; ai < 2; ++ai)
#pragma unroll
        for (int m = 0; m < 4; ++m) { asm volatile("" ::: "memory");
          const int row = brow + ai * 128 + m * 16; const float rs = kind == K_WINB ? rst[row - pm * 256] : 1.0f;
#pragma unroll
          for (int bj = 0; bj < 2; ++bj)
#pragma unroll
            for (int n = 0; n < 2; ++n) { const f32x4 a = ACC_(ai, bj, m, n) * rs; u32x2 w; w.x = pack2(a[0], a[1]); w.y = pack2(a[2], a[3]);
              const int col = pn * 256 + bj * 128 + ccol + n * 16; *(u32x2*)(dst + (kind == K_WINB ? (size_t)row * ldd + col : tix(row, col, 16))) = w; }
        }
    } else if (kind == K_WIN1) {
      bf16_t* mix = (bf16_t*)(ws + R1_MIX); bf16_t* ub = (bf16_t*)(ws + R1_U);
#pragma unroll
      for (int ai = 0; ai < 2; ++ai)
#pragma unroll
        for (int m = 0; m < 4; ++m) { asm volatile("" ::: "memory");
          const int row = brow + ai * 128 + m * 16; int seq, pos, L; row_info(row, seq, pos, L);
          const float rs = rst[row - pm * 256];
          if (pn < 4) {
            if (pos >= 0) {
              bf16_t* wt = (bf16_t*)(r2 + R2_WT) + (seq < 2 ? (size_t)seq * 1024 * LP : (size_t)2 * 1024 * LP + (size_t)(seq - 2) * 1024 * LS);
#pragma unroll
              for (int bj = 0; bj < 2; ++bj)
#pragma unroll
                for (int n = 0; n < 2; ++n) { const f32x4 a = ACC_(ai, bj, m, n) * rs; const int col = pn * 256 + bj * 128 + ccol + n * 16;
#pragma unroll
                  for (int j = 0; j < 4; ++j) wt[(size_t)(col + j) * L + pos] = f2bf(a[j]); }
            }
          } else if (pn < 6) {
#pragma unroll
            for (int bj = 0; bj < 2; ++bj)
#pragma unroll
              for (int n = 0; n < 2; ++n) { const f32x4 a = ACC_(ai, bj, m, n) * rs; u32x2 w; w.x = pack2(a[0], a[1]); w.y = pack2(a[2], a[3]);
                *(u32x2*)(mix + tix(row, 512 + (pn - 4) * 256 + bj * 128 + ccol + n * 16, 16)) = w; }
          } else {
#pragma unroll
            for (int n = 0; n < 2; ++n) { const f32x4 a = (ACC_(ai, 0, m, n) * rs) * (ACC_(ai, 1, m, n) * rs); u32x2 w; w.x = pack2(a[0], a[1]); w.y = pack2(a[2], a[3]);
              *(u32x2*)(ub + (size_t)row * 512 + (pn - 6) * 128 + ccol + n * 16) = w; }
          }
        }
    } else {
      bf16_t* mix = (bf16_t*)(ws + R1_MIX);
      const float* tc = (const float*)(ws + T_TAILC);
      const float* ct = tc + (f3_grp ? TC_CTS : TC_CTP); const float* st = tc + (f3_grp ? TC_STS : TC_STP);
      const int NN = f3_grp ? 2048 : 1024;
      const float* tv = (const float*)(ws + T_TAILV) + (f3_grp ? 32768 : 0) + (size_t)f3_k1 * NN * 2;
      const float scale = f3_grp ? rsqrtf(128.0f * LS) : rsqrtf(128.0f * LP);
#pragma unroll
      for (int ai = 0; ai < 2; ++ai)
#pragma unroll
        for (int m = 0; m < 4; ++m) { asm volatile("" ::: "memory");
          const int k2 = f3_mt * 256 + wr * 64 + fr + ai * 128 + m * 16;
          const float c2 = ct[k2], s2 = st[k2]; const int pos = f3_k1 + 16 * k2;
#pragma unroll
          for (int bj = 0; bj < 2; ++bj)
#pragma unroll
            for (int n = 0; n < 2; ++n) {
              const int ni = f3_nt * 256 + bj * 128 + ccol + n * 16; const int sl = ni >> 9, c = ni & 511;
              const int row = (f3_grp ? 2 * LPP + sl * LPS : sl * LPP) + PADR + pos;
              const f32x4 t0 = *(const f32x4*)(tv + (size_t)ni * 2), t1 = *(const f32x4*)(tv + (size_t)ni * 2 + 4);
              const f32x4 a = acc[ai][bj][m][n];
              const float o0 = (a[0] + c2 * t0[0] + s2 * t0[1]) * scale, o1 = (a[1] + c2 * t0[2] + s2 * t0[3]) * scale,
                          o2 = (a[2] + c2 * t1[0] + s2 * t1[1]) * scale, o3 = (a[3] + c2 * t1[2] + s2 * t1[3]) * scale;
              u32x2 w; w.x = pack2(o0, o1); w.y = pack2(o2, o3);
              *(u32x2*)(mix + tix(row, c, 16)) = w;
            }
        }
    }
  }
}

__device__ __forceinline__ void gemm_phase(const int kind, const int idx, const Params& p, LAS unsigned char* lds, const int seqid = 0) {
  unsigned char* ws = p.ws + opq0_(); unsigned char* r2 = (unsigned char*)p.out + opq0_();
  int nM = MT, nN = 4, K = 1024;
  const bf16_t* Wt = nullptr;
  switch (kind) {
    case K_UP: nN = 22; Wt = (const bf16_t*)(ws + (idx == 0 ? W0_F1UP : idx == 1 ? W0_F2UP : idx == 2 ? W1_F1UP : W1_F2UP)); break;
    case K_DN: nN = 4; K = FF; Wt = (const bf16_t*)(ws + (idx == 0 ? W0_F1DN : idx == 1 ? W0_F2DN : idx == 2 ? W1_F1DN : W1_F2DN)); break;
    case K_WINA: nN = 13; Wt = (const bf16_t*)(ws + W0_INA); break;
    case K_WINB: nN = 7; Wt = (const bf16_t*)(ws + W0_INB); break;
    case K_WOUT: nN = 4; Wt = (const bf16_t*)(ws + (idx == 0 ? W0_OUT : W1_OUT)); break;
    case K_WIN1: nN = 10; Wt = (const bf16_t*)(ws + W1_IN); break;
    case K_F3: nM = 1; nN = 256; break;
    default: nM = 4; nN = 4; K = 512; break;
  }
  const int U = nM * nN;
  for (int it = 0;; ++it) {
    int pm, pn;
    int khalf = -1;
    const bool split = kind == K_DN;
    if (split) {
      const LAS int* ctl = (const LAS int*)(lds + LDS_CTL);
      const int x = __builtin_amdgcn_readfirstlane(ctl[0]), slot = __builtin_amdgcn_readfirstlane(ctl[1]), nx = __builtin_amdgcn_readfirstlane(ctl[2]), ok = __builtin_amdgcn_readfirstlane(ctl[3]);
      int f = -1, hu = -1;
      if (ok) { const int li = it * nx + slot;
        if (li < 16 * nN) f = 16 * nN * x + li;
        else { const int hs = (6 * nN * x) >> 3, he = (6 * nN * (x + 1)) >> 3, j = li - 16 * nN; if (j < he - hs) hu = hs + j; else break; } }
      else { const int l = it * (int)gridDim.x + bidx_(); if (l < 128 * nN) f = l; else if (l < 134 * nN) hu = l - 128 * nN; else break; }
      if (f >= 0) { const int nig = 8 * nN, gid = f / nig, within = f % nig; pm = gid * 8 + (within & 7); pn = within >> 3; }
      else { const int u = hu >> 1; khalf = hu & 1; pm = 128 + u % 3; pn = u / 3; }
    } else if (!unit_for(it, U, nM, nN, pm, pn, lds)) break;
    const bf16_t* A; const bf16_t* Bt; int lda, ldb;
    int f3_k1 = 0, f3_mt = 0, f3_nt = 0, f3_grp = 0;
    if (kind == K_F3) {
      const int u = pn;
      if (u < 128) { f3_grp = 0; f3_k1 = u >> 3; f3_mt = (u >> 2) & 1; f3_nt = u & 3;
        A = (const bf16_t*)(ws + T_ADFTP) + (size_t)f3_mt * 256 * 1024; lda = 1024; Bt = (const bf16_t*)(r2 + R2_BTFP) + ((size_t)f3_k1 * 1024 + f3_nt * 256) * 1024; ldb = 1024; K = 1024; }
      else { const int v = u - 128; f3_grp = 1; f3_k1 = v >> 3; f3_mt = 0; f3_nt = v & 7;
        A = (const bf16_t*)(ws + T_ADFTS); lda = 512; Bt = (const bf16_t*)(ws + R1_BTFS) + ((size_t)f3_k1 * 2048 + f3_nt * 256) * 512; ldb = 512; K = 512; }
    } else if (kind == K_DN) {
      A = pm < MT_A ? (const bf16_t*)(ws + R1_ACTA) + (size_t)pm * 256 * FF : (const bf16_t*)(r2 + R2_ACTB) + (size_t)(pm - MT_A) * 256 * FF; lda = FF;
      Bt = Wt + (size_t)pn * 256 * FF; ldb = FF;
      K = FF;
    } else if (kind == K_WOUT) {
      A = (const bf16_t*)(ws + R1_MIX) + (size_t)pm * 256 * 1024; lda = 1024; Bt = Wt + (size_t)pn * 256 * 1024; ldb = 1024;
    } else if (kind == K_FOLD) {
      A = (const bf16_t*)(ws + T_FT) + (size_t)pm * 256 * 512; lda = 512; Bt = (const bf16_t*)(ws + T_WTMP) + (size_t)pn * 256 * 512; ldb = 512;
    } else {
      A = (const bf16_t*)(ws + OFF_H) + (size_t)pm * 256 * 1024; lda = 1024; Bt = Wt + (size_t)pn * 256 * 1024; ldb = 1024;
    }
    const bool tA = kind == K_UP || kind == K_DN || kind == K_WINA || kind == K_WINB || kind == K_WIN1 || kind == K_WOUT;
    const bool tB = tA;
    const int KF = K;
    if (khalf >= 0) { const int hk = (K >> 7) * khalf; K >>= 1; A += tA ? (size_t)hk * 8192 : (size_t)hk * 64; Bt += (size_t)hk * 8192; }
    if (kind == K_UP || kind == K_WINA || kind == K_WINB || kind == K_WIN1) {
      const int t = tidx_(); if (t < 256) ((LAS float*)(lds + LDS_RSTD))[t] = row_rstd((const float*)(ws + T_ROWSQ), pm * 256 + t);
    }
    f32x4 acc[2][2][4][2];
    gemm_core(A, tA ? 64 : lda, tA ? (size_t)16384 : (size_t)128, tA ? (size_t)(KF >> 6) * 16384 : (size_t)128 * lda * 2,
              Bt, tB ? 64 : ldb, tB ? (size_t)16384 : (size_t)128, tB ? (size_t)(KF >> 6) * 16384 : (size_t)128 * ldb * 2, K, lds, acc);
    const float* partial = nullptr;
    if (khalf >= 0) {
      const int u = (pm - 128) + 3 * pn; const int t = tidx_();
      float* scr = (float*)(r2 + R2_SPLITK) + (size_t)u * 65536;
      unsigned* flag = (unsigned*)(ws + T_BAR + 13824) + u;
      if (khalf == 0) {
#pragma unroll
        for (int a = 0; a < 2; ++a)
#pragma unroll
          for (int b = 0; b < 2; ++b)
#pragma unroll
            for (int m = 0; m < 4; ++m)
#pragma unroll
              for (int n = 0; n < 2; ++n) *(f32x4*)(scr + (size_t)((((a * 2 + b) * 4 + m) * 2 + n) * 512 + t) * 4) = acc[a][b][m][n];
        asm volatile("s_waitcnt vmcnt(0)" ::: "memory");
        __syncthreads();
        if (t == 0) { __builtin_amdgcn_fence(__ATOMIC_RELEASE, "agent"); asm volatile("s_waitcnt vmcnt(0)" ::: "memory"); __hip_atomic_store(flag, (unsigned)seqid, __ATOMIC_RELAXED, __HIP_MEMORY_SCOPE_AGENT); }
        __syncthreads();
        continue;
      } else {
        if (t == 0) { unsigned sp = 0; while (__hip_atomic_load(flag, __ATOMIC_RELAXED, __HIP_MEMORY_SCOPE_AGENT) < (unsigned)seqid) { __builtin_amdgcn_s_sleep(2); if (++sp > (1u << 24)) break; }
          __builtin_amdgcn_fence(__ATOMIC_ACQUIRE, "agent"); asm volatile("s_waitcnt vmcnt(0)" ::: "memory"); }
        __syncthreads();
        partial = scr;
      }
    }
    { F3Info f3; f3.grp = f3_grp; f3.k1 = f3_k1; f3.mt = f3_mt; f3.nt = f3_nt; gemm_epilogue(kind, pm, pn, f3, acc, ws, r2, lds, partial); }
    WAIT_V(0);
    __syncthreads();
  }
}

struct UnitDesc { int pm, pn, khalf, K, valid; const bf16_t* A; const bf16_t* Bt; };
__device__ __forceinline__ void gemm_phase2(const int kind, const int idx, const Params& p, LAS unsigned char* lds, const int seqid = 0) {
  unsigned char* ws = p.ws + opq0_(); unsigned char* r2 = (unsigned char*)p.out + opq0_();
  int nN = 4, KF = 1024;
  const bf16_t* Wt = nullptr;
  switch (kind) {
    case K_UP: nN = 22; Wt = (const bf16_t*)(ws + (idx == 0 ? W0_F1UP : idx == 1 ? W0_F2UP : idx == 2 ? W1_F1UP : W1_F2UP)); break;
    case K_DN: nN = 4; KF = FF; Wt = (const bf16_t*)(ws + (idx == 0 ? W0_F1DN : idx == 1 ? W0_F2DN : idx == 2 ? W1_F1DN : W1_F2DN)); break;
    case K_WINA: nN = 13; Wt = (const bf16_t*)(ws + W0_INA); break;
    case K_WOUT: nN = 4; Wt = (const bf16_t*)(ws + (idx == 0 ? W0_OUT : W1_OUT)); break;
    default: nN = 10; Wt = (const bf16_t*)(ws + W1_IN); break;
  }
  const int U = MT * nN;
  const bool tA = true;
  const int ldaE = tA ? 64 : 1024; const size_t kstA = tA ? 16384 : 128, hAE = tA ? (size_t)(KF >> 6) * 16384 : (size_t)128 * 1024 * 2, hBE = (size_t)(KF >> 6) * 16384;
  auto decode = [&](int it, UnitDesc& u) {
    u.valid = 0; u.khalf = -1; u.K = KF; int pm = 0, pn = 0;
    if (kind == K_DN) {
      const LAS int* ctl = (const LAS int*)(lds + LDS_CTL);
      const int x = __builtin_amdgcn_readfirstlane(ctl[0]), slot = __builtin_amdgcn_readfirstlane(ctl[1]), nx = __builtin_amdgcn_readfirstlane(ctl[2]), ok = __builtin_amdgcn_readfirstlane(ctl[3]);
      int f = -1, hu = -1;
      if (ok) { const int li = it * nx + slot;
        if (li < 16 * nN) f = 16 * nN * x + li;
        else { const int hs = (6 * nN * x) >> 3, he = (6 * nN * (x + 1)) >> 3, j = li - 16 * nN; if (j < he - hs) hu = hs + j; else return; } }
      else { const int l = it * (int)gridDim.x + bidx_(); if (l < 128 * nN) f = l; else if (l < 134 * nN) hu = l - 128 * nN; else return; }
      if (f >= 0) { const int nig = 8 * nN, gid = f / nig, within = f % nig; pm = gid * 8 + (within & 7); pn = within >> 3; }
      else { const int uu = hu >> 1; u.khalf = hu & 1; pm = 128 + uu % 3; pn = uu / 3; }
    } else if (!unit_for(it, U, MT, nN, pm, pn, lds)) return;
    u.valid = 1; u.pm = pm; u.pn = pn;
    if (kind == K_DN) u.A = pm < MT_A ? (const bf16_t*)(ws + R1_ACTA) + (size_t)pm * 256 * FF : (const bf16_t*)(r2 + R2_ACTB) + (size_t)(pm - MT_A) * 256 * FF;
    else if (kind == K_WOUT) u.A = (const bf16_t*)(ws + R1_MIX) + (size_t)pm * 256 * 1024;
    else u.A = (const bf16_t*)(ws + OFF_H) + (size_t)pm * 256 * 1024;
    u.Bt = Wt + (size_t)pn * 256 * KF;
    if (u.khalf >= 0) { const int hk = (KF >> 7) * u.khalf; u.K = KF >> 1; u.A += tA ? (size_t)hk * 8192 : (size_t)hk * 64; u.Bt += (size_t)hk * 8192; }
  };
  const bool need_rstd = kind == K_UP || kind == K_WINA || kind == K_WIN1;
  auto stage_unit = [&](const UnitDesc& u, int par) {
    if (need_rstd) { const int t = tidx_(); if (t < 256) ((LAS float*)(lds + LDS_RSTD + par * 1024))[t] = row_rstd((const float*)(ws + T_ROWSQ), u.pm * 256 + t); }
    gemm_issue(u.A, ldaE, kstA, hAE, u.Bt, 64, 16384, hBE, lds);
  };
  UnitDesc cur, nxt;
  decode(0, cur); if (!cur.valid) return;
  stage_unit(cur, 0);
  for (int it = 0;; ++it) {
    f32x4 acc[2][2][4][2];
    gemm_main(cur.A, ldaE, kstA, hAE, cur.Bt, 64, 16384, hBE, cur.K, lds, acc);
    decode(it + 1, nxt);
    if (nxt.valid) stage_unit(nxt, (it + 1) & 1);
    const float* partial = nullptr; bool skip_epi = false;
    if (cur.khalf >= 0) {
      const int u = (cur.pm - 128) + 3 * cur.pn; const int t = tidx_();
      float* scr = (float*)(r2 + R2_SPLITK) + (size_t)u * 65536;
      unsigned* flag = (unsigned*)(ws + T_BAR + 13824) + u;
      if (cur.khalf == 0) {
#pragma unroll
        for (int a = 0; a < 2; ++a)
#pragma unroll
          for (int b = 0; b < 2; ++b)
#pragma unroll
            for (int m = 0; m < 4; ++m)
#pragma unroll
              for (int n = 0; n < 2; ++n) *(f32x4*)(scr + (size_t)((((a * 2 + b) * 4 + m) * 2 + n) * 512 + t) * 4) = acc[a][b][m][n];
        asm volatile("s_waitcnt vmcnt(0)" ::: "memory");
        __syncthreads();
        if (t == 0) { __builtin_amdgcn_fence(__ATOMIC_RELEASE, "agent"); asm volatile("s_waitcnt vmcnt(0)" ::: "memory"); __hip_atomic_store(flag, (unsigned)seqid, __ATOMIC_RELAXED, __HIP_MEMORY_SCOPE_AGENT); }
        skip_epi = true;
      } else {
        if (t == 0) { unsigned sp = 0; while (__hip_atomic_load(flag, __ATOMIC_RELAXED, __HIP_MEMORY_SCOPE_AGENT) < (unsigned)seqid) { __builtin_amdgcn_s_sleep(2); if (++sp > (1u << 24)) break; }
          __builtin_amdgcn_fence(__ATOMIC_ACQUIRE, "agent"); asm volatile("s_waitcnt vmcnt(0)" ::: "memory"); }
        __syncthreads();
        partial = scr;
      }
    }
    if (!skip_epi) { F3Info f3; f3.grp = 0; f3.k1 = 0; f3.mt = 0; f3.nt = 0; gemm_epilogue(kind, cur.pm, cur.pn, f3, acc, ws, r2, lds + (it & 1) * 1024, partial); }
    WAIT_V(0);
    __syncthreads();
    if (!nxt.valid) break;
    cur = nxt;
  }
}

__device__ __forceinline__ void gemm_phase_stream(const int kind, const int idx, const Params& p, LAS unsigned char* lds) {
  unsigned char* ws = p.ws + opq0_(); unsigned char* r2 = (unsigned char*)p.out + opq0_();
  int nM = MT, nN = 4, K = 1024, lda = 1024, ldb = 1024;
  const bf16_t* Wt = nullptr;
  switch (kind) {
    case K_UP: nN = 22; Wt = (const bf16_t*)(ws + (idx == 0 ? W0_F1UP : idx == 1 ? W0_F2UP : idx == 2 ? W1_F1UP : W1_F2UP)); break;
    case K_DN: nN = 4; K = FF; lda = FF; ldb = FF; Wt = (const bf16_t*)(ws + (idx == 0 ? W0_F1DN : idx == 1 ? W0_F2DN : idx == 2 ? W1_F1DN : W1_F2DN)); break;
    case K_WINA: nN = 13; Wt = (const bf16_t*)(ws + W0_INA); break;
    case K_WINB: nN = 7; Wt = (const bf16_t*)(ws + W0_INB); break;
    case K_WOUT: nN = 4; Wt = (const bf16_t*)(ws + (idx == 0 ? W0_OUT : W1_OUT)); break;
    default: nN = 10; Wt = (const bf16_t*)(ws + W1_IN); break;
  }
  const int U = nM * nN;
  int pm, pn;
  if (!unit_for(0, U, nM, nN, pm, pn, lds)) return;
  const int KB = K >> 6;
  const bool tiledA = kind != K_WOUT;
  auto ptrA = [&](int m) -> const char* {
    if (kind == K_DN) return (const char*)(m < MT_A ? (const bf16_t*)(ws + R1_ACTA) + (size_t)m * 256 * FF : (const bf16_t*)(r2 + R2_ACTB) + (size_t)(m - MT_A) * 256 * FF);
    if (kind == K_WOUT) return (const char*)((const bf16_t*)(ws + R1_MIX) + (size_t)m * 256 * 1024);
    return (const char*)((const bf16_t*)(ws + OFF_H) + (size_t)m * 256 * 1024); };
  auto ptrB = [&](int n) -> const char* { return (const char*)(Wt + (size_t)n * 256 * ldb); };
  const int tid = tidx_(), wid = tid >> 6, lane = tid & 63, wr = wid >> 2, wc = wid & 3, fr = lane & 15, fq = lane >> 4;
  unsigned voffA[2], voffB[2];
#pragma unroll
  for (int i = 0; i < 2; ++i) { int R, C; stage_rc(tid * 16 + i * 8192, R, C); voffA[i] = (unsigned)(R * (tiledA ? 64 : lda) + C) * 2u; voffB[i] = (unsigned)(R * 64 + C) * 2u; }
  const unsigned ldsw = (unsigned)wid * 1024u;
  const int aoff = lds_byte(wr * 64 + fr, fq * 8), boff = lds_byte(wc * 32 + fr, fq * 8);
  const size_t hA = tiledA ? (size_t)KB * 16384 : (size_t)128 * lda * 2, hB = (size_t)KB * 16384, kstepA = tiledA ? 16384 : 128, kstepB = 16384;
  const int nt = K / 64;
  const char* cA = ptrA(pm); const char* cB = ptrB(pn);
  f32x4 acc[2][2][4][2];
#pragma unroll
  for (int a = 0; a < 2; ++a)
#pragma unroll
    for (int b = 0; b < 2; ++b)
#pragma unroll
      for (int m = 0; m < 4; ++m)
#pragma unroll
        for (int n = 0; n < 2; ++n) acc[a][b][m][n] = (f32x4){0.f, 0.f, 0.f, 0.f};
  bf16x8 At[4][2], B0[2][2], B1[2][2];
  STAGE_(SB_(0, 0), cB, voffB); STAGE_(SA_(0, 0), cA, voffA); STAGE_(SB_(0, 1), cB + hB, voffB); STAGE_(SA_(0, 1), cA + hA, voffA);
  if (wr == 1) BAR_;
  WAIT_V(4); BAR_;
  STAGE_(SB_(1, 0), cB + kstepB, voffB); STAGE_(SA_(1, 0), cA + kstepA, voffA); STAGE_(SB_(1, 1), cB + hB + kstepB, voffB);
  WAIT_V(6); BAR_;
  int it = 0;
  for (;;) {
    int pm2 = 0, pn2 = 0;
    const bool has_next = unit_for(it + 1, U, nM, nN, pm2, pn2, lds);
    const char* nA = has_next ? ptrA(pm2) : cA; const char* nB = has_next ? ptrB(pn2) : cB;
    for (int t = 0; t < nt; t += 2) {
      const bool last = (t == nt - 2);
      const char* a1 = cA + (size_t)(t + 1) * kstepA;
      const char* a2 = last ? nA : cA + (size_t)(t + 2) * kstepA; const char* b2 = last ? nB : cB + (size_t)(t + 2) * kstepB;
      const char* a3 = a2 + kstepA; const char* b3 = b2 + kstepB;
      LDB_(B0, 0, 0); SCHED_; LDA_(At, 0, 0); STAGE_(SA_(1, 1), a1 + hA, voffA);
      WAIT_L(8); BAR_; WAIT_L(0); MMA_(0, 0, At, B0); BAR_; SCHED_;
      LDB_(B1, 0, 1); STAGE_(SB_(0, 0), b2, voffB);
      BAR_; WAIT_L(0); MMA_(0, 1, At, B1); BAR_;
      LDA_(At, 0, 1); STAGE_(SA_(0, 0), a2, voffA);
      BAR_; WAIT_L(0); MMA_(1, 0, At, B0); BAR_; SCHED_;
      STAGE_(SB_(0, 1), b2 + hB, voffB);
      WAIT_V(6); BAR_; MMA_(1, 1, At, B1); BAR_;
      LDB_(B0, 1, 0); SCHED_; LDA_(At, 1, 0); STAGE_(SA_(0, 1), a2 + hA, voffA);
      WAIT_L(8); BAR_; WAIT_L(0); MMA_(0, 0, At, B0); BAR_; SCHED_;
      LDB_(B1, 1, 1); STAGE_(SB_(1, 0), b3, voffB);
      BAR_; WAIT_L(0); MMA_(0, 1, At, B1); BAR_;
      LDA_(At, 1, 1); STAGE_(SA_(1, 0), a3, voffA);
      BAR_; WAIT_L(0); MMA_(1, 0, At, B0); BAR_; SCHED_;
      STAGE_(SB_(1, 1), b3 + hB, voffB);
      WAIT_V(6); BAR_; MMA_(1, 1, At, B1); BAR_;
    }
    { unsigned char* ws2 = ws + opq0_(); unsigned char* r22 = r2 + opq0_();
      F3Info f3; f3.grp = 0; f3.k1 = 0; f3.mt = 0; f3.nt = 0; gemm_epilogue(kind, pm, pn, f3, acc, ws2, r22, lds); }
    if (!has_next) break;
#pragma unroll
    for (int a = 0; a < 2; ++a)
#pragma unroll
      for (int b = 0; b < 2; ++b)
#pragma unroll
        for (int m = 0; m < 4; ++m)
#pragma unroll
          for (int n = 0; n < 2; ++n) acc[a][b][m][n] = (f32x4){0.f, 0.f, 0.f, 0.f};
    pm = pm2; pn = pn2; cA = nA; cB = nB; ++it;
  }
  WAIT_V(0);
  if (wr == 0) BAR_;
  BAR_;
  __syncthreads();
}
enum { CM_ID = 0, CM_ROPE = 1 };
struct Job { const float* src; const float* src2; const float* gain; bf16_t* dst; int ldw, K, Np, cm, off, half2; };
__device__ __forceinline__ void conv_tile(const Job& jb, int tn, int tk, LAS unsigned char* lds) {
  LAS float* tile = (LAS float*)lds;
  const int tid = tidx_();
  const int nn = tid & 63, n = tn * 64 + nn;
  const float* src = jb.src; int c;
  if (jb.half2 & 1) { const int t = n >> 8, r = n & 255; if (r >= 128) { src = jb.src2; c = (jb.half2 >> 1) + t * 128 + (r - 128); } else c = jb.off + t * 128 + r; }
  else if (jb.cm == CM_ROPE) { const int pnq = n >> 8, r = n & 255, bj = r >> 7, wc = (r >> 5) & 3, nq = (r >> 4) & 1, i = r & 15, g = bj * 4 + wc;
    c = jb.off + pnq * 256 + (g >> 1) * 64 + nq * 32 + (g & 1) * 16 + i; }
  else c = jb.off + n;
#pragma unroll
  for (int i = 0; i < 8; ++i) { const int kk = i * 8 + (tid >> 6), k = tk * 64 + kk;
    float v = src[(size_t)k * jb.ldw + c]; if (jb.gain) v *= jb.gain[k]; tile[nn * 65 + kk] = v; }
  __syncthreads();
  { const int r = tid >> 3, kc = (tid & 7) * 8; u32x4 w;
    w.x = pack2(tile[r * 65 + kc + 0], tile[r * 65 + kc + 1]); w.y = pack2(tile[r * 65 + kc + 2], tile[r * 65 + kc + 3]);
    w.z = pack2(tile[r * 65 + kc + 4], tile[r * 65 + kc + 5]); w.w = pack2(tile[r * 65 + kc + 6], tile[r * 65 + kc + 7]);
    *(u32x4*)(jb.dst + tix(tn * 64 + r, tk * 64 + kc, jb.K >> 6)) = w; }
  __syncthreads();
}
__device__ __forceinline__ Job mkjob(const float* s, const float* s2, const float* g, bf16_t* d, int ldw, int K, int Np, int cm, int off, int half2) {
  Job j; j.src = s; j.src2 = s2; j.gain = g; j.dst = d; j.ldw = ldw; j.K = K; j.Np = Np; j.cm = cm; j.off = off; j.half2 = half2; return j; }
__device__ __forceinline__ Job get_job(const Params& p, int set, int j, bool tab) {
  unsigned char* ws = p.ws + opq0_();
#define IN0(i) (tab ? inp(ws, i) : p.in[i])
  if (set == 0) {
    switch (j) {
      case 0: return mkjob(IN0(4), IN0(5), IN0(3), (bf16_t*)(ws + W0_F1UP), FF, 1024, 5632, 0, 0, 1);
      case 1: return mkjob(IN0(6), nullptr, nullptr, (bf16_t*)(ws + W0_F1DN), 1024, FF, 1024, 0, 0, 0);
      case 2: return mkjob(IN0(8), nullptr, IN0(7), (bf16_t*)(ws + W0_INA), 3328, 1024, 512, CM_ROPE, 0, 0);
      case 3: return mkjob(IN0(8), nullptr, IN0(7), (bf16_t*)(ws + W0_INA) + (size_t)512 * 1024, 3328, 1024, 1024, 0, 512, 0);
      case 4: return mkjob(IN0(8), nullptr, IN0(7), (bf16_t*)(ws + W0_INB), 3328, 1024, 1792, 0, 1536, 0);
      case 5: return mkjob(IN0(9), nullptr, nullptr, (bf16_t*)(ws + W0_OUT), 1024, 1024, 1024, 0, 0, 0);
      case 6: return mkjob(IN0(22), IN0(23), IN0(21), (bf16_t*)(ws + W0_F2UP), FF, 1024, 5632, 0, 0, 1);
      default: return mkjob(IN0(24), nullptr, nullptr, (bf16_t*)(ws + W0_F2DN), 1024, FF, 1024, 0, 0, 0);
    }
  } else {
    switch (j) {
      case 0: return mkjob(inp(ws, 26), inp(ws, 27), inp(ws, 25), (bf16_t*)(ws + W1_F1UP), FF, 1024, 5632, 0, 0, 1);
      case 1: return mkjob(inp(ws, 28), nullptr, nullptr, (bf16_t*)(ws + W1_F1DN), 1024, FF, 1024, 0, 0, 0);
      case 2: return mkjob(inp(ws, 30), nullptr, inp(ws, 29), (bf16_t*)(ws + W1_IN) + (size_t)1024 * 1024, 2048, 1024, 512, 0, 512, 0);
      case 3: return mkjob(inp(ws, 30), inp(ws, 30), inp(ws, 29), (bf16_t*)(ws + W1_IN) + (size_t)1536 * 1024, 2048, 1024, 1024, 0, 1024, 1 | (1536 << 1));
      case 4: return mkjob(inp(ws, 31), nullptr, nullptr, (bf16_t*)(ws + W1_OUT), 1024, 1024, 1024, 0, 0, 0);
      case 5: return mkjob(inp(ws, 34), inp(ws, 35), inp(ws, 33), (bf16_t*)(ws + W1_F2UP), FF, 1024, 5632, 0, 0, 1);
      case 6: return mkjob(inp(ws, 36), nullptr, nullptr, (bf16_t*)(ws + W1_F2DN), 1024, FF, 1024, 0, 0, 0);
      default: return mkjob(inp(ws, 32), nullptr, nullptr, nullptr, 0, 0, 0, 0, 0, 0);
    }
  }
}
__device__ __forceinline__ void prep_weights(const Params& p, int set, LAS unsigned char* lds) {
  const int j0 = set == 2 ? 4 : set == 3 ? 5 : 0, j1 = set == 0 ? 4 : set == 2 ? 5 : set == 3 ? 8 : 7;
  int base = 0;
  for (int j = j0; j < j1; ++j) {
    const Job jb = get_job(p, set == 1 ? 1 : 0, j, set != 0);
    const int tn = jb.Np / 64, tk = jb.K / 64, nt = tn * tk;
    const int G = gdim_();
    int t0 = (bidx_() - base % G + G) % G;
    for (int t = t0; t < nt; t += G) conv_tile(jb, t / tk, t % tk, lds);
    base += nt;
  }
}

__device__ __forceinline__ void prep_misc(const Params& p) {
  unsigned char* ws = p.ws + opq0_();
  const int tid = tidx_(), lane = tid & 63, gw = bidx_() * 8 + (tid >> 6), nw = gridDim.x * 8;
  bf16_t* h = (bf16_t*)(ws + OFF_H); float* rowsq = (float*)(ws + T_ROWSQ);
  for (int row = gw; row < MROWS; row += nw) {
    int seq, pos, L; row_info(row, seq, pos, L);
    const float* src = nullptr;
    if (pos >= 16) src = (seq < 2 ? p.in[0] + ((size_t)seq * 8192 + (pos - 16)) * 1024 : p.in[1] + ((size_t)(seq - 2) * 4096 + (pos - 16)) * 1024);
    else if (pos >= 0) src = p.in[2] + (size_t)pos * 1024;
    float ss = 0.f;
#pragma unroll
    for (int i = 0; i < 4; ++i) {
      const int c = i * 256 + lane * 4;
      f32x4 v = (f32x4){0.f, 0.f, 0.f, 0.f}; if (src) v = *(const f32x4*)(src + c);
      u32x2 w; w.x = pack2(v[0], v[1]); w.y = pack2(v[2], v[3]);
      *(u32x2*)(h + tix(row, c, 16)) = w;
      const float a = bflo(w.x), b = bfhi(w.x), cc = bflo(w.y), d = bfhi(w.y); ss += (a * a + b * b) + (cc * cc + d * d);
    }
#pragma unroll
    for (int o = 32; o >= 1; o >>= 1) ss += shx(ss, o, lane);
    if (lane < 16) rowsq[(size_t)row * 16 + lane] = lane == 0 ? ss : 0.f;
  }
  const int gt = bidx_() * 512 + tid, ngt = gridDim.x * 512;
  if (gt == 0) {
#pragma unroll
    for (int i = 0; i < 38; ++i) ((unsigned long long*)(ws + T_PTR))[i] = (unsigned long long)p.in[i];
  }
  { float* rc = (float*)(ws + T_ROPE); float* rs = rc + (size_t)LP * 32;
    for (int i = gt; i < LP * 32; i += ngt) { const int pos = i >> 5, d = i & 31; const float inv = powf(10000.0f, -(float)d / 32.0f); const float ang = (float)pos * inv; rc[i] = cosf(ang); rs[i] = sinf(ang); } }
  { bf16_t* a = (bf16_t*)(ws + T_ADFTP);
    for (int i = gt; i < 512 * 1024; i += ngt) { const int k2 = i >> 10, kk = i & 1023, n2 = kk & 511; const int mm = (k2 * n2) % 513; const float x = 2.0f * (float)mm / 513.0f; a[i] = f2bf(kk < 512 ? cospif(x) : sinpif(x)); }
    bf16_t* b = (bf16_t*)(ws + T_ADFTS);
    for (int i = gt; i < 256 * 512; i += ngt) { const int k2 = i >> 9, kk = i & 511, n2 = kk & 255; const int mm = (k2 * n2) % 257; const float x = 2.0f * (float)mm / 257.0f; b[i] = f2bf(kk < 256 ? cospif(x) : sinpif(x)); } }
  { bf16_t* f = (bf16_t*)(ws + T_FT);
    for (int i = gt; i < 1024 * 512; i += ngt) { const int np = i >> 9, kc = i & 511, part = np >> 9, g = (np >> 7) & 3, cp = np & 127, g2 = kc >> 7, c = kc & 127;
      float v = 0.f; if (g2 == g) { const float x = 2.0f * (float)((c * cp) & 127) / 128.0f; v = part == 0 ? cospif(x) : -sinpif(x); } f[i] = f2bf(v); } }
  { bf16_t* w = (bf16_t*)(ws + T_WTMP); const float* src = p.in[30]; const float* g = p.in[29];
    for (int i = gt; i < 1024 * 512; i += ngt) { const int k = i >> 9, c = i & 511; w[i] = f2bf(g[k] * src[(size_t)k * 2048 + c]); } }
  { float* tp = (float*)(ws + T_TWP); for (int i = gt; i < 16 * 513; i += ngt) { const int k1 = i / 513, n2 = i % 513; const float x = 2.0f * (float)(k1 * n2) / (float)LP; tp[2 * i] = cospif(x); tp[2 * i + 1] = sinpif(x); }
    float* ts = (float*)(ws + T_TWS); for (int i = gt; i < 16 * 257; i += ngt) { const int k1 = i / 257, n2 = i % 257; const float x = 2.0f * (float)(k1 * n2) / (float)LS; ts[2 * i] = cospif(x); ts[2 * i + 1] = sinpif(x); } }
  { float* tc = (float*)(ws + T_TAILC);
    for (int i = gt; i < 513; i += ngt) { const float x = 2.0f * (float)((i * 512) % 513) / 513.0f; const float c = cospif(x), s = sinpif(x);
      if (i < 512) { tc[TC_CTP + i] = c; tc[TC_STP + i] = s; } tc[TC_ARCP + i] = c; tc[TC_ARSP + i] = s; }
    for (int i = gt; i < 257; i += ngt) { const float x = 2.0f * (float)((i * 256) % 257) / 257.0f; const float c = cospif(x), s = sinpif(x);
      if (i < 256) { tc[TC_CTS + i] = c; tc[TC_STS + i] = s; } tc[TC_ARCS + i] = c; tc[TC_ARSS + i] = s; } }
  { bf16_t* g2t = (bf16_t*)(ws + T_G2T); const float* g2 = p.in[15]; for (int i = gt; i < 512 * 128; i += ngt) { const int c = i >> 7, r = i & 127; g2t[i] = f2bf(g2[(size_t)r * 512 + c]); } }
}
__device__ __forceinline__ void ret_unit(int uid, int& seq, int& chunk, int& head, int& cidx) {
  if (uid < 520) { seq = uid / 260; const int rem = uid % 260; chunk = rem >> 2; head = rem & 3; cidx = seq * 65 + chunk; }
  else { const int v = uid - 520; const int s = v / 132; seq = 2 + s; const int rem = v % 132; chunk = rem >> 2; head = rem & 3; cidx = 130 + s * 33 + chunk; }
}
__device__ __forceinline__ float ret_lg(int head) { return log1pf(-exp2f(-5.0f - (float)head)); }
constexpr int VT_LD = 136;

__device__ __forceinline__ void load_vT(const bf16_t* mix, int row0, int head, LAS bf16_t* vT) {
  const int tid = tidx_(), j = tid >> 2, e0 = (tid & 3) * 32;
  const u32x4* src = (const u32x4*)(mix + tix(row0 + j, head * 128 + e0, 16));
#pragma unroll
  for (int q = 0; q < 4; ++q) { const u32x4 v = src[q]; const unsigned w[4] = {v.x, v.y, v.z, v.w};
#pragma unroll
    for (int t = 0; t < 4; ++t) { vT[(e0 + q * 8 + t * 2) * VT_LD + j] = (bf16_t)(w[t] & 0xffff); vT[(e0 + q * 8 + t * 2 + 1) * VT_LD + j] = (bf16_t)(w[t] >> 16); } }
}

__device__ __forceinline__ void ret_kv_phase(const Params& p, LAS unsigned char* lds) {
  unsigned char* ws = p.ws + opq0_(); unsigned char* r2 = (unsigned char*)p.out + opq0_();
  const bf16_t* mix = (const bf16_t*)(ws + R1_MIX); const bf16_t* qk = (const bf16_t*)(ws + R1_QK);
  bf16_t* kvf = (bf16_t*)(ws + R1_KVF); bf16_t* kvb = (bf16_t*)(ws + R1_KVB);
  LAS bf16_t* vT = (LAS bf16_t*)lds; LAS bf16_t* kTf = vT + 128 * VT_LD; LAS bf16_t* kTb = kTf + 64 * VT_LD;
  const int tid = tidx_(), wid = tid >> 6, lane = tid & 63, fr = lane & 15, fq = lane >> 4;
  for (int uid = bidx_(); uid < 1048; uid += gridDim.x) {
    int seq, chunk, head, cidx; ret_unit(uid, seq, chunk, head, cidx);
    const int row0 = cidx * 128; const float lg = ret_lg(head);
    __syncthreads();
    load_vT(mix, row0, head, vT);
    { const int j = tid >> 2, d0 = (tid & 3) * 16;
      const float df = __expf(lg * (float)(127 - j)), db = __expf(lg * (float)j);
      const u32x4* src = (const u32x4*)(qk + (size_t)(row0 + j) * 512 + 256 + head * 64 + d0);
#pragma unroll
      for (int q = 0; q < 2; ++q) { const u32x4 v = src[q]; const unsigned w[4] = {v.x, v.y, v.z, v.w};
#pragma unroll
        for (int t = 0; t < 4; ++t) { const float lo = bflo(w[t]), hi = bfhi(w[t]); const int d = d0 + q * 8 + t * 2;
          kTf[d * VT_LD + j] = f2bf(lo * df); kTf[(d + 1) * VT_LD + j] = f2bf(hi * df);
          kTb[d * VT_LD + j] = f2bf(lo * db); kTb[(d + 1) * VT_LD + j] = f2bf(hi * db); } } }
    __syncthreads();
    f32x4 af[4], ab[4];
#pragma unroll
    for (int m = 0; m < 4; ++m) { af[m] = (f32x4){0.f, 0.f, 0.f, 0.f}; ab[m] = (f32x4){0.f, 0.f, 0.f, 0.f}; }
#pragma unroll
    for (int ks = 0; ks < 4; ++ks) {
      const bf16x8 y = *(const LAS bf16x8*)(vT + (wid * 16 + fr) * VT_LD + ks * 32 + fq * 8);
#pragma unroll
      for (int m = 0; m < 4; ++m) {
        const bf16x8 xf = *(const LAS bf16x8*)(kTf + (m * 16 + fr) * VT_LD + ks * 32 + fq * 8);
        const bf16x8 xb = *(const LAS bf16x8*)(kTb + (m * 16 + fr) * VT_LD + ks * 32 + fq * 8);
        af[m] = mfma16(xf, y, af[m]); ab[m] = mfma16(xb, y, ab[m]);
      }
    }
    const size_t o = ((size_t)(cidx * 4 + head) * 128 + wid * 16 + fr) * 64;
#pragma unroll
    for (int m = 0; m < 4; ++m) { u32x2 w; w.x = pack2(af[m][0], af[m][1]); w.y = pack2(af[m][2], af[m][3]); *(u32x2*)(kvf + o + m * 16 + fq * 4) = w;
      w.x = pack2(ab[m][0], ab[m][1]); w.y = pack2(ab[m][2], ab[m][3]); *(u32x2*)(kvb + o + m * 16 + fq * 4) = w; }
  }
}

__device__ __forceinline__ void ret_scan_phase(const Params& p) {
  unsigned char* ws = p.ws + opq0_();
  const int gt = bidx_() * 512 + tidx_(), ngt = gridDim.x * 512;
  for (int w = gt; w < 2 * 24 * 2048; w += ngt) {
    const int dir = w / (24 * 2048), rem = w % (24 * 2048), sh = rem >> 11, eg = rem & 2047, seq = sh >> 2, head = sh & 3;
    const int n = seq < 2 ? 65 : 33, cb = seq < 2 ? seq * 65 : 130 + (seq - 2) * 33;
    bf16_t* base = (bf16_t*)(ws + (dir ? R1_KVB : R1_KVF)) + (size_t)head * 8192 + eg * 4;
    const float gc = __expf(128.0f * ret_lg(head));
    float s0 = 0.f, s1 = 0.f, s2 = 0.f, s3 = 0.f;
    for (int i = 0; i < n; ++i) {
      const int c = dir ? n - 1 - i : i;
      u32x2* ptr = (u32x2*)(base + (size_t)(cb + c) * 4 * 8192);
      const u32x2 x = *ptr;
      u32x2 o; o.x = pack2(s0, s1); o.y = pack2(s2, s3); *ptr = o;
      s0 = gc * s0 + bflo(x.x); s1 = gc * s1 + bfhi(x.x); s2 = gc * s2 + bflo(x.y); s3 = gc * s3 + bfhi(x.y);
    }
  }
}

__device__ __forceinline__ bf16x8 scale_frag(bf16x8 v, float s) {
  bf16x8 o;
#pragma unroll
  for (int i = 0; i < 8; ++i) o[i] = (short)f2bf(bf2f((bf16_t)v[i]) * s);
  return o;
}

__device__ __forceinline__ void ret_out_phase(const Params& p, LAS unsigned char* lds) {
  unsigned char* ws = p.ws + opq0_(); unsigned char* r2 = (unsigned char*)p.out + opq0_();
  bf16_t* mix = (bf16_t*)(ws + R1_MIX); const bf16_t* qk = (const bf16_t*)(ws + R1_QK);
  const bf16_t* kvf = (const bf16_t*)(ws + R1_KVF); const bf16_t* kvb = (const bf16_t*)(ws + R1_KVB);
  LAS bf16_t* vT = (LAS bf16_t*)lds; LAS bf16_t* Pm = vT + 128 * VT_LD;
  const int tid = tidx_(), wid = tid >> 6, lane = tid & 63, fr = lane & 15, fq = lane >> 4;
  for (int uid = bidx_(); uid < 1048; uid += gridDim.x) {
    int seq, chunk, head, cidx; ret_unit(uid, seq, chunk, head, cidx);
    const int row0 = cidx * 128; const float lg = ret_lg(head);
    __syncthreads();
    load_vT(mix, row0, head, vT);
    bf16x8 qf[2];
#pragma unroll
    for (int ks = 0; ks < 2; ++ks) qf[ks] = *(const bf16x8*)(qk + (size_t)(row0 + wid * 16 + fr) * 512 + head * 64 + ks * 32 + fq * 8);
    f32x4 acc[8];
#pragma unroll
    for (int nt = 0; nt < 8; ++nt) {
      acc[nt] = (f32x4){0.f, 0.f, 0.f, 0.f};
#pragma unroll
      for (int ks = 0; ks < 2; ++ks) { const bf16x8 kf = *(const bf16x8*)(qk + (size_t)(row0 + nt * 16 + fr) * 512 + 256 + head * 64 + ks * 32 + fq * 8); acc[nt] = mfma16(qf[ks], kf, acc[nt]); }
    }
#pragma unroll
    for (int nt = 0; nt < 8; ++nt)
#pragma unroll
      for (int r = 0; r < 4; ++r) { const int i = wid * 16 + fq * 4 + r, j = nt * 16 + fr; const int dd = i > j ? i - j : j - i;
        Pm[i * VT_LD + j] = f2bf(acc[nt][r] * __expf(lg * (float)dd)); }
    __syncthreads();
    const int irow = wid * 16 + fr;
    const float g1 = __expf(lg * (float)(irow + 1)), g2 = __expf(lg * (float)(128 - irow));
    bf16x8 q1[2], q2[2];
#pragma unroll
    for (int ks = 0; ks < 2; ++ks) { q1[ks] = scale_frag(qf[ks], g1); q2[ks] = scale_frag(qf[ks], g2); }
    bf16x8 pf[4];
#pragma unroll
    for (int ks = 0; ks < 4; ++ks) pf[ks] = *(const LAS bf16x8*)(Pm + irow * VT_LD + ks * 32 + fq * 8);
    const bf16_t* sp = kvf + (size_t)(cidx * 4 + head) * 8192; const bf16_t* sn = kvb + (size_t)(cidx * 4 + head) * 8192;
    float ssq[4] = {0.f, 0.f, 0.f, 0.f};
#pragma unroll
    for (int nt = 0; nt < 8; ++nt) {
      f32x4 a = (f32x4){0.f, 0.f, 0.f, 0.f};
#pragma unroll
      for (int ks = 0; ks < 4; ++ks) { const bf16x8 y = *(const LAS bf16x8*)(vT + (nt * 16 + fr) * VT_LD + ks * 32 + fq * 8); a = mfma16(pf[ks], y, a); }
#pragma unroll
      for (int ks = 0; ks < 2; ++ks) { const bf16x8 y1 = *(const bf16x8*)(sp + (size_t)(nt * 16 + fr) * 64 + ks * 32 + fq * 8); a = mfma16(q1[ks], y1, a);
        const bf16x8 y2 = *(const bf16x8*)(sn + (size_t)(nt * 16 + fr) * 64 + ks * 32 + fq * 8); a = mfma16(q2[ks], y2, a); }
      acc[nt] = a;
#pragma unroll
      for (int r = 0; r < 4; ++r) ssq[r] += a[r] * a[r];
    }
#pragma unroll
    for (int r = 0; r < 4; ++r) { ssq[r] = rowsum16(ssq[r]); ssq[r] = rsqrtf(ssq[r] * (1.0f / 128.0f) + 1e-5f); }
    __syncthreads();
#pragma unroll
    for (int nt = 0; nt < 8; ++nt)
#pragma unroll
      for (int r = 0; r < 4; ++r) {
        const int i = wid * 16 + fq * 4 + r, e = nt * 16 + fr;
        bf16_t* dst = mix + tix(row0 + i, head * 128 + e, 16);
        const float gr = bf2f(mix[tix(row0 + i, 512 + head * 128 + e, 16)]);
        *dst = f2bf(acc[nt][r] * ssq[r] * gr * sigmoidf_(gr));
      }
  }
}
__device__ __forceinline__ float tanh_fast(float x) { x = fminf(fmaxf(x, -15.f), 15.f); const float e = __expf(2.0f * x); return (e - 1.0f) * rcpf_(e + 1.0f); }
__device__ __forceinline__ f32x4 ld_bf4(const LAS bf16_t* p) { const u32x2 v = *(const LAS u32x2*)p; return (f32x4){bflo(v.x), bfhi(v.x), bflo(v.y), bfhi(v.y)}; }

__device__ __forceinline__ void rwkv_scan_phase(const Params& p, LAS unsigned char* lds) {
  unsigned char* ws = p.ws + opq0_(); unsigned char* r2 = (unsigned char*)p.out + opq0_();
  const bf16_t* prw = (const bf16_t*)(r2 + R2_PRW);
  float* bonus = (float*)(ws + T_BONUS);
  LAS bf16_t* raw = (LAS bf16_t*)lds;
  LAS bf16_t* txw = (LAS bf16_t*)(lds + 21760);
  LAS bf16_t* xab = (LAS bf16_t*)(lds + 26368);
  LAS bf16_t* w2s = (LAS bf16_t*)(lds + 30976);
  LAS bf16_t* a2s = (LAS bf16_t*)(lds + 40192);
  LAS float* pre = (LAS float*)(lds + 49408);
  LAS float* st = (LAS float*)(lds + 65792);
  LAS float* vbuf = (LAS float*)(lds + 106752);
  LAS float* sc = (LAS float*)(lds + 114944);
  LAS float* obuf = (LAS float*)(lds + 115456);
  const int tid = tidx_(), wid = tid >> 6, lane = tid & 63, fr = lane & 15, fq = lane >> 4;
  const float* mu = inp(ws, 10);
  for (int wi = bidx_(); wi < 256; wi += gridDim.x) {
    int dir, seq, head, rbase, NRW, L, rsplit;
    if (wi < 128) { const int chain = wi >> 2; rsplit = wi & 3; dir = chain >> 4; seq = (chain & 15) >> 3; head = chain & 7; NRW = 16; rbase = rsplit * 16; L = LP; }
    else { const int v = wi - 128; const int chain = v >> 1; rsplit = v & 1; dir = chain >> 5; seq = 2 + ((chain & 31) >> 3); head = chain & 7; NRW = 32; rbase = rsplit * 32; L = LS; }
    const int sb = seq_base(seq) + PADR;
    bf16_t* od = (bf16_t*)(ws + (dir ? R1_OB : R1_OF));
    const int nblk = (L + 31) >> 5;
    __syncthreads();
    { const float* w2 = inp(ws, 12) + (size_t)dir * 64 * 512 + head * 64; const float* a2 = inp(ws, 14) + (size_t)dir * 64 * 512 + head * 64;
#pragma unroll
      for (int i = 0; i < 8; ++i) { const int e = tid + i * 512, k = e & 63, r = e >> 6; w2s[k * 72 + r] = f2bf(w2[(size_t)r * 512 + k]); a2s[k * 72 + r] = f2bf(a2[(size_t)r * 512 + k]); } }
    const int kq = tid & 15, k0 = kq * 4, ch0 = head * 64 + k0;
    const f32x4 w0c = *(const f32x4*)(inp(ws, 11) + dir * 512 + ch0), a0c = *(const f32x4*)(inp(ws, 13) + dir * 512 + ch0);
    const f32x4 kkc = *(const f32x4*)(inp(ws, 16) + ch0), kac = *(const f32x4*)(inp(ws, 17) + ch0), rkc = *(const f32x4*)(inp(ws, 18) + ch0);
    const f32x4 mur = *(const f32x4*)(mu + ch0), muk = *(const f32x4*)(mu + 512 + ch0), muv = *(const f32x4*)(mu + 1024 + ch0);
    const int cb = (tid & 15) * 8;
    const f32x4 mub0 = *(const f32x4*)(mu + 1536 + cb), mub1 = *(const f32x4*)(mu + 1536 + cb + 4);
    u32x4 pf[3];
    auto issue = [&](int b) {
      const int ta = dir == 0 ? b * 32 : L - 32 - b * 32;
#pragma unroll
      for (int i = 0; i < 3; ++i) { const int li = tid + i * 512; pf[i] = (u32x4){0u, 0u, 0u, 0u};
        if (li < 1360) { const int ri = li / 40, rem = li % 40, seg = rem >> 3, chk = rem & 7; const int t = ta - 1 + ri;
          const int col = seg < 3 ? seg * 512 + head * 64 : 1536 + (seg - 3) * 64;
          if (t >= 0 && t < L) pf[i] = *(const u32x4*)(prw + (size_t)(sb + t) * 1792 + col + chk * 8); } }
    };
    issue(0);
    const int srow = wid * 4 + fq;
    const bool sactive = wid * 4 < NRW;
    float S0 = 0.f, S1 = 0.f, S2 = 0.f, S3 = 0.f;
    for (int b = 0; b < nblk; ++b) {
      const int ta = dir == 0 ? b * 32 : L - 32 - b * 32;
      const int nst = (L - b * 32) < 32 ? (L - b * 32) : 32;
#pragma unroll
      for (int i = 0; i < 3; ++i) { const int li = tid + i * 512; if (li < 1360) { const int ri = li / 40, rem = li % 40; *(LAS u32x4*)(raw + ri * 320 + rem * 8) = pf[i]; } }
      if (b + 1 < nblk) issue(b + 1);
      __syncthreads();
      { const int tl = tid >> 4, ri = tl + 1;
        const LAS bf16_t* q0 = raw + (ri - 1) * 320 + 192 + cb; const LAS bf16_t* q1 = q0 + 320; const LAS bf16_t* q2 = q1 + 320;
        float x[8];
#pragma unroll
        for (int hh = 0; hh < 2; ++hh) { const f32x4 a = ld_bf4(q0 + hh * 4), c = ld_bf4(q1 + hh * 4), d = ld_bf4(q2 + hh * 4); const f32x4 m = hh ? mub1 : mub0;
#pragma unroll
          for (int j = 0; j < 4; ++j) x[hh * 4 + j] = c[j] + m[j] * (0.5f * (a[j] + d[j]) - c[j]); }
        u32x4 w;
        if (cb < 64) { w.x = pack2(tanh_fast(x[0]), tanh_fast(x[1])); w.y = pack2(tanh_fast(x[2]), tanh_fast(x[3])); w.z = pack2(tanh_fast(x[4]), tanh_fast(x[5])); w.w = pack2(tanh_fast(x[6]), tanh_fast(x[7]));
          *(LAS u32x4*)(txw + tl * 72 + cb) = w; }
        else { w.x = pack2(x[0], x[1]); w.y = pack2(x[2], x[3]); w.z = pack2(x[4], x[5]); w.w = pack2(x[6], x[7]); *(LAS u32x4*)(xab + tl * 72 + cb - 64) = w; } }
      __syncthreads();
      { const int mat = wid >> 2, mt = (wid >> 1) & 1, ntp = wid & 1;
        const LAS bf16_t* X = mat ? xab : txw; const LAS bf16_t* Y = mat ? a2s : w2s;
#pragma unroll
        for (int nn = 0; nn < 2; ++nn) { const int nt = ntp * 2 + nn; f32x4 a = (f32x4){0.f, 0.f, 0.f, 0.f};
#pragma unroll
          for (int ks = 0; ks < 2; ++ks) { const bf16x8 xf = *(const LAS bf16x8*)(X + (mt * 16 + fr) * 72 + ks * 32 + fq * 8); const bf16x8 yf = *(const LAS bf16x8*)(Y + (nt * 16 + fr) * 72 + ks * 32 + fq * 8); a = mfma16(xf, yf, a); }
#pragma unroll
          for (int r = 0; r < 4; ++r) pre[mat * 2048 + (mt * 16 + fq * 4 + r) * 64 + nt * 16 + fr] = a[r]; } }
      __syncthreads();
      { const int tl = tid >> 4, ri = tl + 1, t = ta + tl;
        const LAS bf16_t* q1 = raw + ri * 320 + k0;
        f32x4 xr, xk, xv;
        { const f32x4 a = ld_bf4(q1 - 320), c = ld_bf4(q1), d = ld_bf4(q1 + 320); xr = c + mur * (0.5f * (a + d) - c); }
        { const f32x4 a = ld_bf4(q1 - 320 + 64), c = ld_bf4(q1 + 64), d = ld_bf4(q1 + 320 + 64); xk = c + muk * (0.5f * (a + d) - c); }
        { const f32x4 a = ld_bf4(q1 - 320 + 128), c = ld_bf4(q1 + 128), d = ld_bf4(q1 + 320 + 128); xv = c + muv * (0.5f * (a + d) - c); }
        const f32x4 wp = *(const LAS f32x4*)(pre + tl * 64 + k0), ap = *(const LAS f32x4*)(pre + 2048 + tl * 64 + k0);
        f32x4 w, a, kk, kd, bb, wrr;
        float ss = 0.f;
#pragma unroll
        for (int j = 0; j < 4; ++j) {
          const float wl = w0c[j] + wp[j]; const float ew = 0.60653066f * rcpf_(1.0f + __expf(-wl)); w[j] = __expf(-ew);
          a[j] = rcpf_(1.0f + __expf(-(a0c[j] + ap[j])));
          kk[j] = xk[j] * kkc[j]; ss += kk[j] * kk[j];
          kd[j] = xk[j] * (1.0f + (a[j] - 1.0f) * kac[j]);
          wrr[j] = w[j] * xr[j];
        }
        ss = rowsum16(ss); const float inv = rsqrtf(fmaxf(ss, 1e-24f));
        float br = 0.f, kdr = 0.f, bon = 0.f;
#pragma unroll
        for (int j = 0; j < 4; ++j) { kk[j] *= inv; bb[j] = kk[j] * a[j]; br += bb[j] * xr[j]; kdr += kd[j] * xr[j]; bon += xr[j] * kd[j] * rkc[j]; }
        br = rowsum16(br); kdr = rowsum16(kdr); bon = rowsum16(bon);
        LAS float* s = st + tl * 320 + k0;
        *(LAS f32x4*)(s) = kk; *(LAS f32x4*)(s + 64) = wrr; *(LAS f32x4*)(s + 128) = w; *(LAS f32x4*)(s + 192) = bb; *(LAS f32x4*)(s + 256) = kd;
        *(LAS f32x4*)(vbuf + tl * 64 + k0) = xv;
        if (kq == 0) { sc[tl * 4] = br; sc[tl * 4 + 1] = kdr; if (rsplit == 0 && t >= 0 && t < L) bonus[(size_t)(sb + t) * 16 + dir * 8 + head] = bon; } }
      __syncthreads();
      if (sactive) {
        int tl = dir ? 31 : 0;
        const LAS float* sp = st + tl * 320 + fr * 4;
        f32x4 kk = *(const LAS f32x4*)(sp), wr4 = *(const LAS f32x4*)(sp + 64), w4 = *(const LAS f32x4*)(sp + 128), b4 = *(const LAS f32x4*)(sp + 192), kd4 = *(const LAS f32x4*)(sp + 256);
        float vv = vbuf[tl * 64 + rbase + srow], br = sc[tl * 4], kdr = sc[tl * 4 + 1];
        for (int s = 0; s < nst; ++s) {
          const int tln = s + 1 < nst ? (dir ? 30 - s : s + 1) : tl;
          const LAS float* spn = st + tln * 320 + fr * 4;
          const f32x4 kkn = *(const LAS f32x4*)(spn), wrn = *(const LAS f32x4*)(spn + 64), wn = *(const LAS f32x4*)(spn + 128), bn = *(const LAS f32x4*)(spn + 192), kdn = *(const LAS f32x4*)(spn + 256);
          const float vvn = vbuf[tln * 64 + rbase + srow], brn = sc[tln * 4], kdrn = sc[tln * 4 + 1];
          float skp = (S0 * kk[0] + S1 * kk[1]) + (S2 * kk[2] + S3 * kk[3]);
          float pp = (S0 * wr4[0] + S1 * wr4[1]) + (S2 * wr4[2] + S3 * wr4[3]);
          const float sk = rowsum16(skp), pt = rowsum16(pp);
          S0 = S0 * w4[0] - sk * b4[0] + vv * kd4[0]; S1 = S1 * w4[1] - sk * b4[1] + vv * kd4[1];
          S2 = S2 * w4[2] - sk * b4[2] + vv * kd4[2]; S3 = S3 * w4[3] - sk * b4[3] + vv * kd4[3];
          if (fr == 0) obuf[tl * 32 + srow] = pt - sk * br + vv * kdr;
          kk = kkn; wr4 = wrn; w4 = wn; b4 = bn; kd4 = kdn; vv = vvn; br = brn; kdr = kdrn; tl = tln;
        }
      }
      __syncthreads();
#pragma unroll
      for (int i = 0; i < 2; ++i) { const int e = tid + i * 512, tl = e >> 5, rw = e & 31, t = ta + tl;
        if (rw < NRW && t >= 0 && t < L) od[(size_t)(sb + t) * 512 + head * 64 + rbase + rw] = f2bf(obuf[tl * 32 + rw]); }
    }
  }
}

__device__ __forceinline__ float rowsum8p(float v) { v += dppf<0xB1>(v); v += dppf<0x4E>(v); v += dppf<0x141>(v); return v; }
__device__ __forceinline__ void unpack8p(const u32x4 v, float (&o)[8]) { o[0] = bflo(v.x); o[1] = bfhi(v.x); o[2] = bflo(v.y); o[3] = bfhi(v.y); o[4] = bflo(v.z); o[5] = bfhi(v.z); o[6] = bflo(v.w); o[7] = bfhi(v.w); }
__device__ __forceinline__ void rwkv_post_phase(const Params& p, LAS unsigned char* lds) {
  unsigned char* ws = p.ws + opq0_(); unsigned char* r2 = (unsigned char*)p.out + opq0_();
  const bf16_t* prw = (const bf16_t*)(r2 + R2_PRW);
  const bf16_t* of = (const bf16_t*)(ws + R1_OF); const bf16_t* ob = (const bf16_t*)(ws + R1_OB);
  const float* bonus = (const float*)(ws + T_BONUS); const bf16_t* g2t = (const bf16_t*)(ws + T_G2T);
  bf16_t* mix = (bf16_t*)(ws + R1_MIX);
  const float* mu = inp(ws, 10); const float* lnw = inp(ws, 19); const float* lnb = inp(ws, 20);
  LAS bf16_t* sg = (LAS bf16_t*)lds;
  LAS float* gbuf = (LAS float*)(lds + 34816);
  const int tid = tidx_(), wid = tid >> 6, lane = tid & 63, fr = lane & 15, fq = lane >> 4;
  const int G = gdim_();
  for (int tile = bidx_(); tile < MROWS / 128; tile += G) {
    const int row0 = tile * 128;
    __syncthreads();
    { const int tr = tid >> 2, c0 = (tid & 3) * 32, row = row0 + tr; int seq, pos, L; row_info(row, seq, pos, L);
      const bool hasp = pos > 0, hasn = pos >= 0 && pos < L - 1;
      const bf16_t* pc = prw + (size_t)row * 1792 + 1664 + c0;
#pragma unroll
      for (int q = 0; q < 4; ++q) {
        const u32x4 c = *(const u32x4*)(pc + q * 8); u32x4 a = (u32x4){0u, 0u, 0u, 0u}, d = (u32x4){0u, 0u, 0u, 0u};
        if (hasp) a = *(const u32x4*)(pc - 1792 + q * 8);
        if (hasn) d = *(const u32x4*)(pc + 1792 + q * 8);
        float cv[8], av[8], dv[8]; unpack8p(c, cv); unpack8p(a, av); unpack8p(d, dv);
        const f32x4 m0 = *(const f32x4*)(mu + 1664 + c0 + q * 8), m1 = *(const f32x4*)(mu + 1664 + c0 + q * 8 + 4);
        float x[8];
#pragma unroll
        for (int j = 0; j < 8; ++j) { const float m = j < 4 ? m0[j & 3] : m1[j & 3]; x[j] = sigmoidf_(cv[j] + m * (0.5f * (av[j] + dv[j]) - cv[j])); }
        *(LAS u32x4*)(sg + tr * VT_LD + c0 + q * 8) = (u32x4){pack2(x[0], x[1]), pack2(x[2], x[3]), pack2(x[4], x[5]), pack2(x[6], x[7])};
      } }
    __syncthreads();
    bf16x8 xf[4];
#pragma unroll
    for (int ks = 0; ks < 4; ++ks) xf[ks] = *(const LAS bf16x8*)(sg + (wid * 16 + fr) * VT_LD + ks * 32 + fq * 8);
    const int ch = tid & 7;
#pragma unroll 1
    for (int hd = 0; hd < 8; ++hd) {
      LAS float* gb = gbuf + (hd & 1) * (128 * 68);
#pragma unroll
      for (int nt = 0; nt < 4; ++nt) { f32x4 g = (f32x4){0.f, 0.f, 0.f, 0.f};
#pragma unroll
        for (int ks = 0; ks < 4; ++ks) { const bf16x8 yf = *(const bf16x8*)(g2t + (size_t)(hd * 64 + nt * 16 + fr) * 128 + ks * 32 + fq * 8); g = mfma16(xf[ks], yf, g); }
#pragma unroll
        for (int r = 0; r < 4; ++r) gb[(wid * 16 + fq * 4 + r) * 68 + nt * 16 + fr] = g[r]; }
      __syncthreads();
      const int cg = hd * 64 + ch * 8;
      const f32x4 w0 = *(const f32x4*)(lnw + cg), w1 = *(const f32x4*)(lnw + cg + 4), b0 = *(const f32x4*)(lnb + cg), b1 = *(const f32x4*)(lnb + cg + 4);
      const f32x4 mv0 = *(const f32x4*)(mu + 1024 + cg), mv1 = *(const f32x4*)(mu + 1024 + cg + 4);
#pragma unroll
      for (int i = 0; i < 2; ++i) {
        const int tk = (tid >> 3) + i * 64, row = row0 + tk; int seq, pos, L; row_info(row, seq, pos, L);
        u32x4 res = (u32x4){0u, 0u, 0u, 0u};
        if (pos >= 0) {
          float o1[8], o2[8], o[8];
          unpack8p(*(const u32x4*)(of + (size_t)row * 512 + cg), o1); unpack8p(*(const u32x4*)(ob + (size_t)row * 512 + cg), o2);
          float sum = 0.f;
#pragma unroll
          for (int j = 0; j < 8; ++j) { o[j] = o1[j] + o2[j]; sum += o[j]; }
          sum = rowsum8p(sum); const float mean = sum * (1.0f / 64.0f);
          float vs = 0.f;
#pragma unroll
          for (int j = 0; j < 8; ++j) { const float d = o[j] - mean; vs += d * d; }
          vs = rowsum8p(vs); const float rstd = rsqrtf(vs * (1.0f / 64.0f) + 64e-5f);
          const float bsc = 0.5f * (bonus[(size_t)row * 16 + hd] + bonus[(size_t)row * 16 + 8 + hd]);
          const bf16_t* pv = prw + (size_t)row * 1792 + 1024 + cg;
          float vc[8], va[8], vd[8];
          unpack8p(*(const u32x4*)pv, vc);
          u32x4 ua = (u32x4){0u, 0u, 0u, 0u}, ud = (u32x4){0u, 0u, 0u, 0u};
          if (pos > 0) ua = *(const u32x4*)(pv - 1792);
          if (pos < L - 1) ud = *(const u32x4*)(pv + 1792);
          unpack8p(ua, va); unpack8p(ud, vd);
          const f32x4 g0 = *(const LAS f32x4*)(gb + tk * 68 + ch * 8), g1 = *(const LAS f32x4*)(gb + tk * 68 + ch * 8 + 4);
          float y[8];
#pragma unroll
          for (int j = 0; j < 8; ++j) { const float lw = j < 4 ? w0[j & 3] : w1[j & 3], lb = j < 4 ? b0[j & 3] : b1[j & 3], mm = j < 4 ? mv0[j & 3] : mv1[j & 3], gg = j < 4 ? g0[j & 3] : g1[j & 3];
            const float xv = vc[j] + mm * (0.5f * (va[j] + vd[j]) - vc[j]);
            y[j] = ((o[j] - mean) * rstd * lw + lb + bsc * xv) * gg; }
          res = (u32x4){pack2(y[0], y[1]), pack2(y[2], y[3]), pack2(y[4], y[5]), pack2(y[6], y[7])};
        }
        *(u32x4*)(mix + tix(row, 512 + cg, 16)) = res;
      }
    }
  }
}
__device__ __forceinline__ f32x4 g_bf4(const bf16_t* p) { const u32x2 v = *(const u32x2*)p; return (f32x4){bflo(v.x), bfhi(v.x), bflo(v.y), bfhi(v.y)}; }
__device__ __forceinline__ void unpack8(const u32x4 v, float (&o)[8]) { o[0] = bflo(v.x); o[1] = bfhi(v.x); o[2] = bflo(v.y); o[3] = bfhi(v.y); o[4] = bflo(v.z); o[5] = bfhi(v.z); o[6] = bflo(v.w); o[7] = bfhi(v.w); }
__device__ __forceinline__ float rowsum8(float v) { v += dppf<0xB1>(v); v += dppf<0x4E>(v); v += dppf<0x141>(v); return v; }

constexpr size_t R2_XWA = (size_t)MROWS * 1792 * 2;
static_assert(R2_XWA + (size_t)MROWS * 128 * 2 <= SZ_OUT, "xwa");
__device__ __forceinline__ void xwa_phase(const Params& p) {
  unsigned char* ws = p.ws + opq0_(); unsigned char* r2 = (unsigned char*)p.out + opq0_();
  const bf16_t* prw = (const bf16_t*)(r2 + R2_PRW); bf16_t* xwa = (bf16_t*)(r2 + R2_XWA);
  const float* mu = inp(ws, 10);
  const int gt = bidx_() * 512 + tidx_(), ngt = gdim_() * 512;
  for (int it = gt; it < MROWS * 16; it += ngt) {
    const int row = it >> 4, cb = (it & 15) * 8; int seq, pos, L; row_info(row, seq, pos, L);
    u32x4 o = (u32x4){0u, 0u, 0u, 0u};
    if (pos >= 0) {
      const bf16_t* pc = prw + (size_t)row * 1792 + 1536 + cb;
      u32x4 ua = (u32x4){0u, 0u, 0u, 0u}, ud = (u32x4){0u, 0u, 0u, 0u}; const u32x4 uc = *(const u32x4*)pc;
      if (pos > 0) ua = *(const u32x4*)(pc - 1792);
      if (pos < L - 1) ud = *(const u32x4*)(pc + 1792);
      float a[8], c[8], d[8], x[8]; unpack8(ua, a); unpack8(uc, c); unpack8(ud, d);
      const f32x4 m0 = *(const f32x4*)(mu + 1536 + cb), m1 = *(const f32x4*)(mu + 1536 + cb + 4);
#pragma unroll
      for (int j = 0; j < 8; ++j) { const float m = j < 4 ? m0[j & 3] : m1[j & 3]; x[j] = c[j] + m * (0.5f * (a[j] + d[j]) - c[j]); if (cb < 64) x[j] = tanh_fast(x[j]); }
      o = (u32x4){pack2(x[0], x[1]), pack2(x[2], x[3]), pack2(x[4], x[5]), pack2(x[6], x[7])};
    }
    *(u32x4*)(xwa + (size_t)row * 128 + cb) = o;
  }
}

static_assert(LP % 32 == 16 && LS % 32 == 16, "scan half-blocks assume 16-step halves");
__device__ __forceinline__ void rwkv_scan2_phase(const Params& p, LAS unsigned char* lds) {
  unsigned char* ws = p.ws + opq0_(); unsigned char* r2 = (unsigned char*)p.out + opq0_();
  const bf16_t* prw = (const bf16_t*)(r2 + R2_PRW);
  float* bonus = (float*)(ws + T_BONUS);
  LAS bf16_t* txw = (LAS bf16_t*)(lds + 0);
  LAS bf16_t* xab = (LAS bf16_t*)(lds + 4608);
  LAS bf16_t* w2s = (LAS bf16_t*)(lds + 9216);
  LAS bf16_t* a2s = (LAS bf16_t*)(lds + 18432);
  LAS float* pre = (LAS float*)(lds + 27648);
  LAS float* cst = (LAS float*)(lds + 44032);
  LAS float* stb = (LAS float*)(lds + 46080);
  LAS float* vbb = (LAS float*)(lds + 128000);
  LAS float* scb = (LAS float*)(lds + 132096);
  LAS float* ppb = (LAS float*)(lds + 133120);
  LAS float* skb = (LAS float*)(lds + 141312);
  const int tid = tidx_(), wid = tid >> 6, lane = tid & 63, fr = lane & 15, fq = lane >> 4;
  const float* mu = inp(ws, 10);
  const bool producer = wid >= 4;
  const int pw = wid - 4, ptid = tid - 256;
  const int G = gdim_();
  for (int slot = bidx_(); slot < 256; slot += G) {
    const int nitems = slot < 128 ? 1 : 2;
    for (int itx = 0; itx < nitems; ++itx) {
      int dir, seq, head, rsplit, L;
      if (slot < 128) { const int chain = slot >> 2; rsplit = slot & 3; dir = chain >> 4; seq = (chain & 15) >> 3; head = chain & 7; L = LP; }
      else { const int v = (slot - 128) * 2 + itx; const int chain = v >> 2; rsplit = v & 3; dir = chain >> 5; seq = 2 + ((chain & 31) >> 3); head = chain & 7; L = LS; }
      const int rbase = rsplit * 16;
      const int sb = seq_base(seq) + PADR;
      bf16_t* od = (bf16_t*)(ws + (dir ? R1_OB : R1_OF));
      const int nblk = (L + 31) >> 5;
      __syncthreads();
      { const float* w2 = inp(ws, 12) + (size_t)dir * 64 * 512 + head * 64; const float* a2 = inp(ws, 14) + (size_t)dir * 64 * 512 + head * 64;
#pragma unroll
        for (int i = 0; i < 8; ++i) { const int e = tid + i * 512, k = e & 63, r = e >> 6; w2s[k * 72 + r] = f2bf(w2[(size_t)r * 512 + k]); a2s[k * 72 + r] = f2bf(a2[(size_t)r * 512 + k]); }
        { const int v = tid >> 6, k = tid & 63, c = head * 64 + k; float x;
          switch (v) { case 0: x = inp(ws, 11)[dir * 512 + c]; break; case 1: x = inp(ws, 13)[dir * 512 + c]; break; case 2: x = inp(ws, 16)[c]; break; case 3: x = inp(ws, 17)[c]; break;
                       case 4: x = inp(ws, 18)[c]; break; case 5: x = mu[c]; break; case 6: x = mu[512 + c]; break; default: x = mu[1024 + c]; break; }
          cst[v * 64 + k] = x; } }
      __syncthreads();
      u32x4 pb[2], pd[3][3];
      const bf16_t* xwa = (const bf16_t*)(r2 + R2_XWA);
      const int cbB = (ptid & 15) * 8;
      const int dt = pw * 8 + (lane >> 3), dk0 = (lane & 7) * 8;
      auto issue_b = [&](int b) {
        const int ta = dir == 0 ? b * 32 : L - 32 - b * 32;
#pragma unroll
        for (int q = 0; q < 2; ++q) { const int t = ta + (ptid >> 4) + q * 16; pb[q] = (u32x4){0u, 0u, 0u, 0u};
          if (t >= 0 && t < L) pb[q] = *(const u32x4*)(xwa + (size_t)(sb + t) * 128 + cbB); }
      };
      auto issue_d = [&](int b) {
        const int ta = dir == 0 ? b * 32 : L - 32 - b * 32;
#pragma unroll
        for (int sg = 0; sg < 3; ++sg)
#pragma unroll
          for (int rr = 0; rr < 3; ++rr) { const int t = ta + dt - 1 + rr; pd[sg][rr] = (u32x4){0u, 0u, 0u, 0u};
            if (t >= 0 && t < L) pd[sg][rr] = *(const u32x4*)(prw + (size_t)(sb + t) * 1792 + sg * 512 + head * 64 + dk0); }
      };
      float xk[8] = {0.f, 0.f, 0.f, 0.f, 0.f, 0.f, 0.f, 0.f}; float inv = 0.f, br = 0.f, kdr = 0.f, bon = 0.f;
      if (producer) { issue_b(0); issue_d(0);
#pragma unroll
        for (int q = 0; q < 2; ++q) { const int tlb = (ptid >> 4) + q * 16;
          if (cbB < 64) *(LAS u32x4*)(txw + tlb * 72 + cbB) = pb[q]; else *(LAS u32x4*)(xab + tlb * 72 + cbB - 64) = pb[q]; }
        if (1 < nblk) issue_b(1); }
      __syncthreads();
      const int srow = wid * 4 + fq;
      f32x2_t S01 = {0.f, 0.f}, S23 = {0.f, 0.f};
      for (int b = -1; b <= nblk; ++b) {
        const int cur = b & 1, nxt = cur ^ 1;
        const int nst = (b >= 0 && b < nblk) ? ((L - b * 32) < 32 ? (L - b * 32) : 32) : 0;
        LAS float* st = stb + cur * 10240; LAS float* vb = vbb + cur * 512;
        for (int half = 0; half < 2; ++half) {
          if (producer) {
            const int fb = half ? b : b - 1, ph = half ^ 1;
            if (fb >= 0 && fb < nblk) {
              const int nstp = (L - fb * 32) < 32 ? (L - fb * 32) : 32; const int sl = ptid >> 4, rw = ptid & 15, sidx = ph * 16 + sl;
              if (sidx < nstp) {
                const int tl = dir ? 31 - sidx : sidx; const int t = (dir == 0 ? fb * 32 : L - 32 - fb * 32) + tl; const int bi = fb & 1;
                const f32x4 q = *(const LAS f32x4*)(ppb + ph * 1024 + (sl * 16 + rw) * 4); const float sk = skb[ph * 256 + sl * 16 + rw];
                const float o = ((q[0] + q[1]) + (q[2] + q[3])) - sk * scb[bi * 128 + tl * 4] + vbb[bi * 512 + tl * 16 + rw] * scb[bi * 128 + tl * 4 + 1];
                od[(size_t)(sb + t) * 512 + head * 64 + rbase + rw] = f2bf(o);
              }
            }
          }
          if (!producer) {
            const int s0 = half * 16, s1 = nst < s0 + 16 ? nst : s0 + 16;
            if (s0 < s1) {
              LAS float* ppw = ppb + half * 1024 + srow * 4 + (fr >> 2); LAS float* skw = skb + half * 256 + srow;
              f32x4 kkA, wrA, wA, bA, kdA, kkB, wrB, wB, bB, kdB; float vvA, vvB;
#define LOADR(X, s_) do { const int tl_ = dir ? 31 - (s_) : (s_); const LAS float* sp_ = st + tl_ * 320 + fr * 4; kk##X = *(const LAS f32x4*)(sp_); wr##X = *(const LAS f32x4*)(sp_ + 64); w##X = *(const LAS f32x4*)(sp_ + 128); \
                          b##X = *(const LAS f32x4*)(sp_ + 192); kd##X = *(const LAS f32x4*)(sp_ + 256); vv##X = vb[tl_ * 16 + srow]; } while (0)
#define STEPR(X, s_) do { const f32x2_t ts_ = __builtin_elementwise_fma(S23, kk##X.hi, S01 * kk##X.lo); const f32x2_t tp_ = __builtin_elementwise_fma(S23, wr##X.hi, S01 * wr##X.lo); \
                          const float sk_ = rowsum16(ts_.x + ts_.y); float pp_ = tp_.x + tp_.y; pp_ += dppf<0xB1>(pp_); pp_ += dppf<0x4E>(pp_); \
                          const f32x2_t nsk_ = {-sk_, -sk_}, vv2_ = {vv##X, vv##X}; \
                          S01 = __builtin_elementwise_fma(vv2_, kd##X.lo, __builtin_elementwise_fma(nsk_, b##X.lo, S01 * w##X.lo)); \
                          S23 = __builtin_elementwise_fma(vv2_, kd##X.hi, __builtin_elementwise_fma(nsk_, b##X.hi, S23 * w##X.hi)); \
                          ppw[((s_) - s0) * 64] = pp_; skw[((s_) - s0) * 16] = sk_; } while (0)
              LOADR(A, s0);
              for (int i = 0; i < 8; ++i) {
                const int s = s0 + 2 * i;
                LOADR(B, s + 1);
                STEPR(A, s);
                LOADR(A, i < 7 ? s + 2 : s + 1);
                STEPR(B, s + 1);
              }
#undef LOADR
#undef STEPR
            }
          } else {
            const int bn = b + 1; const int ta = dir == 0 ? bn * 32 : L - 32 - bn * 32;
            LAS float* prew = pre + pw * 1024;
            const int tloc = lane >> 3, tl = pw * 8 + tloc, t = ta + tl;
            LAS float* s = stb + nxt * 10240 + tl * 320 + dk0;
#define DGROUP(hh) do { f32x4 xr4; \
                { const u32x4 ua = pd[0][0], uc = pd[0][1], ud = pd[0][2]; \
                  const unsigned a0 = (hh) ? ua.z : ua.x, a1 = (hh) ? ua.w : ua.y, c0 = (hh) ? uc.z : uc.x, c1 = (hh) ? uc.w : uc.y, d0 = (hh) ? ud.z : ud.x, d1 = (hh) ? ud.w : ud.y; \
                  const float av[4] = {bflo(a0), bfhi(a0), bflo(a1), bfhi(a1)}, cv[4] = {bflo(c0), bfhi(c0), bflo(c1), bfhi(c1)}, dv[4] = {bflo(d0), bfhi(d0), bflo(d1), bfhi(d1)}; \
                  _Pragma("unroll") for (int j = 0; j < 4; ++j) xr4[j] = cv[j] + cst[5 * 64 + dk0 + (hh) * 4 + j] * (0.5f * (av[j] + dv[j]) - cv[j]); } \
                f32x4 w4, kk4, kd4, bb4, wr4; \
                _Pragma("unroll") for (int j = 0; j < 4; ++j) { const int kx = dk0 + (hh) * 4 + j; const float xkj = xk[(hh) * 4 + j]; \
                  const float wl = cst[0 * 64 + kx] + prew[tloc * 64 + kx]; const float ew = 0.60653066f * rcpf_(1.0f + __expf(-wl)); w4[j] = __expf(-ew); \
                  const float aj = rcpf_(1.0f + __expf(-(cst[1 * 64 + kx] + prew[512 + tloc * 64 + kx]))); \
                  kk4[j] = xkj * cst[2 * 64 + kx] * inv; kd4[j] = xkj * (1.0f + (aj - 1.0f) * cst[3 * 64 + kx]); bb4[j] = kk4[j] * aj; wr4[j] = w4[j] * xr4[j]; \
                  br += bb4[j] * xr4[j]; kdr += kd4[j] * xr4[j]; bon += xr4[j] * kd4[j] * cst[4 * 64 + kx]; } \
                *(LAS f32x4*)(s + (hh) * 4) = kk4; *(LAS f32x4*)(s + 64 + (hh) * 4) = wr4; *(LAS f32x4*)(s + 128 + (hh) * 4) = w4; *(LAS f32x4*)(s + 192 + (hh) * 4) = bb4; *(LAS f32x4*)(s + 256 + (hh) * 4) = kd4; } while (0)
            if (half == 0) {
              if (bn < nblk) {
#pragma unroll
                for (int mat = 0; mat < 2; ++mat) { const LAS bf16_t* X = mat ? xab : txw; const LAS bf16_t* Y = mat ? a2s : w2s;
                  const int xr = pw * 8 + (fr & 7);
                  bf16x8 xf[2];
#pragma unroll
                  for (int ks = 0; ks < 2; ++ks) xf[ks] = *(const LAS bf16x8*)(X + xr * 72 + ks * 32 + fq * 8);
#pragma unroll
                  for (int nt = 0; nt < 4; ++nt) { f32x4 a = (f32x4){0.f, 0.f, 0.f, 0.f};
#pragma unroll
                    for (int ks = 0; ks < 2; ++ks) { const bf16x8 yf = *(const LAS bf16x8*)(Y + (nt * 16 + fr) * 72 + ks * 32 + fq * 8); a = mfma16(xf[ks], yf, a); }
                    if (fq < 2) {
#pragma unroll
                      for (int r = 0; r < 4; ++r) prew[mat * 512 + (fq * 4 + r) * 64 + nt * 16 + fr] = a[r]; } } }
                { float a[8], c[8], d[8]; unpack8(pd[1][0], a); unpack8(pd[1][1], c); unpack8(pd[1][2], d);
#pragma unroll
                  for (int j = 0; j < 8; ++j) xk[j] = c[j] + cst[6 * 64 + dk0 + j] * (0.5f * (a[j] + d[j]) - c[j]); }
                float ss = 0.f;
#pragma unroll
                for (int j = 0; j < 8; ++j) { const float q = xk[j] * cst[2 * 64 + dk0 + j]; ss += q * q; }
                ss = rowsum8(ss); inv = rsqrtf(fmaxf(ss, 1e-24f));
                br = 0.f; kdr = 0.f; bon = 0.f;
                DGROUP(0);
              }
            } else {
              if (bn < nblk) {
                DGROUP(1);
                br = rowsum8(br); kdr = rowsum8(kdr); bon = rowsum8(bon);
                float xv[8];
                { float a[8], c[8], d[8]; unpack8(pd[2][0], a); unpack8(pd[2][1], c); unpack8(pd[2][2], d);
#pragma unroll
                  for (int j = 0; j < 8; ++j) xv[j] = c[j] + cst[7 * 64 + dk0 + j] * (0.5f * (a[j] + d[j]) - c[j]); }
                if (dk0 >= rbase && dk0 < rbase + 16) {
                  LAS float* vd = vbb + nxt * 512 + tl * 16 + (dk0 - rbase);
                  *(LAS f32x4*)(vd) = (f32x4){xv[0], xv[1], xv[2], xv[3]}; *(LAS f32x4*)(vd + 4) = (f32x4){xv[4], xv[5], xv[6], xv[7]};
                }
                if ((lane & 7) == 0) { LAS float* scn = scb + nxt * 128; scn[tl * 4] = br; scn[tl * 4 + 1] = kdr; if (rsplit == 0 && t >= 0 && t < L) bonus[(size_t)(sb + t) * 16 + dir * 8 + head] = bon; }
                if (b + 2 < nblk) issue_d(b + 2);
              }
              if (b + 2 < nblk) {
#pragma unroll
                for (int q = 0; q < 2; ++q) { const int tlb = (ptid >> 4) + q * 16;
                  if (cbB < 64) *(LAS u32x4*)(txw + tlb * 72 + cbB) = pb[q]; else *(LAS u32x4*)(xab + tlb * 72 + cbB - 64) = pb[q]; }
                if (b + 3 < nblk) issue_b(b + 3);
              }
            }
#undef DGROUP
          }
          __syncthreads();
        }
      }
    }
  }
}
__device__ __forceinline__ void conv_phase(const Params& p) {
  unsigned char* ws = p.ws + opq0_();
  bf16_t* mix = (bf16_t*)(ws + R1_MIX); const bf16_t* ub = (const bf16_t*)(ws + R1_U); const float* cw = inp(ws, 32);
  const int gt = bidx_() * 512 + tidx_(), ngt = gridDim.x * 512;
  for (int it = gt; it < MROWS * 64; it += ngt) {
    const int row = it >> 6, c0 = (it & 63) * 8; int seq, pos, L; row_info(row, seq, pos, L);
    u32x4 o = (u32x4){0u, 0u, 0u, 0u};
    bf16_t* dst = mix + tix(row, 512 + c0, 16);
    if (pos >= 0) {
      const bf16_t* up = ub + (size_t)row * 512 + c0;
      const u32x4 pb = *(const u32x4*)dst, c = *(const u32x4*)up; u32x4 a = (u32x4){0u, 0u, 0u, 0u}, d = (u32x4){0u, 0u, 0u, 0u};
      if (pos > 0) a = *(const u32x4*)(up - 512);
      if (pos < L - 1) d = *(const u32x4*)(up + 512);
      const unsigned pw[4] = {pb.x, pb.y, pb.z, pb.w}, cw4[4] = {c.x, c.y, c.z, c.w}, aw[4] = {a.x, a.y, a.z, a.w}, dw[4] = {d.x, d.y, d.z, d.w}; unsigned ow[4];
#pragma unroll
      for (int t = 0; t < 4; ++t) { const int cc = c0 + t * 2;
        const float y0 = cw[cc] * bflo(aw[t]) + cw[512 + cc] * bflo(cw4[t]) + cw[1024 + cc] * bflo(dw[t]);
        const float y1 = cw[cc + 1] * bfhi(aw[t]) + cw[512 + cc + 1] * bfhi(cw4[t]) + cw[1024 + cc + 1] * bfhi(dw[t]);
        ow[t] = pack2(bflo(pw[t]) * y0, bfhi(pw[t]) * y1); }
      o = (u32x4){ow[0], ow[1], ow[2], ow[3]};
    }
    *(u32x4*)dst = o;
  }
}

__constant__ float C16[16] = {1.f, 0.92387953f, 0.70710678f, 0.38268343f, 0.f, -0.38268343f, -0.70710678f, -0.92387953f, -1.f, -0.92387953f, -0.70710678f, -0.38268343f, 0.f, 0.38268343f, 0.70710678f, 0.92387953f};
__constant__ float S16[16] = {0.f, 0.38268343f, 0.70710678f, 0.92387953f, 1.f, 0.92387953f, 0.70710678f, 0.38268343f, 0.f, -0.38268343f, -0.70710678f, -0.92387953f, -1.f, -0.92387953f, -0.70710678f, -0.38268343f};
__device__ __forceinline__ void f2_phase(const Params& p) {
  unsigned char* ws = p.ws + opq0_(); unsigned char* r2 = (unsigned char*)p.out + opq0_();
  const int gt = bidx_() * 512 + tidx_(), ngt = gridDim.x * 512;
  constexpr int NPI = 2 * 512 * 513, NSI = 4 * 512 * 257;
  for (int it = gt; it < NPI + NSI; it += ngt) {
    int grp, n2, c, sl, N2, L, NN;
    if (it < NPI) { grp = 0; N2 = 513; L = LP; NN = 1024; n2 = it % 513; const int q = it / 513; c = q & 511; sl = q >> 9; }
    else { const int v = it - NPI; grp = 1; N2 = 257; L = LS; NN = 2048; n2 = v % 257; const int q = v / 257; c = q & 511; sl = q >> 9; }
    const bf16_t* wt = (const bf16_t*)(r2 + (grp ? R2_WTS : R2_WT)) + (size_t)sl * 1024 * L;
    const bf16_t* pr = wt + (size_t)c * L + n2; const bf16_t* pi = wt + (size_t)(512 + c) * L + n2;
    float re[16], im[16];
#pragma unroll
    for (int n1 = 0; n1 < 16; ++n1) { re[n1] = bf2f(pr[n1 * N2]); im[n1] = bf2f(pi[n1 * N2]); }
    const float* tw = (const float*)(ws + (grp ? T_TWS : T_TWP));
    const int ni = sl * 512 + c; const int Kd = 2 * (N2 - 1);
    bf16_t* btf = grp ? (bf16_t*)(ws + R1_BTFS) : (bf16_t*)(r2 + R2_BTFP);
    float* tv = (float*)(ws + T_TAILV) + (grp ? 32768 : 0);
    float Ar[4][4], Ai[4][4];
#pragma unroll
    for (int b = 0; b < 4; ++b) {
      const float x0r = re[b], x0i = im[b], x1r = re[4 + b], x1i = im[4 + b], x2r = re[8 + b], x2i = im[8 + b], x3r = re[12 + b], x3i = im[12 + b];
      const float s02r = x0r + x2r, s02i = x0i + x2i, d02r = x0r - x2r, d02i = x0i - x2i, s13r = x1r + x3r, s13i = x1i + x3i, d13r = x1r - x3r, d13i = x1i - x3i;
      Ar[0][b] = s02r + s13r; Ai[0][b] = s02i + s13i;
      Ar[2][b] = s02r - s13r; Ai[2][b] = s02i - s13i;
      Ar[1][b] = d02r + d13i; Ai[1][b] = d02i - d13r;
      Ar[3][b] = d02r - d13i; Ai[3][b] = d02i + d13r;
    }
#pragma unroll
    for (int c = 1; c < 4; ++c)
#pragma unroll
      for (int b = 1; b < 4; ++b) { const float cc = C16[(c * b) & 15], ss = S16[(c * b) & 15]; const float xr = Ar[c][b], xi = Ai[c][b]; Ar[c][b] = xr * cc + xi * ss; Ai[c][b] = xi * cc - xr * ss; }
#pragma unroll
    for (int c = 0; c < 4; ++c) {
      const float x0r = Ar[c][0], x0i = Ai[c][0], x1r = Ar[c][1], x1i = Ai[c][1], x2r = Ar[c][2], x2i = Ai[c][2], x3r = Ar[c][3], x3i = Ai[c][3];
      const float s02r = x0r + x2r, s02i = x0i + x2i, d02r = x0r - x2r, d02i = x0i - x2i, s13r = x1r + x3r, s13i = x1i + x3i, d13r = x1r - x3r, d13i = x1i - x3i;
      float Or[4], Oi[4];
      Or[0] = s02r + s13r; Oi[0] = s02i + s13i; Or[2] = s02r - s13r; Oi[2] = s02i - s13i;
      Or[1] = d02r + d13i; Oi[1] = d02i - d13r; Or[3] = d02r - d13i; Oi[3] = d02i + d13r;
#pragma unroll
      for (int d = 0; d < 4; ++d) {
        const int k1 = c + 4 * d; const float orr = Or[d], oii = Oi[d];
        const float tc = tw[(k1 * N2 + n2) * 2], ts = tw[(k1 * N2 + n2) * 2 + 1];
        const float ar = tc * orr + ts * oii, ai = tc * oii - ts * orr;
        if (n2 < N2 - 1) { bf16_t* dd = btf + ((size_t)k1 * NN + ni) * Kd + n2; dd[0] = f2bf(ar); dd[N2 - 1] = f2bf(ai); }
        else { float* dd = tv + ((size_t)k1 * NN + ni) * 2; dd[0] = ar; dd[1] = ai; }
      }
    }
  }
}

__device__ __forceinline__ void f3_tail_phase(const Params& p) {
  unsigned char* ws = p.ws + opq0_(); unsigned char* r2 = (unsigned char*)p.out + opq0_();
  bf16_t* mix = (bf16_t*)(ws + R1_MIX); const float* tc = (const float*)(ws + T_TAILC);
  const int lane = tidx_() & 63, gw = bidx_() * 8 + (tidx_() >> 6), nw = gridDim.x * 8;
  for (int it = gw; it < 16 * 1024 + 16 * 2048; it += nw) {
    int grp, k1, ni, N2, NN; if (it < 16384) { grp = 0; k1 = it >> 10; ni = it & 1023; N2 = 513; NN = 1024; } else { const int v = it - 16384; grp = 1; k1 = v >> 11; ni = v & 2047; N2 = 257; NN = 2048; }
    const int H = N2 - 1, Kd = 2 * H;
    const bf16_t* b = (grp ? (const bf16_t*)(ws + R1_BTFS) : (const bf16_t*)(r2 + R2_BTFP)) + ((size_t)k1 * NN + ni) * Kd;
    const float* arc = tc + (grp ? TC_ARCS : TC_ARCP); const float* ars = tc + (grp ? TC_ARSS : TC_ARSP);
    float acc = 0.f;
    if (lane * 8 < H) {
      const u32x4 vr = *(const u32x4*)(b + lane * 8), vi = *(const u32x4*)(b + H + lane * 8);
      const unsigned rw[4] = {vr.x, vr.y, vr.z, vr.w}, iw[4] = {vi.x, vi.y, vi.z, vi.w};
#pragma unroll
      for (int t = 0; t < 4; ++t) { const int n2 = lane * 8 + t * 2;
        acc += arc[n2] * bflo(rw[t]) + arc[n2 + 1] * bfhi(rw[t]) + ars[n2] * bflo(iw[t]) + ars[n2 + 1] * bfhi(iw[t]); }
    }
#pragma unroll
    for (int o = 32; o >= 1; o >>= 1) acc += shx(acc, o, lane);
    if (lane == 0) {
      const float* tv = (const float*)(ws + T_TAILV) + (grp ? 32768 : 0) + ((size_t)k1 * NN + ni) * 2;
      acc += arc[H] * tv[0] + ars[H] * tv[1];
      const float scale = grp ? rsqrtf(128.0f * LS) : rsqrtf(128.0f * LP);
      const int sl = ni >> 9, c = ni & 511, pos = k1 + 16 * H;
      const int row = (grp ? 2 * LPP + sl * LPS : sl * LPP) + PADR + pos;
      mix[tix(row, c, 16)] = f2bf(acc * scale);
    }
  }
}

__device__ __forceinline__ void final_phase(const Params& p) {
  unsigned char* ws = p.ws + opq0_(); const bf16_t* h = (const bf16_t*)(ws + OFF_H); const float* rowsq = (const float*)(ws + T_ROWSQ); const float* g = inp(ws, 37);
  const int lane = tidx_() & 63, gw = bidx_() * 8 + (tidx_() >> 6), nw = gridDim.x * 8;
  for (int row = gw; row < MROWS; row += nw) {
    int seq, pos, L; row_info(row, seq, pos, L); if (pos < 16) continue;
    const float rs = row_rstd(rowsq, row);
    float* dst = p.out + (seq < 2 ? ((size_t)seq * 8192 + (pos - 16)) : ((size_t)16384 + (size_t)(seq - 2) * 4096 + (pos - 16))) * 1024;
#pragma unroll
    for (int i = 0; i < 4; ++i) { const int c = i * 256 + lane * 4; const u32x2 v = *(const u32x2*)(h + tix(row, c, 16)); const f32x4 gg = *(const f32x4*)(g + c);
      f32x4 o; o[0] = bflo(v.x) * rs * gg[0]; o[1] = bfhi(v.x) * rs * gg[1]; o[2] = bflo(v.y) * rs * gg[2]; o[3] = bfhi(v.y) * rs * gg[3]; *(f32x4*)(dst + c) = o; }
  }
}

__global__ void __launch_bounds__(512) __attribute__((amdgpu_flat_work_group_size(512, 512))) mega(Params p) {
  extern __shared__ __attribute__((aligned(16))) unsigned char smem[];
  LAS unsigned char* lds = (LAS unsigned char*)smem;
  cg::grid_group grid = cg::this_grid();
  LAS unsigned* xst = (LAS unsigned*)(lds + LDS_CTL + 32);
  if (threadIdx.x == 0) { xst[0] = 0u; xst[1] = 0u; (void)xb_add(&((unsigned*)(p.ws + T_BAR))[XB_XCNT(xcc_id_())], 1u); }
  __syncthreads();
#define SYNC_ do { XcdBarrier xb_; xb_.bar = (unsigned*)(p.ws + T_BAR); xb_.x = xcc_id_(); xb_.st = xst; xcd_barrier(xb_); } while (0)
  if (threadIdx.x == 0) { const unsigned x = xcc_id_(); LAS int* ctl = (LAS int*)(lds + LDS_CTL);
    const unsigned slot = __hip_atomic_fetch_add((unsigned*)(p.ws + T_CNT) + x, 1u, __ATOMIC_RELAXED, __HIP_MEMORY_SCOPE_AGENT); ctl[0] = (int)x; ctl[1] = (int)slot; }
  prep_misc(p); prep_weights(p, 0, lds); grid.sync();
  if (threadIdx.x == 0) { LAS int* ctl = (LAS int*)(lds + LDS_CTL); int ok = 1, mine = 0;
    for (int i = 0; i < 8; ++i) { const int c = (int)__hip_atomic_load((unsigned*)(p.ws + T_CNT) + i, __ATOMIC_RELAXED, __HIP_MEMORY_SCOPE_AGENT); if (c == 0) ok = 0; if (i == ctl[0]) mine = c; }
    ctl[2] = mine; ctl[3] = ok; }
  __syncthreads();
  gemm_phase2(K_UP, 0, p, lds, 1); SYNC_;
  gemm_phase2(K_DN, 0, p, lds, 2); prep_weights(p, 2, lds); SYNC_;
  gemm_phase2(K_WINA, 0, p, lds, 3); prep_weights(p, 3, lds); SYNC_;
  ret_kv_phase(p, lds); SYNC_;
  ret_scan_phase(p); SYNC_;
  ret_out_phase(p, lds); SYNC_;
  xwa_phase(p); SYNC_;
  rwkv_scan2_phase(p, lds); SYNC_;
  rwkv_post_phase(p, lds); SYNC_;
  gemm_phase2(K_WOUT, 0, p, lds, 4); prep_weights(p, 1, lds); SYNC_;
  gemm_phase2(K_UP, 1, p, lds, 5); gemm_phase(K_FOLD, 0, p, lds); SYNC_;
  gemm_phase2(K_DN, 1, p, lds, 6); SYNC_;
  gemm_phase2(K_UP, 2, p, lds, 7); SYNC_;
  gemm_phase2(K_DN, 2, p, lds, 8); SYNC_;
  gemm_phase2(K_WIN1, 0, p, lds, 9); SYNC_;
  conv_phase(p); SYNC_;
  f2_phase(p); SYNC_;
  gemm_phase(K_F3, 0, p, lds); f3_tail_phase(p); SYNC_;
  gemm_phase2(K_WOUT, 1, p, lds, 10); SYNC_;
  gemm_phase2(K_UP, 3, p, lds, 11); SYNC_;
  gemm_phase2(K_DN, 3, p, lds, 12); SYNC_;
  final_phase(p);
}

extern "C" void kernel_launch(void* const* d_in, const int* in_sizes, int n_in, void* d_out, int out_size, void* d_ws, size_t ws_size, hipStream_t stream) {
  constexpr size_t kDynLds = 145664;
  static int grid_blocks = 0;
  if (!grid_blocks) {
    int dev = 0, cus = 0, per_cu = 0;
    (void)hipGetDevice(&dev);
    (void)hipDeviceGetAttribute(&cus, hipDeviceAttributeMultiprocessorCount, dev);
    (void)hipFuncSetAttribute((const void*)mega, hipFuncAttributeMaxDynamicSharedMemorySize, (int)kDynLds);
    (void)hipOccupancyMaxActiveBlocksPerMultiprocessor(&per_cu, mega, 512, kDynLds);
    if (per_cu < 1) per_cu = 1;
    grid_blocks = cus * 1;
  }
  Params p{};
  for (int i = 0; i < 38; ++i) p.in[i] = (const float*)d_in[i];
  p.out = (float*)d_out; p.ws = (unsigned char*)d_ws;
  (void)hipMemsetAsync((char*)d_ws + T_CNT, 0, 128 + 14336, stream);
  void* args[] = {&p};
  hipError_t e = hipLaunchCooperativeKernel((void*)mega, dim3(grid_blocks), dim3(512), args, kDynLds, stream);
  if (e != hipSuccess) fprintf(stderr, "cooperative launch failed: %s (grid %d)\n", hipGetErrorString(e), grid_blocks);
}
```

```cpp
#include <hip/hip_runtime.h>
#include <hip/hip_cooperative_groups.h>
#include <cstdio>
namespace cg = cooperative_groups;
#define LAS __attribute__((address_space(3)))
typedef unsigned short bf16_t;
typedef short bf16x8 __attribute__((ext_vector_type(8)));
typedef float f32x4 __attribute__((ext_vector_type(4)));
typedef unsigned u32x4 __attribute__((ext_vector_type(4)));
typedef unsigned u32x2 __attribute__((ext_vector_type(2)));

constexpr int DM = 1024, FF = 2816;
constexpr int LP = 8208, LS = 4112, LPP = 8320, LPS = 4224, PADR = 112;
constexpr int MROWS = 2 * LPP + 4 * LPS;
constexpr int MT = MROWS / 256;
constexpr int MT_A = 66;
static_assert(MROWS % 256 == 0, "rows");
constexpr size_t SZ_H = (size_t)MROWS * DM * 2;
constexpr size_t SZ_UP = (size_t)2 * FF * DM * 2, SZ_DN = (size_t)DM * FF * 2, SZ_SQ = (size_t)DM * DM * 2;
constexpr size_t OFF_H = 0;
constexpr size_t OFF_W0 = OFF_H + SZ_H;
constexpr size_t W0_F1UP = OFF_W0, W0_F1DN = W0_F1UP + SZ_UP, W0_INA = W0_F1DN + SZ_DN, W0_INB = W0_INA + (size_t)1536 * DM * 2,
                 W0_OUT = W0_INB + (size_t)1792 * DM * 2, W0_F2UP = W0_OUT + SZ_SQ, W0_F2DN = W0_F2UP + SZ_UP;
constexpr size_t OFF_TAB = W0_F2DN + SZ_DN;
constexpr size_t T_ROWSQ = OFF_TAB;
constexpr size_t T_ROPE = T_ROWSQ + (size_t)MROWS * 16 * 4;
constexpr size_t T_ADFTP = T_ROPE + (size_t)LP * 64 * 4;
constexpr size_t T_ADFTS = T_ADFTP + (size_t)512 * 1024 * 2;
constexpr size_t T_FT = T_ADFTS + (size_t)256 * 512 * 2;
constexpr size_t T_WTMP = T_FT + (size_t)1024 * 512 * 2;
constexpr size_t T_TWP = T_WTMP + (size_t)1024 * 512 * 2;
constexpr size_t T_TWS = T_TWP + 65792;
constexpr size_t T_TAILC = T_TWS + 33024;
constexpr size_t T_TAILV = T_TAILC + 16384;
constexpr size_t T_BONUS = T_TAILV + 131072 + 262144;
constexpr size_t T_G2T = T_BONUS + (size_t)MROWS * 16 * 4;
constexpr size_t T_PTR = T_G2T + 131072;
constexpr size_t T_CNT = T_PTR + 384;
constexpr size_t T_BAR = T_PTR + 512;
constexpr size_t OFF_R1 = T_BAR + 14336;
constexpr int LDS_RSTD = 143360 + 64;
constexpr int LDS_CTL = 143360;
constexpr size_t WS_MIN = 268435456;
constexpr size_t R1_MIX = OFF_R1;
constexpr size_t SZ_MIX = (size_t)MROWS * 1024 * 2;
constexpr size_t R1_OF = R1_MIX + SZ_MIX, R1_OB = R1_OF + (size_t)MROWS * 512 * 2;
constexpr size_t R1_U = R1_MIX + SZ_MIX;
constexpr size_t R1_BTFS = R1_U;
constexpr size_t R1_ACTA = OFF_R1;
constexpr size_t SZ_W1 = SZ_UP + SZ_DN + (size_t)2560 * DM * 2 + SZ_SQ + SZ_UP + SZ_DN;
constexpr size_t OFF_W1 = WS_MIN - SZ_W1;
constexpr size_t W1_F1UP = OFF_W1, W1_F1DN = W1_F1UP + SZ_UP, W1_IN = W1_F1DN + SZ_DN, W1_OUT = W1_IN + (size_t)2560 * DM * 2,
                 W1_F2UP = W1_OUT + SZ_SQ, W1_F2DN = W1_F2UP + SZ_UP;
static_assert(R1_OB + (size_t)MROWS * 512 * 2 <= WS_MIN, "L0 mixer region");
static_assert(R1_ACTA + (size_t)MT_A * 256 * FF * 2 <= OFF_W1, "actA vs W1");
static_assert(R1_U + (size_t)MROWS * 512 * 2 <= OFF_W1, "u vs W1");
static_assert(R1_BTFS + (size_t)16 * 2048 * 512 * 2 <= OFF_W1, "btfs vs W1");
constexpr size_t SZ_OUT = (size_t)32768 * 1024 * 4;
static_assert(((size_t)96 << 20) + (size_t)66 * 262144 <= SZ_OUT && ((size_t)96 << 20) >= (size_t)(MT - MT_A) * 256 * FF * 2, "split-K scratch");
constexpr size_t R2_SPLITK = (size_t)96 << 20;
constexpr size_t R1_QK = R1_OF;
constexpr size_t R1_KVF = R1_OB;
constexpr size_t R1_KVB = R1_KVF + (size_t)1048 * 8192 * 2;
static_assert(R1_KVB + (size_t)1048 * 8192 * 2 <= R1_OB + (size_t)MROWS * 512 * 2, "kv in o_b region");
constexpr size_t R2_PRW = 0;
constexpr size_t R2_ACTB = 0;
constexpr size_t R2_WT = 0;
constexpr size_t R2_WTS = (size_t)2 * 1024 * LP * 2;
constexpr size_t R2_BTFP = R2_WTS + (size_t)4 * 1024 * LS * 2;
static_assert(R2_PRW + (size_t)MROWS * 1792 * 2 <= SZ_OUT, "r2 b");
static_assert(R2_BTFP + (size_t)16 * 1024 * 1024 * 2 <= SZ_OUT, "r2 c");
static_assert((size_t)(MT - MT_A) * 256 * FF * 2 <= SZ_OUT, "r2 d");
constexpr int TC_CTP = 0, TC_STP = 512, TC_ARCP = 1024, TC_ARSP = 1024 + 520, TC_CTS = 2080, TC_STS = 2080 + 256, TC_ARCS = 2600, TC_ARSS = 2600 + 264;

struct Params { const float* in[38]; float* out; unsigned char* ws; };

__device__ __forceinline__ bf16_t f2bf(float f) { unsigned u = __float_as_uint(f); u += 0x7FFFu + ((u >> 16) & 1u); return (bf16_t)(u >> 16); }
__device__ __forceinline__ float bf2f(bf16_t b) { return __uint_as_float(((unsigned)b) << 16); }
typedef float f32x2_t __attribute__((ext_vector_type(2)));
typedef __bf16 bf16x2_t __attribute__((ext_vector_type(2)));
__device__ __forceinline__ unsigned pack2(float a, float b) { f32x2_t v = {a, b}; bf16x2_t r = __builtin_convertvector(v, bf16x2_t); return __builtin_bit_cast(unsigned, r); }
__device__ __forceinline__ float bflo(unsigned u) { return __uint_as_float(u << 16); }
__device__ __forceinline__ float bfhi(unsigned u) { return __uint_as_float(u & 0xffff0000u); }
__device__ __forceinline__ int seq_base(int s) { return s < 2 ? s * LPP : 2 * LPP + (s - 2) * LPS; }
__device__ __forceinline__ void row_info(int row, int& seq, int& pos, int& L) {
  if (row < 2 * LPP) { seq = row >= LPP ? 1 : 0; pos = row - seq * LPP - PADR; L = LP; }
  else { const int r = row - 2 * LPP; const int s = r / LPS; seq = 2 + s; pos = r - s * LPS - PADR; L = LS; }
}
template <int CTRL> __device__ __forceinline__ float dppf(float v) { return __int_as_float(__builtin_amdgcn_update_dpp(0, __float_as_int(v), CTRL, 0xF, 0xF, true)); }
__device__ __forceinline__ float rowsum16(float v) { v += dppf<0xB1>(v); v += dppf<0x4E>(v); v += dppf<0x141>(v); v += dppf<0x140>(v); return v; }
__device__ __forceinline__ float rcpf_(float x) { return __builtin_amdgcn_rcpf(x); }
__device__ __forceinline__ float sigmoidf_(float x) { return rcpf_(1.0f + __expf(-x)); }
__device__ __forceinline__ f32x4 mfma16(bf16x8 a, bf16x8 b, f32x4 c) { return __builtin_amdgcn_mfma_f32_16x16x32_bf16(a, b, c, 0, 0, 0); }
__device__ __forceinline__ const float* inp(const unsigned char* ws, int i) {
  const unsigned long long v = ((const unsigned long long*)(ws + T_PTR))[i];
  const unsigned lo = __builtin_amdgcn_readfirstlane((unsigned)v), hi = __builtin_amdgcn_readfirstlane((unsigned)(v >> 32));
  return (const float*)(((unsigned long long)hi << 32) | (unsigned long long)lo);
}
__device__ __forceinline__ int tidx_() { int t = threadIdx.x; asm volatile("" : "+v"(t)); return t; }
__device__ __forceinline__ int bidx_() { int b = blockIdx.x; asm volatile("" : "+s"(b)); return b; }
__device__ __forceinline__ int gdim_() { int g = __builtin_amdgcn_readfirstlane((int)gridDim.x); asm volatile("" : "+s"(g)); return g; }
__device__ __forceinline__ float shx(float v, int o, int lane) { return __int_as_float(__builtin_amdgcn_ds_bpermute(((lane ^ o) & 63) << 2, __float_as_int(v))); }
__device__ __forceinline__ unsigned xcc_id_() { return (unsigned)__builtin_amdgcn_s_getreg((3 << 11) | 20) & 0xFu; }
__device__ __forceinline__ size_t tix(int row, int col, int KB) { return ((size_t)((row >> 7) * KB + (col >> 6)) << 13) + (size_t)((row & 127) * 64 + (col & 63)); }

#define XB_TMO      128
#define XB_XCNT(j)  (256  + 64 * (j))
#define XB_XSUB(j)  (1280 + 64 * (j))
#define XB_XGEN(j)  (2304 + 64 * (j))
#define XB_TOP      3328
#define XB_TOPGEN   3392
#define XCD_BAR_WORDS 3456
#define XB_SPIN_CAP (1u << 22)
__device__ __forceinline__ unsigned xb_ld(unsigned* p)              { return __hip_atomic_load(p, __ATOMIC_RELAXED, __HIP_MEMORY_SCOPE_AGENT); }
__device__ __forceinline__ unsigned xb_add(unsigned* p, unsigned v) { return __hip_atomic_fetch_add(p, v, __ATOMIC_RELAXED, __HIP_MEMORY_SCOPE_AGENT); }
#define XB_SPIN(cond, bar) do { unsigned _sp = 0; while (cond) { __builtin_amdgcn_s_sleep(1); \
    if ((++_sp & 255u) == 0u) { if (xb_ld(&(bar)[XB_TMO])) break; if (_sp > XB_SPIN_CAP) { atomicAdd(&(bar)[XB_TMO], 1u); break; } } } } while (0)
struct XcdBarrier { unsigned* bar; unsigned x; volatile LAS unsigned* st; };
__device__ __forceinline__ void xcd_barrier_complete(unsigned* bar, unsigned x, unsigned& nloc, unsigned& nx) {
    const unsigned G = gridDim.x * gridDim.y * gridDim.z;
    unsigned sum, cnt, mine, sp = 0u;
    for (;;) {
        sum = 0u; cnt = 0u; mine = 0u;
#pragma unroll
        for (unsigned j = 0; j < 16; ++j) { const unsigned c = xb_ld(&bar[XB_XCNT(j)]); sum += c; cnt += (c > 0u) ? 1u : 0u; mine = (j == x) ? c : mine; }
        if (sum == G) break;
        __builtin_amdgcn_s_sleep(1);
        if ((++sp & 255u) == 0u) { if (xb_ld(&bar[XB_TMO])) break; if (sp > XB_SPIN_CAP) { atomicAdd(&bar[XB_TMO], 1u); break; } }
    }
    nloc = mine > 0u ? mine : 1u; nx = cnt > 0u ? cnt : 1u;
}
__device__ __forceinline__ void xcd_barrier(const XcdBarrier& b) {
    asm volatile("s_waitcnt vmcnt(0)" ::: "memory");
    __syncthreads();
    if (threadIdx.x == 0) {
        unsigned* bar = b.bar;
        __builtin_amdgcn_s_waitcnt(0);
        unsigned nloc = b.st[0], nx = b.st[1];
        if (nloc == 0u) { xcd_barrier_complete(bar, b.x, nloc, nx); b.st[0] = nloc; b.st[1] = nx; }
        const unsigned old = xb_add(&bar[XB_XSUB(b.x)], 1u);
        const unsigned gen = old / nloc;
        if (old + 1u == (gen + 1u) * nloc) {
            __builtin_amdgcn_fence(__ATOMIC_RELEASE, "agent");
            asm volatile("s_waitcnt vmcnt(0)" ::: "memory");
            const unsigned og = xb_add(&bar[XB_TOP], 1u);
            const unsigned tg = og / nx;
            if (og + 1u == (tg + 1u) * nx) xb_add(&bar[XB_TOPGEN], 1u);
            else XB_SPIN(xb_ld(&bar[XB_TOPGEN]) == tg, bar);
            __builtin_amdgcn_fence(__ATOMIC_ACQUIRE, "agent");
            xb_add(&bar[XB_XGEN(b.x)], 1u);
            asm volatile("s_waitcnt vmcnt(0)" ::: "memory");
        } else {
            XB_SPIN(xb_ld(&bar[XB_XGEN(b.x)]) == gen, bar);
            __builtin_amdgcn_fence(__ATOMIC_ACQUIRE, "agent");
            asm volatile("s_waitcnt vmcnt(0)" ::: "memory");
        }
    }
    __syncthreads();
}
__device__ __forceinline__ size_t opq0_() { size_t z = 0; asm volatile("" : "+s"(z)); return z; }
constexpr int HTB = 128 * 64 * 2;
__device__ __forceinline__ int lds_byte(int r, int c) { const int st = (r >> 4) * 2 + (c >> 5), rr = r & 15, cc = c & 31, ob = rr * 64 + cc * 2; return st * 1024 + (ob ^ (((ob >> 9) & 1) << 5)); }
__device__ __forceinline__ void stage_rc(int b, int& R, int& C) { const int st = b / 1024, sb = b % 1024, swz = sb ^ (((sb >> 9) & 1) << 5); R = (st >> 1) * 16 + swz / 64; C = (st & 1) * 32 + (swz % 64) / 2; }

__device__ __forceinline__ void gemm_core(const bf16_t* A, int lda, size_t kstepA, size_t hA, const bf16_t* Bt, int ldb, size_t kstepB, size_t hB, int K, LAS unsigned char* lds, f32x4 (&acc)[2][2][4][2]) {
  const int tid = tidx_(), wid = tid >> 6, lane = tid & 63, wr = wid >> 2, wc = wid & 3, fr = lane & 15, fq = lane >> 4;
  unsigned voffA[2], voffB[2];
#pragma unroll
  for (int i = 0; i < 2; ++i) { int R, C; stage_rc(tid * 16 + i * 8192, R, C); voffA[i] = (unsigned)(R * lda + C) * 2u; voffB[i] = (unsigned)(R * ldb + C) * 2u; }
  const unsigned ldsw = (unsigned)wid * 1024u;
  const int aoff = lds_byte(wr * 64 + fr, fq * 8), boff = lds_byte(wc * 32 + fr, fq * 8);
  const char* gA = (const char*)A; const char* gB = (const char*)Bt;
#define SA_(b, h) (((b) * 2 + (h)) * HTB)
#define SB_(b, h) ((4 + (b) * 2 + (h)) * HTB)
#define STAGE_(bufoff, gbase, voff) do { _Pragma("unroll") for (int _i = 0; _i < 2; ++_i) \
    __builtin_amdgcn_global_load_lds((const unsigned*)((gbase) + (voff)[_i]), (LAS unsigned*)(lds + (bufoff) + ldsw + _i * 8192), 16, 0, 0); } while (0)
#define STA_(b, h, kt) STAGE_(SA_(b, h), gA + (size_t)(h) * hA + (size_t)(kt) * kstepA, voffA)
#define STB_(b, h, kt) STAGE_(SB_(b, h), gB + (size_t)(h) * hB + (size_t)(kt) * kstepB, voffB)
#define LDA_(dst, b, h) do { _Pragma("unroll") for (int m = 0; m < 4; ++m) _Pragma("unroll") for (int k = 0; k < 2; ++k) dst[m][k] = *(const LAS bf16x8*)(lds + SA_(b, h) + aoff + m * 2048 + k * 1024); } while (0)
#define LDB_(dst, b, h) do { _Pragma("unroll") for (int n = 0; n < 2; ++n) _Pragma("unroll") for (int k = 0; k < 2; ++k) dst[n][k] = *(const LAS bf16x8*)(lds + SB_(b, h) + boff + n * 2048 + k * 1024); } while (0)
#define MMA_(ai, bj, At, Bx) do { __builtin_amdgcn_s_setprio(1); _Pragma("unroll") for (int m = 0; m < 4; ++m) _Pragma("unroll") for (int n = 0; n < 2; ++n) _Pragma("unroll") for (int k = 0; k < 2; ++k) \
    acc[ai][bj][m][n] = __builtin_amdgcn_mfma_f32_16x16x32_bf16(Bx[n][k], At[m][k], acc[ai][bj][m][n], 0, 0, 0); __builtin_amdgcn_s_setprio(0); } while (0)
#define WAIT_V(n) asm volatile("s_waitcnt vmcnt(" #n ")" ::: "memory")
#define WAIT_L(n) asm volatile("s_waitcnt lgkmcnt(" #n ")" ::: "memory")
#define BAR_ __builtin_amdgcn_s_barrier()
#define SCHED_ __builtin_amdgcn_sched_barrier(0)
#pragma unroll
  for (int a = 0; a < 2; ++a)
#pragma unroll
    for (int b = 0; b < 2; ++b)
#pragma unroll
      for (int m = 0; m < 4; ++m)
#pragma unroll
        for (int n = 0; n < 2; ++n) acc[a][b][m][n] = (f32x4){0.f, 0.f, 0.f, 0.f};
  bf16x8 At[4][2], B0[2][2], B1[2][2];
  const int nt = K / 64;
  STB_(0, 0, 0); STA_(0, 0, 0); STB_(0, 1, 0); STA_(0, 1, 0);
  if (wr == 1) BAR_;
  WAIT_V(4); BAR_;
  STB_(1, 0, 1); STA_(1, 0, 1); STB_(1, 1, 1);
  WAIT_V(6); BAR_;
  for (int t = 0; t < nt - 2; t += 2) {
    LDB_(B0, 0, 0); SCHED_; LDA_(At, 0, 0); STA_(1, 1, t + 1);
    WAIT_L(8); BAR_; WAIT_L(0); MMA_(0, 0, At, B0); BAR_; SCHED_;
    LDB_(B1, 0, 1); STB_(0, 0, t + 2);
    BAR_; WAIT_L(0); MMA_(0, 1, At, B1); BAR_;
    LDA_(At, 0, 1); STA_(0, 0, t + 2);
    BAR_; WAIT_L(0); MMA_(1, 0, At, B0); BAR_; SCHED_;
    STB_(0, 1, t + 2);
    WAIT_V(6); BAR_; MMA_(1, 1, At, B1); BAR_;
    LDB_(B0, 1, 0); SCHED_; LDA_(At, 1, 0); STA_(0, 1, t + 2);
    WAIT_L(8); BAR_; WAIT_L(0); MMA_(0, 0, At, B0); BAR_; SCHED_;
    LDB_(B1, 1, 1); STB_(1, 0, t + 3);
    BAR_; WAIT_L(0); MMA_(0, 1, At, B1); BAR_;
    LDA_(At, 1, 1); STA_(1, 0, t + 3);
    BAR_; WAIT_L(0); MMA_(1, 0, At, B0); BAR_; SCHED_;
    STB_(1, 1, t + 3);
    WAIT_V(6); BAR_; MMA_(1, 1, At, B1); BAR_;
  }
  { LDB_(B0, 0, 0); LDA_(At, 0, 0); STA_(1, 1, nt - 1);
    BAR_; WAIT_L(0); MMA_(0, 0, At, B0); BAR_;
    LDB_(B1, 0, 1); BAR_; WAIT_L(0); MMA_(0, 1, At, B1); BAR_;
    LDA_(At, 0, 1); WAIT_V(4); BAR_; WAIT_L(0); MMA_(1, 0, At, B0); MMA_(1, 1, At, B1); BAR_; }
  { LDB_(B0, 1, 0); LDA_(At, 1, 0); WAIT_V(2); BAR_; WAIT_L(0); MMA_(0, 0, At, B0); BAR_;
    LDB_(B1, 1, 1); WAIT_V(0); BAR_; WAIT_L(0); MMA_(0, 1, At, B1); BAR_;
    LDA_(At, 1, 1); BAR_; WAIT_L(0); MMA_(1, 0, At, B0); MMA_(1, 1, At, B1); BAR_; }
  if (wr == 0) BAR_;
}

__device__ __forceinline__ bool unit_for(int it, int U, int nM, int nN, int& pm, int& pn, LAS unsigned char* lds) {
  const LAS int* ctl = (const LAS int*)(lds + LDS_CTL);
  const int x = __builtin_amdgcn_readfirstlane(ctl[0]), slot = __builtin_amdgcn_readfirstlane(ctl[1]), nx = __builtin_amdgcn_readfirstlane(ctl[2]), ok = __builtin_amdgcn_readfirstlane(ctl[3]);
  int l;
  if (ok) {
    const int q = U >> 3, r = U & 7;
    const int cnt = x < r ? q + 1 : q, start = x < r ? x * (q + 1) : r * (q + 1) + (x - r) * q;
    const int li = it * nx + slot; if (li >= cnt) return false; l = start + li;
  } else { const int G = gridDim.x, b = bidx_(); l = it * G + b; if (l >= U) return false; }
  const int nig = 8 * nN, gid = l / nig, within = l % nig, fm = gid * 8, gsz = (nM - fm) < 8 ? (nM - fm) : 8;
  pm = fm + within % gsz; pn = within / gsz; return true;
}

enum { K_UP = 0, K_DN = 1, K_WINA = 2, K_WINB = 3, K_WOUT = 4, K_WIN1 = 5, K_F3 = 6, K_FOLD = 7 };

__device__ __forceinline__ float row_rstd(const float* rowsq, int row) {
  const f32x4* q = (const f32x4*)(rowsq + (size_t)row * 16);
  const f32x4 a = q[0], b = q[1], c = q[2], d = q[3];
  const float s = ((a[0] + a[1]) + (a[2] + a[3])) + ((b[0] + b[1]) + (b[2] + b[3])) + ((c[0] + c[1]) + (c[2] + c[3])) + ((d[0] + d[1]) + (d[2] + d[3]));
  return rsqrtf(s * (1.0f / 1024.0f) + 1e-6f);
}

struct F3Info { int grp, k1, mt, nt; };
__device__ __forceinline__ void gemm_epilogue(const int kind, const int pm, const int pn, const F3Info f3, f32x4 (&acc)[2][2][4][2], unsigned char* ws, unsigned char* r2, LAS unsigned char* lds, const float* partial = nullptr) {
  const LAS float* rst = (const LAS float*)(lds + LDS_RSTD);
#define ACC_(ai, bj, m, n) (partial ? acc[ai][bj][m][n] + *(const f32x4*)(partial + (size_t)(((((ai) * 2 + (bj)) * 4 + (m)) * 2 + (n)) * 512 + tid) * 4) : acc[ai][bj][m][n])
  const int f3_grp = f3.grp, f3_k1 = f3.k1, f3_mt = f3.mt, f3_nt = f3.nt;
  {
    ws += opq0_(); r2 += opq0_();
    const int tid = tidx_(), wid = tid >> 6, lane = tid & 63, wr = wid >> 2, wc = wid & 3, fr = lane & 15, fq = lane >> 4;
    bf16_t* h = (bf16_t*)(ws + OFF_H);
    float* rowsq = (float*)(ws + T_ROWSQ);
    const int brow = pm * 256 + wr * 64 + fr;
    const int ccol = wc * 32 + fq * 4;
    if (kind == K_UP) {
      bf16_t* act = pm < MT_A ? (bf16_t*)(ws + R1_ACTA) : (bf16_t*)(r2 + R2_ACTB); const int arow0 = pm < MT_A ? 0 : MT_A * 256;
#pragma unroll
      for (int ai = 0; ai < 2; ++ai)
#pragma unroll
        for (int m = 0; m < 4; ++m) { asm volatile("" ::: "memory");
          const int row = brow + ai * 128 + m * 16; const float rs = rst[row - pm * 256];
#pragma unroll
          for (int n = 0; n < 2; ++n) {
            const f32x4 g = ACC_(ai, 0, m, n) * rs, u = ACC_(ai, 1, m, n) * rs; float o[4];
#pragma unroll
            for (int j = 0; j < 4; ++j) o[j] = g[j] * sigmoidf_(g[j]) * u[j];
            u32x2 w; w.x = pack2(o[0], o[1]); w.y = pack2(o[2], o[3]);
            *(u32x2*)(act + tix(row - arow0, pn * 128 + ccol + n * 16, 44)) = w;
          }
        }
    } else if (kind == K_DN || kind == K_WOUT) {
      const float sc = kind == K_DN ? 0.5f : 1.0f;
#pragma unroll
      for (int ai = 0; ai < 2; ++ai)
#pragma unroll
        for (int m = 0; m < 4; ++m) { asm volatile("" ::: "memory");
          const int row = brow + ai * 128 + m * 16; int seq, pos, L; row_info(row, seq, pos, L);
          float ss = 0.f;
          if (pos >= 0) {
#pragma unroll
            for (int bj = 0; bj < 2; ++bj)
#pragma unroll
              for (int n = 0; n < 2; ++n) {
                bf16_t* hp = h + tix(row, pn * 256 + bj * 128 + ccol + n * 16, 16);
                const u32x2 old = *(const u32x2*)hp; const f32x4 a = ACC_(ai, bj, m, n);
                u32x2 w; w.x = pack2(bflo(old.x) + sc * a[0], bfhi(old.x) + sc * a[1]); w.y = pack2(bflo(old.y) + sc * a[2], bfhi(old.y) + sc * a[3]);
                *(u32x2*)hp = w;
                const float v0 = bflo(w.x), v1 = bfhi(w.x), v2 = bflo(w.y), v3 = bfhi(w.y);
                ss += (v0 * v0 + v1 * v1) + (v2 * v2 + v3 * v3);
              }
          }
          ss += shx(ss, 16, lane); ss += shx(ss, 32, lane);
          if (fq == 0) rowsq[(size_t)row * 16 + pn * 4 + wc] = ss;
        }
    } else if (kind == K_WINA) {
      if (pn < 2) {
        bf16_t* qk = (bf16_t*)(ws + R1_QK);
        const float* rc = (const float*)(ws + T_ROPE); const float* rsn = rc + (size_t)LP * 32;
        const float qs = pn == 0 ? 0.125f : 1.0f;
#pragma unroll
        for (int ai = 0; ai < 2; ++ai)
#pragma unroll
          for (int m = 0; m < 4; ++m) { asm volatile("" ::: "memory");
            const int row = brow + ai * 128 + m * 16; int seq, pos, L; row_info(row, seq, pos, L);
            const float rs = rst[row - pm * 256] * qs; const int pc = pos < 0 ? 0 : pos;
#pragma unroll
            for (int bj = 0; bj < 2; ++bj) {
              const int g = bj * 4 + wc, head = g >> 1, d1 = (g & 1) * 16 + fq * 4;
              const f32x4 x1 = ACC_(ai, bj, m, 0) * rs, x2 = ACC_(ai, bj, m, 1) * rs;
              const f32x4 c = *(const f32x4*)(rc + (size_t)pc * 32 + d1), s = *(const f32x4*)(rsn + (size_t)pc * 32 + d1);
              const f32x4 o1 = x1 * c - x2 * s, o2 = x1 * s + x2 * c;
              bf16_t* dst = qk + (size_t)row * 512 + pn * 256 + head * 64 + d1;
              u32x2 w; w.x = pack2(o1[0], o1[1]); w.y = pack2(o1[2], o1[3]); *(u32x2*)dst = w;
              w.x = pack2(o2[0], o2[1]); w.y = pack2(o2[2], o2[3]); *(u32x2*)(dst + 32) = w;
            }
          }
      } else if (pn >= 6) {
        bf16_t* dst = (bf16_t*)(r2 + R2_PRW);
#pragma unroll
        for (int ai = 0; ai < 2; ++ai)
#pragma unroll
          for (int m = 0; m < 4; ++m) { asm volatile("" ::: "memory");
            const int row = brow + ai * 128 + m * 16; const float rs = rst[row - pm * 256];
#pragma unroll
            for (int bj = 0; bj < 2; ++bj)
#pragma unroll
              for (int n = 0; n < 2; ++n) { const f32x4 a = ACC_(ai, bj, m, n) * rs; u32x2 w; w.x = pack2(a[0], a[1]); w.y = pack2(a[2], a[3]);
                *(u32x2*)(dst + (size_t)row * 1792 + (pn - 6) * 256 + bj * 128 + ccol + n * 16) = w; }
          }
      } else {
        bf16_t* mix = (bf16_t*)(ws + R1_MIX);
#pragma unroll
        for (int ai = 0; ai < 2; ++ai)
#pragma unroll
          for (int m = 0; m < 4; ++m) { asm volatile("" ::: "memory");
            const int row = brow + ai * 128 + m * 16; const float rs = rst[row - pm * 256];
#pragma unroll
            for (int bj = 0; bj < 2; ++bj)
#pragma unroll
              for (int n = 0; n < 2; ++n) { const f32x4 a = ACC_(ai, bj, m, n) * rs; u32x2 w; w.x = pack2(a[0], a[1]); w.y = pack2(a[2], a[3]);
                *(u32x2*)(mix + (size_t)row * 1024 + (pn - 2) * 256 + bj * 128 + ccol + n * 16) = w; }
          }
      }
    } else if (kind == K_WINB || kind == K_FOLD) {
      bf16_t* dst = kind == K_WINB ? (bf16_t*)(r2 + R2_PRW) : (bf16_t*)(ws + W1_IN);
      const int ldd = kind == K_WINB ? 1792 : 1024;
#pragma unroll
      for (int ai = 0; ai < 2; ++ai)
#pragma unroll
        for (int m = 0; m < 4; ++m) { asm volatile("" ::: "memory");
          const int row = brow + ai * 128 + m * 16; const float rs = kind == K_WINB ? rst[row - pm * 256] : 1.0f;
#pragma unroll
          for (int bj = 0; bj < 2; ++bj)
#pragma unroll
            for (int n = 0; n < 2; ++n) { const f32x4 a = ACC_(ai, bj, m, n) * rs; u32x2 w; w.x = pack2(a[0], a[1]); w.y = pack2(a[2], a[3]);
              const int col = pn * 256 + bj * 128 + ccol + n * 16; *(u32x2*)(dst + (kind == K_WINB ? (size_t)row * ldd + col : tix(row, col, 16))) = w; }
        }
    } else if (kind == K_WIN1) {
      bf16_t* mix = (bf16_t*)(ws + R1_MIX); bf16_t* ub = (bf16_t*)(ws + R1_U);
#pragma unroll
      for (int ai = 0; ai < 2; ++ai)
#pragma unroll
        for (int m = 0; m < 4; ++m) { asm volatile("" ::: "memory");
          const int row = brow + ai * 128 + m * 16; int seq, pos, L; row_info(row, seq, pos, L);
          const float rs = rst[row - pm * 256];
          if (pn < 4) {
            if (pos >= 0) {
              bf16_t* wt = (bf16_t*)(r2 + R2_WT) + (seq < 2 ? (size_t)seq * 1024 * LP : (size_t)2 * 1024 * LP + (size_t)(seq - 2) * 1024 * LS);
#pragma unroll
              for (int bj = 0; bj < 2; ++bj)
#pragma unroll
                for (int n = 0; n < 2; ++n) { const f32x4 a = ACC_(ai, bj, m, n) * rs; const int col = pn * 256 + bj * 128 + ccol + n * 16;
#pragma unroll
                  for (int j = 0; j < 4; ++j) wt[(size_t)(col + j) * L + pos] = f2bf(a[j]); }
            }
          } else if (pn < 6) {
#pragma unroll
            for (int bj = 0; bj < 2; ++bj)
#pragma unroll
              for (int n = 0; n < 2; ++n) { const f32x4 a = ACC_(ai, bj, m, n) * rs; u32x2 w; w.x = pack2(a[0], a[1]); w.y = pack2(a[2], a[3]);
                *(u32x2*)(mix + (size_t)row * 1024 + 512 + (pn - 4) * 256 + bj * 128 + ccol + n * 16) = w; }
          } else {
#pragma unroll
            for (int n = 0; n < 2; ++n) { const f32x4 a = (ACC_(ai, 0, m, n) * rs) * (ACC_(ai, 1, m, n) * rs); u32x2 w; w.x = pack2(a[0], a[1]); w.y = pack2(a[2], a[3]);
              *(u32x2*)(ub + (size_t)row * 512 + (pn - 6) * 128 + ccol + n * 16) = w; }
          }
        }
    } else {
      bf16_t* mix = (bf16_t*)(ws + R1_MIX);
      const float* tc = (const float*)(ws + T_TAILC);
      const float* ct = tc + (f3_grp ? TC_CTS : TC_CTP); const float* st = tc + (f3_grp ? TC_STS : TC_STP);
      const int NN = f3_grp ? 2048 : 1024;
      const float* tv = (const float*)(ws + T_TAILV) + (f3_grp ? 32768 : 0) + (size_t)f3_k1 * NN * 2;
      const float scale = f3_grp ? rsqrtf(128.0f * LS) : rsqrtf(128.0f * LP);
#pragma unroll
      for (int ai = 0; ai < 2; ++ai)
#pragma unroll
        for (int m = 0; m < 4; ++m) { asm volatile("" ::: "memory");
          const int k2 = f3_mt * 256 + wr * 64 + fr + ai * 128 + m * 16;
          const float c2 = ct[k2], s2 = st[k2]; const int pos = f3_k1 + 16 * k2;
#pragma unroll
          for (int bj = 0; bj < 2; ++bj)
#pragma unroll
            for (int n = 0; n < 2; ++n) {
              const int ni = f3_nt * 256 + bj * 128 + ccol + n * 16; const int sl = ni >> 9, c = ni & 511;
              const int row = (f3_grp ? 2 * LPP + sl * LPS : sl * LPP) + PADR + pos;
              const f32x4 t0 = *(const f32x4*)(tv + (size_t)ni * 2), t1 = *(const f32x4*)(tv + (size_t)ni * 2 + 4);
              const f32x4 a = acc[ai][bj][m][n];
              const float o0 = (a[0] + c2 * t0[0] + s2 * t0[1]) * scale, o1 = (a[1] + c2 * t0[2] + s2 * t0[3]) * scale,
                          o2 = (a[2] + c2 * t1[0] + s2 * t1[1]) * scale, o3 = (a[3] + c2 * t1[2] + s2 * t1[3]) * scale;
              u32x2 w; w.x = pack2(o0, o1); w.y = pack2(o2, o3);
              *(u32x2*)(mix + (size_t)row * 1024 + c) = w;
            }
        }
    }
  }
}

__device__ __forceinline__ void gemm_phase(const int kind, const int idx, const Params& p, LAS unsigned char* lds, const int seqid = 0) {
  unsigned char* ws = p.ws + opq0_(); unsigned char* r2 = (unsigned char*)p.out + opq0_();
  int nM = MT, nN = 4, K = 1024;
  const bf16_t* Wt = nullptr;
  switch (kind) {
    case K_UP: nN = 22; Wt = (const bf16_t*)(ws + (idx == 0 ? W0_F1UP : idx == 1 ? W0_F2UP : idx == 2 ? W1_F1UP : W1_F2UP)); break;
    case K_DN: nN = 4; K = FF; Wt = (const bf16_t*)(ws + (idx == 0 ? W0_F1DN : idx == 1 ? W0_F2DN : idx == 2 ? W1_F1DN : W1_F2DN)); break;
    case K_WINA: nN = 13; Wt = (const bf16_t*)(ws + W0_INA); break;
    case K_WINB: nN = 7; Wt = (const bf16_t*)(ws + W0_INB); break;
    case K_WOUT: nN = 4; Wt = (const bf16_t*)(ws + (idx == 0 ? W0_OUT : W1_OUT)); break;
    case K_WIN1: nN = 10; Wt = (const bf16_t*)(ws + W1_IN); break;
    case K_F3: nM = 1; nN = 256; break;
    default: nM = 4; nN = 4; K = 512; break;
  }
  const int U = nM * nN;
  for (int it = 0;; ++it) {
    int pm, pn;
    int khalf = -1;
    const bool split = kind == K_DN;
    if (split) {
      const LAS int* ctl = (const LAS int*)(lds + LDS_CTL);
      const int x = __builtin_amdgcn_readfirstlane(ctl[0]), slot = __builtin_amdgcn_readfirstlane(ctl[1]), nx = __builtin_amdgcn_readfirstlane(ctl[2]), ok = __builtin_amdgcn_readfirstlane(ctl[3]);
      int f = -1, hu = -1;
      if (ok) { const int li = it * nx + slot;
        if (li < 16 * nN) f = 16 * nN * x + li;
        else { const int hs = (6 * nN * x) >> 3, he = (6 * nN * (x + 1)) >> 3, j = li - 16 * nN; if (j < he - hs) hu = hs + j; else break; } }
      else { const int l = it * (int)gridDim.x + bidx_(); if (l < 128 * nN) f = l; else if (l < 134 * nN) hu = l - 128 * nN; else break; }
      if (f >= 0) { const int nig = 8 * nN, gid = f / nig, within = f % nig; pm = gid * 8 + (within & 7); pn = within >> 3; }
      else { const int u = hu >> 1; khalf = hu & 1; pm = 128 + u % 3; pn = u / 3; }
    } else if (!unit_for(it, U, nM, nN, pm, pn, lds)) break;
    const bf16_t* A; const bf16_t* Bt; int lda, ldb;
    int f3_k1 = 0, f3_mt = 0, f3_nt = 0, f3_grp = 0;
    if (kind == K_F3) {
      const int u = pn;
      if (u < 128) { f3_grp = 0; f3_k1 = u >> 3; f3_mt = (u >> 2) & 1; f3_nt = u & 3;
        A = (const bf16_t*)(ws + T_ADFTP) + (size_t)f3_mt * 256 * 1024; lda = 1024; Bt = (const bf16_t*)(r2 + R2_BTFP) + ((size_t)f3_k1 * 1024 + f3_nt * 256) * 1024; ldb = 1024; K = 1024; }
      else { const int v = u - 128; f3_grp = 1; f3_k1 = v >> 3; f3_mt = 0; f3_nt = v & 7;
        A = (const bf16_t*)(ws + T_ADFTS); lda = 512; Bt = (const bf16_t*)(ws + R1_BTFS) + ((size_t)f3_k1 * 2048 + f3_nt * 256) * 512; ldb = 512; K = 512; }
    } else if (kind == K_DN) {
      A = pm < MT_A ? (const bf16_t*)(ws + R1_ACTA) + (size_t)pm * 256 * FF : (const bf16_t*)(r2 + R2_ACTB) + (size_t)(pm - MT_A) * 256 * FF; lda = FF;
      Bt = Wt + (size_t)pn * 256 * FF; ldb = FF;
      K = FF;
    } else if (kind == K_WOUT) {
      A = (const bf16_t*)(ws + R1_MIX) + (size_t)pm * 256 * 1024; lda = 1024; Bt = Wt + (size_t)pn * 256 * 1024; ldb = 1024;
    } else if (kind == K_FOLD) {
      A = (const bf16_t*)(ws + T_FT) + (size_t)pm * 256 * 512; lda = 512; Bt = (const bf16_t*)(ws + T_WTMP) + (size_t)pn * 256 * 512; ldb = 512;
    } else {
      A = (const bf16_t*)(ws + OFF_H) + (size_t)pm * 256 * 1024; lda = 1024; Bt = Wt + (size_t)pn * 256 * 1024; ldb = 1024;
    }
    const bool tA = kind == K_UP || kind == K_DN || kind == K_WINA || kind == K_WINB || kind == K_WIN1;
    const bool tB = tA || kind == K_WOUT;
    const int KF = K;
    if (khalf >= 0) { const int hk = (K >> 7) * khalf; K >>= 1; A += tA ? (size_t)hk * 8192 : (size_t)hk * 64; Bt += (size_t)hk * 8192; }
    if (kind == K_UP || kind == K_WINA || kind == K_WINB || kind == K_WIN1) {
      const int t = tidx_(); if (t < 256) ((LAS float*)(lds + LDS_RSTD))[t] = row_rstd((const float*)(ws + T_ROWSQ), pm * 256 + t);
    }
    f32x4 acc[2][2][4][2];
    gemm_core(A, tA ? 64 : lda, tA ? (size_t)16384 : (size_t)128, tA ? (size_t)(KF >> 6) * 16384 : (size_t)128 * lda * 2,
              Bt, tB ? 64 : ldb, tB ? (size_t)16384 : (size_t)128, tB ? (size_t)(KF >> 6) * 16384 : (size_t)128 * ldb * 2, K, lds, acc);
    const float* partial = nullptr;
    if (khalf >= 0) {
      const int u = (pm - 128) + 3 * pn; const int t = tidx_();
      float* scr = (float*)(r2 + R2_SPLITK) + (size_t)u * 65536;
      unsigned* flag = (unsigned*)(ws + T_BAR + 13824) + u;
      if (khalf == 0) {
#pragma unroll
        for (int a = 0; a < 2; ++a)
#pragma unroll
          for (int b = 0; b < 2; ++b)
#pragma unroll
            for (int m = 0; m < 4; ++m)
#pragma unroll
              for (int n = 0; n < 2; ++n) *(f32x4*)(scr + (size_t)((((a * 2 + b) * 4 + m) * 2 + n) * 512 + t) * 4) = acc[a][b][m][n];
        asm volatile("s_waitcnt vmcnt(0)" ::: "memory");
        __syncthreads();
        if (t == 0) { __builtin_amdgcn_fence(__ATOMIC_RELEASE, "agent"); asm volatile("s_waitcnt vmcnt(0)" ::: "memory"); __hip_atomic_store(flag, (unsigned)seqid, __ATOMIC_RELAXED, __HIP_MEMORY_SCOPE_AGENT); }
        __syncthreads();
        continue;
      } else {
        if (t == 0) { unsigned sp = 0; while (__hip_atomic_load(flag, __ATOMIC_RELAXED, __HIP_MEMORY_SCOPE_AGENT) < (unsigned)seqid) { __builtin_amdgcn_s_sleep(2); if (++sp > (1u << 24)) break; }
          __builtin_amdgcn_fence(__ATOMIC_ACQUIRE, "agent"); asm volatile("s_waitcnt vmcnt(0)" ::: "memory"); }
        __syncthreads();
        partial = scr;
      }
    }
    { F3Info f3; f3.grp = f3_grp; f3.k1 = f3_k1; f3.mt = f3_mt; f3.nt = f3_nt; gemm_epilogue(kind, pm, pn, f3, acc, ws, r2, lds, partial); }
    WAIT_V(0);
    __syncthreads();
  }
}

__device__ __forceinline__ void gemm_phase_stream(const int kind, const int idx, const Params& p, LAS unsigned char* lds) {
  unsigned char* ws = p.ws + opq0_(); unsigned char* r2 = (unsigned char*)p.out + opq0_();
  int nM = MT, nN = 4, K = 1024, lda = 1024, ldb = 1024;
  const bf16_t* Wt = nullptr;
  switch (kind) {
    case K_UP: nN = 22; Wt = (const bf16_t*)(ws + (idx == 0 ? W0_F1UP : idx == 1 ? W0_F2UP : idx == 2 ? W1_F1UP : W1_F2UP)); break;
    case K_DN: nN = 4; K = FF; lda = FF; ldb = FF; Wt = (const bf16_t*)(ws + (idx == 0 ? W0_F1DN : idx == 1 ? W0_F2DN : idx == 2 ? W1_F1DN : W1_F2DN)); break;
    case K_WINA: nN = 13; Wt = (const bf16_t*)(ws + W0_INA); break;
    case K_WINB: nN = 7; Wt = (const bf16_t*)(ws + W0_INB); break;
    case K_WOUT: nN = 4; Wt = (const bf16_t*)(ws + (idx == 0 ? W0_OUT : W1_OUT)); break;
    default: nN = 10; Wt = (const bf16_t*)(ws + W1_IN); break;
  }
  const int U = nM * nN;
  int pm, pn;
  if (!unit_for(0, U, nM, nN, pm, pn, lds)) return;
  const int KB = K >> 6;
  const bool tiledA = kind != K_WOUT;
  auto ptrA = [&](int m) -> const char* {
    if (kind == K_DN) return (const char*)(m < MT_A ? (const bf16_t*)(ws + R1_ACTA) + (size_t)m * 256 * FF : (const bf16_t*)(r2 + R2_ACTB) + (size_t)(m - MT_A) * 256 * FF);
    if (kind == K_WOUT) return (const char*)((const bf16_t*)(ws + R1_MIX) + (size_t)m * 256 * 1024);
    return (const char*)((const bf16_t*)(ws + OFF_H) + (size_t)m * 256 * 1024); };
  auto ptrB = [&](int n) -> const char* { return (const char*)(Wt + (size_t)n * 256 * ldb); };
  const int tid = tidx_(), wid = tid >> 6, lane = tid & 63, wr = wid >> 2, wc = wid & 3, fr = lane & 15, fq = lane >> 4;
  unsigned voffA[2], voffB[2];
#pragma unroll
  for (int i = 0; i < 2; ++i) { int R, C; stage_rc(tid * 16 + i * 8192, R, C); voffA[i] = (unsigned)(R * (tiledA ? 64 : lda) + C) * 2u; voffB[i] = (unsigned)(R * 64 + C) * 2u; }
  const unsigned ldsw = (unsigned)wid * 1024u;
  const int aoff = lds_byte(wr * 64 + fr, fq * 8), boff = lds_byte(wc * 32 + fr, fq * 8);
  const size_t hA = tiledA ? (size_t)KB * 16384 : (size_t)128 * lda * 2, hB = (size_t)KB * 16384, kstepA = tiledA ? 16384 : 128, kstepB = 16384;
  const int nt = K / 64;
  const char* cA = ptrA(pm); const char* cB = ptrB(pn);
  f32x4 acc[2][2][4][2];
#pragma unroll
  for (int a = 0; a < 2; ++a)
#pragma unroll
    for (int b = 0; b < 2; ++b)
#pragma unroll
      for (int m = 0; m < 4; ++m)
#pragma unroll
        for (int n = 0; n < 2; ++n) acc[a][b][m][n] = (f32x4){0.f, 0.f, 0.f, 0.f};
  bf16x8 At[4][2], B0[2][2], B1[2][2];
  STAGE_(SB_(0, 0), cB, voffB); STAGE_(SA_(0, 0), cA, voffA); STAGE_(SB_(0, 1), cB + hB, voffB); STAGE_(SA_(0, 1), cA + hA, voffA);
  if (wr == 1) BAR_;
  WAIT_V(4); BAR_;
  STAGE_(SB_(1, 0), cB + kstepB, voffB); STAGE_(SA_(1, 0), cA + kstepA, voffA); STAGE_(SB_(1, 1), cB + hB + kstepB, voffB);
  WAIT_V(6); BAR_;
  int it = 0;
  for (;;) {
    int pm2 = 0, pn2 = 0;
    const bool has_next = unit_for(it + 1, U, nM, nN, pm2, pn2, lds);
    const char* nA = has_next ? ptrA(pm2) : cA; const char* nB = has_next ? ptrB(pn2) : cB;
    for (int t = 0; t < nt; t += 2) {
      const bool last = (t == nt - 2);
      const char* a1 = cA + (size_t)(t + 1) * kstepA;
      const char* a2 = last ? nA : cA + (size_t)(t + 2) * kstepA; const char* b2 = last ? nB : cB + (size_t)(t + 2) * kstepB;
      const char* a3 = a2 + kstepA; const char* b3 = b2 + kstepB;
      LDB_(B0, 0, 0); SCHED_; LDA_(At, 0, 0); STAGE_(SA_(1, 1), a1 + hA, voffA);
      WAIT_L(8); BAR_; WAIT_L(0); MMA_(0, 0, At, B0); BAR_; SCHED_;
      LDB_(B1, 0, 1); STAGE_(SB_(0, 0), b2, voffB);
      BAR_; WAIT_L(0); MMA_(0, 1, At, B1); BAR_;
      LDA_(At, 0, 1); STAGE_(SA_(0, 0), a2, voffA);
      BAR_; WAIT_L(0); MMA_(1, 0, At, B0); BAR_; SCHED_;
      STAGE_(SB_(0, 1), b2 + hB, voffB);
      WAIT_V(6); BAR_; MMA_(1, 1, At, B1); BAR_;
      LDB_(B0, 1, 0); SCHED_; LDA_(At, 1, 0); STAGE_(SA_(0, 1), a2 + hA, voffA);
      WAIT_L(8); BAR_; WAIT_L(0); MMA_(0, 0, At, B0); BAR_; SCHED_;
      LDB_(B1, 1, 1); STAGE_(SB_(1, 0), b3, voffB);
      BAR_; WAIT_L(0); MMA_(0, 1, At, B1); BAR_;
      LDA_(At, 1, 1); STAGE_(SA_(1, 0), a3, voffA);
      BAR_; WAIT_L(0); MMA_(1, 0, At, B0); BAR_; SCHED_;
      STAGE_(SB_(1, 1), b3 + hB, voffB);
      WAIT_V(6); BAR_; MMA_(1, 1, At, B1); BAR_;
    }
    { unsigned char* ws2 = ws + opq0_(); unsigned char* r22 = r2 + opq0_();
      F3Info f3; f3.grp = 0; f3.k1 = 0; f3.mt = 0; f3.nt = 0; gemm_epilogue(kind, pm, pn, f3, acc, ws2, r22, lds); }
    if (!has_next) break;
#pragma unroll
    for (int a = 0; a < 2; ++a)
#pragma unroll
      for (int b = 0; b < 2; ++b)
#pragma unroll
        for (int m = 0; m < 4; ++m)
#pragma unroll
          for (int n = 0; n < 2; ++n) acc[a][b][m][n] = (f32x4){0.f, 0.f, 0.f, 0.f};
    pm = pm2; pn = pn2; cA = nA; cB = nB; ++it;
  }
  WAIT_V(0);
  if (wr == 0) BAR_;
  BAR_;
  __syncthreads();
}
enum { CM_ID = 0, CM_ROPE = 1 };
struct Job { const float* src; const float* src2; const float* gain; bf16_t* dst; int ldw, K, Np, cm, off, half2; };
__device__ __forceinline__ void conv_tile(const Job& jb, int tn, int tk, LAS unsigned char* lds) {
  LAS float* tile = (LAS float*)lds;
  const int tid = tidx_();
  const int nn = tid & 63, n = tn * 64 + nn;
  const float* src = jb.src; int c;
  if (jb.half2 & 1) { const int t = n >> 8, r = n & 255; if (r >= 128) { src = jb.src2; c = (jb.half2 >> 1) + t * 128 + (r - 128); } else c = jb.off + t * 128 + r; }
  else if (jb.cm == CM_ROPE) { const int pnq = n >> 8, r = n & 255, bj = r >> 7, wc = (r >> 5) & 3, nq = (r >> 4) & 1, i = r & 15, g = bj * 4 + wc;
    c = jb.off + pnq * 256 + (g >> 1) * 64 + nq * 32 + (g & 1) * 16 + i; }
  else c = jb.off + n;
#pragma unroll
  for (int i = 0; i < 8; ++i) { const int kk = i * 8 + (tid >> 6), k = tk * 64 + kk;
    float v = src[(size_t)k * jb.ldw + c]; if (jb.gain) v *= jb.gain[k]; tile[nn * 65 + kk] = v; }
  __syncthreads();
  { const int r = tid >> 3, kc = (tid & 7) * 8; u32x4 w;
    w.x = pack2(tile[r * 65 + kc + 0], tile[r * 65 + kc + 1]); w.y = pack2(tile[r * 65 + kc + 2], tile[r * 65 + kc + 3]);
    w.z = pack2(tile[r * 65 + kc + 4], tile[r * 65 + kc + 5]); w.w = pack2(tile[r * 65 + kc + 6], tile[r * 65 + kc + 7]);
    *(u32x4*)(jb.dst + tix(tn * 64 + r, tk * 64 + kc, jb.K >> 6)) = w; }
  __syncthreads();
}
__device__ __forceinline__ Job mkjob(const float* s, const float* s2, const float* g, bf16_t* d, int ldw, int K, int Np, int cm, int off, int half2) {
  Job j; j.src = s; j.src2 = s2; j.gain = g; j.dst = d; j.ldw = ldw; j.K = K; j.Np = Np; j.cm = cm; j.off = off; j.half2 = half2; return j; }
__device__ __forceinline__ Job get_job(const Params& p, int set, int j, bool tab) {
  unsigned char* ws = p.ws + opq0_();
#define IN0(i) (tab ? inp(ws, i) : p.in[i])
  if (set == 0) {
    switch (j) {
      case 0: return mkjob(IN0(4), IN0(5), IN0(3), (bf16_t*)(ws + W0_F1UP), FF, 1024, 5632, 0, 0, 1);
      case 1: return mkjob(IN0(6), nullptr, nullptr, (bf16_t*)(ws + W0_F1DN), 1024, FF, 1024, 0, 0, 0);
      case 2: return mkjob(IN0(8), nullptr, IN0(7), (bf16_t*)(ws + W0_INA), 3328, 1024, 512, CM_ROPE, 0, 0);
      case 3: return mkjob(IN0(8), nullptr, IN0(7), (bf16_t*)(ws + W0_INA) + (size_t)512 * 1024, 3328, 1024, 1024, 0, 512, 0);
      case 4: return mkjob(IN0(8), nullptr, IN0(7), (bf16_t*)(ws + W0_INB), 3328, 1024, 1792, 0, 1536, 0);
      case 5: return mkjob(IN0(9), nullptr, nullptr, (bf16_t*)(ws + W0_OUT), 1024, 1024, 1024, 0, 0, 0);
      case 6: return mkjob(IN0(22), IN0(23), IN0(21), (bf16_t*)(ws + W0_F2UP), FF, 1024, 5632, 0, 0, 1);
      default: return mkjob(IN0(24), nullptr, nullptr, (bf16_t*)(ws + W0_F2DN), 1024, FF, 1024, 0, 0, 0);
    }
  } else {
    switch (j) {
      case 0: return mkjob(inp(ws, 26), inp(ws, 27), inp(ws, 25), (bf16_t*)(ws + W1_F1UP), FF, 1024, 5632, 0, 0, 1);
      case 1: return mkjob(inp(ws, 28), nullptr, nullptr, (bf16_t*)(ws + W1_F1DN), 1024, FF, 1024, 0, 0, 0);
      case 2: return mkjob(inp(ws, 30), nullptr, inp(ws, 29), (bf16_t*)(ws + W1_IN) + (size_t)1024 * 1024, 2048, 1024, 512, 0, 512, 0);
      case 3: return mkjob(inp(ws, 30), inp(ws, 30), inp(ws, 29), (bf16_t*)(ws + W1_IN) + (size_t)1536 * 1024, 2048, 1024, 1024, 0, 1024, 1 | (1536 << 1));
      case 4: return mkjob(inp(ws, 31), nullptr, nullptr, (bf16_t*)(ws + W1_OUT), 1024, 1024, 1024, 0, 0, 0);
      case 5: return mkjob(inp(ws, 34), inp(ws, 35), inp(ws, 33), (bf16_t*)(ws + W1_F2UP), FF, 1024, 5632, 0, 0, 1);
      case 6: return mkjob(inp(ws, 36), nullptr, nullptr, (bf16_t*)(ws + W1_F2DN), 1024, FF, 1024, 0, 0, 0);
      default: return mkjob(inp(ws, 32), nullptr, nullptr, nullptr, 0, 0, 0, 0, 0, 0);
    }
  }
}
__device__ __forceinline__ void prep_weights(const Params& p, int set, LAS unsigned char* lds) {
  const int j0 = set == 2 ? 4 : set == 3 ? 5 : 0, j1 = set == 0 ? 4 : set == 2 ? 5 : set == 3 ? 8 : 7;
  int base = 0;
  for (int j = j0; j < j1; ++j) {
    const Job jb = get_job(p, set == 1 ? 1 : 0, j, set != 0);
    const int tn = jb.Np / 64, tk = jb.K / 64, nt = tn * tk;
    const int G = gdim_();
    int t0 = (bidx_() - base % G + G) % G;
    for (int t = t0; t < nt; t += G) conv_tile(jb, t / tk, t % tk, lds);
    base += nt;
  }
}

__device__ __forceinline__ void prep_misc(const Params& p) {
  unsigned char* ws = p.ws + opq0_();
  const int tid = tidx_(), lane = tid & 63, gw = bidx_() * 8 + (tid >> 6), nw = gridDim.x * 8;
  bf16_t* h = (bf16_t*)(ws + OFF_H); float* rowsq = (float*)(ws + T_ROWSQ);
  for (int row = gw; row < MROWS; row += nw) {
    int seq, pos, L; row_info(row, seq, pos, L);
    const float* src = nullptr;
    if (pos >= 16) src = (seq < 2 ? p.in[0] + ((size_t)seq * 8192 + (pos - 16)) * 1024 : p.in[1] + ((size_t)(seq - 2) * 4096 + (pos - 16)) * 1024);
    else if (pos >= 0) src = p.in[2] + (size_t)pos * 1024;
    float ss = 0.f;
#pragma unroll
    for (int i = 0; i < 4; ++i) {
      const int c = i * 256 + lane * 4;
      f32x4 v = (f32x4){0.f, 0.f, 0.f, 0.f}; if (src) v = *(const f32x4*)(src + c);
      u32x2 w; w.x = pack2(v[0], v[1]); w.y = pack2(v[2], v[3]);
      *(u32x2*)(h + tix(row, c, 16)) = w;
      const float a = bflo(w.x), b = bfhi(w.x), cc = bflo(w.y), d = bfhi(w.y); ss += (a * a + b * b) + (cc * cc + d * d);
    }
#pragma unroll
    for (int o = 32; o >= 1; o >>= 1) ss += shx(ss, o, lane);
    if (lane < 16) rowsq[(size_t)row * 16 + lane] = lane == 0 ? ss : 0.f;
  }
  const int gt = bidx_() * 512 + tid, ngt = gridDim.x * 512;
  if (gt == 0) {
#pragma unroll
    for (int i = 0; i < 38; ++i) ((unsigned long long*)(ws + T_PTR))[i] = (unsigned long long)p.in[i];
  }
  { float* rc = (float*)(ws + T_ROPE); float* rs = rc + (size_t)LP * 32;
    for (int i = gt; i < LP * 32; i += ngt) { const int pos = i >> 5, d = i & 31; const float inv = powf(10000.0f, -(float)d / 32.0f); const float ang = (float)pos * inv; rc[i] = cosf(ang); rs[i] = sinf(ang); } }
  { bf16_t* a = (bf16_t*)(ws + T_ADFTP);
    for (int i = gt; i < 512 * 1024; i += ngt) { const int k2 = i >> 10, kk = i & 1023, n2 = kk & 511; const int mm = (k2 * n2) % 513; const float x = 2.0f * (float)mm / 513.0f; a[i] = f2bf(kk < 512 ? cospif(x) : sinpif(x)); }
    bf16_t* b = (bf16_t*)(ws + T_ADFTS);
    for (int i = gt; i < 256 * 512; i += ngt) { const int k2 = i >> 9, kk = i & 511, n2 = kk & 255; const int mm = (k2 * n2) % 257; const float x = 2.0f * (float)mm / 257.0f; b[i] = f2bf(kk < 256 ? cospif(x) : sinpif(x)); } }
  { bf16_t* f = (bf16_t*)(ws + T_FT);
    for (int i = gt; i < 1024 * 512; i += ngt) { const int np = i >> 9, kc = i & 511, part = np >> 9, g = (np >> 7) & 3, cp = np & 127, g2 = kc >> 7, c = kc & 127;
      float v = 0.f; if (g2 == g) { const float x = 2.0f * (float)((c * cp) & 127) / 128.0f; v = part == 0 ? cospif(x) : -sinpif(x); } f[i] = f2bf(v); } }
  { bf16_t* w = (bf16_t*)(ws + T_WTMP); const float* src = p.in[30]; const float* g = p.in[29];
    for (int i = gt; i < 1024 * 512; i += ngt) { const int k = i >> 9, c = i & 511; w[i] = f2bf(g[k] * src[(size_t)k * 2048 + c]); } }
  { float* tp = (float*)(ws + T_TWP); for (int i = gt; i < 16 * 513; i += ngt) { const int k1 = i / 513, n2 = i % 513; const float x = 2.0f * (float)(k1 * n2) / (float)LP; tp[2 * i] = cospif(x); tp[2 * i + 1] = sinpif(x); }
    float* ts = (float*)(ws + T_TWS); for (int i = gt; i < 16 * 257; i += ngt) { const int k1 = i / 257, n2 = i % 257; const float x = 2.0f * (float)(k1 * n2) / (float)LS; ts[2 * i] = cospif(x); ts[2 * i + 1] = sinpif(x); } }
  { float* tc = (float*)(ws + T_TAILC);
    for (int i = gt; i < 513; i += ngt) { const float x = 2.0f * (float)((i * 512) % 513) / 513.0f; const float c = cospif(x), s = sinpif(x);
      if (i < 512) { tc[TC_CTP + i] = c; tc[TC_STP + i] = s; } tc[TC_ARCP + i] = c; tc[TC_ARSP + i] = s; }
    for (int i = gt; i < 257; i += ngt) { const float x = 2.0f * (float)((i * 256) % 257) / 257.0f; const float c = cospif(x), s = sinpif(x);
      if (i < 256) { tc[TC_CTS + i] = c; tc[TC_STS + i] = s; } tc[TC_ARCS + i] = c; tc[TC_ARSS + i] = s; } }
  { bf16_t* g2t = (bf16_t*)(ws + T_G2T); const float* g2 = p.in[15]; for (int i = gt; i < 512 * 128; i += ngt) { const int c = i >> 7, r = i & 127; g2t[i] = f2bf(g2[(size_t)r * 512 + c]); } }
}
__device__ __forceinline__ void ret_unit(int uid, int& seq, int& chunk, int& head, int& cidx) {
  if (uid < 520) { seq = uid / 260; const int rem = uid % 260; chunk = rem >> 2; head = rem & 3; cidx = seq * 65 + chunk; }
  else { const int v = uid - 520; const int s = v / 132; seq = 2 + s; const int rem = v % 132; chunk = rem >> 2; head = rem & 3; cidx = 130 + s * 33 + chunk; }
}
__device__ __forceinline__ float ret_lg(int head) { return log1pf(-exp2f(-5.0f - (float)head)); }
constexpr int VT_LD = 136;

__device__ __forceinline__ void load_vT(const bf16_t* mix, int row0, int head, LAS bf16_t* vT) {
  const int tid = tidx_(), j = tid >> 2, e0 = (tid & 3) * 32;
  const u32x4* src = (const u32x4*)(mix + (size_t)(row0 + j) * 1024 + head * 128 + e0);
#pragma unroll
  for (int q = 0; q < 4; ++q) { const u32x4 v = src[q]; const unsigned w[4] = {v.x, v.y, v.z, v.w};
#pragma unroll
    for (int t = 0; t < 4; ++t) { vT[(e0 + q * 8 + t * 2) * VT_LD + j] = (bf16_t)(w[t] & 0xffff); vT[(e0 + q * 8 + t * 2 + 1) * VT_LD + j] = (bf16_t)(w[t] >> 16); } }
}

__device__ __forceinline__ void ret_kv_phase(const Params& p, LAS unsigned char* lds) {
  unsigned char* ws = p.ws + opq0_(); unsigned char* r2 = (unsigned char*)p.out + opq0_();
  const bf16_t* mix = (const bf16_t*)(ws + R1_MIX); const bf16_t* qk = (const bf16_t*)(ws + R1_QK);
  bf16_t* kvf = (bf16_t*)(ws + R1_KVF); bf16_t* kvb = (bf16_t*)(ws + R1_KVB);
  LAS bf16_t* vT = (LAS bf16_t*)lds; LAS bf16_t* kTf = vT + 128 * VT_LD; LAS bf16_t* kTb = kTf + 64 * VT_LD;
  const int tid = tidx_(), wid = tid >> 6, lane = tid & 63, fr = lane & 15, fq = lane >> 4;
  for (int uid = bidx_(); uid < 1048; uid += gridDim.x) {
    int seq, chunk, head, cidx; ret_unit(uid, seq, chunk, head, cidx);
    const int row0 = cidx * 128; const float lg = ret_lg(head);
    __syncthreads();
    load_vT(mix, row0, head, vT);
    { const int j = tid >> 2, d0 = (tid & 3) * 16;
      const float df = __expf(lg * (float)(127 - j)), db = __expf(lg * (float)j);
      const u32x4* src = (const u32x4*)(qk + (size_t)(row0 + j) * 512 + 256 + head * 64 + d0);
#pragma unroll
      for (int q = 0; q < 2; ++q) { const u32x4 v = src[q]; const unsigned w[4] = {v.x, v.y, v.z, v.w};
#pragma unroll
        for (int t = 0; t < 4; ++t) { const float lo = bflo(w[t]), hi = bfhi(w[t]); const int d = d0 + q * 8 + t * 2;
          kTf[d * VT_LD + j] = f2bf(lo * df); kTf[(d + 1) * VT_LD + j] = f2bf(hi * df);
          kTb[d * VT_LD + j] = f2bf(lo * db); kTb[(d + 1) * VT_LD + j] = f2bf(hi * db); } } }
    __syncthreads();
    f32x4 af[4], ab[4];
#pragma unroll
    for (int m = 0; m < 4; ++m) { af[m] = (f32x4){0.f, 0.f, 0.f, 0.f}; ab[m] = (f32x4){0.f, 0.f, 0.f, 0.f}; }
#pragma unroll
    for (int ks = 0; ks < 4; ++ks) {
      const bf16x8 y = *(const LAS bf16x8*)(vT + (wid * 16 + fr) * VT_LD + ks * 32 + fq * 8);
#pragma unroll
      for (int m = 0; m < 4; ++m) {
        const bf16x8 xf = *(const LAS bf16x8*)(kTf + (m * 16 + fr) * VT_LD + ks * 32 + fq * 8);
        const bf16x8 xb = *(const LAS bf16x8*)(kTb + (m * 16 + fr) * VT_LD + ks * 32 + fq * 8);
        af[m] = mfma16(xf, y, af[m]); ab[m] = mfma16(xb, y, ab[m]);
      }
    }
    const size_t o = ((size_t)(cidx * 4 + head) * 128 + wid * 16 + fr) * 64;
#pragma unroll
    for (int m = 0; m < 4; ++m) { u32x2 w; w.x = pack2(af[m][0], af[m][1]); w.y = pack2(af[m][2], af[m][3]); *(u32x2*)(kvf + o + m * 16 + fq * 4) = w;
      w.x = pack2(ab[m][0], ab[m][1]); w.y = pack2(ab[m][2], ab[m][3]); *(u32x2*)(kvb + o + m * 16 + fq * 4) = w; }
  }
}

__device__ __forceinline__ void ret_scan_phase(const Params& p) {
  unsigned char* ws = p.ws + opq0_();
  const int gt = bidx_() * 512 + tidx_(), ngt = gridDim.x * 512;
  for (int w = gt; w < 2 * 24 * 2048; w += ngt) {
    const int dir = w / (24 * 2048), rem = w % (24 * 2048), sh = rem >> 11, eg = rem & 2047, seq = sh >> 2, head = sh & 3;
    const int n = seq < 2 ? 65 : 33, cb = seq < 2 ? seq * 65 : 130 + (seq - 2) * 33;
    bf16_t* base = (bf16_t*)(ws + (dir ? R1_KVB : R1_KVF)) + (size_t)head * 8192 + eg * 4;
    const float gc = __expf(128.0f * ret_lg(head));
    float s0 = 0.f, s1 = 0.f, s2 = 0.f, s3 = 0.f;
    for (int i = 0; i < n; ++i) {
      const int c = dir ? n - 1 - i : i;
      u32x2* ptr = (u32x2*)(base + (size_t)(cb + c) * 4 * 8192);
      const u32x2 x = *ptr;
      u32x2 o; o.x = pack2(s0, s1); o.y = pack2(s2, s3); *ptr = o;
      s0 = gc * s0 + bflo(x.x); s1 = gc * s1 + bfhi(x.x); s2 = gc * s2 + bflo(x.y); s3 = gc * s3 + bfhi(x.y);
    }
  }
}

__device__ __forceinline__ bf16x8 scale_frag(bf16x8 v, float s) {
  bf16x8 o;
#pragma unroll
  for (int i = 0; i < 8; ++i) o[i] = (short)f2bf(bf2f((bf16_t)v[i]) * s);
  return o;
}

__device__ __forceinline__ void ret_out_phase(const Params& p, LAS unsigned char* lds) {
  unsigned char* ws = p.ws + opq0_(); unsigned char* r2 = (unsigned char*)p.out + opq0_();
  bf16_t* mix = (bf16_t*)(ws + R1_MIX); const bf16_t* qk = (const bf16_t*)(ws + R1_QK);
  const bf16_t* kvf = (const bf16_t*)(ws + R1_KVF); const bf16_t* kvb = (const bf16_t*)(ws + R1_KVB);
  LAS bf16_t* vT = (LAS bf16_t*)lds; LAS bf16_t* Pm = vT + 128 * VT_LD;
  const int tid = tidx_(), wid = tid >> 6, lane = tid & 63, fr = lane & 15, fq = lane >> 4;
  for (int uid = bidx_(); uid < 1048; uid += gridDim.x) {
    int seq, chunk, head, cidx; ret_unit(uid, seq, chunk, head, cidx);
    const int row0 = cidx * 128; const float lg = ret_lg(head);
    __syncthreads();
    load_vT(mix, row0, head, vT);
    bf16x8 qf[2];
#pragma unroll
    for (int ks = 0; ks < 2; ++ks) qf[ks] = *(const bf16x8*)(qk + (size_t)(row0 + wid * 16 + fr) * 512 + head * 64 + ks * 32 + fq * 8);
    f32x4 acc[8];
#pragma unroll
    for (int nt = 0; nt < 8; ++nt) {
      acc[nt] = (f32x4){0.f, 0.f, 0.f, 0.f};
#pragma unroll
      for (int ks = 0; ks < 2; ++ks) { const bf16x8 kf = *(const bf16x8*)(qk + (size_t)(row0 + nt * 16 + fr) * 512 + 256 + head * 64 + ks * 32 + fq * 8); acc[nt] = mfma16(qf[ks], kf, acc[nt]); }
    }
#pragma unroll
    for (int nt = 0; nt < 8; ++nt)
#pragma unroll
      for (int r = 0; r < 4; ++r) { const int i = wid * 16 + fq * 4 + r, j = nt * 16 + fr; const int dd = i > j ? i - j : j - i;
        Pm[i * VT_LD + j] = f2bf(acc[nt][r] * __expf(lg * (float)dd)); }
    __syncthreads();
    const int irow = wid * 16 + fr;
    const float g1 = __expf(lg * (float)(irow + 1)), g2 = __expf(lg * (float)(128 - irow));
    bf16x8 q1[2], q2[2];
#pragma unroll
    for (int ks = 0; ks < 2; ++ks) { q1[ks] = scale_frag(qf[ks], g1); q2[ks] = scale_frag(qf[ks], g2); }
    bf16x8 pf[4];
#pragma unroll
    for (int ks = 0; ks < 4; ++ks) pf[ks] = *(const LAS bf16x8*)(Pm + irow * VT_LD + ks * 32 + fq * 8);
    const bf16_t* sp = kvf + (size_t)(cidx * 4 + head) * 8192; const bf16_t* sn = kvb + (size_t)(cidx * 4 + head) * 8192;
    float ssq[4] = {0.f, 0.f, 0.f, 0.f};
#pragma unroll
    for (int nt = 0; nt < 8; ++nt) {
      f32x4 a = (f32x4){0.f, 0.f, 0.f, 0.f};
#pragma unroll
      for (int ks = 0; ks < 4; ++ks) { const bf16x8 y = *(const LAS bf16x8*)(vT + (nt * 16 + fr) * VT_LD + ks * 32 + fq * 8); a = mfma16(pf[ks], y, a); }
#pragma unroll
      for (int ks = 0; ks < 2; ++ks) { const bf16x8 y1 = *(const bf16x8*)(sp + (size_t)(nt * 16 + fr) * 64 + ks * 32 + fq * 8); a = mfma16(q1[ks], y1, a);
        const bf16x8 y2 = *(const bf16x8*)(sn + (size_t)(nt * 16 + fr) * 64 + ks * 32 + fq * 8); a = mfma16(q2[ks], y2, a); }
      acc[nt] = a;
#pragma unroll
      for (int r = 0; r < 4; ++r) ssq[r] += a[r] * a[r];
    }
#pragma unroll
    for (int r = 0; r < 4; ++r) { ssq[r] = rowsum16(ssq[r]); ssq[r] = rsqrtf(ssq[r] * (1.0f / 128.0f) + 1e-5f); }
    __syncthreads();
#pragma unroll
    for (int nt = 0; nt < 8; ++nt)
#pragma unroll
      for (int r = 0; r < 4; ++r) {
        const int i = wid * 16 + fq * 4 + r, e = nt * 16 + fr;
        bf16_t* dst = mix + (size_t)(row0 + i) * 1024 + head * 128 + e;
        const float gr = bf2f(dst[512]);
        *dst = f2bf(acc[nt][r] * ssq[r] * gr * sigmoidf_(gr));
      }
  }
}
__device__ __forceinline__ float tanh_fast(float x) { x = fminf(fmaxf(x, -15.f), 15.f); const float e = __expf(2.0f * x); return (e - 1.0f) * rcpf_(e + 1.0f); }
__device__ __forceinline__ f32x4 ld_bf4(const LAS bf16_t* p) { const u32x2 v = *(const LAS u32x2*)p; return (f32x4){bflo(v.x), bfhi(v.x), bflo(v.y), bfhi(v.y)}; }

__device__ __forceinline__ void rwkv_scan_phase(const Params& p, LAS unsigned char* lds) {
  unsigned char* ws = p.ws + opq0_(); unsigned char* r2 = (unsigned char*)p.out + opq0_();
  const bf16_t* prw = (const bf16_t*)(r2 + R2_PRW);
  float* bonus = (float*)(ws + T_BONUS);
  LAS bf16_t* raw = (LAS bf16_t*)lds;
  LAS bf16_t* txw = (LAS bf16_t*)(lds + 21760);
  LAS bf16_t* xab = (LAS bf16_t*)(lds + 26368);
  LAS bf16_t* w2s = (LAS bf16_t*)(lds + 30976);
  LAS bf16_t* a2s = (LAS bf16_t*)(lds + 40192);
  LAS float* pre = (LAS float*)(lds + 49408);
  LAS float* st = (LAS float*)(lds + 65792);
  LAS float* vbuf = (LAS float*)(lds + 106752);
  LAS float* sc = (LAS float*)(lds + 114944);
  LAS float* obuf = (LAS float*)(lds + 115456);
  const int tid = tidx_(), wid = tid >> 6, lane = tid & 63, fr = lane & 15, fq = lane >> 4;
  const float* mu = inp(ws, 10);
  for (int wi = bidx_(); wi < 256; wi += gridDim.x) {
    int dir, seq, head, rbase, NRW, L, rsplit;
    if (wi < 128) { const int chain = wi >> 2; rsplit = wi & 3; dir = chain >> 4; seq = (chain & 15) >> 3; head = chain & 7; NRW = 16; rbase = rsplit * 16; L = LP; }
    else { const int v = wi - 128; const int chain = v >> 1; rsplit = v & 1; dir = chain >> 5; seq = 2 + ((chain & 31) >> 3); head = chain & 7; NRW = 32; rbase = rsplit * 32; L = LS; }
    const int sb = seq_base(seq) + PADR;
    bf16_t* od = (bf16_t*)(ws + (dir ? R1_OB : R1_OF));
    const int nblk = (L + 31) >> 5;
    __syncthreads();
    { const float* w2 = inp(ws, 12) + (size_t)dir * 64 * 512 + head * 64; const float* a2 = inp(ws, 14) + (size_t)dir * 64 * 512 + head * 64;
#pragma unroll
      for (int i = 0; i < 8; ++i) { const int e = tid + i * 512, k = e & 63, r = e >> 6; w2s[k * 72 + r] = f2bf(w2[(size_t)r * 512 + k]); a2s[k * 72 + r] = f2bf(a2[(size_t)r * 512 + k]); } }
    const int kq = tid & 15, k0 = kq * 4, ch0 = head * 64 + k0;
    const f32x4 w0c = *(const f32x4*)(inp(ws, 11) + dir * 512 + ch0), a0c = *(const f32x4*)(inp(ws, 13) + dir * 512 + ch0);
    const f32x4 kkc = *(const f32x4*)(inp(ws, 16) + ch0), kac = *(const f32x4*)(inp(ws, 17) + ch0), rkc = *(const f32x4*)(inp(ws, 18) + ch0);
    const f32x4 mur = *(const f32x4*)(mu + ch0), muk = *(const f32x4*)(mu + 512 + ch0), muv = *(const f32x4*)(mu + 1024 + ch0);
    const int cb = (tid & 15) * 8;
    const f32x4 mub0 = *(const f32x4*)(mu + 1536 + cb), mub1 = *(const f32x4*)(mu + 1536 + cb + 4);
    u32x4 pf[3];
    auto issue = [&](int b) {
      const int ta = dir == 0 ? b * 32 : L - 32 - b * 32;
#pragma unroll
      for (int i = 0; i < 3; ++i) { const int li = tid + i * 512; pf[i] = (u32x4){0u, 0u, 0u, 0u};
        if (li < 1360) { const int ri = li / 40, rem = li % 40, seg = rem >> 3, chk = rem & 7; const int t = ta - 1 + ri;
          const int col = seg < 3 ? seg * 512 + head * 64 : 1536 + (seg - 3) * 64;
          if (t >= 0 && t < L) pf[i] = *(const u32x4*)(prw + (size_t)(sb + t) * 1792 + col + chk * 8); } }
    };
    issue(0);
    const int srow = wid * 4 + fq;
    const bool sactive = wid * 4 < NRW;
    float S0 = 0.f, S1 = 0.f, S2 = 0.f, S3 = 0.f;
    for (int b = 0; b < nblk; ++b) {
      const int ta = dir == 0 ? b * 32 : L - 32 - b * 32;
      const int nst = (L - b * 32) < 32 ? (L - b * 32) : 32;
#pragma unroll
      for (int i = 0; i < 3; ++i) { const int li = tid + i * 512; if (li < 1360) { const int ri = li / 40, rem = li % 40; *(LAS u32x4*)(raw + ri * 320 + rem * 8) = pf[i]; } }
      if (b + 1 < nblk) issue(b + 1);
      __syncthreads();
      { const int tl = tid >> 4, ri = tl + 1;
        const LAS bf16_t* q0 = raw + (ri - 1) * 320 + 192 + cb; const LAS bf16_t* q1 = q0 + 320; const LAS bf16_t* q2 = q1 + 320;
        float x[8];
#pragma unroll
        for (int hh = 0; hh < 2; ++hh) { const f32x4 a = ld_bf4(q0 + hh * 4), c = ld_bf4(q1 + hh * 4), d = ld_bf4(q2 + hh * 4); const f32x4 m = hh ? mub1 : mub0;
#pragma unroll
          for (int j = 0; j < 4; ++j) x[hh * 4 + j] = c[j] + m[j] * (0.5f * (a[j] + d[j]) - c[j]); }
        u32x4 w;
        if (cb < 64) { w.x = pack2(tanh_fast(x[0]), tanh_fast(x[1])); w.y = pack2(tanh_fast(x[2]), tanh_fast(x[3])); w.z = pack2(tanh_fast(x[4]), tanh_fast(x[5])); w.w = pack2(tanh_fast(x[6]), tanh_fast(x[7]));
          *(LAS u32x4*)(txw + tl * 72 + cb) = w; }
        else { w.x = pack2(x[0], x[1]); w.y = pack2(x[2], x[3]); w.z = pack2(x[4], x[5]); w.w = pack2(x[6], x[7]); *(LAS u32x4*)(xab + tl * 72 + cb - 64) = w; } }
      __syncthreads();
      { const int mat = wid >> 2, mt = (wid >> 1) & 1, ntp = wid & 1;
        const LAS bf16_t* X = mat ? xab : txw; const LAS bf16_t* Y = mat ? a2s : w2s;
#pragma unroll
        for (int nn = 0; nn < 2; ++nn) { const int nt = ntp * 2 + nn; f32x4 a = (f32x4){0.f, 0.f, 0.f, 0.f};
#pragma unroll
          for (int ks = 0; ks < 2; ++ks) { const bf16x8 xf = *(const LAS bf16x8*)(X + (mt * 16 + fr) * 72 + ks * 32 + fq * 8); const bf16x8 yf = *(const LAS bf16x8*)(Y + (nt * 16 + fr) * 72 + ks * 32 + fq * 8); a = mfma16(xf, yf, a); }
#pragma unroll
          for (int r = 0; r < 4; ++r) pre[mat * 2048 + (mt * 16 + fq * 4 + r) * 64 + nt * 16 + fr] = a[r]; } }
      __syncthreads();
      { const int tl = tid >> 4, ri = tl + 1, t = ta + tl;
        const LAS bf16_t* q1 = raw + ri * 320 + k0;
        f32x4 xr, xk, xv;
        { const f32x4 a = ld_bf4(q1 - 320), c = ld_bf4(q1), d = ld_bf4(q1 + 320); xr = c + mur * (0.5f * (a + d) - c); }
        { const f32x4 a = ld_bf4(q1 - 320 + 64), c = ld_bf4(q1 + 64), d = ld_bf4(q1 + 320 + 64); xk = c + muk * (0.5f * (a + d) - c); }
        { const f32x4 a = ld_bf4(q1 - 320 + 128), c = ld_bf4(q1 + 128), d = ld_bf4(q1 + 320 + 128); xv = c + muv * (0.5f * (a + d) - c); }
        const f32x4 wp = *(const LAS f32x4*)(pre + tl * 64 + k0), ap = *(const LAS f32x4*)(pre + 2048 + tl * 64 + k0);
        f32x4 w, a, kk, kd, bb, wrr;
        float ss = 0.f;
#pragma unroll
        for (int j = 0; j < 4; ++j) {
          const float wl = w0c[j] + wp[j]; const float ew = 0.60653066f * rcpf_(1.0f + __expf(-wl)); w[j] = __expf(-ew);
          a[j] = rcpf_(1.0f + __expf(-(a0c[j] + ap[j])));
          kk[j] = xk[j] * kkc[j]; ss += kk[j] * kk[j];
          kd[j] = xk[j] * (1.0f + (a[j] - 1.0f) * kac[j]);
          wrr[j] = w[j] * xr[j];
        }
        ss = rowsum16(ss); const float inv = rsqrtf(fmaxf(ss, 1e-24f));
        float br = 0.f, kdr = 0.f, bon = 0.f;
#pragma unroll
        for (int j = 0; j < 4; ++j) { kk[j] *= inv; bb[j] = kk[j] * a[j]; br += bb[j] * xr[j]; kdr += kd[j] * xr[j]; bon += xr[j] * kd[j] * rkc[j]; }
        br = rowsum16(br); kdr = rowsum16(kdr); bon = rowsum16(bon);
        LAS float* s = st + tl * 320 + k0;
        *(LAS f32x4*)(s) = kk; *(LAS f32x4*)(s + 64) = wrr; *(LAS f32x4*)(s + 128) = w; *(LAS f32x4*)(s + 192) = bb; *(LAS f32x4*)(s + 256) = kd;
        *(LAS f32x4*)(vbuf + tl * 64 + k0) = xv;
        if (kq == 0) { sc[tl * 4] = br; sc[tl * 4 + 1] = kdr; if (rsplit == 0 && t >= 0 && t < L) bonus[(size_t)(sb + t) * 16 + dir * 8 + head] = bon; } }
      __syncthreads();
      if (sactive) {
        int tl = dir ? 31 : 0;
        const LAS float* sp = st + tl * 320 + fr * 4;
        f32x4 kk = *(const LAS f32x4*)(sp), wr4 = *(const LAS f32x4*)(sp + 64), w4 = *(const LAS f32x4*)(sp + 128), b4 = *(const LAS f32x4*)(sp + 192), kd4 = *(const LAS f32x4*)(sp + 256);
        float vv = vbuf[tl * 64 + rbase + srow], br = sc[tl * 4], kdr = sc[tl * 4 + 1];
        for (int s = 0; s < nst; ++s) {
          const int tln = s + 1 < nst ? (dir ? 30 - s : s + 1) : tl;
          const LAS float* spn = st + tln * 320 + fr * 4;
          const f32x4 kkn = *(const LAS f32x4*)(spn), wrn = *(const LAS f32x4*)(spn + 64), wn = *(const LAS f32x4*)(spn + 128), bn = *(const LAS f32x4*)(spn + 192), kdn = *(const LAS f32x4*)(spn + 256);
          const float vvn = vbuf[tln * 64 + rbase + srow], brn = sc[tln * 4], kdrn = sc[tln * 4 + 1];
          float skp = (S0 * kk[0] + S1 * kk[1]) + (S2 * kk[2] + S3 * kk[3]);
          float pp = (S0 * wr4[0] + S1 * wr4[1]) + (S2 * wr4[2] + S3 * wr4[3]);
          const float sk = rowsum16(skp), pt = rowsum16(pp);
          S0 = S0 * w4[0] - sk * b4[0] + vv * kd4[0]; S1 = S1 * w4[1] - sk * b4[1] + vv * kd4[1];
          S2 = S2 * w4[2] - sk * b4[2] + vv * kd4[2]; S3 = S3 * w4[3] - sk * b4[3] + vv * kd4[3];
          if (fr == 0) obuf[tl * 32 + srow] = pt - sk * br + vv * kdr;
          kk = kkn; wr4 = wrn; w4 = wn; b4 = bn; kd4 = kdn; vv = vvn; br = brn; kdr = kdrn; tl = tln;
        }
      }
      __syncthreads();
#pragma unroll
      for (int i = 0; i < 2; ++i) { const int e = tid + i * 512, tl = e >> 5, rw = e & 31, t = ta + tl;
        if (rw < NRW && t >= 0 && t < L) od[(size_t)(sb + t) * 512 + head * 64 + rbase + rw] = f2bf(obuf[tl * 32 + rw]); }
    }
  }
}

__device__ __forceinline__ float rowsum8p(float v) { v += dppf<0xB1>(v); v += dppf<0x4E>(v); v += dppf<0x141>(v); return v; }
__device__ __forceinline__ void unpack8p(const u32x4 v, float (&o)[8]) { o[0] = bflo(v.x); o[1] = bfhi(v.x); o[2] = bflo(v.y); o[3] = bfhi(v.y); o[4] = bflo(v.z); o[5] = bfhi(v.z); o[6] = bflo(v.w); o[7] = bfhi(v.w); }
__device__ __forceinline__ void rwkv_post_phase(const Params& p, LAS unsigned char* lds) {
  unsigned char* ws = p.ws + opq0_(); unsigned char* r2 = (unsigned char*)p.out + opq0_();
  const bf16_t* prw = (const bf16_t*)(r2 + R2_PRW);
  const bf16_t* of = (const bf16_t*)(ws + R1_OF); const bf16_t* ob = (const bf16_t*)(ws + R1_OB);
  const float* bonus = (const float*)(ws + T_BONUS); const bf16_t* g2t = (const bf16_t*)(ws + T_G2T);
  bf16_t* mix = (bf16_t*)(ws + R1_MIX);
  const float* mu = inp(ws, 10); const float* lnw = inp(ws, 19); const float* lnb = inp(ws, 20);
  LAS bf16_t* sg = (LAS bf16_t*)lds;
  LAS float* gbuf = (LAS float*)(lds + 34816);
  const int tid = tidx_(), wid = tid >> 6, lane = tid & 63, fr = lane & 15, fq = lane >> 4;
  const int G = gdim_();
  for (int wjob = bidx_(); wjob < 256 + 48; wjob += G) {
    const int tile = wjob < 256 ? wjob : 256 + ((wjob - 256) >> 3); const int hd0 = wjob < 256 ? 0 : ((wjob - 256) & 7), hd1 = wjob < 256 ? 8 : hd0 + 1;
    const int row0 = tile * 128;
    __syncthreads();
    { const int tr = tid >> 2, c0 = (tid & 3) * 32, row = row0 + tr; int seq, pos, L; row_info(row, seq, pos, L);
      const bool hasp = pos > 0, hasn = pos >= 0 && pos < L - 1;
      const bf16_t* pc = prw + (size_t)row * 1792 + 1664 + c0;
#pragma unroll
      for (int q = 0; q < 4; ++q) {
        const u32x4 c = *(const u32x4*)(pc + q * 8); u32x4 a = (u32x4){0u, 0u, 0u, 0u}, d = (u32x4){0u, 0u, 0u, 0u};
        if (hasp) a = *(const u32x4*)(pc - 1792 + q * 8);
        if (hasn) d = *(const u32x4*)(pc + 1792 + q * 8);
        float cv[8], av[8], dv[8]; unpack8p(c, cv); unpack8p(a, av); unpack8p(d, dv);
        const f32x4 m0 = *(const f32x4*)(mu + 1664 + c0 + q * 8), m1 = *(const f32x4*)(mu + 1664 + c0 + q * 8 + 4);
        float x[8];
#pragma unroll
        for (int j = 0; j < 8; ++j) { const float m = j < 4 ? m0[j & 3] : m1[j & 3]; x[j] = sigmoidf_(cv[j] + m * (0.5f * (av[j] + dv[j]) - cv[j])); }
        *(LAS u32x4*)(sg + tr * VT_LD + c0 + q * 8) = (u32x4){pack2(x[0], x[1]), pack2(x[2], x[3]), pack2(x[4], x[5]), pack2(x[6], x[7])};
      } }
    __syncthreads();
    bf16x8 xf[4];
#pragma unroll
    for (int ks = 0; ks < 4; ++ks) xf[ks] = *(const LAS bf16x8*)(sg + (wid * 16 + fr) * VT_LD + ks * 32 + fq * 8);
    const int ch = tid & 7;
#pragma unroll 1
    for (int hd = hd0; hd < hd1; ++hd) {
      LAS float* gb = gbuf + (hd & 1) * (128 * 68);
#pragma unroll
      for (int nt = 0; nt < 4; ++nt) { f32x4 g = (f32x4){0.f, 0.f, 0.f, 0.f};
#pragma unroll
        for (int ks = 0; ks < 4; ++ks) { const bf16x8 yf = *(const bf16x8*)(g2t + (size_t)(hd * 64 + nt * 16 + fr) * 128 + ks * 32 + fq * 8); g = mfma16(xf[ks], yf, g); }
#pragma unroll
        for (int r = 0; r < 4; ++r) gb[(wid * 16 + fq * 4 + r) * 68 + nt * 16 + fr] = g[r]; }
      __syncthreads();
      const int cg = hd * 64 + ch * 8;
      const f32x4 w0 = *(const f32x4*)(lnw + cg), w1 = *(const f32x4*)(lnw + cg + 4), b0 = *(const f32x4*)(lnb + cg), b1 = *(const f32x4*)(lnb + cg + 4);
      const f32x4 mv0 = *(const f32x4*)(mu + 1024 + cg), mv1 = *(const f32x4*)(mu + 1024 + cg + 4);
#pragma unroll
      for (int i = 0; i < 2; ++i) {
        const int tk = (tid >> 3) + i * 64, row = row0 + tk; int seq, pos, L; row_info(row, seq, pos, L);
        u32x4 res = (u32x4){0u, 0u, 0u, 0u};
        if (pos >= 0) {
          float o1[8], o2[8], o[8];
          unpack8p(*(const u32x4*)(of + (size_t)row * 512 + cg), o1); unpack8p(*(const u32x4*)(ob + (size_t)row * 512 + cg), o2);
          float sum = 0.f;
#pragma unroll
          for (int j = 0; j < 8; ++j) { o[j] = o1[j] + o2[j]; sum += o[j]; }
          sum = rowsum8p(sum); const float mean = sum * (1.0f / 64.0f);
          float vs = 0.f;
#pragma unroll
          for (int j = 0; j < 8; ++j) { const float d = o[j] - mean; vs += d * d; }
          vs = rowsum8p(vs); const float rstd = rsqrtf(vs * (1.0f / 64.0f) + 64e-5f);
          const float bsc = 0.5f * (bonus[(size_t)row * 16 + hd] + bonus[(size_t)row * 16 + 8 + hd]);
          const bf16_t* pv = prw + (size_t)row * 1792 + 1024 + cg;
          float vc[8], va[8], vd[8];
          unpack8p(*(const u32x4*)pv, vc);
          u32x4 ua = (u32x4){0u, 0u, 0u, 0u}, ud = (u32x4){0u, 0u, 0u, 0u};
          if (pos > 0) ua = *(const u32x4*)(pv - 1792);
          if (pos < L - 1) ud = *(const u32x4*)(pv + 1792);
          unpack8p(ua, va); unpack8p(ud, vd);
          const f32x4 g0 = *(const LAS f32x4*)(gb + tk * 68 + ch * 8), g1 = *(const LAS f32x4*)(gb + tk * 68 + ch * 8 + 4);
          float y[8];
#pragma unroll
          for (int j = 0; j < 8; ++j) { const float lw = j < 4 ? w0[j & 3] : w1[j & 3], lb = j < 4 ? b0[j & 3] : b1[j & 3], mm = j < 4 ? mv0[j & 3] : mv1[j & 3], gg = j < 4 ? g0[j & 3] : g1[j & 3];
            const float xv = vc[j] + mm * (0.5f * (va[j] + vd[j]) - vc[j]);
            y[j] = ((o[j] - mean) * rstd * lw + lb + bsc * xv) * gg; }
          res = (u32x4){pack2(y[0], y[1]), pack2(y[2], y[3]), pack2(y[4], y[5]), pack2(y[6], y[7])};
        }
        *(u32x4*)(mix + (size_t)row * 1024 + 512 + cg) = res;
      }
    }
  }
}
__device__ __forceinline__ f32x4 g_bf4(const bf16_t* p) { const u32x2 v = *(const u32x2*)p; return (f32x4){bflo(v.x), bfhi(v.x), bflo(v.y), bfhi(v.y)}; }
__device__ __forceinline__ void unpack8(const u32x4 v, float (&o)[8]) { o[0] = bflo(v.x); o[1] = bfhi(v.x); o[2] = bflo(v.y); o[3] = bfhi(v.y); o[4] = bflo(v.z); o[5] = bfhi(v.z); o[6] = bflo(v.w); o[7] = bfhi(v.w); }
__device__ __forceinline__ float rowsum8(float v) { v += dppf<0xB1>(v); v += dppf<0x4E>(v); v += dppf<0x141>(v); return v; }

constexpr size_t R2_XWA = (size_t)MROWS * 1792 * 2;
static_assert(R2_XWA + (size_t)MROWS * 128 * 2 <= SZ_OUT, "xwa");
__device__ __forceinline__ void xwa_phase(const Params& p) {
  unsigned char* ws = p.ws + opq0_(); unsigned char* r2 = (unsigned char*)p.out + opq0_();
  const bf16_t* prw = (const bf16_t*)(r2 + R2_PRW); bf16_t* xwa = (bf16_t*)(r2 + R2_XWA);
  const float* mu = inp(ws, 10);
  const int gt = bidx_() * 512 + tidx_(), ngt = gdim_() * 512;
  for (int it = gt; it < MROWS * 16; it += ngt) {
    const int row = it >> 4, cb = (it & 15) * 8; int seq, pos, L; row_info(row, seq, pos, L);
    u32x4 o = (u32x4){0u, 0u, 0u, 0u};
    if (pos >= 0) {
      const bf16_t* pc = prw + (size_t)row * 1792 + 1536 + cb;
      u32x4 ua = (u32x4){0u, 0u, 0u, 0u}, ud = (u32x4){0u, 0u, 0u, 0u}; const u32x4 uc = *(const u32x4*)pc;
      if (pos > 0) ua = *(const u32x4*)(pc - 1792);
      if (pos < L - 1) ud = *(const u32x4*)(pc + 1792);
      float a[8], c[8], d[8], x[8]; unpack8(ua, a); unpack8(uc, c); unpack8(ud, d);
      const f32x4 m0 = *(const f32x4*)(mu + 1536 + cb), m1 = *(const f32x4*)(mu + 1536 + cb + 4);
#pragma unroll
      for (int j = 0; j < 8; ++j) { const float m = j < 4 ? m0[j & 3] : m1[j & 3]; x[j] = c[j] + m * (0.5f * (a[j] + d[j]) - c[j]); if (cb < 64) x[j] = tanh_fast(x[j]); }
      o = (u32x4){pack2(x[0], x[1]), pack2(x[2], x[3]), pack2(x[4], x[5]), pack2(x[6], x[7])};
    }
    *(u32x4*)(xwa + (size_t)row * 128 + cb) = o;
  }
}

static_assert(LP % 32 == 16 && LS % 32 == 16, "scan half-blocks assume 16-step halves");
__device__ __forceinline__ void rwkv_scan2_phase(const Params& p, LAS unsigned char* lds) {
  unsigned char* ws = p.ws + opq0_(); unsigned char* r2 = (unsigned char*)p.out + opq0_();
  const bf16_t* prw = (const bf16_t*)(r2 + R2_PRW);
  float* bonus = (float*)(ws + T_BONUS);
  LAS bf16_t* txw = (LAS bf16_t*)(lds + 0);
  LAS bf16_t* xab = (LAS bf16_t*)(lds + 4608);
  LAS bf16_t* w2s = (LAS bf16_t*)(lds + 9216);
  LAS bf16_t* a2s = (LAS bf16_t*)(lds + 18432);
  LAS float* pre = (LAS float*)(lds + 27648);
  LAS float* cst = (LAS float*)(lds + 44032);
  LAS float* stb = (LAS float*)(lds + 46080);
  LAS float* vbb = (LAS float*)(lds + 128000);
  LAS float* scb = (LAS float*)(lds + 132096);
  LAS float* ppb = (LAS float*)(lds + 133120);
  LAS float* skb = (LAS float*)(lds + 141312);
  const int tid = tidx_(), wid = tid >> 6, lane = tid & 63, fr = lane & 15, fq = lane >> 4;
  const float* mu = inp(ws, 10);
  const bool producer = wid >= 4;
  const int pw = wid - 4, ptid = tid - 256;
  const int G = gdim_();
  for (int slot = bidx_(); slot < 256; slot += G) {
    const int nitems = slot < 128 ? 1 : 2;
    for (int itx = 0; itx < nitems; ++itx) {
      int dir, seq, head, rsplit, L;
      if (slot < 128) { const int chain = slot >> 2; rsplit = slot & 3; dir = chain >> 4; seq = (chain & 15) >> 3; head = chain & 7; L = LP; }
      else { const int v = (slot - 128) * 2 + itx; const int chain = v >> 2; rsplit = v & 3; dir = chain >> 5; seq = 2 + ((chain & 31) >> 3); head = chain & 7; L = LS; }
      const int rbase = rsplit * 16;
      const int sb = seq_base(seq) + PADR;
      bf16_t* od = (bf16_t*)(ws + (dir ? R1_OB : R1_OF));
      const int nblk = (L + 31) >> 5;
      __syncthreads();
      { const float* w2 = inp(ws, 12) + (size_t)dir * 64 * 512 + head * 64; const float* a2 = inp(ws, 14) + (size_t)dir * 64 * 512 + head * 64;
#pragma unroll
        for (int i = 0; i < 8; ++i) { const int e = tid + i * 512, k = e & 63, r = e >> 6; w2s[k * 72 + r] = f2bf(w2[(size_t)r * 512 + k]); a2s[k * 72 + r] = f2bf(a2[(size_t)r * 512 + k]); }
        { const int v = tid >> 6, k = tid & 63, c = head * 64 + k; float x;
          switch (v) { case 0: x = inp(ws, 11)[dir * 512 + c]; break; case 1: x = inp(ws, 13)[dir * 512 + c]; break; case 2: x = inp(ws, 16)[c]; break; case 3: x = inp(ws, 17)[c]; break;
                       case 4: x = inp(ws, 18)[c]; break; case 5: x = mu[c]; break; case 6: x = mu[512 + c]; break; default: x = mu[1024 + c]; break; }
          cst[v * 64 + k] = x; } }
      __syncthreads();
      u32x4 pb[2], pd[3][3];
      const bf16_t* xwa = (const bf16_t*)(r2 + R2_XWA);
      const int cbB = (ptid & 15) * 8;
      const int dt = pw * 8 + (lane >> 3), dk0 = (lane & 7) * 8;
      auto issue_b = [&](int b) {
        const int ta = dir == 0 ? b * 32 : L - 32 - b * 32;
#pragma unroll
        for (int q = 0; q < 2; ++q) { const int t = ta + (ptid >> 4) + q * 16; pb[q] = (u32x4){0u, 0u, 0u, 0u};
          if (t >= 0 && t < L) pb[q] = *(const u32x4*)(xwa + (size_t)(sb + t) * 128 + cbB); }
      };
      auto issue_d = [&](int b) {
        const int ta = dir == 0 ? b * 32 : L - 32 - b * 32;
#pragma unroll
        for (int sg = 0; sg < 3; ++sg)
#pragma unroll
          for (int rr = 0; rr < 3; ++rr) { const int t = ta + dt - 1 + rr; pd[sg][rr] = (u32x4){0u, 0u, 0u, 0u};
            if (t >= 0 && t < L) pd[sg][rr] = *(const u32x4*)(prw + (size_t)(sb + t) * 1792 + sg * 512 + head * 64 + dk0); }
      };
      float xk[8] = {0.f, 0.f, 0.f, 0.f, 0.f, 0.f, 0.f, 0.f}; float inv = 0.f, br = 0.f, kdr = 0.f, bon = 0.f;
      if (producer) { issue_b(0); issue_d(0);
#pragma unroll
        for (int q = 0; q < 2; ++q) { const int tlb = (ptid >> 4) + q * 16;
          if (cbB < 64) *(LAS u32x4*)(txw + tlb * 72 + cbB) = pb[q]; else *(LAS u32x4*)(xab + tlb * 72 + cbB - 64) = pb[q]; }
        if (1 < nblk) issue_b(1); }
      __syncthreads();
      const int srow = wid * 4 + fq;
      f32x2_t S01 = {0.f, 0.f}, S23 = {0.f, 0.f};
      for (int b = -1; b <= nblk; ++b) {
        const int cur = b & 1, nxt = cur ^ 1;
        const int nst = (b >= 0 && b < nblk) ? ((L - b * 32) < 32 ? (L - b * 32) : 32) : 0;
        LAS float* st = stb + cur * 10240; LAS float* vb = vbb + cur * 512;
        for (int half = 0; half < 2; ++half) {
          if (producer) {
            const int fb = half ? b : b - 1, ph = half ^ 1;
            if (fb >= 0 && fb < nblk) {
              const int nstp = (L - fb * 32) < 32 ? (L - fb * 32) : 32; const int sl = ptid >> 4, rw = ptid & 15, sidx = ph * 16 + sl;
              if (sidx < nstp) {
                const int tl = dir ? 31 - sidx : sidx; const int t = (dir == 0 ? fb * 32 : L - 32 - fb * 32) + tl; const int bi = fb & 1;
                const f32x4 q = *(const LAS f32x4*)(ppb + ph * 1024 + (sl * 16 + rw) * 4); const float sk = skb[ph * 256 + sl * 16 + rw];
                const float o = ((q[0] + q[1]) + (q[2] + q[3])) - sk * scb[bi * 128 + tl * 4] + vbb[bi * 512 + tl * 16 + rw] * scb[bi * 128 + tl * 4 + 1];
                od[(size_t)(sb + t) * 512 + head * 64 + rbase + rw] = f2bf(o);
              }
            }
          }
          if (!producer) {
            const int s0 = half * 16, s1 = nst < s0 + 16 ? nst : s0 + 16;
            if (s0 < s1) {
              LAS float* ppw = ppb + half * 1024 + srow * 4 + (fr >> 2); LAS float* skw = skb + half * 256 + srow;
              f32x4 kkA, wrA, wA, bA, kdA, kkB, wrB, wB, bB, kdB; float vvA, vvB;
#define LOADR(X, s_) do { const int tl_ = dir ? 31 - (s_) : (s_); const LAS float* sp_ = st + tl_ * 320 + fr * 4; kk##X = *(const LAS f32x4*)(sp_); wr##X = *(const LAS f32x4*)(sp_ + 64); w##X = *(const LAS f32x4*)(sp_ + 128); \
                          b##X = *(const LAS f32x4*)(sp_ + 192); kd##X = *(const LAS f32x4*)(sp_ + 256); vv##X = vb[tl_ * 16 + srow]; } while (0)
#define STEPR(X, s_) do { const f32x2_t ts_ = __builtin_elementwise_fma(S23, kk##X.hi, S01 * kk##X.lo); const f32x2_t tp_ = __builtin_elementwise_fma(S23, wr##X.hi, S01 * wr##X.lo); \
                          const float sk_ = rowsum16(ts_.x + ts_.y); float pp_ = tp_.x + tp_.y; pp_ += dppf<0xB1>(pp_); pp_ += dppf<0x4E>(pp_); \
                          const f32x2_t nsk_ = {-sk_, -sk_}, vv2_ = {vv##X, vv##X}; \
                          S01 = __builtin_elementwise_fma(vv2_, kd##X.lo, __builtin_elementwise_fma(nsk_, b##X.lo, S01 * w##X.lo)); \
                          S23 = __builtin_elementwise_fma(vv2_, kd##X.hi, __builtin_elementwise_fma(nsk_, b##X.hi, S23 * w##X.hi)); \
                          ppw[((s_) - s0) * 64] = pp_; skw[((s_) - s0) * 16] = sk_; } while (0)
              LOADR(A, s0);
              for (int i = 0; i < 8; ++i) {
                const int s = s0 + 2 * i;
                LOADR(B, s + 1);
                STEPR(A, s);
                LOADR(A, i < 7 ? s + 2 : s + 1);
                STEPR(B, s + 1);
              }
#undef LOADR
#undef STEPR
            }
          } else {
            const int bn = b + 1; const int ta = dir == 0 ? bn * 32 : L - 32 - bn * 32;
            LAS float* prew = pre + pw * 1024;
            const int tloc = lane >> 3, tl = pw * 8 + tloc, t = ta + tl;
            LAS float* s = stb + nxt * 10240 + tl * 320 + dk0;
#define DGROUP(hh) do { f32x4 xr4; \
                { const u32x4 ua = pd[0][0], uc = pd[0][1], ud = pd[0][2]; \
                  const unsigned a0 = (hh) ? ua.z : ua.x, a1 = (hh) ? ua.w : ua.y, c0 = (hh) ? uc.z : uc.x, c1 = (hh) ? uc.w : uc.y, d0 = (hh) ? ud.z : ud.x, d1 = (hh) ? ud.w : ud.y; \
                  const float av[4] = {bflo(a0), bfhi(a0), bflo(a1), bfhi(a1)}, cv[4] = {bflo(c0), bfhi(c0), bflo(c1), bfhi(c1)}, dv[4] = {bflo(d0), bfhi(d0), bflo(d1), bfhi(d1)}; \
                  _Pragma("unroll") for (int j = 0; j < 4; ++j) xr4[j] = cv[j] + cst[5 * 64 + dk0 + (hh) * 4 + j] * (0.5f * (av[j] + dv[j]) - cv[j]); } \
                f32x4 w4, kk4, kd4, bb4, wr4; \
                _Pragma("unroll") for (int j = 0; j < 4; ++j) { const int kx = dk0 + (hh) * 4 + j; const float xkj = xk[(hh) * 4 + j]; \
                  const float wl = cst[0 * 64 + kx] + prew[tloc * 64 + kx]; const float ew = 0.60653066f * rcpf_(1.0f + __expf(-wl)); w4[j] = __expf(-ew); \
                  const float aj = rcpf_(1.0f + __expf(-(cst[1 * 64 + kx] + prew[512 + tloc * 64 + kx]))); \
                  kk4[j] = xkj * cst[2 * 64 + kx] * inv; kd4[j] = xkj * (1.0f + (aj - 1.0f) * cst[3 * 64 + kx]); bb4[j] = kk4[j] * aj; wr4[j] = w4[j] * xr4[j]; \
                  br += bb4[j] * xr4[j]; kdr += kd4[j] * xr4[j]; bon += xr4[j] * kd4[j] * cst[4 * 64 + kx]; } \
                *(LAS f32x4*)(s + (hh) * 4) = kk4; *(LAS f32x4*)(s + 64 + (hh) * 4) = wr4; *(LAS f32x4*)(s + 128 + (hh) * 4) = w4; *(LAS f32x4*)(s + 192 + (hh) * 4) = bb4; *(LAS f32x4*)(s + 256 + (hh) * 4) = kd4; } while (0)
            if (half == 0) {
              if (bn < nblk) {
#pragma unroll
                for (int mat = 0; mat < 2; ++mat) { const LAS bf16_t* X = mat ? xab : txw; const LAS bf16_t* Y = mat ? a2s : w2s;
                  const int xr = pw * 8 + (fr & 7);
                  bf16x8 xf[2];
#pragma unroll
                  for (int ks = 0; ks < 2; ++ks) xf[ks] = *(const LAS bf16x8*)(X + xr * 72 + ks * 32 + fq * 8);
#pragma unroll
                  for (int nt = 0; nt < 4; ++nt) { f32x4 a = (f32x4){0.f, 0.f, 0.f, 0.f};
#pragma unroll
                    for (int ks = 0; ks < 2; ++ks) { const bf16x8 yf = *(const LAS bf16x8*)(Y + (nt * 16 + fr) * 72 + ks * 32 + fq * 8); a = mfma16(xf[ks], yf, a); }
                    if (fq < 2) {
#pragma unroll
                      for (int r = 0; r < 4; ++r) prew[mat * 512 + (fq * 4 + r) * 64 + nt * 16 + fr] = a[r]; } } }
                { float a[8], c[8], d[8]; unpack8(pd[1][0], a); unpack8(pd[1][1], c); unpack8(pd[1][2], d);
#pragma unroll
                  for (int j = 0; j < 8; ++j) xk[j] = c[j] + cst[6 * 64 + dk0 + j] * (0.5f * (a[j] + d[j]) - c[j]); }
                float ss = 0.f;
#pragma unroll
                for (int j = 0; j < 8; ++j) { const float q = xk[j] * cst[2 * 64 + dk0 + j]; ss += q * q; }
                ss = rowsum8(ss); inv = rsqrtf(fmaxf(ss, 1e-24f));
                br = 0.f; kdr = 0.f; bon = 0.f;
                DGROUP(0);
              }
            } else {
              if (bn < nblk) {
                DGROUP(1);
                br = rowsum8(br); kdr = rowsum8(kdr); bon = rowsum8(bon);
                float xv[8];
                { float a[8], c[8], d[8]; unpack8(pd[2][0], a); unpack8(pd[2][1], c); unpack8(pd[2][2], d);
#pragma unroll
                  for (int j = 0; j < 8; ++j) xv[j] = c[j] + cst[7 * 64 + dk0 + j] * (0.5f * (a[j] + d[j]) - c[j]); }
                if (dk0 >= rbase && dk0 < rbase + 16) {
                  LAS float* vd = vbb + nxt * 512 + tl * 16 + (dk0 - rbase);
                  *(LAS f32x4*)(vd) = (f32x4){xv[0], xv[1], xv[2], xv[3]}; *(LAS f32x4*)(vd + 4) = (f32x4){xv[4], xv[5], xv[6], xv[7]};
                }
                if ((lane & 7) == 0) { LAS float* scn = scb + nxt * 128; scn[tl * 4] = br; scn[tl * 4 + 1] = kdr; if (rsplit == 0 && t >= 0 && t < L) bonus[(size_t)(sb + t) * 16 + dir * 8 + head] = bon; }
                if (b + 2 < nblk) issue_d(b + 2);
              }
              if (b + 2 < nblk) {
#pragma unroll
                for (int q = 0; q < 2; ++q) { const int tlb = (ptid >> 4) + q * 16;
                  if (cbB < 64) *(LAS u32x4*)(txw + tlb * 72 + cbB) = pb[q]; else *(LAS u32x4*)(xab + tlb * 72 + cbB - 64) = pb[q]; }
                if (b + 3 < nblk) issue_b(b + 3);
              }
            }
#undef DGROUP
          }
          __syncthreads();
        }
      }
    }
  }
}
__device__ __forceinline__ void conv_phase(const Params& p) {
  unsigned char* ws = p.ws + opq0_();
  bf16_t* mix = (bf16_t*)(ws + R1_MIX); const bf16_t* ub = (const bf16_t*)(ws + R1_U); const float* cw = inp(ws, 32);
  const int gt = bidx_() * 512 + tidx_(), ngt = gridDim.x * 512;
  for (int it = gt; it < MROWS * 64; it += ngt) {
    const int row = it >> 6, c0 = (it & 63) * 8; int seq, pos, L; row_info(row, seq, pos, L);
    u32x4 o = (u32x4){0u, 0u, 0u, 0u};
    bf16_t* dst = mix + (size_t)row * 1024 + 512 + c0;
    if (pos >= 0) {
      const bf16_t* up = ub + (size_t)row * 512 + c0;
      const u32x4 pb = *(const u32x4*)dst, c = *(const u32x4*)up; u32x4 a = (u32x4){0u, 0u, 0u, 0u}, d = (u32x4){0u, 0u, 0u, 0u};
      if (pos > 0) a = *(const u32x4*)(up - 512);
      if (pos < L - 1) d = *(const u32x4*)(up + 512);
      const unsigned pw[4] = {pb.x, pb.y, pb.z, pb.w}, cw4[4] = {c.x, c.y, c.z, c.w}, aw[4] = {a.x, a.y, a.z, a.w}, dw[4] = {d.x, d.y, d.z, d.w}; unsigned ow[4];
#pragma unroll
      for (int t = 0; t < 4; ++t) { const int cc = c0 + t * 2;
        const float y0 = cw[cc] * bflo(aw[t]) + cw[512 + cc] * bflo(cw4[t]) + cw[1024 + cc] * bflo(dw[t]);
        const float y1 = cw[cc + 1] * bfhi(aw[t]) + cw[512 + cc + 1] * bfhi(cw4[t]) + cw[1024 + cc + 1] * bfhi(dw[t]);
        ow[t] = pack2(bflo(pw[t]) * y0, bfhi(pw[t]) * y1); }
      o = (u32x4){ow[0], ow[1], ow[2], ow[3]};
    }
    *(u32x4*)dst = o;
  }
}

__constant__ float C16[16] = {1.f, 0.92387953f, 0.70710678f, 0.38268343f, 0.f, -0.38268343f, -0.70710678f, -0.92387953f, -1.f, -0.92387953f, -0.70710678f, -0.38268343f, 0.f, 0.38268343f, 0.70710678f, 0.92387953f};
__constant__ float S16[16] = {0.f, 0.38268343f, 0.70710678f, 0.92387953f, 1.f, 0.92387953f, 0.70710678f, 0.38268343f, 0.f, -0.38268343f, -0.70710678f, -0.92387953f, -1.f, -0.92387953f, -0.70710678f, -0.38268343f};
__device__ __forceinline__ void f2_phase(const Params& p) {
  unsigned char* ws = p.ws + opq0_(); unsigned char* r2 = (unsigned char*)p.out + opq0_();
  const int gt = bidx_() * 512 + tidx_(), ngt = gridDim.x * 512;
  constexpr int NPI = 2 * 512 * 513, NSI = 4 * 512 * 257;
  for (int it = gt; it < NPI + NSI; it += ngt) {
    int grp, n2, c, sl, N2, L, NN;
    if (it < NPI) { grp = 0; N2 = 513; L = LP; NN = 1024; n2 = it % 513; const int q = it / 513; c = q & 511; sl = q >> 9; }
    else { const int v = it - NPI; grp = 1; N2 = 257; L = LS; NN = 2048; n2 = v % 257; const int q = v / 257; c = q & 511; sl = q >> 9; }
    const bf16_t* wt = (const bf16_t*)(r2 + (grp ? R2_WTS : R2_WT)) + (size_t)sl * 1024 * L;
    const bf16_t* pr = wt + (size_t)c * L + n2; const bf16_t* pi = wt + (size_t)(512 + c) * L + n2;
    float re[16], im[16];
#pragma unroll
    for (int n1 = 0; n1 < 16; ++n1) { re[n1] = bf2f(pr[n1 * N2]); im[n1] = bf2f(pi[n1 * N2]); }
    const float* tw = (const float*)(ws + (grp ? T_TWS : T_TWP));
    const int ni = sl * 512 + c; const int Kd = 2 * (N2 - 1);
    bf16_t* btf = grp ? (bf16_t*)(ws + R1_BTFS) : (bf16_t*)(r2 + R2_BTFP);
    float* tv = (float*)(ws + T_TAILV) + (grp ? 32768 : 0);
    float Ar[4][4], Ai[4][4];
#pragma unroll
    for (int b = 0; b < 4; ++b) {
      const float x0r = re[b], x0i = im[b], x1r = re[4 + b], x1i = im[4 + b], x2r = re[8 + b], x2i = im[8 + b], x3r = re[12 + b], x3i = im[12 + b];
      const float s02r = x0r + x2r, s02i = x0i + x2i, d02r = x0r - x2r, d02i = x0i - x2i, s13r = x1r + x3r, s13i = x1i + x3i, d13r = x1r - x3r, d13i = x1i - x3i;
      Ar[0][b] = s02r + s13r; Ai[0][b] = s02i + s13i;
      Ar[2][b] = s02r - s13r; Ai[2][b] = s02i - s13i;
      Ar[1][b] = d02r + d13i; Ai[1][b] = d02i - d13r;
      Ar[3][b] = d02r - d13i; Ai[3][b] = d02i + d13r;
    }
#pragma unroll
    for (int c = 1; c < 4; ++c)
#pragma unroll
      for (int b = 1; b < 4; ++b) { const float cc = C16[(c * b) & 15], ss = S16[(c * b) & 15]; const float xr = Ar[c][b], xi = Ai[c][b]; Ar[c][b] = xr * cc + xi * ss; Ai[c][b] = xi * cc - xr * ss; }
#pragma unroll
    for (int c = 0; c < 4; ++c) {
      const float x0r = Ar[c][0], x0i = Ai[c][0], x1r = Ar[c][1], x1i = Ai[c][1], x2r = Ar[c][2], x2i = Ai[c][2], x3r = Ar[c][3], x3i = Ai[c][3];
      const float s02r = x0r + x2r, s02i = x0i + x2i, d02r = x0r - x2r, d02i = x0i - x2i, s13r = x1r + x3r, s13i = x1i + x3i, d13r = x1r - x3r, d13i = x1i - x3i;
      float Or[4], Oi[4];
      Or[0] = s02r + s13r; Oi[0] = s02i + s13i; Or[2] = s02r - s13r; Oi[2] = s02i - s13i;
      Or[1] = d02r + d13i; Oi[1] = d02i - d13r; Or[3] = d02r - d13i; Oi[3] = d02i + d13r;
#pragma unroll
      for (int d = 0; d < 4; ++d) {
        const int k1 = c + 4 * d; const float orr = Or[d], oii = Oi[d];
        const float tc = tw[(k1 * N2 + n2) * 2], ts = tw[(k1 * N2 + n2) * 2 + 1];
        const float ar = tc * orr + ts * oii, ai = tc * oii - ts * orr;
        if (n2 < N2 - 1) { bf16_t* dd = btf + ((size_t)k1 * NN + ni) * Kd + n2; dd[0] = f2bf(ar); dd[N2 - 1] = f2bf(ai); }
        else { float* dd = tv + ((size_t)k1 * NN + ni) * 2; dd[0] = ar; dd[1] = ai; }
      }
    }
  }
}

__device__ __forceinline__ void f3_tail_phase(const Params& p) {
  unsigned char* ws = p.ws + opq0_(); unsigned char* r2 = (unsigned char*)p.out + opq0_();
  bf16_t* mix = (bf16_t*)(ws + R1_MIX); const float* tc = (const float*)(ws + T_TAILC);
  const int lane = tidx_() & 63, gw = bidx_() * 8 + (tidx_() >> 6), nw = gridDim.x * 8;
  for (int it = gw; it < 16 * 1024 + 16 * 2048; it += nw) {
    int grp, k1, ni, N2, NN; if (it < 16384) { grp = 0; k1 = it >> 10; ni = it & 1023; N2 = 513; NN = 1024; } else { const int v = it - 16384; grp = 1; k1 = v >> 11; ni = v & 2047; N2 = 257; NN = 2048; }
    const int H = N2 - 1, Kd = 2 * H;
    const bf16_t* b = (grp ? (const bf16_t*)(ws + R1_BTFS) : (const bf16_t*)(r2 + R2_BTFP)) + ((size_t)k1 * NN + ni) * Kd;
    const float* arc = tc + (grp ? TC_ARCS : TC_ARCP); const float* ars = tc + (grp ? TC_ARSS : TC_ARSP);
    float acc = 0.f;
    if (lane * 8 < H) {
      const u32x4 vr = *(const u32x4*)(b + lane * 8), vi = *(const u32x4*)(b + H + lane * 8);
      const unsigned rw[4] = {vr.x, vr.y, vr.z, vr.w}, iw[4] = {vi.x, vi.y, vi.z, vi.w};
#pragma unroll
      for (int t = 0; t < 4; ++t) { const int n2 = lane * 8 + t * 2;
        acc += arc[n2] * bflo(rw[t]) + arc[n2 + 1] * bfhi(rw[t]) + ars[n2] * bflo(iw[t]) + ars[n2 + 1] * bfhi(iw[t]); }
    }
#pragma unroll
    for (int o = 32; o >= 1; o >>= 1) acc += shx(acc, o, lane);
    if (lane == 0) {
      const float* tv = (const float*)(ws + T_TAILV) + (grp ? 32768 : 0) + ((size_t)k1 * NN + ni) * 2;
      acc += arc[H] * tv[0] + ars[H] * tv[1];
      const float scale = grp ? rsqrtf(128.0f * LS) : rsqrtf(128.0f * LP);
      const int sl = ni >> 9, c = ni & 511, pos = k1 + 16 * H;
      const int row = (grp ? 2 * LPP + sl * LPS : sl * LPP) + PADR + pos;
      mix[(size_t)row * 1024 + c] = f2bf(acc * scale);
    }
  }
}

__device__ __forceinline__ void final_phase(const Params& p) {
  unsigned char* ws = p.ws + opq0_(); const bf16_t* h = (const bf16_t*)(ws + OFF_H); const float* rowsq = (const float*)(ws + T_ROWSQ); const float* g = inp(ws, 37);
  const int lane = tidx_() & 63, gw = bidx_() * 8 + (tidx_() >> 6), nw = gridDim.x * 8;
  for (int row = gw; row < MROWS; row += nw) {
    int seq, pos, L; row_info(row, seq, pos, L); if (pos < 16) continue;
    const float rs = row_rstd(rowsq, row);
    float* dst = p.out + (seq < 2 ? ((size_t)seq * 8192 + (pos - 16)) : ((size_t)16384 + (size_t)(seq - 2) * 4096 + (pos - 16))) * 1024;
#pragma unroll
    for (int i = 0; i < 4; ++i) { const int c = i * 256 + lane * 4; const u32x2 v = *(const u32x2*)(h + tix(row, c, 16)); const f32x4 gg = *(const f32x4*)(g + c);
      f32x4 o; o[0] = bflo(v.x) * rs * gg[0]; o[1] = bfhi(v.x) * rs * gg[1]; o[2] = bflo(v.y) * rs * gg[2]; o[3] = bfhi(v.y) * rs * gg[3]; *(f32x4*)(dst + c) = o; }
  }
}

__global__ void __launch_bounds__(512) __attribute__((amdgpu_flat_work_group_size(512, 512))) mega(Params p) {
  extern __shared__ __attribute__((aligned(16))) unsigned char smem[];
  LAS unsigned char* lds = (LAS unsigned char*)smem;
  cg::grid_group grid = cg::this_grid();
  LAS unsigned* xst = (LAS unsigned*)(lds + LDS_CTL + 32);
  if (threadIdx.x == 0) { xst[0] = 0u; xst[1] = 0u; (void)xb_add(&((unsigned*)(p.ws + T_BAR))[XB_XCNT(xcc_id_())], 1u); }
  __syncthreads();
#define SYNC_ do { XcdBarrier xb_; xb_.bar = (unsigned*)(p.ws + T_BAR); xb_.x = xcc_id_(); xb_.st = xst; xcd_barrier(xb_); } while (0)
  if (threadIdx.x == 0) { const unsigned x = xcc_id_(); LAS int* ctl = (LAS int*)(lds + LDS_CTL);
    const unsigned slot = __hip_atomic_fetch_add((unsigned*)(p.ws + T_CNT) + x, 1u, __ATOMIC_RELAXED, __HIP_MEMORY_SCOPE_AGENT); ctl[0] = (int)x; ctl[1] = (int)slot; }
  prep_misc(p); prep_weights(p, 0, lds); grid.sync();
  if (threadIdx.x == 0) { LAS int* ctl = (LAS int*)(lds + LDS_CTL); int ok = 1, mine = 0;
    for (int i = 0; i < 8; ++i) { const int c = (int)__hip_atomic_load((unsigned*)(p.ws + T_CNT) + i, __ATOMIC_RELAXED, __HIP_MEMORY_SCOPE_AGENT); if (c == 0) ok = 0; if (i == ctl[0]) mine = c; }
    ctl[2] = mine; ctl[3] = ok; }
  __syncthreads();
  gemm_phase(K_UP, 0, p, lds, 1); SYNC_;
  gemm_phase(K_DN, 0, p, lds, 2); prep_weights(p, 2, lds); SYNC_;
  gemm_phase(K_WINA, 0, p, lds, 3); prep_weights(p, 3, lds); SYNC_;
  ret_kv_phase(p, lds); SYNC_;
  ret_scan_phase(p); SYNC_;
  ret_out_phase(p, lds); SYNC_;
  xwa_phase(p); SYNC_;
  rwkv_scan2_phase(p, lds); SYNC_;
  rwkv_post_phase(p, lds); SYNC_;
  gemm_phase(K_WOUT, 0, p, lds, 4); prep_weights(p, 1, lds); SYNC_;
  gemm_phase(K_UP, 1, p, lds, 5); gemm_phase(K_FOLD, 0, p, lds); SYNC_;
  gemm_phase(K_DN, 1, p, lds, 6); SYNC_;
  gemm_phase(K_UP, 2, p, lds, 7); SYNC_;
  gemm_phase(K_DN, 2, p, lds, 8); SYNC_;
  gemm_phase(K_WIN1, 0, p, lds, 9); SYNC_;
  conv_phase(p); SYNC_;
  f2_phase(p); SYNC_;
  gemm_phase(K_F3, 0, p, lds); f3_tail_phase(p); SYNC_;
  gemm_phase(K_WOUT, 1, p, lds, 10); SYNC_;
  gemm_phase(K_UP, 3, p, lds, 11); SYNC_;
  gemm_phase(K_DN, 3, p, lds, 12); SYNC_;
  final_phase(p);
}

extern "C" void kernel_launch(void* const* d_in, const int* in_sizes, int n_in, void* d_out, int out_size, void* d_ws, size_t ws_size, hipStream_t stream) {
  constexpr size_t kDynLds = 144640;
  static int grid_blocks = 0;
  if (!grid_blocks) {
    int dev = 0, cus = 0, per_cu = 0;
    (void)hipGetDevice(&dev);
    (void)hipDeviceGetAttribute(&cus, hipDeviceAttributeMultiprocessorCount, dev);
    (void)hipFuncSetAttribute((const void*)mega, hipFuncAttributeMaxDynamicSharedMemorySize, (int)kDynLds);
    (void)hipOccupancyMaxActiveBlocksPerMultiprocessor(&per_cu, mega, 512, kDynLds);
    if (per_cu < 1) per_cu = 1;
    grid_blocks = cus * 1;
  }
  Params p{};
  for (int i = 0; i < 38; ++i) p.in[i] = (const float*)d_in[i];
  p.out = (float*)d_out; p.ws = (unsigned char*)d_ws;
  (void)hipMemsetAsync((char*)d_ws + T_CNT, 0, 128 + 14336, stream);
  void* args[] = {&p};
  hipError_t e = hipLaunchCooperativeKernel((void*)mega, dim3(grid_blocks), dim3(512), args, kDynLds, stream);
  if (e != hipSuccess) fprintf(stderr, "cooperative launch failed: %s (grid %d)\n", hipGetErrorString(e), grid_blocks);
}
```

```cpp
#include <hip/hip_runtime.h>
#include <hip/hip_cooperative_groups.h>
#include <cstdio>
namespace cg = cooperative_groups;
#define LAS __attribute__((address_space(3)))
typedef unsigned short bf16_t;
typedef short bf16x8 __attribute__((ext_vector_type(8)));
typedef float f32x4 __attribute__((ext_vector_type(4)));
typedef unsigned u32x4 __attribute__((ext_vector_type(4)));
typedef unsigned u32x2 __attribute__((ext_vector_type(2)));

constexpr int DM = 1024, FF = 2816;
constexpr int LP = 8208, LS = 4112, LPP = 8320, LPS = 4224, PADR = 112;
constexpr int MROWS = 2 * LPP + 4 * LPS;
constexpr int MT = MROWS / 256;
constexpr int MT_A = 66;
static_assert(MROWS % 256 == 0, "rows");
constexpr size_t SZ_H = (size_t)MROWS * DM * 2;
constexpr size_t SZ_UP = (size_t)2 * FF * DM * 2, SZ_DN = (size_t)DM * FF * 2, SZ_SQ = (size_t)DM * DM * 2;
constexpr size_t OFF_H = 0;
constexpr size_t OFF_W0 = OFF_H + SZ_H;
constexpr size_t W0_F1UP = OFF_W0, W0_F1DN = W0_F1UP + SZ_UP, W0_INA = W0_F1DN + SZ_DN, W0_INB = W0_INA + (size_t)1536 * DM * 2,
                 W0_OUT = W0_INB + (size_t)1792 * DM * 2, W0_F2UP = W0_OUT + SZ_SQ, W0_F2DN = W0_F2UP + SZ_UP;
constexpr size_t OFF_TAB = W0_F2DN + SZ_DN;
constexpr size_t T_ROWSQ = OFF_TAB;
constexpr size_t T_ROPE = T_ROWSQ + (size_t)MROWS * 16 * 4;
constexpr size_t T_ADFTP = T_ROPE + (size_t)LP * 64 * 4;
constexpr size_t T_ADFTS = T_ADFTP + (size_t)512 * 1024 * 2;
constexpr size_t T_FT = T_ADFTS + (size_t)256 * 512 * 2;
constexpr size_t T_WTMP = T_FT + (size_t)1024 * 512 * 2;
constexpr size_t T_TWP = T_WTMP + (size_t)1024 * 512 * 2;
constexpr size_t T_TWS = T_TWP + 65792;
constexpr size_t T_TAILC = T_TWS + 33024;
constexpr size_t T_TAILV = T_TAILC + 16384;
constexpr size_t T_BONUS = T_TAILV + 131072 + 262144;
constexpr size_t T_G2T = T_BONUS + (size_t)MROWS * 16 * 4;
constexpr size_t T_PTR = T_G2T + 131072;
constexpr size_t T_CNT = T_PTR + 384;
constexpr size_t T_BAR = T_PTR + 512;
constexpr size_t OFF_R1 = T_BAR + 14336;
constexpr int LDS_RSTD = 143360 + 64;
constexpr int LDS_CTL = 143360;
constexpr size_t WS_MIN = 268435456;
constexpr size_t R1_MIX = OFF_R1;
constexpr size_t SZ_MIX = (size_t)MROWS * 1024 * 2;
constexpr size_t R1_OF = R1_MIX + SZ_MIX, R1_OB = R1_OF + (size_t)MROWS * 512 * 2;
constexpr size_t R1_U = R1_MIX + SZ_MIX;
constexpr size_t R1_BTFS = R1_U;
constexpr size_t R1_ACTA = OFF_R1;
constexpr size_t SZ_W1 = SZ_UP + SZ_DN + (size_t)2560 * DM * 2 + SZ_SQ + SZ_UP + SZ_DN;
constexpr size_t OFF_W1 = WS_MIN - SZ_W1;
constexpr size_t W1_F1UP = OFF_W1, W1_F1DN = W1_F1UP + SZ_UP, W1_IN = W1_F1DN + SZ_DN, W1_OUT = W1_IN + (size_t)2560 * DM * 2,
                 W1_F2UP = W1_OUT + SZ_SQ, W1_F2DN = W1_F2UP + SZ_UP;
static_assert(R1_OB + (size_t)MROWS * 512 * 2 <= WS_MIN, "L0 mixer region");
static_assert(R1_ACTA + (size_t)MT_A * 256 * FF * 2 <= OFF_W1, "actA vs W1");
static_assert(R1_U + (size_t)MROWS * 512 * 2 <= OFF_W1, "u vs W1");
static_assert(R1_BTFS + (size_t)16 * 2048 * 512 * 2 <= OFF_W1, "btfs vs W1");
constexpr size_t SZ_OUT = (size_t)32768 * 1024 * 4;
static_assert(((size_t)96 << 20) + (size_t)66 * 262144 <= SZ_OUT && ((size_t)96 << 20) >= (size_t)(MT - MT_A) * 256 * FF * 2, "split-K scratch");
constexpr size_t R2_SPLITK = (size_t)96 << 20;
constexpr size_t R1_QK = R1_OF;
constexpr size_t R1_KVF = R1_OB;
constexpr size_t R1_KVB = R1_KVF + (size_t)1048 * 8192 * 2;
static_assert(R1_KVB + (size_t)1048 * 8192 * 2 <= R1_OB + (size_t)MROWS * 512 * 2, "kv in o_b region");
constexpr size_t R2_PRW = 0;
constexpr size_t R2_ACTB = 0;
constexpr size_t R2_WT = 0;
constexpr size_t R2_WTS = (size_t)2 * 1024 * LP * 2;
constexpr size_t R2_BTFP = R2_WTS + (size_t)4 * 1024 * LS * 2;
static_assert(R2_PRW + (size_t)MROWS * 1792 * 2 <= SZ_OUT, "r2 b");
static_assert(R2_BTFP + (size_t)16 * 1024 * 1024 * 2 <= SZ_OUT, "r2 c");
static_assert((size_t)(MT - MT_A) * 256 * FF * 2 <= SZ_OUT, "r2 d");
constexpr int TC_CTP = 0, TC_STP = 512, TC_ARCP = 1024, TC_ARSP = 1024 + 520, TC_CTS = 2080, TC_STS = 2080 + 256, TC_ARCS = 2600, TC_ARSS = 2600 + 264;

struct Params { const float* in[38]; float* out; unsigned char* ws; };

__device__ __forceinline__ bf16_t f2bf(float f) { unsigned u = __float_as_uint(f); u += 0x7FFFu + ((u >> 16) & 1u); return (bf16_t)(u >> 16); }
__device__ __forceinline__ float bf2f(bf16_t b) { return __uint_as_float(((unsigned)b) << 16); }
typedef float f32x2_t __attribute__((ext_vector_type(2)));
typedef __bf16 bf16x2_t __attribute__((ext_vector_type(2)));
__device__ __forceinline__ unsigned pack2(float a, float b) { f32x2_t v = {a, b}; bf16x2_t r = __builtin_convertvector(v, bf16x2_t); return __builtin_bit_cast(unsigned, r); }
__device__ __forceinline__ float bflo(unsigned u) { return __uint_as_float(u << 16); }
__device__ __forceinline__ float bfhi(unsigned u) { return __uint_as_float(u & 0xffff0000u); }
__device__ __forceinline__ int seq_base(int s) { return s < 2 ? s * LPP : 2 * LPP + (s - 2) * LPS; }
__device__ __forceinline__ void row_info(int row, int& seq, int& pos, int& L) {
  if (row < 2 * LPP) { seq = row >= LPP ? 1 : 0; pos = row - seq * LPP - PADR; L = LP; }
  else { const int r = row - 2 * LPP; const int s = r / LPS; seq = 2 + s; pos = r - s * LPS - PADR; L = LS; }
}
template <int CTRL> __device__ __forceinline__ float dppf(float v) { return __int_as_float(__builtin_amdgcn_update_dpp(0, __float_as_int(v), CTRL, 0xF, 0xF, true)); }
__device__ __forceinline__ float rowsum16(float v) { v += dppf<0xB1>(v); v += dppf<0x4E>(v); v += dppf<0x141>(v); v += dppf<0x140>(v); return v; }
__device__ __forceinline__ float rcpf_(float x) { return __builtin_amdgcn_rcpf(x); }
__device__ __forceinline__ float sigmoidf_(float x) { return rcpf_(1.0f + __expf(-x)); }
__device__ __forceinline__ f32x4 mfma16(bf16x8 a, bf16x8 b, f32x4 c) { return __builtin_amdgcn_mfma_f32_16x16x32_bf16(a, b, c, 0, 0, 0); }
__device__ __forceinline__ const float* inp(const unsigned char* ws, int i) {
  const unsigned long long v = ((const unsigned long long*)(ws + T_PTR))[i];
  const unsigned lo = __builtin_amdgcn_readfirstlane((unsigned)v), hi = __builtin_amdgcn_readfirstlane((unsigned)(v >> 32));
  return (const float*)(((unsigned long long)hi << 32) | (unsigned long long)lo);
}
__device__ __forceinline__ int tidx_() { int t = threadIdx.x; asm volatile("" : "+v"(t)); return t; }
__device__ __forceinline__ int bidx_() { int b = blockIdx.x; asm volatile("" : "+s"(b)); return b; }
__device__ __forceinline__ int gdim_() { int g = __builtin_amdgcn_readfirstlane((int)gridDim.x); asm volatile("" : "+s"(g)); return g; }
__device__ __forceinline__ float shx(float v, int o, int lane) { return __int_as_float(__builtin_amdgcn_ds_bpermute(((lane ^ o) & 63) << 2, __float_as_int(v))); }
__device__ __forceinline__ unsigned xcc_id_() { return (unsigned)__builtin_amdgcn_s_getreg((3 << 11) | 20) & 0xFu; }
__device__ __forceinline__ size_t tix(int row, int col, int KB) { return ((size_t)((row >> 7) * KB + (col >> 6)) << 13) + (size_t)((row & 127) * 64 + (col & 63)); }

#define XB_TMO      128
#define XB_XCNT(j)  (256  + 64 * (j))
#define XB_XSUB(j)  (1280 + 64 * (j))
#define XB_XGEN(j)  (2304 + 64 * (j))
#define XB_TOP      3328
#define XB_TOPGEN   3392
#define XCD_BAR_WORDS 3456
#define XB_SPIN_CAP (1u << 22)
__device__ __forceinline__ unsigned xb_ld(unsigned* p)              { return __hip_atomic_load(p, __ATOMIC_RELAXED, __HIP_MEMORY_SCOPE_AGENT); }
__device__ __forceinline__ unsigned xb_add(unsigned* p, unsigned v) { return __hip_atomic_fetch_add(p, v, __ATOMIC_RELAXED, __HIP_MEMORY_SCOPE_AGENT); }
#define XB_SPIN(cond, bar) do { unsigned _sp = 0; while (cond) { __builtin_amdgcn_s_sleep(1); \
    if ((++_sp & 255u) == 0u) { if (xb_ld(&(bar)[XB_TMO])) break; if (_sp > XB_SPIN_CAP) { atomicAdd(&(bar)[XB_TMO], 1u); break; } } } } while (0)
struct XcdBarrier { unsigned* bar; unsigned x; volatile LAS unsigned* st; };
__device__ __forceinline__ void xcd_barrier_complete(unsigned* bar, unsigned x, unsigned& nloc, unsigned& nx) {
    const unsigned G = gridDim.x * gridDim.y * gridDim.z;
    unsigned sum, cnt, mine, sp = 0u;
    for (;;) {
        sum = 0u; cnt = 0u; mine = 0u;
#pragma unroll
        for (unsigned j = 0; j < 16; ++j) { const unsigned c = xb_ld(&bar[XB_XCNT(j)]); sum += c; cnt += (c > 0u) ? 1u : 0u; mine = (j == x) ? c : mine; }
        if (sum == G) break;
        __builtin_amdgcn_s_sleep(1);
        if ((++sp & 255u) == 0u) { if (xb_ld(&bar[XB_TMO])) break; if (sp > XB_SPIN_CAP) { atomicAdd(&bar[XB_TMO], 1u); break; } }
    }
    nloc = mine > 0u ? mine : 1u; nx = cnt > 0u ? cnt : 1u;
}
__device__ __forceinline__ void xcd_barrier(const XcdBarrier& b) {
    asm volatile("s_waitcnt vmcnt(0)" ::: "memory");
    __syncthreads();
    if (threadIdx.x == 0) {
        unsigned* bar = b.bar;
        __builtin_amdgcn_s_waitcnt(0);
        unsigned nloc = b.st[0], nx = b.st[1];
        if (nloc == 0u) { xcd_barrier_complete(bar, b.x, nloc, nx); b.st[0] = nloc; b.st[1] = nx; }
        const unsigned old = xb_add(&bar[XB_XSUB(b.x)], 1u);
        const unsigned gen = old / nloc;
        if (old + 1u == (gen + 1u) * nloc) {
            __builtin_amdgcn_fence(__ATOMIC_RELEASE, "agent");
            asm volatile("s_waitcnt vmcnt(0)" ::: "memory");
            const unsigned og = xb_add(&bar[XB_TOP], 1u);
            const unsigned tg = og / nx;
            if (og + 1u == (tg + 1u) * nx) xb_add(&bar[XB_TOPGEN], 1u);
            else XB_SPIN(xb_ld(&bar[XB_TOPGEN]) == tg, bar);
            __builtin_amdgcn_fence(__ATOMIC_ACQUIRE, "agent");
            xb_add(&bar[XB_XGEN(b.x)], 1u);
            asm volatile("s_waitcnt vmcnt(0)" ::: "memory");
        } else {
            XB_SPIN(xb_ld(&bar[XB_XGEN(b.x)]) == gen, bar);
            __builtin_amdgcn_fence(__ATOMIC_ACQUIRE, "agent");
            asm volatile("s_waitcnt vmcnt(0)" ::: "memory");
        }
    }
    __syncthreads();
}
__device__ __forceinline__ size_t opq0_() { size_t z = 0; asm volatile("" : "+s"(z)); return z; }
constexpr int HTB = 128 * 64 * 2;
__device__ __forceinline__ int lds_byte(int r, int c) { const int st = (r >> 4) * 2 + (c >> 5), rr = r & 15, cc = c & 31, ob = rr * 64 + cc * 2; return st * 1024 + (ob ^ (((ob >> 9) & 1) << 5)); }
__device__ __forceinline__ void stage_rc(int b, int& R, int& C) { const int st = b / 1024, sb = b % 1024, swz = sb ^ (((sb >> 9) & 1) << 5); R = (st >> 1) * 16 + swz / 64; C = (st & 1) * 32 + (swz % 64) / 2; }

__device__ __forceinline__ void gemm_core(const bf16_t* A, int lda, size_t kstepA, size_t hA, const bf16_t* Bt, int ldb, size_t kstepB, size_t hB, int K, LAS unsigned char* lds, f32x4 (&acc)[2][2][4][2]) {
  const int tid = tidx_(), wid = tid >> 6, lane = tid & 63, wr = wid >> 2, wc = wid & 3, fr = lane & 15, fq = lane >> 4;
  unsigned voffA[2], voffB[2];
#pragma unroll
  for (int i = 0; i < 2; ++i) { int R, C; stage_rc(tid * 16 + i * 8192, R, C); voffA[i] = (unsigned)(R * lda + C) * 2u; voffB[i] = (unsigned)(R * ldb + C) * 2u; }
  const unsigned ldsw = (unsigned)wid * 1024u;
  const int aoff = lds_byte(wr * 64 + fr, fq * 8), boff = lds_byte(wc * 32 + fr, fq * 8);
  const char* gA = (const char*)A; const char* gB = (const char*)Bt;
#define SA_(b, h) (((b) * 2 + (h)) * HTB)
#define SB_(b, h) ((4 + (b) * 2 + (h)) * HTB)
#define STAGE_(bufoff, gbase, voff) do { _Pragma("unroll") for (int _i = 0; _i < 2; ++_i) \
    __builtin_amdgcn_global_load_lds((const unsigned*)((gbase) + (voff)[_i]), (LAS unsigned*)(lds + (bufoff) + ldsw + _i * 8192), 16, 0, 0); } while (0)
#define STA_(b, h, kt) STAGE_(SA_(b, h), gA + (size_t)(h) * hA + (size_t)(kt) * kstepA, voffA)
#define STB_(b, h, kt) STAGE_(SB_(b, h), gB + (size_t)(h) * hB + (size_t)(kt) * kstepB, voffB)
#define LDA_(dst, b, h) do { _Pragma("unroll") for (int m = 0; m < 4; ++m) _Pragma("unroll") for (int k = 0; k < 2; ++k) dst[m][k] = *(const LAS bf16x8*)(lds + SA_(b, h) + aoff + m * 2048 + k * 1024); } while (0)
#define LDB_(dst, b, h) do { _Pragma("unroll") for (int n = 0; n < 2; ++n) _Pragma("unroll") for (int k = 0; k < 2; ++k) dst[n][k] = *(const LAS bf16x8*)(lds + SB_(b, h) + boff + n * 2048 + k * 1024); } while (0)
#define MMA_(ai, bj, At, Bx) do { __builtin_amdgcn_s_setprio(1); _Pragma("unroll") for (int m = 0; m < 4; ++m) _Pragma("unroll") for (int n = 0; n < 2; ++n) _Pragma("unroll") for (int k = 0; k < 2; ++k) \
    acc[ai][bj][m][n] = __builtin_amdgcn_mfma_f32_16x16x32_bf16(Bx[n][k], At[m][k], acc[ai][bj][m][n], 0, 0, 0); __builtin_amdgcn_s_setprio(0); } while (0)
#define WAIT_V(n) asm volatile("s_waitcnt vmcnt(" #n ")" ::: "memory")
#define WAIT_L(n) asm volatile("s_waitcnt lgkmcnt(" #n ")" ::: "memory")
#define BAR_ __builtin_amdgcn_s_barrier()
#define SCHED_ __builtin_amdgcn_sched_barrier(0)
#pragma unroll
  for (int a = 0; a < 2; ++a)
#pragma unroll
    for (int b = 0; b < 2; ++b)
#pragma unroll
      for (int m = 0; m < 4; ++m)
#pragma unroll
        for (int n = 0; n < 2; ++n) acc[a][b][m][n] = (f32x4){0.f, 0.f, 0.f, 0.f};
  bf16x8 At[4][2], B0[2][2], B1[2][2];
  const int nt = K / 64;
  STB_(0, 0, 0); STA_(0, 0, 0); STB_(0, 1, 0); STA_(0, 1, 0);
  if (wr == 1) BAR_;
  WAIT_V(4); BAR_;
  STB_(1, 0, 1); STA_(1, 0, 1); STB_(1, 1, 1);
  WAIT_V(6); BAR_;
  for (int t = 0; t < nt - 2; t += 2) {
    LDB_(B0, 0, 0); SCHED_; LDA_(At, 0, 0); STA_(1, 1, t + 1);
    WAIT_L(8); BAR_; WAIT_L(0); MMA_(0, 0, At, B0); BAR_; SCHED_;
    LDB_(B1, 0, 1); STB_(0, 0, t + 2);
    BAR_; WAIT_L(0); MMA_(0, 1, At, B1); BAR_;
    LDA_(At, 0, 1); STA_(0, 0, t + 2);
    BAR_; WAIT_L(0); MMA_(1, 0, At, B0); BAR_; SCHED_;
    STB_(0, 1, t + 2);
    WAIT_V(6); BAR_; MMA_(1, 1, At, B1); BAR_;
    LDB_(B0, 1, 0); SCHED_; LDA_(At, 1, 0); STA_(0, 1, t + 2);
    WAIT_L(8); BAR_; WAIT_L(0); MMA_(0, 0, At, B0); BAR_; SCHED_;
    LDB_(B1, 1, 1); STB_(1, 0, t + 3);
    BAR_; WAIT_L(0); MMA_(0, 1, At, B1); BAR_;
    LDA_(At, 1, 1); STA_(1, 0, t + 3);
    BAR_; WAIT_L(0); MMA_(1, 0, At, B0); BAR_; SCHED_;
    STB_(1, 1, t + 3);
    WAIT_V(6); BAR_; MMA_(1, 1, At, B1); BAR_;
  }
  { LDB_(B0, 0, 0); LDA_(At, 0, 0); STA_(1, 1, nt - 1);
    BAR_; WAIT_L(0); MMA_(0, 0, At, B0); BAR_;
    LDB_(B1, 0, 1); BAR_; WAIT_L(0); MMA_(0, 1, At, B1); BAR_;
    LDA_(At, 0, 1); WAIT_V(4); BAR_; WAIT_L(0); MMA_(1, 0, At, B0); MMA_(1, 1, At, B1); BAR_; }
  { LDB_(B0, 1, 0); LDA_(At, 1, 0); WAIT_V(2); BAR_; WAIT_L(0); MMA_(0, 0, At, B0); BAR_;
    LDB_(B1, 1, 1); WAIT_V(0); BAR_; WAIT_L(0); MMA_(0, 1, At, B1); BAR_;
    LDA_(At, 1, 1); BAR_; WAIT_L(0); MMA_(1, 0, At, B0); MMA_(1, 1, At, B1); BAR_; }
  if (wr == 0) BAR_;
}

__device__ __forceinline__ bool unit_for(int it, int U, int nM, int nN, int& pm, int& pn, LAS unsigned char* lds) {
  const LAS int* ctl = (const LAS int*)(lds + LDS_CTL);
  const int x = __builtin_amdgcn_readfirstlane(ctl[0]), slot = __builtin_amdgcn_readfirstlane(ctl[1]), nx = __builtin_amdgcn_readfirstlane(ctl[2]), ok = __builtin_amdgcn_readfirstlane(ctl[3]);
  int l;
  if (ok) {
    const int q = U >> 3, r = U & 7;
    const int cnt = x < r ? q + 1 : q, start = x < r ? x * (q + 1) : r * (q + 1) + (x - r) * q;
    const int li = it * nx + slot; if (li >= cnt) return false; l = start + li;
  } else { const int G = gridDim.x, b = bidx_(); l = it * G + b; if (l >= U) return false; }
  const int nig = 8 * nN, gid = l / nig, within = l % nig, fm = gid * 8, gsz = (nM - fm) < 8 ? (nM - fm) : 8;
  pm = fm + within % gsz; pn = within / gsz; return true;
}

enum { K_UP = 0, K_DN = 1, K_WINA = 2, K_WINB = 3, K_WOUT = 4, K_WIN1 = 5, K_F3 = 6, K_FOLD = 7 };

__device__ __forceinline__ float row_rstd(const float* rowsq, int row) {
  const f32x4* q = (const f32x4*)(rowsq + (size_t)row * 16);
  const f32x4 a = q[0], b = q[1], c = q[2], d = q[3];
  const float s = ((a[0] + a[1]) + (a[2] + a[3])) + ((b[0] + b[1]) + (b[2] + b[3])) + ((c[0] + c[1]) + (c[2] + c[3])) + ((d[0] + d[1]) + (d[2] + d[3]));
  return rsqrtf(s * (1.0f / 1024.0f) + 1e-6f);
}

struct F3Info { int grp, k1, mt, nt; };
__device__ __forceinline__ void gemm_epilogue(const int kind, const int pm, const int pn, const F3Info f3, f32x4 (&acc)[2][2][4][2], unsigned char* ws, unsigned char* r2, LAS unsigned char* lds, const float* partial = nullptr) {
  const LAS float* rst = (const LAS float*)(lds + LDS_RSTD);
#define ACC_(ai, bj, m, n) (partial ? acc[ai][bj][m][n] + *(const f32x4*)(partial + (size_t)(((((ai) * 2 + (bj)) * 4 + (m)) * 2 + (n)) * 512 + tid) * 4) : acc[ai][bj][m][n])
  const int f3_grp = f3.grp, f3_k1 = f3.k1, f3_mt = f3.mt, f3_nt = f3.nt;
  {
    ws += opq0_(); r2 += opq0_();
    const int tid = tidx_(), wid = tid >> 6, lane = tid & 63, wr = wid >> 2, wc = wid & 3, fr = lane & 15, fq = lane >> 4;
    bf16_t* h = (bf16_t*)(ws + OFF_H);
    float* rowsq = (float*)(ws + T_ROWSQ);
    const int brow = pm * 256 + wr * 64 + fr;
    const int ccol = wc * 32 + fq * 4;
    if (kind == K_UP) {
      bf16_t* act = pm < MT_A ? (bf16_t*)(ws + R1_ACTA) : (bf16_t*)(r2 + R2_ACTB); const int arow0 = pm < MT_A ? 0 : MT_A * 256;
      bf16_t* actb = act + ((size_t)(((pm - (pm < MT_A ? 0 : MT_A)) * 2 * 44 + pn * 2 + (wc >> 1))) << 13) + (wr * 64 + fr) * 64 + (wc & 1) * 32 + fq * 4;
#pragma unroll
      for (int ai = 0; ai < 2; ++ai)
#pragma unroll
        for (int m = 0; m < 4; ++m) { asm volatile("" ::: "memory");
          const int row = brow + ai * 128 + m * 16; const float rs = rst[row - pm * 256];
#pragma unroll
          for (int n = 0; n < 2; ++n) {
            const f32x4 g = ACC_(ai, 0, m, n) * rs, u = ACC_(ai, 1, m, n) * rs; float o[4];
#pragma unroll
            for (int j = 0; j < 4; ++j) o[j] = g[j] * sigmoidf_(g[j]) * u[j];
            u32x2 w; w.x = pack2(o[0], o[1]); w.y = pack2(o[2], o[3]);
            *(u32x2*)(actb + ai * (44 << 13) + m * 1024 + n * 16) = w;
          }
        }
    } else if (kind == K_DN || kind == K_WOUT) {
      const float sc = kind == K_DN ? 0.5f : 1.0f;
      bf16_t* hb = h + ((size_t)((pm * 2 * 16 + pn * 4 + (wc >> 1))) << 13) + (wr * 64 + fr) * 64 + (wc & 1) * 32 + fq * 4;
#pragma unroll
      for (int ai = 0; ai < 2; ++ai)
#pragma unroll
        for (int m = 0; m < 4; ++m) { asm volatile("" ::: "memory");
          const int row = brow + ai * 128 + m * 16; int seq, pos, L; row_info(row, seq, pos, L);
          float ss = 0.f;
          if (pos >= 0) {
#pragma unroll
            for (int bj = 0; bj < 2; ++bj)
#pragma unroll
              for (int n = 0; n < 2; ++n) {
                bf16_t* hp = hb + ai * (16 << 13) + bj * (2 << 13) + m * 1024 + n * 16;
                const u32x2 old = *(const u32x2*)hp; const f32x4 a = ACC_(ai, bj, m, n);
                u32x2 w; w.x = pack2(bflo(old.x) + sc * a[0], bfhi(old.x) + sc * a[1]); w.y = pack2(bflo(old.y) + sc * a[2], bfhi(old.y) + sc * a[3]);
                *(u32x2*)hp = w;
                const float v0 = bflo(w.x), v1 = bfhi(w.x), v2 = bflo(w.y), v3 = bfhi(w.y);
                ss += (v0 * v0 + v1 * v1) + (v2 * v2 + v3 * v3);
              }
          }
          ss += shx(ss, 16, lane); ss += shx(ss, 32, lane);
          if (fq == 0) rowsq[(size_t)row * 16 + pn * 4 + wc] = ss;
        }
    } else if (kind == K_WINA) {
      if (pn < 2) {
        bf16_t* qk = (bf16_t*)(ws + R1_QK);
        const float* rc = (const float*)(ws + T_ROPE); const float* rsn = rc + (size_t)LP * 32;
        const float qs = pn == 0 ? 0.125f : 1.0f;
#pragma unroll
        for (int ai = 0; ai < 2; ++ai)
#pragma unroll
          for (int m = 0; m < 4; ++m) { asm volatile("" ::: "memory");
            const int row = brow + ai * 128 + m * 16; int seq, pos, L; row_info(row, seq, pos, L);
            const float rs = rst[row - pm * 256] * qs; const int pc = pos < 0 ? 0 : pos;
#pragma unroll
            for (int bj = 0; bj < 2; ++bj) {
              const int g = bj * 4 + wc, head = g >> 1, d1 = (g & 1) * 16 + fq * 4;
              const f32x4 x1 = ACC_(ai, bj, m, 0) * rs, x2 = ACC_(ai, bj, m, 1) * rs;
              const f32x4 c = *(const f32x4*)(rc + (size_t)pc * 32 + d1), s = *(const f32x4*)(rsn + (size_t)pc * 32 + d1);
              const f32x4 o1 = x1 * c - x2 * s, o2 = x1 * s + x2 * c;
              bf16_t* dst = qk + (size_t)row * 512 + pn * 256 + head * 64 + d1;
              u32x2 w; w.x = pack2(o1[0], o1[1]); w.y = pack2(o1[2], o1[3]); *(u32x2*)dst = w;
              w.x = pack2(o2[0], o2[1]); w.y = pack2(o2[2], o2[3]); *(u32x2*)(dst + 32) = w;
            }
          }
      } else if (pn >= 6) {
        bf16_t* dst = (bf16_t*)(r2 + R2_PRW);
#pragma unroll
        for (int ai = 0; ai < 2; ++ai)
#pragma unroll
          for (int m = 0; m < 4; ++m) { asm volatile("" ::: "memory");
            const int row = brow + ai * 128 + m * 16; const float rs = rst[row - pm * 256];
#pragma unroll
            for (int bj = 0; bj < 2; ++bj)
#pragma unroll
              for (int n = 0; n < 2; ++n) { const f32x4 a = ACC_(ai, bj, m, n) * rs; u32x2 w; w.x = pack2(a[0], a[1]); w.y = pack2(a[2], a[3]);
                *(u32x2*)(dst + (size_t)row * 1792 + (pn - 6) * 256 + bj * 128 + ccol + n * 16) = w; }
          }
      } else {
        bf16_t* mix = (bf16_t*)(ws + R1_MIX);
#pragma unroll
        for (int ai = 0; ai < 2; ++ai)
#pragma unroll
          for (int m = 0; m < 4; ++m) { asm volatile("" ::: "memory");
            const int row = brow + ai * 128 + m * 16; const float rs = rst[row - pm * 256];
#pragma unroll
            for (int bj = 0; bj < 2; ++bj)
#pragma unroll
              for (int n = 0; n < 2; ++n) { const f32x4 a = ACC_(ai, bj, m, n) * rs; u32x2 w; w.x = pack2(a[0], a[1]); w.y = pack2(a[2], a[3]);
                *(u32x2*)(mix + (size_t)row * 1024 + (pn - 2) * 256 + bj * 128 + ccol + n * 16) = w; }
          }
      }
    } else if (kind == K_WINB || kind == K_FOLD) {
      bf16_t* dst = kind == K_WINB ? (bf16_t*)(r2 + R2_PRW) : (bf16_t*)(ws + W1_IN);
      const int ldd = kind == K_WINB ? 1792 : 1024;
#pragma unroll
      for (int ai = 0; ai < 2; ++ai)
#pragma unroll
        for (int m = 0; m < 4; ++m) { asm volatile("" ::: "memory");
          const int row = brow + ai * 128 + m * 16; const float rs = kind == K_WINB ? rst[row - pm * 256] : 1.0f;
#pragma unroll
          for (int bj = 0; bj < 2; ++bj)
#pragma unroll
            for (int n = 0; n < 2; ++n) { const f32x4 a = ACC_(ai, bj, m, n) * rs; u32x2 w; w.x = pack2(a[0], a[1]); w.y = pack2(a[2], a[3]);
              const int col = pn * 256 + bj * 128 + ccol + n * 16; *(u32x2*)(dst + (kind == K_WINB ? (size_t)row * ldd + col : tix(row, col, 16))) = w; }
        }
    } else if (kind == K_WIN1) {
      bf16_t* mix = (bf16_t*)(ws + R1_MIX); bf16_t* ub = (bf16_t*)(ws + R1_U);
#pragma unroll
      for (int ai = 0; ai < 2; ++ai)
#pragma unroll
        for (int m = 0; m < 4; ++m) { asm volatile("" ::: "memory");
          const int row = brow + ai * 128 + m * 16; int seq, pos, L; row_info(row, seq, pos, L);
          const float rs = rst[row - pm * 256];
          if (pn < 4) {
            if (pos >= 0) {
              bf16_t* wt = (bf16_t*)(r2 + R2_WT) + (seq < 2 ? (size_t)seq * 1024 * LP : (size_t)2 * 1024 * LP + (size_t)(seq - 2) * 1024 * LS);
#pragma unroll
              for (int bj = 0; bj < 2; ++bj)
#pragma unroll
                for (int n = 0; n < 2; ++n) { const f32x4 a = ACC_(ai, bj, m, n) * rs; const int col = pn * 256 + bj * 128 + ccol + n * 16;
#pragma unroll
                  for (int j = 0; j < 4; ++j) wt[(size_t)(col + j) * L + pos] = f2bf(a[j]); }
            }
          } else if (pn < 6) {
#pragma unroll
            for (int bj = 0; bj < 2; ++bj)
#pragma unroll
              for (int n = 0; n < 2; ++n) { const f32x4 a = ACC_(ai, bj, m, n) * rs; u32x2 w; w.x = pack2(a[0], a[1]); w.y = pack2(a[2], a[3]);
                *(u32x2*)(mix + (size_t)row * 1024 + 512 + (pn - 4) * 256 + bj * 128 + ccol + n * 16) = w; }
          } else {
#pragma unroll
            for (int n = 0; n < 2; ++n) { const f32x4 a = (ACC_(ai, 0, m, n) * rs) * (ACC_(ai, 1, m, n) * rs); u32x2 w; w.x = pack2(a[0], a[1]); w.y = pack2(a[2], a[3]);
              *(u32x2*)(ub + (size_t)row * 512 + (pn - 6) * 128 + ccol + n * 16) = w; }
          }
        }
    } else {
      bf16_t* mix = (bf16_t*)(ws + R1_MIX);
      const float* tc = (const float*)(ws + T_TAILC);
      const float* ct = tc + (f3_grp ? TC_CTS : TC_CTP); const float* st = tc + (f3_grp ? TC_STS : TC_STP);
      const int NN = f3_grp ? 2048 : 1024;
      const float* tv = (const float*)(ws + T_TAILV) + (f3_grp ? 32768 : 0) + (size_t)f3_k1 * NN * 2;
      const float scale = f3_grp ? rsqrtf(128.0f * LS) : rsqrtf(128.0f * LP);
#pragma unroll
      for (int ai = 0; ai < 2; ++ai)
#pragma unroll
        for (int m = 0; m < 4; ++m) { asm volatile("" ::: "memory");
          const int k2 = f3_mt * 256 + wr * 64 + fr + ai * 128 + m * 16;
          const float c2 = ct[k2], s2 = st[k2]; const int pos = f3_k1 + 16 * k2;
#pragma unroll
          for (int bj = 0; bj < 2; ++bj)
#pragma unroll
            for (int n = 0; n < 2; ++n) {
              const int ni = f3_nt * 256 + bj * 128 + ccol + n * 16; const int sl = ni >> 9, c = ni & 511;
              const int row = (f3_grp ? 2 * LPP + sl * LPS : sl * LPP) + PADR + pos;
              const f32x4 t0 = *(const f32x4*)(tv + (size_t)ni * 2), t1 = *(const f32x4*)(tv + (size_t)ni * 2 + 4);
              const f32x4 a = acc[ai][bj][m][n];
              const float o0 = (a[0] + c2 * t0[0] + s2 * t0[1]) * scale, o1 = (a[1] + c2 * t0[2] + s2 * t0[3]) * scale,
                          o2 = (a[2] + c2 * t1[0] + s2 * t1[1]) * scale, o3 = (a[3] + c2 * t1[2] + s2 * t1[3]) * scale;
              u32x2 w; w.x = pack2(o0, o1); w.y = pack2(o2, o3);
              *(u32x2*)(mix + (size_t)row * 1024 + c) = w;
            }
        }
    }
  }
}

__device__ __forceinline__ void gemm_phase(const int kind, const int idx, const Params& p, LAS unsigned char* lds, const int seqid = 0) {
  unsigned char* ws = p.ws + opq0_(); unsigned char* r2 = (unsigned char*)p.out + opq0_();
  int nM = MT, nN = 4, K = 1024;
  const bf16_t* Wt = nullptr;
  switch (kind) {
    case K_UP: nN = 22; Wt = (const bf16_t*)(ws + (idx == 0 ? W0_F1UP : idx == 1 ? W0_F2UP : idx == 2 ? W1_F1UP : W1_F2UP)); break;
    case K_DN: nN = 4; K = FF; Wt = (const bf16_t*)(ws + (idx == 0 ? W0_F1DN : idx == 1 ? W0_F2DN : idx == 2 ? W1_F1DN : W1_F2DN)); break;
    case K_WINA: nN = 13; Wt = (const bf16_t*)(ws + W0_INA); break;
    case K_WINB: nN = 7; Wt = (const bf16_t*)(ws + W0_INB); break;
    case K_WOUT: nN = 4; Wt = (const bf16_t*)(ws + (idx == 0 ? W0_OUT : W1_OUT)); break;
    case K_WIN1: nN = 10; Wt = (const bf16_t*)(ws + W1_IN); break;
    case K_F3: nM = 1; nN = 256; break;
    default: nM = 4; nN = 4; K = 512; break;
  }
  const int U = nM * nN;
  for (int it = 0;; ++it) {
    int pm, pn;
    int khalf = -1;
    const bool split = kind == K_DN;
    if (split) {
      const LAS int* ctl = (const LAS int*)(lds + LDS_CTL);
      const int x = __builtin_amdgcn_readfirstlane(ctl[0]), slot = __builtin_amdgcn_readfirstlane(ctl[1]), nx = __builtin_amdgcn_readfirstlane(ctl[2]), ok = __builtin_amdgcn_readfirstlane(ctl[3]);
      int f = -1, hu = -1;
      if (ok) { const int li = it * nx + slot;
        if (li < 16 * nN) f = 16 * nN * x + li;
        else { const int hs = (6 * nN * x) >> 3, he = (6 * nN * (x + 1)) >> 3, j = li - 16 * nN; if (j < he - hs) hu = hs + j; else break; } }
      else { const int l = it * (int)gridDim.x + bidx_(); if (l < 128 * nN) f = l; else if (l < 134 * nN) hu = l - 128 * nN; else break; }
      if (f >= 0) { const int nig = 8 * nN, gid = f / nig, within = f % nig; pm = gid * 8 + (within & 7); pn = within >> 3; }
      else { const int u = hu >> 1; khalf = hu & 1; pm = 128 + u % 3; pn = u / 3; }
    } else if (!unit_for(it, U, nM, nN, pm, pn, lds)) break;
    const bf16_t* A; const bf16_t* Bt; int lda, ldb;
    int f3_k1 = 0, f3_mt = 0, f3_nt = 0, f3_grp = 0;
    if (kind == K_F3) {
      const int u = pn;
      if (u < 128) { f3_grp = 0; f3_k1 = u >> 3; f3_mt = (u >> 2) & 1; f3_nt = u & 3;
        A = (const bf16_t*)(ws + T_ADFTP) + (size_t)f3_mt * 256 * 1024; lda = 1024; Bt = (const bf16_t*)(r2 + R2_BTFP) + ((size_t)f3_k1 * 1024 + f3_nt * 256) * 1024; ldb = 1024; K = 1024; }
      else { const int v = u - 128; f3_grp = 1; f3_k1 = v >> 3; f3_mt = 0; f3_nt = v & 7;
        A = (const bf16_t*)(ws + T_ADFTS); lda = 512; Bt = (const bf16_t*)(ws + R1_BTFS) + ((size_t)f3_k1 * 2048 + f3_nt * 256) * 512; ldb = 512; K = 512; }
    } else if (kind == K_DN) {
      A = pm < MT_A ? (const bf16_t*)(ws + R1_ACTA) + (size_t)pm * 256 * FF : (const bf16_t*)(r2 + R2_ACTB) + (size_t)(pm - MT_A) * 256 * FF; lda = FF;
      Bt = Wt + (size_t)pn * 256 * FF; ldb = FF;
      K = FF;
    } else if (kind == K_WOUT) {
      A = (const bf16_t*)(ws + R1_MIX) + (size_t)pm * 256 * 1024; lda = 1024; Bt = Wt + (size_t)pn * 256 * 1024; ldb = 1024;
    } else if (kind == K_FOLD) {
      A = (const bf16_t*)(ws + T_FT) + (size_t)pm * 256 * 512; lda = 512; Bt = (const bf16_t*)(ws + T_WTMP) + (size_t)pn * 256 * 512; ldb = 512;
    } else {
      A = (const bf16_t*)(ws + OFF_H) + (size_t)pm * 256 * 1024; lda = 1024; Bt = Wt + (size_t)pn * 256 * 1024; ldb = 1024;
    }
    const bool tA = kind == K_UP || kind == K_DN || kind == K_WINA || kind == K_WINB || kind == K_WIN1;
    const bool tB = tA || kind == K_WOUT;
    const int KF = K;
    if (khalf >= 0) { const int hk = (K >> 7) * khalf; K >>= 1; A += tA ? (size_t)hk * 8192 : (size_t)hk * 64; Bt += (size_t)hk * 8192; }
    if (kind == K_UP || kind == K_WINA || kind == K_WINB || kind == K_WIN1) {
      const int t = tidx_(); if (t < 256) ((LAS float*)(lds + LDS_RSTD))[t] = row_rstd((const float*)(ws + T_ROWSQ), pm * 256 + t);
    }
    f32x4 acc[2][2][4][2];
    gemm_core(A, tA ? 64 : lda, tA ? (size_t)16384 : (size_t)128, tA ? (size_t)(KF >> 6) * 16384 : (size_t)128 * lda * 2,
              Bt, tB ? 64 : ldb, tB ? (size_t)16384 : (size_t)128, tB ? (size_t)(KF >> 6) * 16384 : (size_t)128 * ldb * 2, K, lds, acc);
    const float* partial = nullptr;
    if (khalf >= 0) {
      const int u = (pm - 128) + 3 * pn; const int t = tidx_();
      float* scr = (float*)(r2 + R2_SPLITK) + (size_t)u * 65536;
      unsigned* flag = (unsigned*)(ws + T_BAR + 13824) + u;
      if (khalf == 0) {
#pragma unroll
        for (int a = 0; a < 2; ++a)
#pragma unroll
          for (int b = 0; b < 2; ++b)
#pragma unroll
            for (int m = 0; m < 4; ++m)
#pragma unroll
              for (int n = 0; n < 2; ++n) *(f32x4*)(scr + (size_t)((((a * 2 + b) * 4 + m) * 2 + n) * 512 + t) * 4) = acc[a][b][m][n];
        asm volatile("s_waitcnt vmcnt(0)" ::: "memory");
        __syncthreads();
        if (t == 0) { __builtin_amdgcn_fence(__ATOMIC_RELEASE, "agent"); asm volatile("s_waitcnt vmcnt(0)" ::: "memory"); __hip_atomic_store(flag, (unsigned)seqid, __ATOMIC_RELAXED, __HIP_MEMORY_SCOPE_AGENT); }
        __syncthreads();
        continue;
      } else {
        if (t == 0) { unsigned sp = 0; while (__hip_atomic_load(flag, __ATOMIC_RELAXED, __HIP_MEMORY_SCOPE_AGENT) < (unsigned)seqid) { __builtin_amdgcn_s_sleep(2); if (++sp > (1u << 24)) break; }
          __builtin_amdgcn_fence(__ATOMIC_ACQUIRE, "agent"); asm volatile("s_waitcnt vmcnt(0)" ::: "memory"); }
        __syncthreads();
        partial = scr;
      }
    }
    { F3Info f3; f3.grp = f3_grp; f3.k1 = f3_k1; f3.mt = f3_mt; f3.nt = f3_nt; gemm_epilogue(kind, pm, pn, f3, acc, ws, r2, lds, partial); }
    WAIT_V(0);
    __syncthreads();
  }
}

__device__ __forceinline__ void gemm_phase_stream(const int kind, const int idx, const Params& p, LAS unsigned char* lds) {
  unsigned char* ws = p.ws + opq0_(); unsigned char* r2 = (unsigned char*)p.out + opq0_();
  int nM = MT, nN = 4, K = 1024, lda = 1024, ldb = 1024;
  const bf16_t* Wt = nullptr;
  switch (kind) {
    case K_UP: nN = 22; Wt = (const bf16_t*)(ws + (idx == 0 ? W0_F1UP : idx == 1 ? W0_F2UP : idx == 2 ? W1_F1UP : W1_F2UP)); break;
    case K_DN: nN = 4; K = FF; lda = FF; ldb = FF; Wt = (const bf16_t*)(ws + (idx == 0 ? W0_F1DN : idx == 1 ? W0_F2DN : idx == 2 ? W1_F1DN : W1_F2DN)); break;
    case K_WINA: nN = 13; Wt = (const bf16_t*)(ws + W0_INA); break;
    case K_WINB: nN = 7; Wt = (const bf16_t*)(ws + W0_INB); break;
    case K_WOUT: nN = 4; Wt = (const bf16_t*)(ws + (idx == 0 ? W0_OUT : W1_OUT)); break;
    default: nN = 10; Wt = (const bf16_t*)(ws + W1_IN); break;
  }
  const int U = nM * nN;
  int pm, pn;
  if (!unit_for(0, U, nM, nN, pm, pn, lds)) return;
  const int KB = K >> 6;
  const bool tiledA = kind != K_WOUT;
  auto ptrA = [&](int m) -> const char* {
    if (kind == K_DN) return (const char*)(m < MT_A ? (const bf16_t*)(ws + R1_ACTA) + (size_t)m * 256 * FF : (const bf16_t*)(r2 + R2_ACTB) + (size_t)(m - MT_A) * 256 * FF);
    if (kind == K_WOUT) return (const char*)((const bf16_t*)(ws + R1_MIX) + (size_t)m * 256 * 1024);
    return (const char*)((const bf16_t*)(ws + OFF_H) + (size_t)m * 256 * 1024); };
  auto ptrB = [&](int n) -> const char* { return (const char*)(Wt + (size_t)n * 256 * ldb); };
  const int tid = tidx_(), wid = tid >> 6, lane = tid & 63, wr = wid >> 2, wc = wid & 3, fr = lane & 15, fq = lane >> 4;
  unsigned voffA[2], voffB[2];
#pragma unroll
  for (int i = 0; i < 2; ++i) { int R, C; stage_rc(tid * 16 + i * 8192, R, C); voffA[i] = (unsigned)(R * (tiledA ? 64 : lda) + C) * 2u; voffB[i] = (unsigned)(R * 64 + C) * 2u; }
  const unsigned ldsw = (unsigned)wid * 1024u;
  const int aoff = lds_byte(wr * 64 + fr, fq * 8), boff = lds_byte(wc * 32 + fr, fq * 8);
  const size_t hA = tiledA ? (size_t)KB * 16384 : (size_t)128 * lda * 2, hB = (size_t)KB * 16384, kstepA = tiledA ? 16384 : 128, kstepB = 16384;
  const int nt = K / 64;
  const char* cA = ptrA(pm); const char* cB = ptrB(pn);
  f32x4 acc[2][2][4][2];
#pragma unroll
  for (int a = 0; a < 2; ++a)
#pragma unroll
    for (int b = 0; b < 2; ++b)
#pragma unroll
      for (int m = 0; m < 4; ++m)
#pragma unroll
        for (int n = 0; n < 2; ++n) acc[a][b][m][n] = (f32x4){0.f, 0.f, 0.f, 0.f};
  bf16x8 At[4][2], B0[2][2], B1[2][2];
  STAGE_(SB_(0, 0), cB, voffB); STAGE_(SA_(0, 0), cA, voffA); STAGE_(SB_(0, 1), cB + hB, voffB); STAGE_(SA_(0, 1), cA + hA, voffA);
  if (wr == 1) BAR_;
  WAIT_V(4); BAR_;
  STAGE_(SB_(1, 0), cB + kstepB, voffB); STAGE_(SA_(1, 0), cA + kstepA, voffA); STAGE_(SB_(1, 1), cB + hB + kstepB, voffB);
  WAIT_V(6); BAR_;
  int it = 0;
  for (;;) {
    int pm2 = 0, pn2 = 0;
    const bool has_next = unit_for(it + 1, U, nM, nN, pm2, pn2, lds);
    const char* nA = has_next ? ptrA(pm2) : cA; const char* nB = has_next ? ptrB(pn2) : cB;
    for (int t = 0; t < nt; t += 2) {
      const bool last = (t == nt - 2);
      const char* a1 = cA + (size_t)(t + 1) * kstepA;
      const char* a2 = last ? nA : cA + (size_t)(t + 2) * kstepA; const char* b2 = last ? nB : cB + (size_t)(t + 2) * kstepB;
      const char* a3 = a2 + kstepA; const char* b3 = b2 + kstepB;
      LDB_(B0, 0, 0); SCHED_; LDA_(At, 0, 0); STAGE_(SA_(1, 1), a1 + hA, voffA);
      WAIT_L(8); BAR_; WAIT_L(0); MMA_(0, 0, At, B0); BAR_; SCHED_;
      LDB_(B1, 0, 1); STAGE_(SB_(0, 0), b2, voffB);
      BAR_; WAIT_L(0); MMA_(0, 1, At, B1); BAR_;
      LDA_(At, 0, 1); STAGE_(SA_(0, 0), a2, voffA);
      BAR_; WAIT_L(0); MMA_(1, 0, At, B0); BAR_; SCHED_;
      STAGE_(SB_(0, 1), b2 + hB, voffB);
      WAIT_V(6); BAR_; MMA_(1, 1, At, B1); BAR_;
      LDB_(B0, 1, 0); SCHED_; LDA_(At, 1, 0); STAGE_(SA_(0, 1), a2 + hA, voffA);
      WAIT_L(8); BAR_; WAIT_L(0); MMA_(0, 0, At, B0); BAR_; SCHED_;
      LDB_(B1, 1, 1); STAGE_(SB_(1, 0), b3, voffB);
      BAR_; WAIT_L(0); MMA_(0, 1, At, B1); BAR_;
      LDA_(At, 1, 1); STAGE_(SA_(1, 0), a3, voffA);
      BAR_; WAIT_L(0); MMA_(1, 0, At, B0); BAR_; SCHED_;
      STAGE_(SB_(1, 1), b3 + hB, voffB);
      WAIT_V(6); BAR_; MMA_(1, 1, At, B1); BAR_;
    }
    { unsigned char* ws2 = ws + opq0_(); unsigned char* r22 = r2 + opq0_();
      F3Info f3; f3.grp = 0; f3.k1 = 0; f3.mt = 0; f3.nt = 0; gemm_epilogue(kind, pm, pn, f3, acc, ws2, r22, lds); }
    if (!has_next) break;
#pragma unroll
    for (int a = 0; a < 2; ++a)
#pragma unroll
      for (int b = 0; b < 2; ++b)
#pragma unroll
        for (int m = 0; m < 4; ++m)
#pragma unroll
          for (int n = 0; n < 2; ++n) acc[a][b][m][n] = (f32x4){0.f, 0.f, 0.f, 0.f};
    pm = pm2; pn = pn2; cA = nA; cB = nB; ++it;
  }
  WAIT_V(0);
  if (wr == 0) BAR_;
  BAR_;
  __syncthreads();
}
enum { CM_ID = 0, CM_ROPE = 1 };
struct Job { const float* src; const float* src2; const float* gain; bf16_t* dst; int ldw, K, Np, cm, off, half2; };
__device__ __forceinline__ void conv_tile(const Job& jb, int tn, int tk, LAS unsigned char* lds) {
  LAS float* tile = (LAS float*)lds;
  const int tid = tidx_();
  const int nn = tid & 63, n = tn * 64 + nn;
  const float* src = jb.src; int c;
  if (jb.half2 & 1) { const int t = n >> 8, r = n & 255; if (r >= 128) { src = jb.src2; c = (jb.half2 >> 1) + t * 128 + (r - 128); } else c = jb.off + t * 128 + r; }
  else if (jb.cm == CM_ROPE) { const int pnq = n >> 8, r = n & 255, bj = r >> 7, wc = (r >> 5) & 3, nq = (r >> 4) & 1, i = r & 15, g = bj * 4 + wc;
    c = jb.off + pnq * 256 + (g >> 1) * 64 + nq * 32 + (g & 1) * 16 + i; }
  else c = jb.off + n;
#pragma unroll
  for (int i = 0; i < 8; ++i) { const int kk = i * 8 + (tid >> 6), k = tk * 64 + kk;
    float v = src[(size_t)k * jb.ldw + c]; if (jb.gain) v *= jb.gain[k]; tile[nn * 65 + kk] = v; }
  __syncthreads();
  { const int r = tid >> 3, kc = (tid & 7) * 8; u32x4 w;
    w.x = pack2(tile[r * 65 + kc + 0], tile[r * 65 + kc + 1]); w.y = pack2(tile[r * 65 + kc + 2], tile[r * 65 + kc + 3]);
    w.z = pack2(tile[r * 65 + kc + 4], tile[r * 65 + kc + 5]); w.w = pack2(tile[r * 65 + kc + 6], tile[r * 65 + kc + 7]);
    *(u32x4*)(jb.dst + tix(tn * 64 + r, tk * 64 + kc, jb.K >> 6)) = w; }
  __syncthreads();
}
__device__ __forceinline__ Job mkjob(const float* s, const float* s2, const float* g, bf16_t* d, int ldw, int K, int Np, int cm, int off, int half2) {
  Job j; j.src = s; j.src2 = s2; j.gain = g; j.dst = d; j.ldw = ldw; j.K = K; j.Np = Np; j.cm = cm; j.off = off; j.half2 = half2; return j; }
__device__ __forceinline__ Job get_job(const Params& p, int set, int j, bool tab) {
  unsigned char* ws = p.ws + opq0_();
#define IN0(i) (tab ? inp(ws, i) : p.in[i])
  if (set == 0) {
    switch (j) {
      case 0: return mkjob(IN0(4), IN0(5), IN0(3), (bf16_t*)(ws + W0_F1UP), FF, 1024, 5632, 0, 0, 1);
      case 1: return mkjob(IN0(6), nullptr, nullptr, (bf16_t*)(ws + W0_F1DN), 1024, FF, 1024, 0, 0, 0);
      case 2: return mkjob(IN0(8), nullptr, IN0(7), (bf16_t*)(ws + W0_INA), 3328, 1024, 512, CM_ROPE, 0, 0);
      case 3: return mkjob(IN0(8), nullptr, IN0(7), (bf16_t*)(ws + W0_INA) + (size_t)512 * 1024, 3328, 1024, 1024, 0, 512, 0);
      case 4: return mkjob(IN0(8), nullptr, IN0(7), (bf16_t*)(ws + W0_INB), 3328, 1024, 1792, 0, 1536, 0);
      case 5: return mkjob(IN0(9), nullptr, nullptr, (bf16_t*)(ws + W0_OUT), 1024, 1024, 1024, 0, 0, 0);
      case 6: return mkjob(IN0(22), IN0(23), IN0(21), (bf16_t*)(ws + W0_F2UP), FF, 1024, 5632, 0, 0, 1);
      default: return mkjob(IN0(24), nullptr, nullptr, (bf16_t*)(ws + W0_F2DN), 1024, FF, 1024, 0, 0, 0);
    }
  } else {
    switch (j) {
      case 0: return mkjob(inp(ws, 26), inp(ws, 27), inp(ws, 25), (bf16_t*)(ws + W1_F1UP), FF, 1024, 5632, 0, 0, 1);
      case 1: return mkjob(inp(ws, 28), nullptr, nullptr, (bf16_t*)(ws + W1_F1DN), 1024, FF, 1024, 0, 0, 0);
      case 2: return mkjob(inp(ws, 30), nullptr, inp(ws, 29), (bf16_t*)(ws + W1_IN) + (size_t)1024 * 1024, 2048, 1024, 512, 0, 512, 0);
      case 3: return mkjob(inp(ws, 30), inp(ws, 30), inp(ws, 29), (bf16_t*)(ws + W1_IN) + (size_t)1536 * 1024, 2048, 1024, 1024, 0, 1024, 1 | (1536 << 1));
      case 4: return mkjob(inp(ws, 31), nullptr, nullptr, (bf16_t*)(ws + W1_OUT), 1024, 1024, 1024, 0, 0, 0);
      case 5: return mkjob(inp(ws, 34), inp(ws, 35), inp(ws, 33), (bf16_t*)(ws + W1_F2UP), FF, 1024, 5632, 0, 0, 1);
      case 6: return mkjob(inp(ws, 36), nullptr, nullptr, (bf16_t*)(ws + W1_F2DN), 1024, FF, 1024, 0, 0, 0);
      default: return mkjob(inp(ws, 32), nullptr, nullptr, nullptr, 0, 0, 0, 0, 0, 0);
    }
  }
}
__device__ __forceinline__ void prep_weights(const Params& p, int set, LAS unsigned char* lds) {
  const int j0 = set == 2 ? 4 : set == 3 ? 5 : 0, j1 = set == 0 ? 4 : set == 2 ? 5 : set == 3 ? 8 : 7;
  int base = 0;
  for (int j = j0; j < j1; ++j) {
    const Job jb = get_job(p, set == 1 ? 1 : 0, j, set != 0);
    const int tn = jb.Np / 64, tk = jb.K / 64, nt = tn * tk;
    const int G = gdim_();
    int t0 = (bidx_() - base % G + G) % G;
    for (int t = t0; t < nt; t += G) conv_tile(jb, t / tk, t % tk, lds);
    base += nt;
  }
}

__device__ __forceinline__ void prep_misc(const Params& p) {
  unsigned char* ws = p.ws + opq0_();
  const int tid = tidx_(), lane = tid & 63, gw = bidx_() * 8 + (tid >> 6), nw = gridDim.x * 8;
  bf16_t* h = (bf16_t*)(ws + OFF_H); float* rowsq = (float*)(ws + T_ROWSQ);
  for (int row = gw; row < MROWS; row += nw) {
    int seq, pos, L; row_info(row, seq, pos, L);
    const float* src = nullptr;
    if (pos >= 16) src = (seq < 2 ? p.in[0] + ((size_t)seq * 8192 + (pos - 16)) * 1024 : p.in[1] + ((size_t)(seq - 2) * 4096 + (pos - 16)) * 1024);
    else if (pos >= 0) src = p.in[2] + (size_t)pos * 1024;
    float ss = 0.f;
#pragma unroll
    for (int i = 0; i < 4; ++i) {
      const int c = i * 256 + lane * 4;
      f32x4 v = (f32x4){0.f, 0.f, 0.f, 0.f}; if (src) v = *(const f32x4*)(src + c);
      u32x2 w; w.x = pack2(v[0], v[1]); w.y = pack2(v[2], v[3]);
      *(u32x2*)(h + tix(row, c, 16)) = w;
      const float a = bflo(w.x), b = bfhi(w.x), cc = bflo(w.y), d = bfhi(w.y); ss += (a * a + b * b) + (cc * cc + d * d);
    }
#pragma unroll
    for (int o = 32; o >= 1; o >>= 1) ss += shx(ss, o, lane);
    if (lane < 16) rowsq[(size_t)row * 16 + lane] = lane == 0 ? ss : 0.f;
  }
  const int gt = bidx_() * 512 + tid, ngt = gridDim.x * 512;
  if (gt == 0) {
#pragma unroll
    for (int i = 0; i < 38; ++i) ((unsigned long long*)(ws + T_PTR))[i] = (unsigned long long)p.in[i];
  }
  { float* rc = (float*)(ws + T_ROPE); float* rs = rc + (size_t)LP * 32;
    for (int i = gt; i < LP * 32; i += ngt) { const int pos = i >> 5, d = i & 31; const float inv = powf(10000.0f, -(float)d / 32.0f); const float ang = (float)pos * inv; rc[i] = cosf(ang); rs[i] = sinf(ang); } }
  { bf16_t* a = (bf16_t*)(ws + T_ADFTP);
    for (int i = gt; i < 512 * 1024; i += ngt) { const int k2 = i >> 10, kk = i & 1023, n2 = kk & 511; const int mm = (k2 * n2) % 513; const float x = 2.0f * (float)mm / 513.0f; a[i] = f2bf(kk < 512 ? cospif(x) : sinpif(x)); }
    bf16_t* b = (bf16_t*)(ws + T_ADFTS);
    for (int i = gt; i < 256 * 512; i += ngt) { const int k2 = i >> 9, kk = i & 511, n2 = kk & 255; const int mm = (k2 * n2) % 257; const float x = 2.0f * (float)mm / 257.0f; b[i] = f2bf(kk < 256 ? cospif(x) : sinpif(x)); } }
  { bf16_t* f = (bf16_t*)(ws + T_FT);
    for (int i = gt; i < 1024 * 512; i += ngt) { const int np = i >> 9, kc = i & 511, part = np >> 9, g = (np >> 7) & 3, cp = np & 127, g2 = kc >> 7, c = kc & 127;
      float v = 0.f; if (g2 == g) { const float x = 2.0f * (float)((c * cp) & 127) / 128.0f; v = part == 0 ? cospif(x) : -sinpif(x); } f[i] = f2bf(v); } }
  { bf16_t* w = (bf16_t*)(ws + T_WTMP); const float* src = p.in[30]; const float* g = p.in[29];
    for (int i = gt; i < 1024 * 512; i += ngt) { const int k = i >> 9, c = i & 511; w[i] = f2bf(g[k] * src[(size_t)k * 2048 + c]); } }
  { float* tp = (float*)(ws + T_TWP); for (int i = gt; i < 16 * 513; i += ngt) { const int k1 = i / 513, n2 = i % 513; const float x = 2.0f * (float)(k1 * n2) / (float)LP; tp[2 * i] = cospif(x); tp[2 * i + 1] = sinpif(x); }
    float* ts = (float*)(ws + T_TWS); for (int i = gt; i < 16 * 257; i += ngt) { const int k1 = i / 257, n2 = i % 257; const float x = 2.0f * (float)(k1 * n2) / (float)LS; ts[2 * i] = cospif(x); ts[2 * i + 1] = sinpif(x); } }
  { float* tc = (float*)(ws + T_TAILC);
    for (int i = gt; i < 513; i += ngt) { const float x = 2.0f * (float)((i * 512) % 513) / 513.0f; const float c = cospif(x), s = sinpif(x);
      if (i < 512) { tc[TC_CTP + i] = c; tc[TC_STP + i] = s; } tc[TC_ARCP + i] = c; tc[TC_ARSP + i] = s; }
    for (int i = gt; i < 257; i += ngt) { const float x = 2.0f * (float)((i * 256) % 257) / 257.0f; const float c = cospif(x), s = sinpif(x);
      if (i < 256) { tc[TC_CTS + i] = c; tc[TC_STS + i] = s; } tc[TC_ARCS + i] = c; tc[TC_ARSS + i] = s; } }
  { bf16_t* g2t = (bf16_t*)(ws + T_G2T); const float* g2 = p.in[15]; for (int i = gt; i < 512 * 128; i += ngt) { const int c = i >> 7, r = i & 127; g2t[i] = f2bf(g2[(size_t)r * 512 + c]); } }
}
__device__ __forceinline__ void ret_unit(int uid, int& seq, int& chunk, int& head, int& cidx) {
  if (uid < 520) { seq = uid / 260; const int rem = uid % 260; chunk = rem >> 2; head = rem & 3; cidx = seq * 65 + chunk; }
  else { const int v = uid - 520; const int s = v / 132; seq = 2 + s; const int rem = v % 132; chunk = rem >> 2; head = rem & 3; cidx = 130 + s * 33 + chunk; }
}
__device__ __forceinline__ float ret_lg(int head) { return log1pf(-exp2f(-5.0f - (float)head)); }
constexpr int VT_LD = 136;

__device__ __forceinline__ void load_vT(const bf16_t* mix, int row0, int head, LAS bf16_t* vT) {
  const int tid = tidx_(), j = tid >> 2, e0 = (tid & 3) * 32;
  const u32x4* src = (const u32x4*)(mix + (size_t)(row0 + j) * 1024 + head * 128 + e0);
#pragma unroll
  for (int q = 0; q < 4; ++q) { const u32x4 v = src[q]; const unsigned w[4] = {v.x, v.y, v.z, v.w};
#pragma unroll
    for (int t = 0; t < 4; ++t) { vT[(e0 + q * 8 + t * 2) * VT_LD + j] = (bf16_t)(w[t] & 0xffff); vT[(e0 + q * 8 + t * 2 + 1) * VT_LD + j] = (bf16_t)(w[t] >> 16); } }
}

__device__ __forceinline__ void ret_kv_phase(const Params& p, LAS unsigned char* lds) {
  unsigned char* ws = p.ws + opq0_(); unsigned char* r2 = (unsigned char*)p.out + opq0_();
  const bf16_t* mix = (const bf16_t*)(ws + R1_MIX); const bf16_t* qk = (const bf16_t*)(ws + R1_QK);
  bf16_t* kvf = (bf16_t*)(ws + R1_KVF); bf16_t* kvb = (bf16_t*)(ws + R1_KVB);
  LAS bf16_t* vT = (LAS bf16_t*)lds; LAS bf16_t* kTf = vT + 128 * VT_LD; LAS bf16_t* kTb = kTf + 64 * VT_LD;
  const int tid = tidx_(), wid = tid >> 6, lane = tid & 63, fr = lane & 15, fq = lane >> 4;
  for (int uid = bidx_(); uid < 1048; uid += gridDim.x) {
    int seq, chunk, head, cidx; ret_unit(uid, seq, chunk, head, cidx);
    const int row0 = cidx * 128; const float lg = ret_lg(head);
    __syncthreads();
    load_vT(mix, row0, head, vT);
    { const int j = tid >> 2, d0 = (tid & 3) * 16;
      const float df = __expf(lg * (float)(127 - j)), db = __expf(lg * (float)j);
      const u32x4* src = (const u32x4*)(qk + (size_t)(row0 + j) * 512 + 256 + head * 64 + d0);
#pragma unroll
      for (int q = 0; q < 2; ++q) { const u32x4 v = src[q]; const unsigned w[4] = {v.x, v.y, v.z, v.w};
#pragma unroll
        for (int t = 0; t < 4; ++t) { const float lo = bflo(w[t]), hi = bfhi(w[t]); const int d = d0 + q * 8 + t * 2;
          kTf[d * VT_LD + j] = f2bf(lo * df); kTf[(d + 1) * VT_LD + j] = f2bf(hi * df);
          kTb[d * VT_LD + j] = f2bf(lo * db); kTb[(d + 1) * VT_LD + j] = f2bf(hi * db); } } }
    __syncthreads();
    f32x4 af[4], ab[4];
#pragma unroll
    for (int m = 0; m < 4; ++m) { af[m] = (f32x4){0.f, 0.f, 0.f, 0.f}; ab[m] = (f32x4){0.f, 0.f, 0.f, 0.f}; }
#pragma unroll
    for (int ks = 0; ks < 4; ++ks) {
      const bf16x8 y = *(const LAS bf16x8*)(vT + (wid * 16 + fr) * VT_LD + ks * 32 + fq * 8);
#pragma unroll
      for (int m = 0; m < 4; ++m) {
        const bf16x8 xf = *(const LAS bf16x8*)(kTf + (m * 16 + fr) * VT_LD + ks * 32 + fq * 8);
        const bf16x8 xb = *(const LAS bf16x8*)(kTb + (m * 16 + fr) * VT_LD + ks * 32 + fq * 8);
        af[m] = mfma16(xf, y, af[m]); ab[m] = mfma16(xb, y, ab[m]);
      }
    }
    const size_t o = ((size_t)(cidx * 4 + head) * 128 + wid * 16 + fr) * 64;
#pragma unroll
    for (int m = 0; m < 4; ++m) { u32x2 w; w.x = pack2(af[m][0], af[m][1]); w.y = pack2(af[m][2], af[m][3]); *(u32x2*)(kvf + o + m * 16 + fq * 4) = w;
      w.x = pack2(ab[m][0], ab[m][1]); w.y = pack2(ab[m][2], ab[m][3]); *(u32x2*)(kvb + o + m * 16 + fq * 4) = w; }
  }
}

__device__ __forceinline__ void ret_scan_phase(const Params& p) {
  unsigned char* ws = p.ws + opq0_();
  const int gt = bidx_() * 512 + tidx_(), ngt = gridDim.x * 512;
  for (int w = gt; w < 2 * 24 * 2048; w += ngt) {
    const int dir = w / (24 * 2048), rem = w % (24 * 2048), sh = rem >> 11, eg = rem & 2047, seq = sh >> 2, head = sh & 3;
    const int n = seq < 2 ? 65 : 33, cb = seq < 2 ? seq * 65 : 130 + (seq - 2) * 33;
    bf16_t* base = (bf16_t*)(ws + (dir ? R1_KVB : R1_KVF)) + (size_t)head * 8192 + eg * 4;
    const float gc = __expf(128.0f * ret_lg(head));
    float s0 = 0.f, s1 = 0.f, s2 = 0.f, s3 = 0.f;
    for (int i = 0; i < n; ++i) {
      const int c = dir ? n - 1 - i : i;
      u32x2* ptr = (u32x2*)(base + (size_t)(cb + c) * 4 * 8192);
      const u32x2 x = *ptr;
      u32x2 o; o.x = pack2(s0, s1); o.y = pack2(s2, s3); *ptr = o;
      s0 = gc * s0 + bflo(x.x); s1 = gc * s1 + bfhi(x.x); s2 = gc * s2 + bflo(x.y); s3 = gc * s3 + bfhi(x.y);
    }
  }
}

__device__ __forceinline__ bf16x8 scale_frag(bf16x8 v, float s) {
  bf16x8 o;
#pragma unroll
  for (int i = 0; i < 8; ++i) o[i] = (short)f2bf(bf2f((bf16_t)v[i]) * s);
  return o;
}

__device__ __forceinline__ void ret_out_phase(const Params& p, LAS unsigned char* lds) {
  unsigned char* ws = p.ws + opq0_(); unsigned char* r2 = (unsigned char*)p.out + opq0_();
  bf16_t* mix = (bf16_t*)(ws + R1_MIX); const bf16_t* qk = (const bf16_t*)(ws + R1_QK);
  const bf16_t* kvf = (const bf16_t*)(ws + R1_KVF); const bf16_t* kvb = (const bf16_t*)(ws + R1_KVB);
  LAS bf16_t* vT = (LAS bf16_t*)lds; LAS bf16_t* Pm = vT + 128 * VT_LD;
  const int tid = tidx_(), wid = tid >> 6, lane = tid & 63, fr = lane & 15, fq = lane >> 4;
  for (int uid = bidx_(); uid < 1048; uid += gridDim.x) {
    int seq, chunk, head, cidx; ret_unit(uid, seq, chunk, head, cidx);
    const int row0 = cidx * 128; const float lg = ret_lg(head);
    __syncthreads();
    load_vT(mix, row0, head, vT);
    bf16x8 qf[2];
#pragma unroll
    for (int ks = 0; ks < 2; ++ks) qf[ks] = *(const bf16x8*)(qk + (size_t)(row0 + wid * 16 + fr) * 512 + head * 64 + ks * 32 + fq * 8);
    f32x4 acc[8];
#pragma unroll
    for (int nt = 0; nt < 8; ++nt) {
      acc[nt] = (f32x4){0.f, 0.f, 0.f, 0.f};
#pragma unroll
      for (int ks = 0; ks < 2; ++ks) { const bf16x8 kf = *(const bf16x8*)(qk + (size_t)(row0 + nt * 16 + fr) * 512 + 256 + head * 64 + ks * 32 + fq * 8); acc[nt] = mfma16(qf[ks], kf, acc[nt]); }
    }
#pragma unroll
    for (int nt = 0; nt < 8; ++nt)
#pragma unroll
      for (int r = 0; r < 4; ++r) { const int i = wid * 16 + fq * 4 + r, j = nt * 16 + fr; const int dd = i > j ? i - j : j - i;
        Pm[i * VT_LD + j] = f2bf(acc[nt][r] * __expf(lg * (float)dd)); }
    __syncthreads();
    const int irow = wid * 16 + fr;
    const float g1 = __expf(lg * (float)(irow + 1)), g2 = __expf(lg * (float)(128 - irow));
    bf16x8 q1[2], q2[2];
#pragma unroll
    for (int ks = 0; ks < 2; ++ks) { q1[ks] = scale_frag(qf[ks], g1); q2[ks] = scale_frag(qf[ks], g2); }
    bf16x8 pf[4];
#pragma unroll
    for (int ks = 0; ks < 4; ++ks) pf[ks] = *(const LAS bf16x8*)(Pm + irow * VT_LD + ks * 32 + fq * 8);
    const bf16_t* sp = kvf + (size_t)(cidx * 4 + head) * 8192; const bf16_t* sn = kvb + (size_t)(cidx * 4 + head) * 8192;
    float ssq[4] = {0.f, 0.f, 0.f, 0.f};
#pragma unroll
    for (int nt = 0; nt < 8; ++nt) {
      f32x4 a = (f32x4){0.f, 0.f, 0.f, 0.f};
#pragma unroll
      for (int ks = 0; ks < 4; ++ks) { const bf16x8 y = *(const LAS bf16x8*)(vT + (nt * 16 + fr) * VT_LD + ks * 32 + fq * 8); a = mfma16(pf[ks], y, a); }
#pragma unroll
      for (int ks = 0; ks < 2; ++ks) { const bf16x8 y1 = *(const bf16x8*)(sp + (size_t)(nt * 16 + fr) * 64 + ks * 32 + fq * 8); a = mfma16(q1[ks], y1, a);
        const bf16x8 y2 = *(const bf16x8*)(sn + (size_t)(nt * 16 + fr) * 64 + ks * 32 + fq * 8); a = mfma16(q2[ks], y2, a); }
      acc[nt] = a;
#pragma unroll
      for (int r = 0; r < 4; ++r) ssq[r] += a[r] * a[r];
    }
#pragma unroll
    for (int r = 0; r < 4; ++r) { ssq[r] = rowsum16(ssq[r]); ssq[r] = rsqrtf(ssq[r] * (1.0f / 128.0f) + 1e-5f); }
    __syncthreads();
#pragma unroll
    for (int nt = 0; nt < 8; ++nt)
#pragma unroll
      for (int r = 0; r < 4; ++r) {
        const int i = wid * 16 + fq * 4 + r, e = nt * 16 + fr;
        bf16_t* dst = mix + (size_t)(row0 + i) * 1024 + head * 128 + e;
        const float gr = bf2f(dst[512]);
        *dst = f2bf(acc[nt][r] * ssq[r] * gr * sigmoidf_(gr));
      }
  }
}
__device__ __forceinline__ float tanh_fast(float x) { x = fminf(fmaxf(x, -15.f), 15.f); const float e = __expf(2.0f * x); return (e - 1.0f) * rcpf_(e + 1.0f); }
__device__ __forceinline__ f32x4 ld_bf4(const LAS bf16_t* p) { const u32x2 v = *(const LAS u32x2*)p; return (f32x4){bflo(v.x), bfhi(v.x), bflo(v.y), bfhi(v.y)}; }

__device__ __forceinline__ void rwkv_scan_phase(const Params& p, LAS unsigned char* lds) {
  unsigned char* ws = p.ws + opq0_(); unsigned char* r2 = (unsigned char*)p.out + opq0_();
  const bf16_t* prw = (const bf16_t*)(r2 + R2_PRW);
  float* bonus = (float*)(ws + T_BONUS);
  LAS bf16_t* raw = (LAS bf16_t*)lds;
  LAS bf16_t* txw = (LAS bf16_t*)(lds + 21760);
  LAS bf16_t* xab = (LAS bf16_t*)(lds + 26368);
  LAS bf16_t* w2s = (LAS bf16_t*)(lds + 30976);
  LAS bf16_t* a2s = (LAS bf16_t*)(lds + 40192);
  LAS float* pre = (LAS float*)(lds + 49408);
  LAS float* st = (LAS float*)(lds + 65792);
  LAS float* vbuf = (LAS float*)(lds + 106752);
  LAS float* sc = (LAS float*)(lds + 114944);
  LAS float* obuf = (LAS float*)(lds + 115456);
  const int tid = tidx_(), wid = tid >> 6, lane = tid & 63, fr = lane & 15, fq = lane >> 4;
  const float* mu = inp(ws, 10);
  for (int wi = bidx_(); wi < 256; wi += gridDim.x) {
    int dir, seq, head, rbase, NRW, L, rsplit;
    if (wi < 128) { const int chain = wi >> 2; rsplit = wi & 3; dir = chain >> 4; seq = (chain & 15) >> 3; head = chain & 7; NRW = 16; rbase = rsplit * 16; L = LP; }
    else { const int v = wi - 128; const int chain = v >> 1; rsplit = v & 1; dir = chain >> 5; seq = 2 + ((chain & 31) >> 3); head = chain & 7; NRW = 32; rbase = rsplit * 32; L = LS; }
    const int sb = seq_base(seq) + PADR;
    bf16_t* od = (bf16_t*)(ws + (dir ? R1_OB : R1_OF));
    const int nblk = (L + 31) >> 5;
    __syncthreads();
    { const float* w2 = inp(ws, 12) + (size_t)dir * 64 * 512 + head * 64; const float* a2 = inp(ws, 14) + (size_t)dir * 64 * 512 + head * 64;
#pragma unroll
      for (int i = 0; i < 8; ++i) { const int e = tid + i * 512, k = e & 63, r = e >> 6; w2s[k * 72 + r] = f2bf(w2[(size_t)r * 512 + k]); a2s[k * 72 + r] = f2bf(a2[(size_t)r * 512 + k]); } }
    const int kq = tid & 15, k0 = kq * 4, ch0 = head * 64 + k0;
    const f32x4 w0c = *(const f32x4*)(inp(ws, 11) + dir * 512 + ch0), a0c = *(const f32x4*)(inp(ws, 13) + dir * 512 + ch0);
    const f32x4 kkc = *(const f32x4*)(inp(ws, 16) + ch0), kac = *(const f32x4*)(inp(ws, 17) + ch0), rkc = *(const f32x4*)(inp(ws, 18) + ch0);
    const f32x4 mur = *(const f32x4*)(mu + ch0), muk = *(const f32x4*)(mu + 512 + ch0), muv = *(const f32x4*)(mu + 1024 + ch0);
    const int cb = (tid & 15) * 8;
    const f32x4 mub0 = *(const f32x4*)(mu + 1536 + cb), mub1 = *(const f32x4*)(mu + 1536 + cb + 4);
    u32x4 pf[3];
    auto issue = [&](int b) {
      const int ta = dir == 0 ? b * 32 : L - 32 - b * 32;
#pragma unroll
      for (int i = 0; i < 3; ++i) { const int li = tid + i * 512; pf[i] = (u32x4){0u, 0u, 0u, 0u};
        if (li < 1360) { const int ri = li / 40, rem = li % 40, seg = rem >> 3, chk = rem & 7; const int t = ta - 1 + ri;
          const int col = seg < 3 ? seg * 512 + head * 64 : 1536 + (seg - 3) * 64;
          if (t >= 0 && t < L) pf[i] = *(const u32x4*)(prw + (size_t)(sb + t) * 1792 + col + chk * 8); } }
    };
    issue(0);
    const int srow = wid * 4 + fq;
    const bool sactive = wid * 4 < NRW;
    float S0 = 0.f, S1 = 0.f, S2 = 0.f, S3 = 0.f;
    for (int b = 0; b < nblk; ++b) {
      const int ta = dir == 0 ? b * 32 : L - 32 - b * 32;
      const int nst = (L - b * 32) < 32 ? (L - b * 32) : 32;
#pragma unroll
      for (int i = 0; i < 3; ++i) { const int li = tid + i * 512; if (li < 1360) { const int ri = li / 40, rem = li % 40; *(LAS u32x4*)(raw + ri * 320 + rem * 8) = pf[i]; } }
      if (b + 1 < nblk) issue(b + 1);
      __syncthreads();
      { const int tl = tid >> 4, ri = tl + 1;
        const LAS bf16_t* q0 = raw + (ri - 1) * 320 + 192 + cb; const LAS bf16_t* q1 = q0 + 320; const LAS bf16_t* q2 = q1 + 320;
        float x[8];
#pragma unroll
        for (int hh = 0; hh < 2; ++hh) { const f32x4 a = ld_bf4(q0 + hh * 4), c = ld_bf4(q1 + hh * 4), d = ld_bf4(q2 + hh * 4); const f32x4 m = hh ? mub1 : mub0;
#pragma unroll
          for (int j = 0; j < 4; ++j) x[hh * 4 + j] = c[j] + m[j] * (0.5f * (a[j] + d[j]) - c[j]); }
        u32x4 w;
        if (cb < 64) { w.x = pack2(tanh_fast(x[0]), tanh_fast(x[1])); w.y = pack2(tanh_fast(x[2]), tanh_fast(x[3])); w.z = pack2(tanh_fast(x[4]), tanh_fast(x[5])); w.w = pack2(tanh_fast(x[6]), tanh_fast(x[7]));
          *(LAS u32x4*)(txw + tl * 72 + cb) = w; }
        else { w.x = pack2(x[0], x[1]); w.y = pack2(x[2], x[3]); w.z = pack2(x[4], x[5]); w.w = pack2(x[6], x[7]); *(LAS u32x4*)(xab + tl * 72 + cb - 64) = w; } }
      __syncthreads();
      { const int mat = wid >> 2, mt = (wid >> 1) & 1, ntp = wid & 1;
        const LAS bf16_t* X = mat ? xab : txw; const LAS bf16_t* Y = mat ? a2s : w2s;
#pragma unroll
        for (int nn = 0; nn < 2; ++nn) { const int nt = ntp * 2 + nn; f32x4 a = (f32x4){0.f, 0.f, 0.f, 0.f};
#pragma unroll
          for (int ks = 0; ks < 2; ++ks) { const bf16x8 xf = *(const LAS bf16x8*)(X + (mt * 16 + fr) * 72 + ks * 32 + fq * 8); const bf16x8 yf = *(const LAS bf16x8*)(Y + (nt * 16 + fr) * 72 + ks * 32 + fq * 8); a = mfma16(xf, yf, a); }
#pragma unroll
          for (int r = 0; r < 4; ++r) pre[mat * 2048 + (mt * 16 + fq * 4 + r) * 64 + nt * 16 + fr] = a[r]; } }
      __syncthreads();
      { const int tl = tid >> 4, ri = tl + 1, t = ta + tl;
        const LAS bf16_t* q1 = raw + ri * 320 + k0;
        f32x4 xr, xk, xv;
        { const f32x4 a = ld_bf4(q1 - 320), c = ld_bf4(q1), d = ld_bf4(q1 + 320); xr = c + mur * (0.5f * (a + d) - c); }
        { const f32x4 a = ld_bf4(q1 - 320 + 64), c = ld_bf4(q1 + 64), d = ld_bf4(q1 + 320 + 64); xk = c + muk * (0.5f * (a + d) - c); }
        { const f32x4 a = ld_bf4(q1 - 320 + 128), c = ld_bf4(q1 + 128), d = ld_bf4(q1 + 320 + 128); xv = c + muv * (0.5f * (a + d) - c); }
        const f32x4 wp = *(const LAS f32x4*)(pre + tl * 64 + k0), ap = *(const LAS f32x4*)(pre + 2048 + tl * 64 + k0);
        f32x4 w, a, kk, kd, bb, wrr;
        float ss = 0.f;
#pragma unroll
        for (int j = 0; j < 4; ++j) {
          const float wl = w0c[j] + wp[j]; const float ew = 0.60653066f * rcpf_(1.0f + __expf(-wl)); w[j] = __expf(-ew);
          a[j] = rcpf_(1.0f + __expf(-(a0c[j] + ap[j])));
          kk[j] = xk[j] * kkc[j]; ss += kk[j] * kk[j];
          kd[j] = xk[j] * (1.0f + (a[j] - 1.0f) * kac[j]);
          wrr[j] = w[j] * xr[j];
        }
        ss = rowsum16(ss); const float inv = rsqrtf(fmaxf(ss, 1e-24f));
        float br = 0.f, kdr = 0.f, bon = 0.f;
#pragma unroll
        for (int j = 0; j < 4; ++j) { kk[j] *= inv; bb[j] = kk[j] * a[j]; br += bb[j] * xr[j]; kdr += kd[j] * xr[j]; bon += xr[j] * kd[j] * rkc[j]; }
        br = rowsum16(br); kdr = rowsum16(kdr); bon = rowsum16(bon);
        LAS float* s = st + tl * 320 + k0;
        *(LAS f32x4*)(s) = kk; *(LAS f32x4*)(s + 64) = wrr; *(LAS f32x4*)(s + 128) = w; *(LAS f32x4*)(s + 192) = bb; *(LAS f32x4*)(s + 256) = kd;
        *(LAS f32x4*)(vbuf + tl * 64 + k0) = xv;
        if (kq == 0) { sc[tl * 4] = br; sc[tl * 4 + 1] = kdr; if (rsplit == 0 && t >= 0 && t < L) bonus[(size_t)(sb + t) * 16 + dir * 8 + head] = bon; } }
      __syncthreads();
      if (sactive) {
        int tl = dir ? 31 : 0;
        const LAS float* sp = st + tl * 320 + fr * 4;
        f32x4 kk = *(const LAS f32x4*)(sp), wr4 = *(const LAS f32x4*)(sp + 64), w4 = *(const LAS f32x4*)(sp + 128), b4 = *(const LAS f32x4*)(sp + 192), kd4 = *(const LAS f32x4*)(sp + 256);
        float vv = vbuf[tl * 64 + rbase + srow], br = sc[tl * 4], kdr = sc[tl * 4 + 1];
        for (int s = 0; s < nst; ++s) {
          const int tln = s + 1 < nst ? (dir ? 30 - s : s + 1) : tl;
          const LAS float* spn = st + tln * 320 + fr * 4;
          const f32x4 kkn = *(const LAS f32x4*)(spn), wrn = *(const LAS f32x4*)(spn + 64), wn = *(const LAS f32x4*)(spn + 128), bn = *(const LAS f32x4*)(spn + 192), kdn = *(const LAS f32x4*)(spn + 256);
          const float vvn = vbuf[tln * 64 + rbase + srow], brn = sc[tln * 4], kdrn = sc[tln * 4 + 1];
          float skp = (S0 * kk[0] + S1 * kk[1]) + (S2 * kk[2] + S3 * kk[3]);
          float pp = (S0 * wr4[0] + S1 * wr4[1]) + (S2 * wr4[2] + S3 * wr4[3]);
          const float sk = rowsum16(skp), pt = rowsum16(pp);
          S0 = S0 * w4[0] - sk * b4[0] + vv * kd4[0]; S1 = S1 * w4[1] - sk * b4[1] + vv * kd4[1];
          S2 = S2 * w4[2] - sk * b4[2] + vv * kd4[2]; S3 = S3 * w4[3] - sk * b4[3] + vv * kd4[3];
          if (fr == 0) obuf[tl * 32 + srow] = pt - sk * br + vv * kdr;
          kk = kkn; wr4 = wrn; w4 = wn; b4 = bn; kd4 = kdn; vv = vvn; br = brn; kdr = kdrn; tl = tln;
        }
      }
      __syncthreads();
#pragma unroll
      for (int i = 0; i < 2; ++i) { const int e = tid + i * 512, tl = e >> 5, rw = e & 31, t = ta + tl;
        if (rw < NRW && t >= 0 && t < L) od[(size_t)(sb + t) * 512 + head * 64 + rbase + rw] = f2bf(obuf[tl * 32 + rw]); }
    }
  }
}

__device__ __forceinline__ float rowsum8p(float v) { v += dppf<0xB1>(v); v += dppf<0x4E>(v); v += dppf<0x141>(v); return v; }
__device__ __forceinline__ void unpack8p(const u32x4 v, float (&o)[8]) { o[0] = bflo(v.x); o[1] = bfhi(v.x); o[2] = bflo(v.y); o[3] = bfhi(v.y); o[4] = bflo(v.z); o[5] = bfhi(v.z); o[6] = bflo(v.w); o[7] = bfhi(v.w); }
__device__ __forceinline__ void rwkv_post_phase(const Params& p, LAS unsigned char* lds) {
  unsigned char* ws = p.ws + opq0_(); unsigned char* r2 = (unsigned char*)p.out + opq0_();
  const bf16_t* prw = (const bf16_t*)(r2 + R2_PRW);
  const bf16_t* of = (const bf16_t*)(ws + R1_OF); const bf16_t* ob = (const bf16_t*)(ws + R1_OB);
  const float* bonus = (const float*)(ws + T_BONUS); const bf16_t* g2t = (const bf16_t*)(ws + T_G2T);
  bf16_t* mix = (bf16_t*)(ws + R1_MIX);
  const float* mu = inp(ws, 10); const float* lnw = inp(ws, 19); const float* lnb = inp(ws, 20);
  LAS bf16_t* sg = (LAS bf16_t*)lds;
  LAS float* gbuf = (LAS float*)(lds + 34816);
  const int tid = tidx_(), wid = tid >> 6, lane = tid & 63, fr = lane & 15, fq = lane >> 4;
  const int G = gdim_();
  for (int wjob = bidx_(); wjob < 256 + 48; wjob += G) {
    const int tile = wjob < 256 ? wjob : 256 + ((wjob - 256) >> 3); const int hd0 = wjob < 256 ? 0 : ((wjob - 256) & 7), hd1 = wjob < 256 ? 8 : hd0 + 1;
    const int row0 = tile * 128;
    __syncthreads();
    { const int tr = tid >> 2, c0 = (tid & 3) * 32, row = row0 + tr; int seq, pos, L; row_info(row, seq, pos, L);
      const bool hasp = pos > 0, hasn = pos >= 0 && pos < L - 1;
      const bf16_t* pc = prw + (size_t)row * 1792 + 1664 + c0;
#pragma unroll
      for (int q = 0; q < 4; ++q) {
        const u32x4 c = *(const u32x4*)(pc + q * 8); u32x4 a = (u32x4){0u, 0u, 0u, 0u}, d = (u32x4){0u, 0u, 0u, 0u};
        if (hasp) a = *(const u32x4*)(pc - 1792 + q * 8);
        if (hasn) d = *(const u32x4*)(pc + 1792 + q * 8);
        float cv[8], av[8], dv[8]; unpack8p(c, cv); unpack8p(a, av); unpack8p(d, dv);
        const f32x4 m0 = *(const f32x4*)(mu + 1664 + c0 + q * 8), m1 = *(const f32x4*)(mu + 1664 + c0 + q * 8 + 4);
        float x[8];
#pragma unroll
        for (int j = 0; j < 8; ++j) { const float m = j < 4 ? m0[j & 3] : m1[j & 3]; x[j] = sigmoidf_(cv[j] + m * (0.5f * (av[j] + dv[j]) - cv[j])); }
        *(LAS u32x4*)(sg + tr * VT_LD + c0 + q * 8) = (u32x4){pack2(x[0], x[1]), pack2(x[2], x[3]), pack2(x[4], x[5]), pack2(x[6], x[7])};
      } }
    __syncthreads();
    bf16x8 xf[4];
#pragma unroll
    for (int ks = 0; ks < 4; ++ks) xf[ks] = *(const LAS bf16x8*)(sg + (wid * 16 + fr) * VT_LD + ks * 32 + fq * 8);
    const int ch = tid & 7;
#pragma unroll 1
    for (int hd = hd0; hd < hd1; ++hd) {
      LAS float* gb = gbuf + (hd & 1) * (128 * 68);
#pragma unroll
      for (int nt = 0; nt < 4; ++nt) { f32x4 g = (f32x4){0.f, 0.f, 0.f, 0.f};
#pragma unroll
        for (int ks = 0; ks < 4; ++ks) { const bf16x8 yf = *(const bf16x8*)(g2t + (size_t)(hd * 64 + nt * 16 + fr) * 128 + ks * 32 + fq * 8); g = mfma16(xf[ks], yf, g); }
#pragma unroll
        for (int r = 0; r < 4; ++r) gb[(wid * 16 + fq * 4 + r) * 68 + nt * 16 + fr] = g[r]; }
      __syncthreads();
      const int cg = hd * 64 + ch * 8;
      const f32x4 w0 = *(const f32x4*)(lnw + cg), w1 = *(const f32x4*)(lnw + cg + 4), b0 = *(const f32x4*)(lnb + cg), b1 = *(const f32x4*)(lnb + cg + 4);
      const f32x4 mv0 = *(const f32x4*)(mu + 1024 + cg), mv1 = *(const f32x4*)(mu + 1024 + cg + 4);
#pragma unroll
      for (int i = 0; i < 2; ++i) {
        const int tk = (tid >> 3) + i * 64, row = row0 + tk; int seq, pos, L; row_info(row, seq, pos, L);
        u32x4 res = (u32x4){0u, 0u, 0u, 0u};
        if (pos >= 0) {
          float o1[8], o2[8], o[8];
          unpack8p(*(const u32x4*)(of + (size_t)row * 512 + cg), o1); unpack8p(*(const u32x4*)(ob + (size_t)row * 512 + cg), o2);
          float sum = 0.f;
#pragma unroll
          for (int j = 0; j < 8; ++j) { o[j] = o1[j] + o2[j]; sum += o[j]; }
          sum = rowsum8p(sum); const float mean = sum * (1.0f / 64.0f);
          float vs = 0.f;
#pragma unroll
          for (int j = 0; j < 8; ++j) { const float d = o[j] - mean; vs += d * d; }
          vs = rowsum8p(vs); const float rstd = rsqrtf(vs * (1.0f / 64.0f) + 64e-5f);
          const float bsc = 0.5f * (bonus[(size_t)row * 16 + hd] + bonus[(size_t)row * 16 + 8 + hd]);
          const bf16_t* pv = prw + (size_t)row * 1792 + 1024 + cg;
          float vc[8], va[8], vd[8];
          unpack8p(*(const u32x4*)pv, vc);
          u32x4 ua = (u32x4){0u, 0u, 0u, 0u}, ud = (u32x4){0u, 0u, 0u, 0u};
          if (pos > 0) ua = *(const u32x4*)(pv - 1792);
          if (pos < L - 1) ud = *(const u32x4*)(pv + 1792);
          unpack8p(ua, va); unpack8p(ud, vd);
          const f32x4 g0 = *(const LAS f32x4*)(gb + tk * 68 + ch * 8), g1 = *(const LAS f32x4*)(gb + tk * 68 + ch * 8 + 4);
          float y[8];
#pragma unroll
          for (int j = 0; j < 8; ++j) { const float lw = j < 4 ? w0[j & 3] : w1[j & 3], lb = j < 4 ? b0[j & 3] : b1[j & 3], mm = j < 4 ? mv0[j & 3] : mv1[j & 3], gg = j < 4 ? g0[j & 3] : g1[j & 3];
            const float xv = vc[j] + mm * (0.5f * (va[j] + vd[j]) - vc[j]);
            y[j] = ((o[j] - mean) * rstd * lw + lb + bsc * xv) * gg; }
          res = (u32x4){pack2(y[0], y[1]), pack2(y[2], y[3]), pack2(y[4], y[5]), pack2(y[6], y[7])};
        }
        *(u32x4*)(mix + (size_t)row * 1024 + 512 + cg) = res;
      }
    }
  }
}
__device__ __forceinline__ f32x4 g_bf4(const bf16_t* p) { const u32x2 v = *(const u32x2*)p; return (f32x4){bflo(v.x), bfhi(v.x), bflo(v.y), bfhi(v.y)}; }
__device__ __forceinline__ void unpack8(const u32x4 v, float (&o)[8]) { o[0] = bflo(v.x); o[1] = bfhi(v.x); o[2] = bflo(v.y); o[3] = bfhi(v.y); o[4] = bflo(v.z); o[5] = bfhi(v.z); o[6] = bflo(v.w); o[7] = bfhi(v.w); }
__device__ __forceinline__ float rowsum8(float v) { v += dppf<0xB1>(v); v += dppf<0x4E>(v); v += dppf<0x141>(v); return v; }

constexpr size_t R2_XWA = (size_t)MROWS * 1792 * 2;
static_assert(R2_XWA + (size_t)MROWS * 128 * 2 <= SZ_OUT, "xwa");
__device__ __forceinline__ void xwa_phase(const Params& p) {
  unsigned char* ws = p.ws + opq0_(); unsigned char* r2 = (unsigned char*)p.out + opq0_();
  const bf16_t* prw = (const bf16_t*)(r2 + R2_PRW); bf16_t* xwa = (bf16_t*)(r2 + R2_XWA);
  const float* mu = inp(ws, 10);
  const int gt = bidx_() * 512 + tidx_(), ngt = gdim_() * 512;
  for (int it = gt; it < MROWS * 16; it += ngt) {
    const int row = it >> 4, cb = (it & 15) * 8; int seq, pos, L; row_info(row, seq, pos, L);
    u32x4 o = (u32x4){0u, 0u, 0u, 0u};
    if (pos >= 0) {
      const bf16_t* pc = prw + (size_t)row * 1792 + 1536 + cb;
      u32x4 ua = (u32x4){0u, 0u, 0u, 0u}, ud = (u32x4){0u, 0u, 0u, 0u}; const u32x4 uc = *(const u32x4*)pc;
      if (pos > 0) ua = *(const u32x4*)(pc - 1792);
      if (pos < L - 1) ud = *(const u32x4*)(pc + 1792);
      float a[8], c[8], d[8], x[8]; unpack8(ua, a); unpack8(uc, c); unpack8(ud, d);
      const f32x4 m0 = *(const f32x4*)(mu + 1536 + cb), m1 = *(const f32x4*)(mu + 1536 + cb + 4);
#pragma unroll
      for (int j = 0; j < 8; ++j) { const float m = j < 4 ? m0[j & 3] : m1[j & 3]; x[j] = c[j] + m * (0.5f * (a[j] + d[j]) - c[j]); if (cb < 64) x[j] = tanh_fast(x[j]); }
      o = (u32x4){pack2(x[0], x[1]), pack2(x[2], x[3]), pack2(x[4], x[5]), pack2(x[6], x[7])};
    }
    *(u32x4*)(xwa + (size_t)row * 128 + cb) = o;
  }
}

static_assert(LP % 32 == 16 && LS % 32 == 16, "scan half-blocks assume 16-step halves");
__device__ __forceinline__ void rwkv_scan2_phase(const Params& p, LAS unsigned char* lds) {
  unsigned char* ws = p.ws + opq0_(); unsigned char* r2 = (unsigned char*)p.out + opq0_();
  const bf16_t* prw = (const bf16_t*)(r2 + R2_PRW);
  float* bonus = (float*)(ws + T_BONUS);
  LAS bf16_t* txw = (LAS bf16_t*)(lds + 0);
  LAS bf16_t* xab = (LAS bf16_t*)(lds + 4608);
  LAS bf16_t* w2s = (LAS bf16_t*)(lds + 9216);
  LAS bf16_t* a2s = (LAS bf16_t*)(lds + 18432);
  LAS float* pre = (LAS float*)(lds + 27648);
  LAS float* cst = (LAS float*)(lds + 44032);
  LAS float* stb = (LAS float*)(lds + 46080);
  LAS float* vbb = (LAS float*)(lds + 128000);
  LAS float* scb = (LAS float*)(lds + 132096);
  LAS float* ppb = (LAS float*)(lds + 133120);
  LAS float* skb = (LAS float*)(lds + 141312);
  const int tid = tidx_(), wid = tid >> 6, lane = tid & 63, fr = lane & 15, fq = lane >> 4;
  const float* mu = inp(ws, 10);
  const bool producer = wid >= 4;
  const int pw = wid - 4, ptid = tid - 256;
  const int G = gdim_();
  for (int slot = bidx_(); slot < 256; slot += G) {
    const int nitems = slot < 128 ? 1 : 2;
    for (int itx = 0; itx < nitems; ++itx) {
      int dir, seq, head, rsplit, L;
      if (slot < 128) { const int chain = slot >> 2; rsplit = slot & 3; dir = chain >> 4; seq = (chain & 15) >> 3; head = chain & 7; L = LP; }
      else { const int v = (slot - 128) * 2 + itx; const int chain = v >> 2; rsplit = v & 3; dir = chain >> 5; seq = 2 + ((chain & 31) >> 3); head = chain & 7; L = LS; }
      const int rbase = rsplit * 16;
      const int sb = seq_base(seq) + PADR;
      bf16_t* od = (bf16_t*)(ws + (dir ? R1_OB : R1_OF));
      const int nblk = (L + 31) >> 5;
      __syncthreads();
      { const float* w2 = inp(ws, 12) + (size_t)dir * 64 * 512 + head * 64; const float* a2 = inp(ws, 14) + (size_t)dir * 64 * 512 + head * 64;
#pragma unroll
        for (int i = 0; i < 8; ++i) { const int e = tid + i * 512, k = e & 63, r = e >> 6; w2s[k * 72 + r] = f2bf(w2[(size_t)r * 512 + k]); a2s[k * 72 + r] = f2bf(a2[(size_t)r * 512 + k]); }
        { const int v = tid >> 6, k = tid & 63, c = head * 64 + k; float x;
          switch (v) { case 0: x = inp(ws, 11)[dir * 512 + c]; break; case 1: x = inp(ws, 13)[dir * 512 + c]; break; case 2: x = inp(ws, 16)[c]; break; case 3: x = inp(ws, 17)[c]; break;
                       case 4: x = inp(ws, 18)[c]; break; case 5: x = mu[c]; break; case 6: x = mu[512 + c]; break; default: x = mu[1024 + c]; break; }
          cst[v * 64 + k] = x; } }
      __syncthreads();
      u32x4 pb[2], pd[3][3];
      const bf16_t* xwa = (const bf16_t*)(r2 + R2_XWA);
      const int cbB = (ptid & 15) * 8;
      const int dt = pw * 8 + (lane >> 3), dk0 = (lane & 7) * 8;
      auto issue_b = [&](int b) {
        const int ta = dir == 0 ? b * 32 : L - 32 - b * 32;
#pragma unroll
        for (int q = 0; q < 2; ++q) { const int t = ta + (ptid >> 4) + q * 16; pb[q] = (u32x4){0u, 0u, 0u, 0u};
          if (t >= 0 && t < L) pb[q] = *(const u32x4*)(xwa + (size_t)(sb + t) * 128 + cbB); }
      };
      auto issue_d = [&](int b) {
        const int ta = dir == 0 ? b * 32 : L - 32 - b * 32;
#pragma unroll
        for (int sg = 0; sg < 3; ++sg)
#pragma unroll
          for (int rr = 0; rr < 3; ++rr) { const int t = ta + dt - 1 + rr; pd[sg][rr] = (u32x4){0u, 0u, 0u, 0u};
            if (t >= 0 && t < L) pd[sg][rr] = *(const u32x4*)(prw + (size_t)(sb + t) * 1792 + sg * 512 + head * 64 + dk0); }
      };
      float xk[8] = {0.f, 0.f, 0.f, 0.f, 0.f, 0.f, 0.f, 0.f}; float inv = 0.f, br = 0.f, kdr = 0.f, bon = 0.f;
      if (producer) { issue_b(0); issue_d(0);
#pragma unroll
        for (int q = 0; q < 2; ++q) { const int tlb = (ptid >> 4) + q * 16;
          if (cbB < 64) *(LAS u32x4*)(txw + tlb * 72 + cbB) = pb[q]; else *(LAS u32x4*)(xab + tlb * 72 + cbB - 64) = pb[q]; }
        if (1 < nblk) issue_b(1); }
      __syncthreads();
      const int srow = wid * 4 + fq;
      f32x2_t S01 = {0.f, 0.f}, S23 = {0.f, 0.f};
      for (int b = -1; b <= nblk; ++b) {
        const int cur = b & 1, nxt = cur ^ 1;
        const int nst = (b >= 0 && b < nblk) ? ((L - b * 32) < 32 ? (L - b * 32) : 32) : 0;
        LAS float* st = stb + cur * 10240; LAS float* vb = vbb + cur * 512;
        for (int half = 0; half < 2; ++half) {
          if (producer) {
            const int fb = half ? b : b - 1, ph = half ^ 1;
            if (fb >= 0 && fb < nblk) {
              const int nstp = (L - fb * 32) < 32 ? (L - fb * 32) : 32; const int sl = ptid >> 4, rw = ptid & 15, sidx = ph * 16 + sl;
              if (sidx < nstp) {
                const int tl = dir ? 31 - sidx : sidx; const int t = (dir == 0 ? fb * 32 : L - 32 - fb * 32) + tl; const int bi = fb & 1;
                const f32x4 q = *(const LAS f32x4*)(ppb + ph * 1024 + (sl * 16 + rw) * 4); const float sk = skb[ph * 256 + sl * 16 + rw];
                const float o = ((q[0] + q[1]) + (q[2] + q[3])) - sk * scb[bi * 128 + tl * 4] + vbb[bi * 512 + tl * 16 + rw] * scb[bi * 128 + tl * 4 + 1];
                od[(size_t)(sb + t) * 512 + head * 64 + rbase + rw] = f2bf(o);
              }
            }
          }
          if (!producer) {
            const int s0 = half * 16, s1 = nst < s0 + 16 ? nst : s0 + 16;
            if (s0 < s1) {
              LAS float* ppw = ppb + half * 1024 + srow * 4 + (fr >> 2); LAS float* skw = skb + half * 256 + srow;
              f32x4 kkA, wrA, wA, bA, kdA, kkB, wrB, wB, bB, kdB; float vvA, vvB;
#define LOADR(X, s_) do { const int tl_ = dir ? 31 - (s_) : (s_); const LAS float* sp_ = st + tl_ * 320 + fr * 4; kk##X = *(const LAS f32x4*)(sp_); wr##X = *(const LAS f32x4*)(sp_ + 64); w##X = *(const LAS f32x4*)(sp_ + 128); \
                          b##X = *(const LAS f32x4*)(sp_ + 192); kd##X = *(const LAS f32x4*)(sp_ + 256); vv##X = vb[tl_ * 16 + srow]; } while (0)
#define STEPR(X, s_) do { const f32x2_t ts_ = __builtin_elementwise_fma(S23, kk##X.hi, S01 * kk##X.lo); const f32x2_t tp_ = __builtin_elementwise_fma(S23, wr##X.hi, S01 * wr##X.lo); \
                          const float sk_ = rowsum16(ts_.x + ts_.y); float pp_ = tp_.x + tp_.y; pp_ += dppf<0xB1>(pp_); pp_ += dppf<0x4E>(pp_); \
                          const f32x2_t nsk_ = {-sk_, -sk_}, vv2_ = {vv##X, vv##X}; \
                          S01 = __builtin_elementwise_fma(vv2_, kd##X.lo, __builtin_elementwise_fma(nsk_, b##X.lo, S01 * w##X.lo)); \
                          S23 = __builtin_elementwise_fma(vv2_, kd##X.hi, __builtin_elementwise_fma(nsk_, b##X.hi, S23 * w##X.hi)); \
                          ppw[((s_) - s0) * 64] = pp_; skw[((s_) - s0) * 16] = sk_; } while (0)
              LOADR(A, s0);
              for (int i = 0; i < 8; ++i) {
                const int s = s0 + 2 * i;
                LOADR(B, s + 1);
                STEPR(A, s);
                LOADR(A, i < 7 ? s + 2 : s + 1);
                STEPR(B, s + 1);
              }
#undef LOADR
#undef STEPR
            }
          } else {
            const int bn = b + 1; const int ta = dir == 0 ? bn * 32 : L - 32 - bn * 32;
            LAS float* prew = pre + pw * 1024;
            const int tloc = lane >> 3, tl = pw * 8 + tloc, t = ta + tl;
            LAS float* s = stb + nxt * 10240 + tl * 320 + dk0;
#define DGROUP(hh) do { f32x4 xr4; \
                { const u32x4 ua = pd[0][0], uc = pd[0][1], ud = pd[0][2]; \
                  const unsigned a0 = (hh) ? ua.z : ua.x, a1 = (hh) ? ua.w : ua.y, c0 = (hh) ? uc.z : uc.x, c1 = (hh) ? uc.w : uc.y, d0 = (hh) ? ud.z : ud.x, d1 = (hh) ? ud.w : ud.y; \
                  const float av[4] = {bflo(a0), bfhi(a0), bflo(a1), bfhi(a1)}, cv[4] = {bflo(c0), bfhi(c0), bflo(c1), bfhi(c1)}, dv[4] = {bflo(d0), bfhi(d0), bflo(d1), bfhi(d1)}; \
                  _Pragma("unroll") for (int j = 0; j < 4; ++j) xr4[j] = cv[j] + cst[5 * 64 + dk0 + (hh) * 4 + j] * (0.5f * (av[j] + dv[j]) - cv[j]); } \
                f32x4 w4, kk4, kd4, bb4, wr4; \
                _Pragma("unroll") for (int j = 0; j < 4; ++j) { const int kx = dk0 + (hh) * 4 + j; const float xkj = xk[(hh) * 4 + j]; \
                  const float wl = cst[0 * 64 + kx] + prew[tloc * 64 + kx]; const float ew = 0.60653066f * rcpf_(1.0f + __expf(-wl)); w4[j] = __expf(-ew); \
                  const float aj = rcpf_(1.0f + __expf(-(cst[1 * 64 + kx] + prew[512 + tloc * 64 + kx]))); \
                  kk4[j] = xkj * cst[2 * 64 + kx] * inv; kd4[j] = xkj * (1.0f + (aj - 1.0f) * cst[3 * 64 + kx]); bb4[j] = kk4[j] * aj; wr4[j] = w4[j] * xr4[j]; \
                  br += bb4[j] * xr4[j]; kdr += kd4[j] * xr4[j]; bon += xr4[j] * kd4[j] * cst[4 * 64 + kx]; } \
                *(LAS f32x4*)(s + (hh) * 4) = kk4; *(LAS f32x4*)(s + 64 + (hh) * 4) = wr4; *(LAS f32x4*)(s + 128 + (hh) * 4) = w4; *(LAS f32x4*)(s + 192 + (hh) * 4) = bb4; *(LAS f32x4*)(s + 256 + (hh) * 4) = kd4; } while (0)
            if (half == 0) {
              if (bn < nblk) {
#pragma unroll
                for (int mat = 0; mat < 2; ++mat) { const LAS bf16_t* X = mat ? xab : txw; const LAS bf16_t* Y = mat ? a2s : w2s;
                  const int xr = pw * 8 + (fr & 7);
                  bf16x8 xf[2];
#pragma unroll
                  for (int ks = 0; ks < 2; ++ks) xf[ks] = *(const LAS bf16x8*)(X + xr * 72 + ks * 32 + fq * 8);
#pragma unroll
                  for (int nt = 0; nt < 4; ++nt) { f32x4 a = (f32x4){0.f, 0.f, 0.f, 0.f};
#pragma unroll
                    for (int ks = 0; ks < 2; ++ks) { const bf16x8 yf = *(const LAS bf16x8*)(Y + (nt * 16 + fr) * 72 + ks * 32 + fq * 8); a = mfma16(xf[ks], yf, a); }
                    if (fq < 2) {
#pragma unroll
                      for (int r = 0; r < 4; ++r) prew[mat * 512 + (fq * 4 + r) * 64 + nt * 16 + fr] = a[r]; } } }
                { float a[8], c[8], d[8]; unpack8(pd[1][0], a); unpack8(pd[1][1], c); unpack8(pd[1][2], d);
#pragma unroll
                  for (int j = 0; j < 8; ++j) xk[j] = c[j] + cst[6 * 64 + dk0 + j] * (0.5f * (a[j] + d[j]) - c[j]); }
                float ss = 0.f;
#pragma unroll
                for (int j = 0; j < 8; ++j) { const float q = xk[j] * cst[2 * 64 + dk0 + j]; ss += q * q; }
                ss = rowsum8(ss); inv = rsqrtf(fmaxf(ss, 1e-24f));
                br = 0.f; kdr = 0.f; bon = 0.f;
                DGROUP(0);
              }
            } else {
              if (bn < nblk) {
                DGROUP(1);
                br = rowsum8(br); kdr = rowsum8(kdr); bon = rowsum8(bon);
                float xv[8];
                { float a[8], c[8], d[8]; unpack8(pd[2][0], a); unpack8(pd[2][1], c); unpack8(pd[2][2], d);
#pragma unroll
                  for (int j = 0; j < 8; ++j) xv[j] = c[j] + cst[7 * 64 + dk0 + j] * (0.5f * (a[j] + d[j]) - c[j]); }
                if (dk0 >= rbase && dk0 < rbase + 16) {
                  LAS float* vd = vbb + nxt * 512 + tl * 16 + (dk0 - rbase);
                  *(LAS f32x4*)(vd) = (f32x4){xv[0], xv[1], xv[2], xv[3]}; *(LAS f32x4*)(vd + 4) = (f32x4){xv[4], xv[5], xv[6], xv[7]};
                }
                if ((lane & 7) == 0) { LAS float* scn = scb + nxt * 128; scn[tl * 4] = br; scn[tl * 4 + 1] = kdr; if (rsplit == 0 && t >= 0 && t < L) bonus[(size_t)(sb + t) * 16 + dir * 8 + head] = bon; }
                if (b + 2 < nblk) issue_d(b + 2);
              }
              if (b + 2 < nblk) {
#pragma unroll
                for (int q = 0; q < 2; ++q) { const int tlb = (ptid >> 4) + q * 16;
                  if (cbB < 64) *(LAS u32x4*)(txw + tlb * 72 + cbB) = pb[q]; else *(LAS u32x4*)(xab + tlb * 72 + cbB - 64) = pb[q]; }
                if (b + 3 < nblk) issue_b(b + 3);
              }
            }
#undef DGROUP
          }
          __syncthreads();
        }
      }
    }
  }
}
__device__ __forceinline__ void conv_phase(const Params& p) {
  unsigned char* ws = p.ws + opq0_();
  bf16_t* mix = (bf16_t*)(ws + R1_MIX); const bf16_t* ub = (const bf16_t*)(ws + R1_U); const float* cw = inp(ws, 32);
  const int gt = bidx_() * 512 + tidx_(), ngt = gridDim.x * 512;
  for (int it = gt; it < MROWS * 64; it += ngt) {
    const int row = it >> 6, c0 = (it & 63) * 8; int seq, pos, L; row_info(row, seq, pos, L);
    u32x4 o = (u32x4){0u, 0u, 0u, 0u};
    bf16_t* dst = mix + (size_t)row * 1024 + 512 + c0;
    if (pos >= 0) {
      const bf16_t* up = ub + (size_t)row * 512 + c0;
      const u32x4 pb = *(const u32x4*)dst, c = *(const u32x4*)up; u32x4 a = (u32x4){0u, 0u, 0u, 0u}, d = (u32x4){0u, 0u, 0u, 0u};
      if (pos > 0) a = *(const u32x4*)(up - 512);
      if (pos < L - 1) d = *(const u32x4*)(up + 512);
      const unsigned pw[4] = {pb.x, pb.y, pb.z, pb.w}, cw4[4] = {c.x, c.y, c.z, c.w}, aw[4] = {a.x, a.y, a.z, a.w}, dw[4] = {d.x, d.y, d.z, d.w}; unsigned ow[4];
#pragma unroll
      for (int t = 0; t < 4; ++t) { const int cc = c0 + t * 2;
        const float y0 = cw[cc] * bflo(aw[t]) + cw[512 + cc] * bflo(cw4[t]) + cw[1024 + cc] * bflo(dw[t]);
        const float y1 = cw[cc + 1] * bfhi(aw[t]) + cw[512 + cc + 1] * bfhi(cw4[t]) + cw[1024 + cc + 1] * bfhi(dw[t]);
        ow[t] = pack2(bflo(pw[t]) * y0, bfhi(pw[t]) * y1); }
      o = (u32x4){ow[0], ow[1], ow[2], ow[3]};
    }
    *(u32x4*)dst = o;
  }
}

__constant__ float C16[16] = {1.f, 0.92387953f, 0.70710678f, 0.38268343f, 0.f, -0.38268343f, -0.70710678f, -0.92387953f, -1.f, -0.92387953f, -0.70710678f, -0.38268343f, 0.f, 0.38268343f, 0.70710678f, 0.92387953f};
__constant__ float S16[16] = {0.f, 0.38268343f, 0.70710678f, 0.92387953f, 1.f, 0.92387953f, 0.70710678f, 0.38268343f, 0.f, -0.38268343f, -0.70710678f, -0.92387953f, -1.f, -0.92387953f, -0.70710678f, -0.38268343f};
__device__ __forceinline__ void f2_phase(const Params& p) {
  unsigned char* ws = p.ws + opq0_(); unsigned char* r2 = (unsigned char*)p.out + opq0_();
  const int gt = bidx_() * 512 + tidx_(), ngt = gridDim.x * 512;
  constexpr int NPI = 2 * 512 * 513, NSI = 4 * 512 * 257;
  for (int it = gt; it < NPI + NSI; it += ngt) {
    int grp, n2, c, sl, N2, L, NN;
    if (it < NPI) { grp = 0; N2 = 513; L = LP; NN = 1024; n2 = it % 513; const int q = it / 513; c = q & 511; sl = q >> 9; }
    else { const int v = it - NPI; grp = 1; N2 = 257; L = LS; NN = 2048; n2 = v % 257; const int q = v / 257; c = q & 511; sl = q >> 9; }
    const bf16_t* wt = (const bf16_t*)(r2 + (grp ? R2_WTS : R2_WT)) + (size_t)sl * 1024 * L;
    const bf16_t* pr = wt + (size_t)c * L + n2; const bf16_t* pi = wt + (size_t)(512 + c) * L + n2;
    float re[16], im[16];
#pragma unroll
    for (int n1 = 0; n1 < 16; ++n1) { re[n1] = bf2f(pr[n1 * N2]); im[n1] = bf2f(pi[n1 * N2]); }
    const float* tw = (const float*)(ws + (grp ? T_TWS : T_TWP));
    const int ni = sl * 512 + c; const int Kd = 2 * (N2 - 1);
    bf16_t* btf = grp ? (bf16_t*)(ws + R1_BTFS) : (bf16_t*)(r2 + R2_BTFP);
    float* tv = (float*)(ws + T_TAILV) + (grp ? 32768 : 0);
    float Ar[4][4], Ai[4][4];
#pragma unroll
    for (int b = 0; b < 4; ++b) {
      const float x0r = re[b], x0i = im[b], x1r = re[4 + b], x1i = im[4 + b], x2r = re[8 + b], x2i = im[8 + b], x3r = re[12 + b], x3i = im[12 + b];
      const float s02r = x0r + x2r, s02i = x0i + x2i, d02r = x0r - x2r, d02i = x0i - x2i, s13r = x1r + x3r, s13i = x1i + x3i, d13r = x1r - x3r, d13i = x1i - x3i;
      Ar[0][b] = s02r + s13r; Ai[0][b] = s02i + s13i;
      Ar[2][b] = s02r - s13r; Ai[2][b] = s02i - s13i;
      Ar[1][b] = d02r + d13i; Ai[1][b] = d02i - d13r;
      Ar[3][b] = d02r - d13i; Ai[3][b] = d02i + d13r;
    }
#pragma unroll
    for (int c = 1; c < 4; ++c)
#pragma unroll
      for (int b = 1; b < 4; ++b) { const float cc = C16[(c * b) & 15], ss = S16[(c * b) & 15]; const float xr = Ar[c][b], xi = Ai[c][b]; Ar[c][b] = xr * cc + xi * ss; Ai[c][b] = xi * cc - xr * ss; }
#pragma unroll
    for (int c = 0; c < 4; ++c) {
      const float x0r = Ar[c][0], x0i = Ai[c][0], x1r = Ar[c][1], x1i = Ai[c][1], x2r = Ar[c][2], x2i = Ai[c][2], x3r = Ar[c][3], x3i = Ai[c][3];
      const float s02r = x0r + x2r, s02i = x0i + x2i, d02r = x0r - x2r, d02i = x0i - x2i, s13r = x1r + x3r, s13i = x1i + x3i, d13r = x1r - x3r, d13i = x1i - x3i;
      float Or[4], Oi[4];
      Or[0] = s02r + s13r; Oi[0] = s02i + s13i; Or[2] = s02r - s13r; Oi[2] = s02i - s13i;
      Or[1] = d02r + d13i; Oi[1] = d02i - d13r; Or[3] = d02r - d13i; Oi[3] = d02i + d13r;
#pragma unroll
      for (int d = 0; d < 4; ++d) {
        const int k1 = c + 4 * d; const float orr = Or[d], oii = Oi[d];
        const float tc = tw[(k1 * N2 + n2) * 2], ts = tw[(k1 * N2 + n2) * 2 + 1];
        const float ar = tc * orr + ts * oii, ai = tc * oii - ts * orr;
        if (n2 < N2 - 1) { bf16_t* dd = btf + ((size_t)k1 * NN + ni) * Kd + n2; dd[0] = f2bf(ar); dd[N2 - 1] = f2bf(ai); }
        else { float* dd = tv + ((size_t)k1 * NN + ni) * 2; dd[0] = ar; dd[1] = ai; }
      }
    }
  }
}

__device__ __forceinline__ void f3_tail_phase(const Params& p) {
  unsigned char* ws = p.ws + opq0_(); unsigned char* r2 = (unsigned char*)p.out + opq0_();
  bf16_t* mix = (bf16_t*)(ws + R1_MIX); const float* tc = (const float*)(ws + T_TAILC);
  const int lane = tidx_() & 63, gw = bidx_() * 8 + (tidx_() >> 6), nw = gridDim.x * 8;
  for (int it = gw; it < 16 * 1024 + 16 * 2048; it += nw) {
    int grp, k1, ni, N2, NN; if (it < 16384) { grp = 0; k1 = it >> 10; ni = it & 1023; N2 = 513; NN = 1024; } else { const int v = it - 16384; grp = 1; k1 = v >> 11; ni = v & 2047; N2 = 257; NN = 2048; }
    const int H = N2 - 1, Kd = 2 * H;
    const bf16_t* b = (grp ? (const bf16_t*)(ws + R1_BTFS) : (const bf16_t*)(r2 + R2_BTFP)) + ((size_t)k1 * NN + ni) * Kd;
    const float* arc = tc + (grp ? TC_ARCS : TC_ARCP); const float* ars = tc + (grp ? TC_ARSS : TC_ARSP);
    float acc = 0.f;
    if (lane * 8 < H) {
      const u32x4 vr = *(const u32x4*)(b + lane * 8), vi = *(const u32x4*)(b + H + lane * 8);
      const unsigned rw[4] = {vr.x, vr.y, vr.z, vr.w}, iw[4] = {vi.x, vi.y, vi.z, vi.w};
#pragma unroll
      for (int t = 0; t < 4; ++t) { const int n2 = lane * 8 + t * 2;
        acc += arc[n2] * bflo(rw[t]) + arc[n2 + 1] * bfhi(rw[t]) + ars[n2] * bflo(iw[t]) + ars[n2 + 1] * bfhi(iw[t]); }
    }
#pragma unroll
    for (int o = 32; o >= 1; o >>= 1) acc += shx(acc, o, lane);
    if (lane == 0) {
      const float* tv = (const float*)(ws + T_TAILV) + (grp ? 32768 : 0) + ((size_t)k1 * NN + ni) * 2;
      acc += arc[H] * tv[0] + ars[H] * tv[1];
      const float scale = grp ? rsqrtf(128.0f * LS) : rsqrtf(128.0f * LP);
      const int sl = ni >> 9, c = ni & 511, pos = k1 + 16 * H;
      const int row = (grp ? 2 * LPP + sl * LPS : sl * LPP) + PADR + pos;
      mix[(size_t)row * 1024 + c] = f2bf(acc * scale);
    }
  }
}

__device__ __forceinline__ void final_phase(const Params& p) {
  unsigned char* ws = p.ws + opq0_(); const bf16_t* h = (const bf16_t*)(ws + OFF_H); const float* rowsq = (const float*)(ws + T_ROWSQ); const float* g = inp(ws, 37);
  const int lane = tidx_() & 63, gw = bidx_() * 8 + (tidx_() >> 6), nw = gridDim.x * 8;
  for (int row = gw; row < MROWS; row += nw) {
    int seq, pos, L; row_info(row, seq, pos, L); if (pos < 16) continue;
    const float rs = row_rstd(rowsq, row);
    float* dst = p.out + (seq < 2 ? ((size_t)seq * 8192 + (pos - 16)) : ((size_t)16384 + (size_t)(seq - 2) * 4096 + (pos - 16))) * 1024;
#pragma unroll
    for (int i = 0; i < 4; ++i) { const int c = i * 256 + lane * 4; const u32x2 v = *(const u32x2*)(h + tix(row, c, 16)); const f32x4 gg = *(const f32x4*)(g + c);
      f32x4 o; o[0] = bflo(v.x) * rs * gg[0]; o[1] = bfhi(v.x) * rs * gg[1]; o[2] = bflo(v.y) * rs * gg[2]; o[3] = bfhi(v.y) * rs * gg[3]; *(f32x4*)(dst + c) = o; }
  }
}

__global__ void __launch_bounds__(512) __attribute__((amdgpu_flat_work_group_size(512, 512))) mega(Params p) {
  extern __shared__ __attribute__((aligned(16))) unsigned char smem[];
  LAS unsigned char* lds = (LAS unsigned char*)smem;
  cg::grid_group grid = cg::this_grid();
  LAS unsigned* xst = (LAS unsigned*)(lds + LDS_CTL + 32);
  if (threadIdx.x == 0) { xst[0] = 0u; xst[1] = 0u; (void)xb_add(&((unsigned*)(p.ws + T_BAR))[XB_XCNT(xcc_id_())], 1u); }
  __syncthreads();
#define SYNC_ do { XcdBarrier xb_; xb_.bar = (unsigned*)(p.ws + T_BAR); xb_.x = xcc_id_(); xb_.st = xst; xcd_barrier(xb_); } while (0)
  if (threadIdx.x == 0) { const unsigned x = xcc_id_(); LAS int* ctl = (LAS int*)(lds + LDS_CTL);
    const unsigned slot = __hip_atomic_fetch_add((unsigned*)(p.ws + T_CNT) + x, 1u, __ATOMIC_RELAXED, __HIP_MEMORY_SCOPE_AGENT); ctl[0] = (int)x; ctl[1] = (int)slot; }
  prep_misc(p); prep_weights(p, 0, lds); grid.sync();
  if (threadIdx.x == 0) { LAS int* ctl = (LAS int*)(lds + LDS_CTL); int ok = 1, mine = 0;
    for (int i = 0; i < 8; ++i) { const int c = (int)__hip_atomic_load((unsigned*)(p.ws + T_CNT) + i, __ATOMIC_RELAXED, __HIP_MEMORY_SCOPE_AGENT); if (c == 0) ok = 0; if (i == ctl[0]) mine = c; }
    ctl[2] = mine; ctl[3] = ok; }
  __syncthreads();
  gemm_phase(K_UP, 0, p, lds, 1); SYNC_;
  gemm_phase(K_DN, 0, p, lds, 2); prep_weights(p, 2, lds); SYNC_;
  gemm_phase(K_WINA, 0, p, lds, 3); prep_weights(p, 3, lds); SYNC_;
  ret_kv_phase(p, lds); SYNC_;
  ret_scan_phase(p); SYNC_;
  ret_out_phase(p, lds); SYNC_;
  xwa_phase(p); SYNC_;
  rwkv_scan2_phase(p, lds); SYNC_;
  rwkv_post_phase(p, lds); SYNC_;
  gemm_phase(K_WOUT, 0, p, lds, 4); prep_weights(p, 1, lds); SYNC_;
  gemm_phase(K_UP, 1, p, lds, 5); gemm_phase(K_FOLD, 0, p, lds); SYNC_;
  gemm_phase(K_DN, 1, p, lds, 6); SYNC_;
  gemm_phase(K_UP, 2, p, lds, 7); SYNC_;
  gemm_phase(K_DN, 2, p, lds, 8); SYNC_;
  gemm_phase(K_WIN1, 0, p, lds, 9); SYNC_;
  conv_phase(p); SYNC_;
  f2_phase(p); SYNC_;
  gemm_phase(K_F3, 0, p, lds); f3_tail_phase(p); SYNC_;
  gemm_phase(K_WOUT, 1, p, lds, 10); SYNC_;
  gemm_phase(K_UP, 3, p, lds, 11); SYNC_;
  gemm_phase(K_DN, 3, p, lds, 12); SYNC_;
  final_phase(p);
}

extern "C" void kernel_launch(void* const* d_in, const int* in_sizes, int n_in, void* d_out, int out_size, void* d_ws, size_t ws_size, hipStream_t stream) {
  constexpr size_t kDynLds = 144640;
  static int grid_blocks = 0;
  if (!grid_blocks) {
    int dev = 0, cus = 0, per_cu = 0;
    (void)hipGetDevice(&dev);
    (void)hipDeviceGetAttribute(&cus, hipDeviceAttributeMultiprocessorCount, dev);
    (void)hipFuncSetAttribute((const void*)mega, hipFuncAttributeMaxDynamicSharedMemorySize, (int)kDynLds);
    (void)hipOccupancyMaxActiveBlocksPerMultiprocessor(&per_cu, mega, 512, kDynLds);
    if (per_cu < 1) per_cu = 1;
    grid_blocks = cus * 1;
  }
  Params p{};
  for (int i = 0; i < 38; ++i) p.in[i] = (const float*)d_in[i];
  p.out = (float*)d_out; p.ws = (unsigned char*)d_ws;
  (void)hipMemsetAsync((char*)d_ws + T_CNT, 0, 128 + 14336, stream);
  void* args[] = {&p};
  hipError_t e = hipLaunchCooperativeKernel((void*)mega, dim3(grid_blocks), dim3(512), args, kDynLds, stream);
  if (e != hipSuccess) fprintf(stderr, "cooperative launch failed: %s (grid %d)\n", hipGetErrorString(e), grid_blocks);
}
```

```cpp
#include <hip/hip_runtime.h>
#include <hip/hip_cooperative_groups.h>
#include <cstdio>
namespace cg = cooperative_groups;
#define LAS __attribute__((address_space(3)))
typedef unsigned short bf16_t;
typedef short bf16x8 __attribute__((ext_vector_type(8)));
typedef float f32x4 __attribute__((ext_vector_type(4)));
typedef unsigned u32x4 __attribute__((ext_vector_type(4)));
typedef unsigned u32x2 __attribute__((ext_vector_type(2)));

constexpr int DM = 1024, FF = 2816;
constexpr int LP = 8208, LS = 4112, LPP = 8320, LPS = 4224, PADR = 112;
constexpr int MROWS = 2 * LPP + 4 * LPS;
constexpr int MT = MROWS / 256;
constexpr int MT_A = 66;
static_assert(MROWS % 256 == 0, "rows");
constexpr size_t SZ_H = (size_t)MROWS * DM * 2;
constexpr size_t SZ_UP = (size_t)2 * FF * DM * 2, SZ_DN = (size_t)DM * FF * 2, SZ_SQ = (size_t)DM * DM * 2;
constexpr size_t OFF_H = 0;
constexpr size_t OFF_W0 = OFF_H + SZ_H;
constexpr size_t W0_F1UP = OFF_W0, W0_F1DN = W0_F1UP + SZ_UP, W0_INA = W0_F1DN + SZ_DN, W0_INB = W0_INA + (size_t)1536 * DM * 2,
                 W0_OUT = W0_INB + (size_t)1792 * DM * 2, W0_F2UP = W0_OUT + SZ_SQ, W0_F2DN = W0_F2UP + SZ_UP;
constexpr size_t OFF_TAB = W0_F2DN + SZ_DN;
constexpr size_t T_ROWSQ = OFF_TAB;
constexpr size_t T_ROPE = T_ROWSQ + (size_t)MROWS * 16 * 4;
constexpr size_t T_ADFTP = T_ROPE + (size_t)LP * 64 * 4;
constexpr size_t T_ADFTS = T_ADFTP + (size_t)512 * 1024 * 2;
constexpr size_t T_FT = T_ADFTS + (size_t)256 * 512 * 2;
constexpr size_t T_WTMP = T_FT + (size_t)1024 * 512 * 2;
constexpr size_t T_TWP = T_WTMP + (size_t)1024 * 512 * 2;
constexpr size_t T_TWS = T_TWP + 65792;
constexpr size_t T_TAILC = T_TWS + 33024;
constexpr size_t T_TAILV = T_TAILC + 16384;
constexpr size_t T_BONUS = T_TAILV + 131072 + 262144;
constexpr size_t T_G2T = T_BONUS + (size_t)MROWS * 16 * 4;
constexpr size_t T_PTR = T_G2T + 131072;
constexpr size_t T_CNT = T_PTR + 384;
constexpr size_t T_BAR = T_PTR + 512;
constexpr size_t OFF_R1 = T_BAR + 14336;
constexpr int LDS_RSTD = 146944 + 64;
constexpr int LDS_CTL = 146944;
constexpr size_t WS_MIN = 268435456;
constexpr size_t R1_MIX = OFF_R1;
constexpr size_t SZ_MIX = (size_t)MROWS * 1024 * 2;
constexpr size_t R1_OF = R1_MIX + SZ_MIX, R1_OB = R1_OF + (size_t)MROWS * 512 * 2;
constexpr size_t R1_U = R1_MIX + SZ_MIX;
constexpr size_t R1_BTFS = R1_U;
constexpr size_t R1_ACTA = OFF_R1;
constexpr size_t SZ_W1 = SZ_UP + SZ_DN + (size_t)2560 * DM * 2 + SZ_SQ + SZ_UP + SZ_DN;
constexpr size_t OFF_W1 = WS_MIN - SZ_W1;
constexpr size_t W1_F1UP = OFF_W1, W1_F1DN = W1_F1UP + SZ_UP, W1_IN = W1_F1DN + SZ_DN, W1_OUT = W1_IN + (size_t)2560 * DM * 2,
                 W1_F2UP = W1_OUT + SZ_SQ, W1_F2DN = W1_F2UP + SZ_UP;
static_assert(R1_OB + (size_t)MROWS * 512 * 2 <= WS_MIN, "L0 mixer region");
static_assert(R1_ACTA + (size_t)MT_A * 256 * FF * 2 <= OFF_W1, "actA vs W1");
static_assert(R1_U + (size_t)MROWS * 512 * 2 <= OFF_W1, "u vs W1");
static_assert(R1_BTFS + (size_t)16 * 2048 * 512 * 2 <= OFF_W1, "btfs vs W1");
constexpr size_t SZ_OUT = (size_t)32768 * 1024 * 4;
static_assert(((size_t)96 << 20) + (size_t)66 * 262144 <= SZ_OUT && ((size_t)96 << 20) >= (size_t)(MT - MT_A) * 256 * FF * 2, "split-K scratch");
constexpr size_t R2_SPLITK = (size_t)96 << 20;
constexpr size_t R1_QK = R1_OF;
constexpr size_t R1_KVF = R1_OB;
constexpr size_t R1_KVB = R1_KVF + (size_t)1048 * 8192 * 2;
static_assert(R1_KVB + (size_t)1048 * 8192 * 2 <= R1_OB + (size_t)MROWS * 512 * 2, "kv in o_b region");
constexpr size_t R2_PRW = 0;
constexpr size_t R2_ACTB = 0;
constexpr size_t R2_WT = 0;
constexpr size_t R2_WTS = (size_t)2 * 1024 * LP * 2;
constexpr size_t R2_BTFP = R2_WTS + (size_t)4 * 1024 * LS * 2;
static_assert(R2_PRW + (size_t)MROWS * 1792 * 2 <= SZ_OUT, "r2 b");
static_assert(R2_BTFP + (size_t)16 * 1024 * 1024 * 2 <= SZ_OUT, "r2 c");
static_assert((size_t)(MT - MT_A) * 256 * FF * 2 <= SZ_OUT, "r2 d");
constexpr int TC_CTP = 0, TC_STP = 512, TC_ARCP = 1024, TC_ARSP = 1024 + 520, TC_CTS = 2080, TC_STS = 2080 + 256, TC_ARCS = 2600, TC_ARSS = 2600 + 264;

struct Params { const float* in[38]; float* out; unsigned char* ws; };

__device__ __forceinline__ bf16_t f2bf(float f) { unsigned u = __float_as_uint(f); u += 0x7FFFu + ((u >> 16) & 1u); return (bf16_t)(u >> 16); }
__device__ __forceinline__ float bf2f(bf16_t b) { return __uint_as_float(((unsigned)b) << 16); }
typedef float f32x2_t __attribute__((ext_vector_type(2)));
typedef __bf16 bf16x2_t __attribute__((ext_vector_type(2)));
__device__ __forceinline__ unsigned pack2(float a, float b) { f32x2_t v = {a, b}; bf16x2_t r = __builtin_convertvector(v, bf16x2_t); return __builtin_bit_cast(unsigned, r); }
__device__ __forceinline__ float bflo(unsigned u) { return __uint_as_float(u << 16); }
__device__ __forceinline__ float bfhi(unsigned u) { return __uint_as_float(u & 0xffff0000u); }
__device__ __forceinline__ int seq_base(int s) { return s < 2 ? s * LPP : 2 * LPP + (s - 2) * LPS; }
__device__ __forceinline__ void row_info(int row, int& seq, int& pos, int& L) {
  if (row < 2 * LPP) { seq = row >= LPP ? 1 : 0; pos = row - seq * LPP - PADR; L = LP; }
  else { const int r = row - 2 * LPP; const int s = r / LPS; seq = 2 + s; pos = r - s * LPS - PADR; L = LS; }
}
template <int CTRL> __device__ __forceinline__ float dppf(float v) { return __int_as_float(__builtin_amdgcn_update_dpp(0, __float_as_int(v), CTRL, 0xF, 0xF, true)); }
__device__ __forceinline__ float rowsum16(float v) { v += dppf<0xB1>(v); v += dppf<0x4E>(v); v += dppf<0x141>(v); v += dppf<0x140>(v); return v; }
__device__ __forceinline__ float rcpf_(float x) { return __builtin_amdgcn_rcpf(x); }
__device__ __forceinline__ float sigmoidf_(float x) { return rcpf_(1.0f + __expf(-x)); }
__device__ __forceinline__ f32x4 mfma16(bf16x8 a, bf16x8 b, f32x4 c) { return __builtin_amdgcn_mfma_f32_16x16x32_bf16(a, b, c, 0, 0, 0); }
__device__ __forceinline__ const float* inp(const unsigned char* ws, int i) {
  const unsigned long long v = ((const unsigned long long*)(ws + T_PTR))[i];
  const unsigned lo = __builtin_amdgcn_readfirstlane((unsigned)v), hi = __builtin_amdgcn_readfirstlane((unsigned)(v >> 32));
  return (const float*)(((unsigned long long)hi << 32) | (unsigned long long)lo);
}
__device__ __forceinline__ int tidx_() { int t = threadIdx.x; asm volatile("" : "+v"(t)); return t; }
__device__ __forceinline__ int bidx_() { int b = blockIdx.x; asm volatile("" : "+s"(b)); return b; }
__device__ __forceinline__ int gdim_() { int g = __builtin_amdgcn_readfirstlane((int)gridDim.x); asm volatile("" : "+s"(g)); return g; }
__device__ __forceinline__ float shx(float v, int o, int lane) { return __int_as_float(__builtin_amdgcn_ds_bpermute(((lane ^ o) & 63) << 2, __float_as_int(v))); }
__device__ __forceinline__ unsigned xcc_id_() { return (unsigned)__builtin_amdgcn_s_getreg((3 << 11) | 20) & 0xFu; }
__device__ __forceinline__ size_t tix(int row, int col, int KB) { return ((size_t)((row >> 7) * KB + (col >> 6)) << 13) + (size_t)((row & 127) * 64 + (col & 63)); }

#define XB_TMO      128
#define XB_XCNT(j)  (256  + 64 * (j))
#define XB_XSUB(j)  (1280 + 64 * (j))
#define XB_XGEN(j)  (2304 + 64 * (j))
#define XB_TOP      3328
#define XB_TOPGEN   3392
#define XCD_BAR_WORDS 3456
#define XB_SPIN_CAP (1u << 22)
__device__ __forceinline__ unsigned xb_ld(unsigned* p)              { return __hip_atomic_load(p, __ATOMIC_RELAXED, __HIP_MEMORY_SCOPE_AGENT); }
__device__ __forceinline__ unsigned xb_add(unsigned* p, unsigned v) { return __hip_atomic_fetch_add(p, v, __ATOMIC_RELAXED, __HIP_MEMORY_SCOPE_AGENT); }
#define XB_SPIN(cond, bar) do { unsigned _sp = 0; while (cond) { __builtin_amdgcn_s_sleep(1); \
    if ((++_sp & 255u) == 0u) { if (xb_ld(&(bar)[XB_TMO])) break; if (_sp > XB_SPIN_CAP) { atomicAdd(&(bar)[XB_TMO], 1u); break; } } } } while (0)
struct XcdBarrier { unsigned* bar; unsigned x; volatile LAS unsigned* st; };
__device__ __forceinline__ void xcd_barrier_complete(unsigned* bar, unsigned x, unsigned& nloc, unsigned& nx) {
    const unsigned G = gridDim.x * gridDim.y * gridDim.z;
    unsigned sum, cnt, mine, sp = 0u;
    for (;;) {
        sum = 0u; cnt = 0u; mine = 0u;
#pragma unroll
        for (unsigned j = 0; j < 16; ++j) { const unsigned c = xb_ld(&bar[XB_XCNT(j)]); sum += c; cnt += (c > 0u) ? 1u : 0u; mine = (j == x) ? c : mine; }
        if (sum == G) break;
        __builtin_amdgcn_s_sleep(1);
        if ((++sp & 255u) == 0u) { if (xb_ld(&bar[XB_TMO])) break; if (sp > XB_SPIN_CAP) { atomicAdd(&bar[XB_TMO], 1u); break; } }
    }
    nloc = mine > 0u ? mine : 1u; nx = cnt > 0u ? cnt : 1u;
}
__device__ __forceinline__ void xcd_barrier(const XcdBarrier& b) {
    asm volatile("s_waitcnt vmcnt(0)" ::: "memory");
    __syncthreads();
    if (threadIdx.x == 0) {
        unsigned* bar = b.bar;
        __builtin_amdgcn_s_waitcnt(0);
        unsigned nloc = b.st[0], nx = b.st[1];
        if (nloc == 0u) { xcd_barrier_complete(bar, b.x, nloc, nx); b.st[0] = nloc; b.st[1] = nx; }
        const unsigned old = xb_add(&bar[XB_XSUB(b.x)], 1u);
        const unsigned gen = old / nloc;
        if (old + 1u == (gen + 1u) * nloc) {
            __builtin_amdgcn_fence(__ATOMIC_RELEASE, "agent");
            asm volatile("s_waitcnt vmcnt(0)" ::: "memory");
            const unsigned og = xb_add(&bar[XB_TOP], 1u);
            const unsigned tg = og / nx;
            if (og + 1u == (tg + 1u) * nx) xb_add(&bar[XB_TOPGEN], 1u);
            else XB_SPIN(xb_ld(&bar[XB_TOPGEN]) == tg, bar);
            __builtin_amdgcn_fence(__ATOMIC_ACQUIRE, "agent");
            xb_add(&bar[XB_XGEN(b.x)], 1u);
            asm volatile("s_waitcnt vmcnt(0)" ::: "memory");
        } else {
            XB_SPIN(xb_ld(&bar[XB_XGEN(b.x)]) == gen, bar);
            __builtin_amdgcn_fence(__ATOMIC_ACQUIRE, "agent");
            asm volatile("s_waitcnt vmcnt(0)" ::: "memory");
        }
    }
    __syncthreads();
}
__device__ __forceinline__ size_t opq0_() { size_t z = 0; asm volatile("" : "+s"(z)); return z; }
constexpr int HTB = 128 * 64 * 2;
__device__ __forceinline__ int lds_byte(int r, int c) { const int st = (r >> 4) * 2 + (c >> 5), rr = r & 15, cc = c & 31, ob = rr * 64 + cc * 2; return st * 1024 + (ob ^ (((ob >> 9) & 1) << 5)); }
__device__ __forceinline__ void stage_rc(int b, int& R, int& C) { const int st = b / 1024, sb = b % 1024, swz = sb ^ (((sb >> 9) & 1) << 5); R = (st >> 1) * 16 + swz / 64; C = (st & 1) * 32 + (swz % 64) / 2; }

__device__ __forceinline__ void gemm_core(const bf16_t* A, int lda, size_t kstepA, size_t hA, const bf16_t* Bt, int ldb, size_t kstepB, size_t hB, int K, LAS unsigned char* lds, f32x4 (&acc)[2][2][4][2]) {
  const int tid = tidx_(), wid = tid >> 6, lane = tid & 63, wr = wid >> 2, wc = wid & 3, fr = lane & 15, fq = lane >> 4;
  unsigned voffA[2], voffB[2];
#pragma unroll
  for (int i = 0; i < 2; ++i) { int R, C; stage_rc(tid * 16 + i * 8192, R, C); voffA[i] = (unsigned)(R * lda + C) * 2u; voffB[i] = (unsigned)(R * ldb + C) * 2u; }
  const unsigned ldsw = (unsigned)wid * 1024u;
  const int aoff = lds_byte(wr * 64 + fr, fq * 8), boff = lds_byte(wc * 32 + fr, fq * 8);
  const char* gA = (const char*)A; const char* gB = (const char*)Bt;
#define SA_(b, h) (((b) * 2 + (h)) * HTB)
#define SB_(b, h) ((4 + (b) * 2 + (h)) * HTB)
#define STAGE_(bufoff, gbase, voff) do { _Pragma("unroll") for (int _i = 0; _i < 2; ++_i) \
    __builtin_amdgcn_global_load_lds((const unsigned*)((gbase) + (voff)[_i]), (LAS unsigned*)(lds + (bufoff) + ldsw + _i * 8192), 16, 0, 0); } while (0)
#define STA_(b, h, kt) STAGE_(SA_(b, h), gA + (size_t)(h) * hA + (size_t)(kt) * kstepA, voffA)
#define STB_(b, h, kt) STAGE_(SB_(b, h), gB + (size_t)(h) * hB + (size_t)(kt) * kstepB, voffB)
#define LDA_(dst, b, h) do { _Pragma("unroll") for (int m = 0; m < 4; ++m) _Pragma("unroll") for (int k = 0; k < 2; ++k) dst[m][k] = *(const LAS bf16x8*)(lds + SA_(b, h) + aoff + m * 2048 + k * 1024); } while (0)
#define LDB_(dst, b, h) do { _Pragma("unroll") for (int n = 0; n < 2; ++n) _Pragma("unroll") for (int k = 0; k < 2; ++k) dst[n][k] = *(const LAS bf16x8*)(lds + SB_(b, h) + boff + n * 2048 + k * 1024); } while (0)
#define MMA_(ai, bj, At, Bx) do { __builtin_amdgcn_s_setprio(1); _Pragma("unroll") for (int m = 0; m < 4; ++m) _Pragma("unroll") for (int n = 0; n < 2; ++n) _Pragma("unroll") for (int k = 0; k < 2; ++k) \
    acc[ai][bj][m][n] = __builtin_amdgcn_mfma_f32_16x16x32_bf16(Bx[n][k], At[m][k], acc[ai][bj][m][n], 0, 0, 0); __builtin_amdgcn_s_setprio(0); } while (0)
#define WAIT_V(n) asm volatile("s_waitcnt vmcnt(" #n ")" ::: "memory")
#define WAIT_L(n) asm volatile("s_waitcnt lgkmcnt(" #n ")" ::: "memory")
#define BAR_ __builtin_amdgcn_s_barrier()
#define SCHED_ __builtin_amdgcn_sched_barrier(0)
#pragma unroll
  for (int a = 0; a < 2; ++a)
#pragma unroll
    for (int b = 0; b < 2; ++b)
#pragma unroll
      for (int m = 0; m < 4; ++m)
#pragma unroll
        for (int n = 0; n < 2; ++n) acc[a][b][m][n] = (f32x4){0.f, 0.f, 0.f, 0.f};
  bf16x8 At[4][2], B0[2][2], B1[2][2];
  const int nt = K / 64;
  STB_(0, 0, 0); STA_(0, 0, 0); STB_(0, 1, 0); STA_(0, 1, 0);
  if (wr == 1) BAR_;
  WAIT_V(4); BAR_;
  STB_(1, 0, 1); STA_(1, 0, 1); STB_(1, 1, 1);
  WAIT_V(6); BAR_;
  for (int t = 0; t < nt - 2; t += 2) {
    LDB_(B0, 0, 0); SCHED_; LDA_(At, 0, 0); STA_(1, 1, t + 1);
    WAIT_L(8); BAR_; WAIT_L(0); MMA_(0, 0, At, B0); BAR_; SCHED_;
    LDB_(B1, 0, 1); STB_(0, 0, t + 2);
    BAR_; WAIT_L(0); MMA_(0, 1, At, B1); BAR_;
    LDA_(At, 0, 1); STA_(0, 0, t + 2);
    BAR_; WAIT_L(0); MMA_(1, 0, At, B0); BAR_; SCHED_;
    STB_(0, 1, t + 2);
    WAIT_V(6); BAR_; MMA_(1, 1, At, B1); BAR_;
    LDB_(B0, 1, 0); SCHED_; LDA_(At, 1, 0); STA_(0, 1, t + 2);
    WAIT_L(8); BAR_; WAIT_L(0); MMA_(0, 0, At, B0); BAR_; SCHED_;
    LDB_(B1, 1, 1); STB_(1, 0, t + 3);
    BAR_; WAIT_L(0); MMA_(0, 1, At, B1); BAR_;
    LDA_(At, 1, 1); STA_(1, 0, t + 3);
    BAR_; WAIT_L(0); MMA_(1, 0, At, B0); BAR_; SCHED_;
    STB_(1, 1, t + 3);
    WAIT_V(6); BAR_; MMA_(1, 1, At, B1); BAR_;
  }
  { LDB_(B0, 0, 0); LDA_(At, 0, 0); STA_(1, 1, nt - 1);
    BAR_; WAIT_L(0); MMA_(0, 0, At, B0); BAR_;
    LDB_(B1, 0, 1); BAR_; WAIT_L(0); MMA_(0, 1, At, B1); BAR_;
    LDA_(At, 0, 1); WAIT_V(4); BAR_; WAIT_L(0); MMA_(1, 0, At, B0); MMA_(1, 1, At, B1); BAR_; }
  { LDB_(B0, 1, 0); LDA_(At, 1, 0); WAIT_V(2); BAR_; WAIT_L(0); MMA_(0, 0, At, B0); BAR_;
    LDB_(B1, 1, 1); WAIT_V(0); BAR_; WAIT_L(0); MMA_(0, 1, At, B1); BAR_;
    LDA_(At, 1, 1); BAR_; WAIT_L(0); MMA_(1, 0, At, B0); MMA_(1, 1, At, B1); BAR_; }
  if (wr == 0) BAR_;
}

__device__ __forceinline__ bool unit_for(int it, int U, int nM, int nN, int& pm, int& pn, LAS unsigned char* lds) {
  const LAS int* ctl = (const LAS int*)(lds + LDS_CTL);
  const int x = __builtin_amdgcn_readfirstlane(ctl[0]), slot = __builtin_amdgcn_readfirstlane(ctl[1]), nx = __builtin_amdgcn_readfirstlane(ctl[2]), ok = __builtin_amdgcn_readfirstlane(ctl[3]);
  int l;
  if (ok) {
    const int q = U >> 3, r = U & 7;
    const int cnt = x < r ? q + 1 : q, start = x < r ? x * (q + 1) : r * (q + 1) + (x - r) * q;
    const int li = it * nx + slot; if (li >= cnt) return false; l = start + li;
  } else { const int G = gridDim.x, b = bidx_(); l = it * G + b; if (l >= U) return false; }
  const int nig = 8 * nN, gid = l / nig, within = l % nig, fm = gid * 8, gsz = (nM - fm) < 8 ? (nM - fm) : 8;
  pm = fm + within % gsz; pn = within / gsz; return true;
}

enum { K_UP = 0, K_DN = 1, K_WINA = 2, K_WINB = 3, K_WOUT = 4, K_WIN1 = 5, K_F3 = 6, K_FOLD = 7 };

__device__ __forceinline__ float row_rstd(const float* rowsq, int row) {
  const f32x4* q = (const f32x4*)(rowsq + (size_t)row * 16);
  const f32x4 a = q[0], b = q[1], c = q[2], d = q[3];
  const float s = ((a[0] + a[1]) + (a[2] + a[3])) + ((b[0] + b[1]) + (b[2] + b[3])) + ((c[0] + c[1]) + (c[2] + c[3])) + ((d[0] + d[1]) + (d[2] + d[3]));
  return rsqrtf(s * (1.0f / 1024.0f) + 1e-6f);
}

struct F3Info { int grp, k1, mt, nt; };
__device__ __forceinline__ void gemm_epilogue(const int kind, const int pm, const int pn, const F3Info f3, f32x4 (&acc)[2][2][4][2], unsigned char* ws, unsigned char* r2, LAS unsigned char* lds, const float* partial = nullptr) {
  const LAS float* rst = (const LAS float*)(lds + LDS_RSTD);
#define ACC_(ai, bj, m, n) (partial ? acc[ai][bj][m][n] + *(const f32x4*)(partial + (size_t)(((((ai) * 2 + (bj)) * 4 + (m)) * 2 + (n)) * 512 + tid) * 4) : acc[ai][bj][m][n])
  const int f3_grp = f3.grp, f3_k1 = f3.k1, f3_mt = f3.mt, f3_nt = f3.nt;
  {
    ws += opq0_(); r2 += opq0_();
    const int tid = tidx_(), wid = tid >> 6, lane = tid & 63, wr = wid >> 2, wc = wid & 3, fr = lane & 15, fq = lane >> 4;
    bf16_t* h = (bf16_t*)(ws + OFF_H);
    float* rowsq = (float*)(ws + T_ROWSQ);
    const int brow = pm * 256 + wr * 64 + fr;
    const int ccol = wc * 32 + fq * 4;
    if (kind == K_UP) {
      bf16_t* act = pm < MT_A ? (bf16_t*)(ws + R1_ACTA) : (bf16_t*)(r2 + R2_ACTB); const int arow0 = pm < MT_A ? 0 : MT_A * 256;
      bf16_t* actb = act + ((size_t)(((pm - (pm < MT_A ? 0 : MT_A)) * 2 * 44 + pn * 2 + (wc >> 1))) << 13) + (wr * 64 + fr) * 64 + (wc & 1) * 32 + fq * 4;
#pragma unroll
      for (int ai = 0; ai < 2; ++ai)
#pragma unroll
        for (int m = 0; m < 4; ++m) { asm volatile("" ::: "memory");
          const int row = brow + ai * 128 + m * 16; const float rs = rst[row - pm * 256];
#pragma unroll
          for (int n = 0; n < 2; ++n) {
            const f32x4 g = ACC_(ai, 0, m, n) * rs, u = ACC_(ai, 1, m, n) * rs; float o[4];
#pragma unroll
            for (int j = 0; j < 4; ++j) o[j] = g[j] * sigmoidf_(g[j]) * u[j];
            u32x2 w; w.x = pack2(o[0], o[1]); w.y = pack2(o[2], o[3]);
            *(u32x2*)(actb + ai * (44 << 13) + m * 1024 + n * 16) = w;
          }
        }
    } else if (kind == K_DN || kind == K_WOUT) {
      const float sc = kind == K_DN ? 0.5f : 1.0f;
      bf16_t* hb = h + ((size_t)((pm * 2 * 16 + pn * 4 + (wc >> 1))) << 13) + (wr * 64 + fr) * 64 + (wc & 1) * 32 + fq * 4;
#pragma unroll
      for (int ai = 0; ai < 2; ++ai)
#pragma unroll
        for (int m = 0; m < 4; ++m) { asm volatile("" ::: "memory");
          const int row = brow + ai * 128 + m * 16; int seq, pos, L; row_info(row, seq, pos, L);
          float ss = 0.f;
          if (pos >= 0) {
#pragma unroll
            for (int bj = 0; bj < 2; ++bj)
#pragma unroll
              for (int n = 0; n < 2; ++n) {
                bf16_t* hp = hb + ai * (16 << 13) + bj * (2 << 13) + m * 1024 + n * 16;
                const u32x2 old = *(const u32x2*)hp; const f32x4 a = ACC_(ai, bj, m, n);
                u32x2 w; w.x = pack2(bflo(old.x) + sc * a[0], bfhi(old.x) + sc * a[1]); w.y = pack2(bflo(old.y) + sc * a[2], bfhi(old.y) + sc * a[3]);
                *(u32x2*)hp = w;
                const float v0 = bflo(w.x), v1 = bfhi(w.x), v2 = bflo(w.y), v3 = bfhi(w.y);
                ss += (v0 * v0 + v1 * v1) + (v2 * v2 + v3 * v3);
              }
          }
          ss += shx(ss, 16, lane); ss += shx(ss, 32, lane);
          if (fq == 0) rowsq[(size_t)row * 16 + pn * 4 + wc] = ss;
        }
    } else if (kind == K_WINA) {
      if (pn < 2) {
        bf16_t* qk = (bf16_t*)(ws + R1_QK);
        const float* rc = (const float*)(ws + T_ROPE); const float* rsn = rc + (size_t)LP * 32;
        const float qs = pn == 0 ? 0.125f : 1.0f;
#pragma unroll
        for (int ai = 0; ai < 2; ++ai)
#pragma unroll
          for (int m = 0; m < 4; ++m) { asm volatile("" ::: "memory");
            const int row = brow + ai * 128 + m * 16; int seq, pos, L; row_info(row, seq, pos, L);
            const float rs = rst[row - pm * 256] * qs; const int pc = pos < 0 ? 0 : pos;
#pragma unroll
            for (int bj = 0; bj < 2; ++bj) {
              const int g = bj * 4 + wc, head = g >> 1, d1 = (g & 1) * 16 + fq * 4;
              const f32x4 x1 = ACC_(ai, bj, m, 0) * rs, x2 = ACC_(ai, bj, m, 1) * rs;
              const f32x4 c = *(const f32x4*)(rc + (size_t)pc * 32 + d1), s = *(const f32x4*)(rsn + (size_t)pc * 32 + d1);
              const f32x4 o1 = x1 * c - x2 * s, o2 = x1 * s + x2 * c;
              bf16_t* dst = qk + (size_t)row * 512 + pn * 256 + head * 64 + d1;
              u32x2 w; w.x = pack2(o1[0], o1[1]); w.y = pack2(o1[2], o1[3]); *(u32x2*)dst = w;
              w.x = pack2(o2[0], o2[1]); w.y = pack2(o2[2], o2[3]); *(u32x2*)(dst + 32) = w;
            }
          }
      } else if (pn >= 6) {
        bf16_t* dst = (bf16_t*)(r2 + R2_PRW);
#pragma unroll
        for (int ai = 0; ai < 2; ++ai)
#pragma unroll
          for (int m = 0; m < 4; ++m) { asm volatile("" ::: "memory");
            const int row = brow + ai * 128 + m * 16; const float rs = rst[row - pm * 256];
#pragma unroll
            for (int bj = 0; bj < 2; ++bj)
#pragma unroll
              for (int n = 0; n < 2; ++n) { const f32x4 a = ACC_(ai, bj, m, n) * rs; u32x2 w; w.x = pack2(a[0], a[1]); w.y = pack2(a[2], a[3]);
                *(u32x2*)(dst + (size_t)row * 1792 + (pn - 6) * 256 + bj * 128 + ccol + n * 16) = w; }
          }
      } else {
        bf16_t* mix = (bf16_t*)(ws + R1_MIX);
#pragma unroll
        for (int ai = 0; ai < 2; ++ai)
#pragma unroll
          for (int m = 0; m < 4; ++m) { asm volatile("" ::: "memory");
            const int row = brow + ai * 128 + m * 16; const float rs = rst[row - pm * 256];
#pragma unroll
            for (int bj = 0; bj < 2; ++bj)
#pragma unroll
              for (int n = 0; n < 2; ++n) { const f32x4 a = ACC_(ai, bj, m, n) * rs; u32x2 w; w.x = pack2(a[0], a[1]); w.y = pack2(a[2], a[3]);
                *(u32x2*)(mix + (size_t)row * 1024 + (pn - 2) * 256 + bj * 128 + ccol + n * 16) = w; }
          }
      }
    } else if (kind == K_WINB || kind == K_FOLD) {
      bf16_t* dst = kind == K_WINB ? (bf16_t*)(r2 + R2_PRW) : (bf16_t*)(ws + W1_IN);
      const int ldd = kind == K_WINB ? 1792 : 1024;
#pragma unroll
      for (int ai = 0; ai < 2; ++ai)
#pragma unroll
        for (int m = 0; m < 4; ++m) { asm volatile("" ::: "memory");
          const int row = brow + ai * 128 + m * 16; const float rs = kind == K_WINB ? rst[row - pm * 256] : 1.0f;
#pragma unroll
          for (int bj = 0; bj < 2; ++bj)
#pragma unroll
            for (int n = 0; n < 2; ++n) { const f32x4 a = ACC_(ai, bj, m, n) * rs; u32x2 w; w.x = pack2(a[0], a[1]); w.y = pack2(a[2], a[3]);
              const int col = pn * 256 + bj * 128 + ccol + n * 16; *(u32x2*)(dst + (kind == K_WINB ? (size_t)row * ldd + col : tix(row, col, 16))) = w; }
        }
    } else if (kind == K_WIN1) {
      bf16_t* mix = (bf16_t*)(ws + R1_MIX); bf16_t* ub = (bf16_t*)(ws + R1_U);
#pragma unroll
      for (int ai = 0; ai < 2; ++ai)
#pragma unroll
        for (int m = 0; m < 4; ++m) { asm volatile("" ::: "memory");
          const int row = brow + ai * 128 + m * 16; int seq, pos, L; row_info(row, seq, pos, L);
          const float rs = rst[row - pm * 256];
          if (pn < 4) {
            if (pos >= 0) {
              bf16_t* wt = (bf16_t*)(r2 + R2_WT) + (seq < 2 ? (size_t)seq * 1024 * LP : (size_t)2 * 1024 * LP + (size_t)(seq - 2) * 1024 * LS);
#pragma unroll
              for (int bj = 0; bj < 2; ++bj)
#pragma unroll
                for (int n = 0; n < 2; ++n) { const f32x4 a = ACC_(ai, bj, m, n) * rs; const int col = pn * 256 + bj * 128 + ccol + n * 16;
#pragma unroll
                  for (int j = 0; j < 4; ++j) wt[(size_t)(col + j) * L + pos] = f2bf(a[j]); }
            }
          } else if (pn < 6) {
#pragma unroll
            for (int bj = 0; bj < 2; ++bj)
#pragma unroll
              for (int n = 0; n < 2; ++n) { const f32x4 a = ACC_(ai, bj, m, n) * rs; u32x2 w; w.x = pack2(a[0], a[1]); w.y = pack2(a[2], a[3]);
                *(u32x2*)(mix + (size_t)row * 1024 + 512 + (pn - 4) * 256 + bj * 128 + ccol + n * 16) = w; }
          } else {
#pragma unroll
            for (int n = 0; n < 2; ++n) { const f32x4 a = (ACC_(ai, 0, m, n) * rs) * (ACC_(ai, 1, m, n) * rs); u32x2 w; w.x = pack2(a[0], a[1]); w.y = pack2(a[2], a[3]);
              *(u32x2*)(ub + (size_t)row * 512 + (pn - 6) * 128 + ccol + n * 16) = w; }
          }
        }
    } else {
      bf16_t* mix = (bf16_t*)(ws + R1_MIX);
      const float* tc = (const float*)(ws + T_TAILC);
      const float* ct = tc + (f3_grp ? TC_CTS : TC_CTP); const float* st = tc + (f3_grp ? TC_STS : TC_STP);
      const int NN = f3_grp ? 2048 : 1024;
      const float* tv = (const float*)(ws + T_TAILV) + (f3_grp ? 32768 : 0) + (size_t)f3_k1 * NN * 2;
      const float scale = f3_grp ? rsqrtf(128.0f * LS) : rsqrtf(128.0f * LP);
#pragma unroll
      for (int ai = 0; ai < 2; ++ai)
#pragma unroll
        for (int m = 0; m < 4; ++m) { asm volatile("" ::: "memory");
          const int k2 = f3_mt * 256 + wr * 64 + fr + ai * 128 + m * 16;
          const float c2 = ct[k2], s2 = st[k2]; const int pos = f3_k1 + 16 * k2;
#pragma unroll
          for (int bj = 0; bj < 2; ++bj)
#pragma unroll
            for (int n = 0; n < 2; ++n) {
              const int ni = f3_nt * 256 + bj * 128 + ccol + n * 16; const int sl = ni >> 9, c = ni & 511;
              const int row = (f3_grp ? 2 * LPP + sl * LPS : sl * LPP) + PADR + pos;
              const f32x4 t0 = *(const f32x4*)(tv + (size_t)ni * 2), t1 = *(const f32x4*)(tv + (size_t)ni * 2 + 4);
              const f32x4 a = acc[ai][bj][m][n];
              const float o0 = (a[0] + c2 * t0[0] + s2 * t0[1]) * scale, o1 = (a[1] + c2 * t0[2] + s2 * t0[3]) * scale,
                          o2 = (a[2] + c2 * t1[0] + s2 * t1[1]) * scale, o3 = (a[3] + c2 * t1[2] + s2 * t1[3]) * scale;
              u32x2 w; w.x = pack2(o0, o1); w.y = pack2(o2, o3);
              *(u32x2*)(mix + (size_t)row * 1024 + c) = w;
            }
        }
    }
  }
}

__device__ __forceinline__ void gemm_phase(const int kind, const int idx, const Params& p, LAS unsigned char* lds, const int seqid = 0) {
  unsigned char* ws = p.ws + opq0_(); unsigned char* r2 = (unsigned char*)p.out + opq0_();
  int nM = MT, nN = 4, K = 1024;
  const bf16_t* Wt = nullptr;
  switch (kind) {
    case K_UP: nN = 22; Wt = (const bf16_t*)(ws + (idx == 0 ? W0_F1UP : idx == 1 ? W0_F2UP : idx == 2 ? W1_F1UP : W1_F2UP)); break;
    case K_DN: nN = 4; K = FF; Wt = (const bf16_t*)(ws + (idx == 0 ? W0_F1DN : idx == 1 ? W0_F2DN : idx == 2 ? W1_F1DN : W1_F2DN)); break;
    case K_WINA: nN = 13; Wt = (const bf16_t*)(ws + W0_INA); break;
    case K_WINB: nN = 7; Wt = (const bf16_t*)(ws + W0_INB); break;
    case K_WOUT: nN = 4; Wt = (const bf16_t*)(ws + (idx == 0 ? W0_OUT : W1_OUT)); break;
    case K_WIN1: nN = 10; Wt = (const bf16_t*)(ws + W1_IN); break;
    case K_F3: nM = 1; nN = 256; break;
    default: nM = 4; nN = 4; K = 512; break;
  }
  const int U = nM * nN;
  for (int it = 0;; ++it) {
    int pm, pn;
    int khalf = -1;
    const bool split = kind == K_DN;
    if (split) {
      const LAS int* ctl = (const LAS int*)(lds + LDS_CTL);
      const int x = __builtin_amdgcn_readfirstlane(ctl[0]), slot = __builtin_amdgcn_readfirstlane(ctl[1]), nx = __builtin_amdgcn_readfirstlane(ctl[2]), ok = __builtin_amdgcn_readfirstlane(ctl[3]);
      int f = -1, hu = -1;
      if (ok) { const int li = it * nx + slot;
        if (li < 16 * nN) f = 16 * nN * x + li;
        else { const int hs = (6 * nN * x) >> 3, he = (6 * nN * (x + 1)) >> 3, j = li - 16 * nN; if (j < he - hs) hu = hs + j; else break; } }
      else { const int l = it * (int)gridDim.x + bidx_(); if (l < 128 * nN) f = l; else if (l < 134 * nN) hu = l - 128 * nN; else break; }
      if (f >= 0) { const int nig = 8 * nN, gid = f / nig, within = f % nig; pm = gid * 8 + (within & 7); pn = within >> 3; }
      else { const int u = hu >> 1; khalf = hu & 1; pm = 128 + u % 3; pn = u / 3; }
    } else if (!unit_for(it, U, nM, nN, pm, pn, lds)) break;
    const bf16_t* A; const bf16_t* Bt; int lda, ldb;
    int f3_k1 = 0, f3_mt = 0, f3_nt = 0, f3_grp = 0;
    if (kind == K_F3) {
      const int u = pn;
      if (u < 128) { f3_grp = 0; f3_k1 = u >> 3; f3_mt = (u >> 2) & 1; f3_nt = u & 3;
        A = (const bf16_t*)(ws + T_ADFTP) + (size_t)f3_mt * 256 * 1024; lda = 1024; Bt = (const bf16_t*)(r2 + R2_BTFP) + ((size_t)f3_k1 * 1024 + f3_nt * 256) * 1024; ldb = 1024; K = 1024; }
      else { const int v = u - 128; f3_grp = 1; f3_k1 = v >> 3; f3_mt = 0; f3_nt = v & 7;
        A = (const bf16_t*)(ws + T_ADFTS); lda = 512; Bt = (const bf16_t*)(ws + R1_BTFS) + ((size_t)f3_k1 * 2048 + f3_nt * 256) * 512; ldb = 512; K = 512; }
    } else if (kind == K_DN) {
      A = pm < MT_A ? (const bf16_t*)(ws + R1_ACTA) + (size_t)pm * 256 * FF : (const bf16_t*)(r2 + R2_ACTB) + (size_t)(pm - MT_A) * 256 * FF; lda = FF;
      Bt = Wt + (size_t)pn * 256 * FF; ldb = FF;
      K = FF;
    } else if (kind == K_WOUT) {
      A = (const bf16_t*)(ws + R1_MIX) + (size_t)pm * 256 * 1024; lda = 1024; Bt = Wt + (size_t)pn * 256 * 1024; ldb = 1024;
    } else if (kind == K_FOLD) {
      A = (const bf16_t*)(ws + T_FT) + (size_t)pm * 256 * 512; lda = 512; Bt = (const bf16_t*)(ws + T_WTMP) + (size_t)pn * 256 * 512; ldb = 512;
    } else {
      A = (const bf16_t*)(ws + OFF_H) + (size_t)pm * 256 * 1024; lda = 1024; Bt = Wt + (size_t)pn * 256 * 1024; ldb = 1024;
    }
    const bool tA = kind == K_UP || kind == K_DN || kind == K_WINA || kind == K_WINB || kind == K_WIN1;
    const bool tB = tA || kind == K_WOUT;
    const int KF = K;
    if (khalf >= 0) { const int hk = (K >> 7) * khalf; K >>= 1; A += tA ? (size_t)hk * 8192 : (size_t)hk * 64; Bt += (size_t)hk * 8192; }
    if (kind == K_UP || kind == K_WINA || kind == K_WINB || kind == K_WIN1) {
      const int t = tidx_(); if (t < 256) ((LAS float*)(lds + LDS_RSTD))[t] = row_rstd((const float*)(ws + T_ROWSQ), pm * 256 + t);
    }
    f32x4 acc[2][2][4][2];
    gemm_core(A, tA ? 64 : lda, tA ? (size_t)16384 : (size_t)128, tA ? (size_t)(KF >> 6) * 16384 : (size_t)128 * lda * 2,
              Bt, tB ? 64 : ldb, tB ? (size_t)16384 : (size_t)128, tB ? (size_t)(KF >> 6) * 16384 : (size_t)128 * ldb * 2, K, lds, acc);
    const float* partial = nullptr;
    if (khalf >= 0) {
      const int u = (pm - 128) + 3 * pn; const int t = tidx_();
      float* scr = (float*)(r2 + R2_SPLITK) + (size_t)u * 65536;
      unsigned* flag = (unsigned*)(ws + T_BAR + 13824) + u;
      if (khalf == 0) {
#pragma unroll
        for (int a = 0; a < 2; ++a)
#pragma unroll
          for (int b = 0; b < 2; ++b)
#pragma unroll
            for (int m = 0; m < 4; ++m)
#pragma unroll
              for (int n = 0; n < 2; ++n) *(f32x4*)(scr + (size_t)((((a * 2 + b) * 4 + m) * 2 + n) * 512 + t) * 4) = acc[a][b][m][n];
        asm volatile("s_waitcnt vmcnt(0)" ::: "memory");
        __syncthreads();
        if (t == 0) { __builtin_amdgcn_fence(__ATOMIC_RELEASE, "agent"); asm volatile("s_waitcnt vmcnt(0)" ::: "memory"); __hip_atomic_store(flag, (unsigned)seqid, __ATOMIC_RELAXED, __HIP_MEMORY_SCOPE_AGENT); }
        __syncthreads();
        continue;
      } else {
        if (t == 0) { unsigned sp = 0; while (__hip_atomic_load(flag, __ATOMIC_RELAXED, __HIP_MEMORY_SCOPE_AGENT) < (unsigned)seqid) { __builtin_amdgcn_s_sleep(2); if (++sp > (1u << 24)) break; }
          __builtin_amdgcn_fence(__ATOMIC_ACQUIRE, "agent"); asm volatile("s_waitcnt vmcnt(0)" ::: "memory"); }
        __syncthreads();
        partial = scr;
      }
    }
    { F3Info f3; f3.grp = f3_grp; f3.k1 = f3_k1; f3.mt = f3_mt; f3.nt = f3_nt; gemm_epilogue(kind, pm, pn, f3, acc, ws, r2, lds, partial); }
    WAIT_V(0);
    __syncthreads();
  }
}

__device__ __forceinline__ void gemm_phase_stream(const int kind, const int idx, const Params& p, LAS unsigned char* lds) {
  unsigned char* ws = p.ws + opq0_(); unsigned char* r2 = (unsigned char*)p.out + opq0_();
  int nM = MT, nN = 4, K = 1024, lda = 1024, ldb = 1024;
  const bf16_t* Wt = nullptr;
  switch (kind) {
    case K_UP: nN = 22; Wt = (const bf16_t*)(ws + (idx == 0 ? W0_F1UP : idx == 1 ? W0_F2UP : idx == 2 ? W1_F1UP : W1_F2UP)); break;
    case K_DN: nN = 4; K = FF; lda = FF; ldb = FF; Wt = (const bf16_t*)(ws + (idx == 0 ? W0_F1DN : idx == 1 ? W0_F2DN : idx == 2 ? W1_F1DN : W1_F2DN)); break;
    case K_WINA: nN = 13; Wt = (const bf16_t*)(ws + W0_INA); break;
    case K_WINB: nN = 7; Wt = (const bf16_t*)(ws + W0_INB); break;
    case K_WOUT: nN = 4; Wt = (const bf16_t*)(ws + (idx == 0 ? W0_OUT : W1_OUT)); break;
    default: nN = 10; Wt = (const bf16_t*)(ws + W1_IN); break;
  }
  const int U = nM * nN;
  int pm, pn;
  if (!unit_for(0, U, nM, nN, pm, pn, lds)) return;
  const int KB = K >> 6;
  const bool tiledA = kind != K_WOUT;
  auto ptrA = [&](int m) -> const char* {
    if (kind == K_DN) return (const char*)(m < MT_A ? (const bf16_t*)(ws + R1_ACTA) + (size_t)m * 256 * FF : (const bf16_t*)(r2 + R2_ACTB) + (size_t)(m - MT_A) * 256 * FF);
    if (kind == K_WOUT) return (const char*)((const bf16_t*)(ws + R1_MIX) + (size_t)m * 256 * 1024);
    return (const char*)((const bf16_t*)(ws + OFF_H) + (size_t)m * 256 * 1024); };
  auto ptrB = [&](int n) -> const char* { return (const char*)(Wt + (size_t)n * 256 * ldb); };
  const int tid = tidx_(), wid = tid >> 6, lane = tid & 63, wr = wid >> 2, wc = wid & 3, fr = lane & 15, fq = lane >> 4;
  unsigned voffA[2], voffB[2];
#pragma unroll
  for (int i = 0; i < 2; ++i) { int R, C; stage_rc(tid * 16 + i * 8192, R, C); voffA[i] = (unsigned)(R * (tiledA ? 64 : lda) + C) * 2u; voffB[i] = (unsigned)(R * 64 + C) * 2u; }
  const unsigned ldsw = (unsigned)wid * 1024u;
  const int aoff = lds_byte(wr * 64 + fr, fq * 8), boff = lds_byte(wc * 32 + fr, fq * 8);
  const size_t hA = tiledA ? (size_t)KB * 16384 : (size_t)128 * lda * 2, hB = (size_t)KB * 16384, kstepA = tiledA ? 16384 : 128, kstepB = 16384;
  const int nt = K / 64;
  const char* cA = ptrA(pm); const char* cB = ptrB(pn);
  f32x4 acc[2][2][4][2];
#pragma unroll
  for (int a = 0; a < 2; ++a)
#pragma unroll
    for (int b = 0; b < 2; ++b)
#pragma unroll
      for (int m = 0; m < 4; ++m)
#pragma unroll
        for (int n = 0; n < 2; ++n) acc[a][b][m][n] = (f32x4){0.f, 0.f, 0.f, 0.f};
  bf16x8 At[4][2], B0[2][2], B1[2][2];
  STAGE_(SB_(0, 0), cB, voffB); STAGE_(SA_(0, 0), cA, voffA); STAGE_(SB_(0, 1), cB + hB, voffB); STAGE_(SA_(0, 1), cA + hA, voffA);
  if (wr == 1) BAR_;
  WAIT_V(4); BAR_;
  STAGE_(SB_(1, 0), cB + kstepB, voffB); STAGE_(SA_(1, 0), cA + kstepA, voffA); STAGE_(SB_(1, 1), cB + hB + kstepB, voffB);
  WAIT_V(6); BAR_;
  int it = 0;
  for (;;) {
    int pm2 = 0, pn2 = 0;
    const bool has_next = unit_for(it + 1, U, nM, nN, pm2, pn2, lds);
    const char* nA = has_next ? ptrA(pm2) : cA; const char* nB = has_next ? ptrB(pn2) : cB;
    for (int t = 0; t < nt; t += 2) {
      const bool last = (t == nt - 2);
      const char* a1 = cA + (size_t)(t + 1) * kstepA;
      const char* a2 = last ? nA : cA + (size_t)(t + 2) * kstepA; const char* b2 = last ? nB : cB + (size_t)(t + 2) * kstepB;
      const char* a3 = a2 + kstepA; const char* b3 = b2 + kstepB;
      LDB_(B0, 0, 0); SCHED_; LDA_(At, 0, 0); STAGE_(SA_(1, 1), a1 + hA, voffA);
      WAIT_L(8); BAR_; WAIT_L(0); MMA_(0, 0, At, B0); BAR_; SCHED_;
      LDB_(B1, 0, 1); STAGE_(SB_(0, 0), b2, voffB);
      BAR_; WAIT_L(0); MMA_(0, 1, At, B1); BAR_;
      LDA_(At, 0, 1); STAGE_(SA_(0, 0), a2, voffA);
      BAR_; WAIT_L(0); MMA_(1, 0, At, B0); BAR_; SCHED_;
      STAGE_(SB_(0, 1), b2 + hB, voffB);
      WAIT_V(6); BAR_; MMA_(1, 1, At, B1); BAR_;
      LDB_(B0, 1, 0); SCHED_; LDA_(At, 1, 0); STAGE_(SA_(0, 1), a2 + hA, voffA);
      WAIT_L(8); BAR_; WAIT_L(0); MMA_(0, 0, At, B0); BAR_; SCHED_;
      LDB_(B1, 1, 1); STAGE_(SB_(1, 0), b3, voffB);
      BAR_; WAIT_L(0); MMA_(0, 1, At, B1); BAR_;
      LDA_(At, 1, 1); STAGE_(SA_(1, 0), a3, voffA);
      BAR_; WAIT_L(0); MMA_(1, 0, At, B0); BAR_; SCHED_;
      STAGE_(SB_(1, 1), b3 + hB, voffB);
      WAIT_V(6); BAR_; MMA_(1, 1, At, B1); BAR_;
    }
    { unsigned char* ws2 = ws + opq0_(); unsigned char* r22 = r2 + opq0_();
      F3Info f3; f3.grp = 0; f3.k1 = 0; f3.mt = 0; f3.nt = 0; gemm_epilogue(kind, pm, pn, f3, acc, ws2, r22, lds); }
    if (!has_next) break;
#pragma unroll
    for (int a = 0; a < 2; ++a)
#pragma unroll
      for (int b = 0; b < 2; ++b)
#pragma unroll
        for (int m = 0; m < 4; ++m)
#pragma unroll
          for (int n = 0; n < 2; ++n) acc[a][b][m][n] = (f32x4){0.f, 0.f, 0.f, 0.f};
    pm = pm2; pn = pn2; cA = nA; cB = nB; ++it;
  }
  WAIT_V(0);
  if (wr == 0) BAR_;
  BAR_;
  __syncthreads();
}
enum { CM_ID = 0, CM_ROPE = 1 };
struct Job { const float* src; const float* src2; const float* gain; bf16_t* dst; int ldw, K, Np, cm, off, half2; };
__device__ __forceinline__ void conv_tile(const Job& jb, int tn, int tk, LAS unsigned char* lds) {
  LAS float* tile = (LAS float*)lds;
  const int tid = tidx_();
  const int nn = tid & 63, n = tn * 64 + nn;
  const float* src = jb.src; int c;
  if (jb.half2 & 1) { const int t = n >> 8, r = n & 255; if (r >= 128) { src = jb.src2; c = (jb.half2 >> 1) + t * 128 + (r - 128); } else c = jb.off + t * 128 + r; }
  else if (jb.cm == CM_ROPE) { const int pnq = n >> 8, r = n & 255, bj = r >> 7, wc = (r >> 5) & 3, nq = (r >> 4) & 1, i = r & 15, g = bj * 4 + wc;
    c = jb.off + pnq * 256 + (g >> 1) * 64 + nq * 32 + (g & 1) * 16 + i; }
  else c = jb.off + n;
#pragma unroll
  for (int i = 0; i < 8; ++i) { const int kk = i * 8 + (tid >> 6), k = tk * 64 + kk;
    float v = src[(size_t)k * jb.ldw + c]; if (jb.gain) v *= jb.gain[k]; tile[nn * 65 + kk] = v; }
  __syncthreads();
  { const int r = tid >> 3, kc = (tid & 7) * 8; u32x4 w;
    w.x = pack2(tile[r * 65 + kc + 0], tile[r * 65 + kc + 1]); w.y = pack2(tile[r * 65 + kc + 2], tile[r * 65 + kc + 3]);
    w.z = pack2(tile[r * 65 + kc + 4], tile[r * 65 + kc + 5]); w.w = pack2(tile[r * 65 + kc + 6], tile[r * 65 + kc + 7]);
    *(u32x4*)(jb.dst + tix(tn * 64 + r, tk * 64 + kc, jb.K >> 6)) = w; }
  __syncthreads();
}
__device__ __forceinline__ Job mkjob(const float* s, const float* s2, const float* g, bf16_t* d, int ldw, int K, int Np, int cm, int off, int half2) {
  Job j; j.src = s; j.src2 = s2; j.gain = g; j.dst = d; j.ldw = ldw; j.K = K; j.Np = Np; j.cm = cm; j.off = off; j.half2 = half2; return j; }
__device__ __forceinline__ Job get_job(const Params& p, int set, int j, bool tab) {
  unsigned char* ws = p.ws + opq0_();
#define IN0(i) (tab ? inp(ws, i) : p.in[i])
  if (set == 0) {
    switch (j) {
      case 0: return mkjob(IN0(4), IN0(5), IN0(3), (bf16_t*)(ws + W0_F1UP), FF, 1024, 5632, 0, 0, 1);
      case 1: return mkjob(IN0(6), nullptr, nullptr, (bf16_t*)(ws + W0_F1DN), 1024, FF, 1024, 0, 0, 0);
      case 2: return mkjob(IN0(8), nullptr, IN0(7), (bf16_t*)(ws + W0_INA), 3328, 1024, 512, CM_ROPE, 0, 0);
      case 3: return mkjob(IN0(8), nullptr, IN0(7), (bf16_t*)(ws + W0_INA) + (size_t)512 * 1024, 3328, 1024, 1024, 0, 512, 0);
      case 4: return mkjob(IN0(8), nullptr, IN0(7), (bf16_t*)(ws + W0_INB), 3328, 1024, 1792, 0, 1536, 0);
      case 5: return mkjob(IN0(9), nullptr, nullptr, (bf16_t*)(ws + W0_OUT), 1024, 1024, 1024, 0, 0, 0);
      case 6: return mkjob(IN0(22), IN0(23), IN0(21), (bf16_t*)(ws + W0_F2UP), FF, 1024, 5632, 0, 0, 1);
      default: return mkjob(IN0(24), nullptr, nullptr, (bf16_t*)(ws + W0_F2DN), 1024, FF, 1024, 0, 0, 0);
    }
  } else {
    switch (j) {
      case 0: return mkjob(inp(ws, 26), inp(ws, 27), inp(ws, 25), (bf16_t*)(ws + W1_F1UP), FF, 1024, 5632, 0, 0, 1);
      case 1: return mkjob(inp(ws, 28), nullptr, nullptr, (bf16_t*)(ws + W1_F1DN), 1024, FF, 1024, 0, 0, 0);
      case 2: return mkjob(inp(ws, 30), nullptr, inp(ws, 29), (bf16_t*)(ws + W1_IN) + (size_t)1024 * 1024, 2048, 1024, 512, 0, 512, 0);
      case 3: return mkjob(inp(ws, 30), inp(ws, 30), inp(ws, 29), (bf16_t*)(ws + W1_IN) + (size_t)1536 * 1024, 2048, 1024, 1024, 0, 1024, 1 | (1536 << 1));
      case 4: return mkjob(inp(ws, 31), nullptr, nullptr, (bf16_t*)(ws + W1_OUT), 1024, 1024, 1024, 0, 0, 0);
      case 5: return mkjob(inp(ws, 34), inp(ws, 35), inp(ws, 33), (bf16_t*)(ws + W1_F2UP), FF, 1024, 5632, 0, 0, 1);
      case 6: return mkjob(inp(ws, 36), nullptr, nullptr, (bf16_t*)(ws + W1_F2DN), 1024, FF, 1024, 0, 0, 0);
      default: return mkjob(inp(ws, 32), nullptr, nullptr, nullptr, 0, 0, 0, 0, 0, 0);
    }
  }
}
__device__ __forceinline__ void prep_weights(const Params& p, int set, LAS unsigned char* lds) {
  const int j0 = set == 2 ? 4 : set == 3 ? 5 : 0, j1 = set == 0 ? 4 : set == 2 ? 5 : set == 3 ? 8 : 7;
  int base = 0;
  for (int j = j0; j < j1; ++j) {
    const Job jb = get_job(p, set == 1 ? 1 : 0, j, set != 0);
    const int tn = jb.Np / 64, tk = jb.K / 64, nt = tn * tk;
    const int G = gdim_();
    int t0 = (bidx_() - base % G + G) % G;
    for (int t = t0; t < nt; t += G) conv_tile(jb, t / tk, t % tk, lds);
    base += nt;
  }
}

__device__ __forceinline__ void prep_misc(const Params& p) {
  unsigned char* ws = p.ws + opq0_();
  const int tid = tidx_(), lane = tid & 63, gw = bidx_() * 8 + (tid >> 6), nw = gridDim.x * 8;
  bf16_t* h = (bf16_t*)(ws + OFF_H); float* rowsq = (float*)(ws + T_ROWSQ);
  for (int row = gw; row < MROWS; row += nw) {
    int seq, pos, L; row_info(row, seq, pos, L);
    const float* src = nullptr;
    if (pos >= 16) src = (seq < 2 ? p.in[0] + ((size_t)seq * 8192 + (pos - 16)) * 1024 : p.in[1] + ((size_t)(seq - 2) * 4096 + (pos - 16)) * 1024);
    else if (pos >= 0) src = p.in[2] + (size_t)pos * 1024;
    float ss = 0.f;
#pragma unroll
    for (int i = 0; i < 4; ++i) {
      const int c = i * 256 + lane * 4;
      f32x4 v = (f32x4){0.f, 0.f, 0.f, 0.f}; if (src) v = *(const f32x4*)(src + c);
      u32x2 w; w.x = pack2(v[0], v[1]); w.y = pack2(v[2], v[3]);
      *(u32x2*)(h + tix(row, c, 16)) = w;
      const float a = bflo(w.x), b = bfhi(w.x), cc = bflo(w.y), d = bfhi(w.y); ss += (a * a + b * b) + (cc * cc + d * d);
    }
#pragma unroll
    for (int o = 32; o >= 1; o >>= 1) ss += shx(ss, o, lane);
    if (lane < 16) rowsq[(size_t)row * 16 + lane] = lane == 0 ? ss : 0.f;
  }
  const int gt = bidx_() * 512 + tid, ngt = gridDim.x * 512;
  if (gt == 0) {
#pragma unroll
    for (int i = 0; i < 38; ++i) ((unsigned long long*)(ws + T_PTR))[i] = (unsigned long long)p.in[i];
  }
  { float* rc = (float*)(ws + T_ROPE); float* rs = rc + (size_t)LP * 32;
    for (int i = gt; i < LP * 32; i += ngt) { const int pos = i >> 5, d = i & 31; const float inv = powf(10000.0f, -(float)d / 32.0f); const float ang = (float)pos * inv; rc[i] = cosf(ang); rs[i] = sinf(ang); } }
  { bf16_t* a = (bf16_t*)(ws + T_ADFTP);
    for (int i = gt; i < 512 * 1024; i += ngt) { const int k2 = i >> 10, kk = i & 1023, n2 = kk & 511; const int mm = (k2 * n2) % 513; const float x = 2.0f * (float)mm / 513.0f; a[i] = f2bf(kk < 512 ? cospif(x) : sinpif(x)); }
    bf16_t* b = (bf16_t*)(ws + T_ADFTS);
    for (int i = gt; i < 256 * 512; i += ngt) { const int k2 = i >> 9, kk = i & 511, n2 = kk & 255; const int mm = (k2 * n2) % 257; const float x = 2.0f * (float)mm / 257.0f; b[i] = f2bf(kk < 256 ? cospif(x) : sinpif(x)); } }
  { bf16_t* f = (bf16_t*)(ws + T_FT);
    for (int i = gt; i < 1024 * 512; i += ngt) { const int np = i >> 9, kc = i & 511, part = np >> 9, g = (np >> 7) & 3, cp = np & 127, g2 = kc >> 7, c = kc & 127;
      float v = 0.f; if (g2 == g) { const float x = 2.0f * (float)((c * cp) & 127) / 128.0f; v = part == 0 ? cospif(x) : -sinpif(x); } f[i] = f2bf(v); } }
  { bf16_t* w = (bf16_t*)(ws + T_WTMP); const float* src = p.in[30]; const float* g = p.in[29];
    for (int i = gt; i < 1024 * 512; i += ngt) { const int k = i >> 9, c = i & 511; w[i] = f2bf(g[k] * src[(size_t)k * 2048 + c]); } }
  { float* tp = (float*)(ws + T_TWP); for (int i = gt; i < 16 * 513; i += ngt) { const int k1 = i / 513, n2 = i % 513; const float x = 2.0f * (float)(k1 * n2) / (float)LP; tp[2 * i] = cospif(x); tp[2 * i + 1] = sinpif(x); }
    float* ts = (float*)(ws + T_TWS); for (int i = gt; i < 16 * 257; i += ngt) { const int k1 = i / 257, n2 = i % 257; const float x = 2.0f * (float)(k1 * n2) / (float)LS; ts[2 * i] = cospif(x); ts[2 * i + 1] = sinpif(x); } }
  { float* tc = (float*)(ws + T_TAILC);
    for (int i = gt; i < 513; i += ngt) { const float x = 2.0f * (float)((i * 512) % 513) / 513.0f; const float c = cospif(x), s = sinpif(x);
      if (i < 512) { tc[TC_CTP + i] = c; tc[TC_STP + i] = s; } tc[TC_ARCP + i] = c; tc[TC_ARSP + i] = s; }
    for (int i = gt; i < 257; i += ngt) { const float x = 2.0f * (float)((i * 256) % 257) / 257.0f; const float c = cospif(x), s = sinpif(x);
      if (i < 256) { tc[TC_CTS + i] = c; tc[TC_STS + i] = s; } tc[TC_ARCS + i] = c; tc[TC_ARSS + i] = s; } }
  { bf16_t* g2t = (bf16_t*)(ws + T_G2T); const float* g2 = p.in[15]; for (int i = gt; i < 512 * 128; i += ngt) { const int c = i >> 7, r = i & 127; g2t[i] = f2bf(g2[(size_t)r * 512 + c]); } }
}
__device__ __forceinline__ void ret_unit(int uid, int& seq, int& chunk, int& head, int& cidx) {
  if (uid < 520) { seq = uid / 260; const int rem = uid % 260; chunk = rem >> 2; head = rem & 3; cidx = seq * 65 + chunk; }
  else { const int v = uid - 520; const int s = v / 132; seq = 2 + s; const int rem = v % 132; chunk = rem >> 2; head = rem & 3; cidx = 130 + s * 33 + chunk; }
}
__device__ __forceinline__ float ret_lg(int head) { return log1pf(-exp2f(-5.0f - (float)head)); }
constexpr int VT_LD = 136;

__device__ __forceinline__ void load_vT(const bf16_t* mix, int row0, int head, LAS bf16_t* vT) {
  const int tid = tidx_(), j = tid >> 2, e0 = (tid & 3) * 32;
  const u32x4* src = (const u32x4*)(mix + (size_t)(row0 + j) * 1024 + head * 128 + e0);
#pragma unroll
  for (int q = 0; q < 4; ++q) { const u32x4 v = src[q]; const unsigned w[4] = {v.x, v.y, v.z, v.w};
#pragma unroll
    for (int t = 0; t < 4; ++t) { vT[(e0 + q * 8 + t * 2) * VT_LD + j] = (bf16_t)(w[t] & 0xffff); vT[(e0 + q * 8 + t * 2 + 1) * VT_LD + j] = (bf16_t)(w[t] >> 16); } }
}

__device__ __forceinline__ void ret_kv_phase(const Params& p, LAS unsigned char* lds) {
  unsigned char* ws = p.ws + opq0_(); unsigned char* r2 = (unsigned char*)p.out + opq0_();
  const bf16_t* mix = (const bf16_t*)(ws + R1_MIX); const bf16_t* qk = (const bf16_t*)(ws + R1_QK);
  bf16_t* kvf = (bf16_t*)(ws + R1_KVF); bf16_t* kvb = (bf16_t*)(ws + R1_KVB);
  LAS bf16_t* vT = (LAS bf16_t*)lds; LAS bf16_t* kTf = vT + 128 * VT_LD; LAS bf16_t* kTb = kTf + 64 * VT_LD;
  const int tid = tidx_(), wid = tid >> 6, lane = tid & 63, fr = lane & 15, fq = lane >> 4;
  for (int uid = bidx_(); uid < 1048; uid += gridDim.x) {
    int seq, chunk, head, cidx; ret_unit(uid, seq, chunk, head, cidx);
    const int row0 = cidx * 128; const float lg = ret_lg(head);
    __syncthreads();
    load_vT(mix, row0, head, vT);
    { const int j = tid >> 2, d0 = (tid & 3) * 16;
      const float df = __expf(lg * (float)(127 - j)), db = __expf(lg * (float)j);
      const u32x4* src = (const u32x4*)(qk + (size_t)(row0 + j) * 512 + 256 + head * 64 + d0);
#pragma unroll
      for (int q = 0; q < 2; ++q) { const u32x4 v = src[q]; const unsigned w[4] = {v.x, v.y, v.z, v.w};
#pragma unroll
        for (int t = 0; t < 4; ++t) { const float lo = bflo(w[t]), hi = bfhi(w[t]); const int d = d0 + q * 8 + t * 2;
          kTf[d * VT_LD + j] = f2bf(lo * df); kTf[(d + 1) * VT_LD + j] = f2bf(hi * df);
          kTb[d * VT_LD + j] = f2bf(lo * db); kTb[(d + 1) * VT_LD + j] = f2bf(hi * db); } } }
    __syncthreads();
    f32x4 af[4], ab[4];
#pragma unroll
    for (int m = 0; m < 4; ++m) { af[m] = (f32x4){0.f, 0.f, 0.f, 0.f}; ab[m] = (f32x4){0.f, 0.f, 0.f, 0.f}; }
#pragma unroll
    for (int ks = 0; ks < 4; ++ks) {
      const bf16x8 y = *(const LAS bf16x8*)(vT + (wid * 16 + fr) * VT_LD + ks * 32 + fq * 8);
#pragma unroll
      for (int m = 0; m < 4; ++m) {
        const bf16x8 xf = *(const LAS bf16x8*)(kTf + (m * 16 + fr) * VT_LD + ks * 32 + fq * 8);
        const bf16x8 xb = *(const LAS bf16x8*)(kTb + (m * 16 + fr) * VT_LD + ks * 32 + fq * 8);
        af[m] = mfma16(xf, y, af[m]); ab[m] = mfma16(xb, y, ab[m]);
      }
    }
    const size_t o = ((size_t)(cidx * 4 + head) * 128 + wid * 16 + fr) * 64;
#pragma unroll
    for (int m = 0; m < 4; ++m) { u32x2 w; w.x = pack2(af[m][0], af[m][1]); w.y = pack2(af[m][2], af[m][3]); *(u32x2*)(kvf + o + m * 16 + fq * 4) = w;
      w.x = pack2(ab[m][0], ab[m][1]); w.y = pack2(ab[m][2], ab[m][3]); *(u32x2*)(kvb + o + m * 16 + fq * 4) = w; }
  }
}

__device__ __forceinline__ void ret_scan_phase(const Params& p) {
  unsigned char* ws = p.ws + opq0_();
  const int gt = bidx_() * 512 + tidx_(), ngt = gridDim.x * 512;
  for (int w = gt; w < 2 * 24 * 2048; w += ngt) {
    const int dir = w / (24 * 2048), rem = w % (24 * 2048), sh = rem >> 11, eg = rem & 2047, seq = sh >> 2, head = sh & 3;
    const int n = seq < 2 ? 65 : 33, cb = seq < 2 ? seq * 65 : 130 + (seq - 2) * 33;
    bf16_t* base = (bf16_t*)(ws + (dir ? R1_KVB : R1_KVF)) + (size_t)head * 8192 + eg * 4;
    const float gc = __expf(128.0f * ret_lg(head));
    float s0 = 0.f, s1 = 0.f, s2 = 0.f, s3 = 0.f;
    for (int i = 0; i < n; ++i) {
      const int c = dir ? n - 1 - i : i;
      u32x2* ptr = (u32x2*)(base + (size_t)(cb + c) * 4 * 8192);
      const u32x2 x = *ptr;
      u32x2 o; o.x = pack2(s0, s1); o.y = pack2(s2, s3); *ptr = o;
      s0 = gc * s0 + bflo(x.x); s1 = gc * s1 + bfhi(x.x); s2 = gc * s2 + bflo(x.y); s3 = gc * s3 + bfhi(x.y);
    }
  }
}

__device__ __forceinline__ bf16x8 scale_frag(bf16x8 v, float s) {
  bf16x8 o;
#pragma unroll
  for (int i = 0; i < 8; ++i) o[i] = (short)f2bf(bf2f((bf16_t)v[i]) * s);
  return o;
}

__device__ __forceinline__ void ret_out_phase(const Params& p, LAS unsigned char* lds) {
  unsigned char* ws = p.ws + opq0_(); unsigned char* r2 = (unsigned char*)p.out + opq0_();
  bf16_t* mix = (bf16_t*)(ws + R1_MIX); const bf16_t* qk = (const bf16_t*)(ws + R1_QK);
  const bf16_t* kvf = (const bf16_t*)(ws + R1_KVF); const bf16_t* kvb = (const bf16_t*)(ws + R1_KVB);
  LAS bf16_t* vT = (LAS bf16_t*)lds; LAS bf16_t* Pm = vT + 128 * VT_LD;
  const int tid = tidx_(), wid = tid >> 6, lane = tid & 63, fr = lane & 15, fq = lane >> 4;
  for (int uid = bidx_(); uid < 1048; uid += gridDim.x) {
    int seq, chunk, head, cidx; ret_unit(uid, seq, chunk, head, cidx);
    const int row0 = cidx * 128; const float lg = ret_lg(head);
    __syncthreads();
    load_vT(mix, row0, head, vT);
    bf16x8 qf[2];
#pragma unroll
    for (int ks = 0; ks < 2; ++ks) qf[ks] = *(const bf16x8*)(qk + (size_t)(row0 + wid * 16 + fr) * 512 + head * 64 + ks * 32 + fq * 8);
    f32x4 acc[8];
#pragma unroll
    for (int nt = 0; nt < 8; ++nt) {
      acc[nt] = (f32x4){0.f, 0.f, 0.f, 0.f};
#pragma unroll
      for (int ks = 0; ks < 2; ++ks) { const bf16x8 kf = *(const bf16x8*)(qk + (size_t)(row0 + nt * 16 + fr) * 512 + 256 + head * 64 + ks * 32 + fq * 8); acc[nt] = mfma16(qf[ks], kf, acc[nt]); }
    }
#pragma unroll
    for (int nt = 0; nt < 8; ++nt)
#pragma unroll
      for (int r = 0; r < 4; ++r) { const int i = wid * 16 + fq * 4 + r, j = nt * 16 + fr; const int dd = i > j ? i - j : j - i;
        Pm[i * VT_LD + j] = f2bf(acc[nt][r] * __expf(lg * (float)dd)); }
    __syncthreads();
    const int irow = wid * 16 + fr;
    const float g1 = __expf(lg * (float)(irow + 1)), g2 = __expf(lg * (float)(128 - irow));
    bf16x8 q1[2], q2[2];
#pragma unroll
    for (int ks = 0; ks < 2; ++ks) { q1[ks] = scale_frag(qf[ks], g1); q2[ks] = scale_frag(qf[ks], g2); }
    bf16x8 pf[4];
#pragma unroll
    for (int ks = 0; ks < 4; ++ks) pf[ks] = *(const LAS bf16x8*)(Pm + irow * VT_LD + ks * 32 + fq * 8);
    const bf16_t* sp = kvf + (size_t)(cidx * 4 + head) * 8192; const bf16_t* sn = kvb + (size_t)(cidx * 4 + head) * 8192;
    float ssq[4] = {0.f, 0.f, 0.f, 0.f};
#pragma unroll
    for (int nt = 0; nt < 8; ++nt) {
      f32x4 a = (f32x4){0.f, 0.f, 0.f, 0.f};
#pragma unroll
      for (int ks = 0; ks < 4; ++ks) { const bf16x8 y = *(const LAS bf16x8*)(vT + (nt * 16 + fr) * VT_LD + ks * 32 + fq * 8); a = mfma16(pf[ks], y, a); }
#pragma unroll
      for (int ks = 0; ks < 2; ++ks) { const bf16x8 y1 = *(const bf16x8*)(sp + (size_t)(nt * 16 + fr) * 64 + ks * 32 + fq * 8); a = mfma16(q1[ks], y1, a);
        const bf16x8 y2 = *(const bf16x8*)(sn + (size_t)(nt * 16 + fr) * 64 + ks * 32 + fq * 8); a = mfma16(q2[ks], y2, a); }
      acc[nt] = a;
#pragma unroll
      for (int r = 0; r < 4; ++r) ssq[r] += a[r] * a[r];
    }
#pragma unroll
    for (int r = 0; r < 4; ++r) { ssq[r] = rowsum16(ssq[r]); ssq[r] = rsqrtf(ssq[r] * (1.0f / 128.0f) + 1e-5f); }
    __syncthreads();
#pragma unroll
    for (int nt = 0; nt < 8; ++nt)
#pragma unroll
      for (int r = 0; r < 4; ++r) {
        const int i = wid * 16 + fq * 4 + r, e = nt * 16 + fr;
        bf16_t* dst = mix + (size_t)(row0 + i) * 1024 + head * 128 + e;
        const float gr = bf2f(dst[512]);
        *dst = f2bf(acc[nt][r] * ssq[r] * gr * sigmoidf_(gr));
      }
  }
}
__device__ __forceinline__ float tanh_fast(float x) { x = fminf(fmaxf(x, -15.f), 15.f); const float e = __expf(2.0f * x); return (e - 1.0f) * rcpf_(e + 1.0f); }
__device__ __forceinline__ f32x4 ld_bf4(const LAS bf16_t* p) { const u32x2 v = *(const LAS u32x2*)p; return (f32x4){bflo(v.x), bfhi(v.x), bflo(v.y), bfhi(v.y)}; }

__device__ __forceinline__ void rwkv_scan_phase(const Params& p, LAS unsigned char* lds) {
  unsigned char* ws = p.ws + opq0_(); unsigned char* r2 = (unsigned char*)p.out + opq0_();
  const bf16_t* prw = (const bf16_t*)(r2 + R2_PRW);
  float* bonus = (float*)(ws + T_BONUS);
  LAS bf16_t* raw = (LAS bf16_t*)lds;
  LAS bf16_t* txw = (LAS bf16_t*)(lds + 21760);
  LAS bf16_t* xab = (LAS bf16_t*)(lds + 26368);
  LAS bf16_t* w2s = (LAS bf16_t*)(lds + 30976);
  LAS bf16_t* a2s = (LAS bf16_t*)(lds + 40192);
  LAS float* pre = (LAS float*)(lds + 49408);
  LAS float* st = (LAS float*)(lds + 65792);
  LAS float* vbuf = (LAS float*)(lds + 106752);
  LAS float* sc = (LAS float*)(lds + 114944);
  LAS float* obuf = (LAS float*)(lds + 115456);
  const int tid = tidx_(), wid = tid >> 6, lane = tid & 63, fr = lane & 15, fq = lane >> 4;
  const float* mu = inp(ws, 10);
  for (int wi = bidx_(); wi < 256; wi += gridDim.x) {
    int dir, seq, head, rbase, NRW, L, rsplit;
    if (wi < 128) { const int chain = wi >> 2; rsplit = wi & 3; dir = chain >> 4; seq = (chain & 15) >> 3; head = chain & 7; NRW = 16; rbase = rsplit * 16; L = LP; }
    else { const int v = wi - 128; const int chain = v >> 1; rsplit = v & 1; dir = chain >> 5; seq = 2 + ((chain & 31) >> 3); head = chain & 7; NRW = 32; rbase = rsplit * 32; L = LS; }
    const int sb = seq_base(seq) + PADR;
    bf16_t* od = (bf16_t*)(ws + (dir ? R1_OB : R1_OF));
    const int nblk = (L + 31) >> 5;
    __syncthreads();
    { const float* w2 = inp(ws, 12) + (size_t)dir * 64 * 512 + head * 64; const float* a2 = inp(ws, 14) + (size_t)dir * 64 * 512 + head * 64;
#pragma unroll
      for (int i = 0; i < 8; ++i) { const int e = tid + i * 512, k = e & 63, r = e >> 6; w2s[k * 72 + r] = f2bf(w2[(size_t)r * 512 + k]); a2s[k * 72 + r] = f2bf(a2[(size_t)r * 512 + k]); } }
    const int kq = tid & 15, k0 = kq * 4, ch0 = head * 64 + k0;
    const f32x4 w0c = *(const f32x4*)(inp(ws, 11) + dir * 512 + ch0), a0c = *(const f32x4*)(inp(ws, 13) + dir * 512 + ch0);
    const f32x4 kkc = *(const f32x4*)(inp(ws, 16) + ch0), kac = *(const f32x4*)(inp(ws, 17) + ch0), rkc = *(const f32x4*)(inp(ws, 18) + ch0);
    const f32x4 mur = *(const f32x4*)(mu + ch0), muk = *(const f32x4*)(mu + 512 + ch0), muv = *(const f32x4*)(mu + 1024 + ch0);
    const int cb = (tid & 15) * 8;
    const f32x4 mub0 = *(const f32x4*)(mu + 1536 + cb), mub1 = *(const f32x4*)(mu + 1536 + cb + 4);
    u32x4 pf[3];
    auto issue = [&](int b) {
      const int ta = dir == 0 ? b * 32 : L - 32 - b * 32;
#pragma unroll
      for (int i = 0; i < 3; ++i) { const int li = tid + i * 512; pf[i] = (u32x4){0u, 0u, 0u, 0u};
        if (li < 1360) { const int ri = li / 40, rem = li % 40, seg = rem >> 3, chk = rem & 7; const int t = ta - 1 + ri;
          const int col = seg < 3 ? seg * 512 + head * 64 : 1536 + (seg - 3) * 64;
          if (t >= 0 && t < L) pf[i] = *(const u32x4*)(prw + (size_t)(sb + t) * 1792 + col + chk * 8); } }
    };
    issue(0);
    const int srow = wid * 4 + fq;
    const bool sactive = wid * 4 < NRW;
    float S0 = 0.f, S1 = 0.f, S2 = 0.f, S3 = 0.f;
    for (int b = 0; b < nblk; ++b) {
      const int ta = dir == 0 ? b * 32 : L - 32 - b * 32;
      const int nst = (L - b * 32) < 32 ? (L - b * 32) : 32;
#pragma unroll
      for (int i = 0; i < 3; ++i) { const int li = tid + i * 512; if (li < 1360) { const int ri = li / 40, rem = li % 40; *(LAS u32x4*)(raw + ri * 320 + rem * 8) = pf[i]; } }
      if (b + 1 < nblk) issue(b + 1);
      __syncthreads();
      { const int tl = tid >> 4, ri = tl + 1;
        const LAS bf16_t* q0 = raw + (ri - 1) * 320 + 192 + cb; const LAS bf16_t* q1 = q0 + 320; const LAS bf16_t* q2 = q1 + 320;
        float x[8];
#pragma unroll
        for (int hh = 0; hh < 2; ++hh) { const f32x4 a = ld_bf4(q0 + hh * 4), c = ld_bf4(q1 + hh * 4), d = ld_bf4(q2 + hh * 4); const f32x4 m = hh ? mub1 : mub0;
#pragma unroll
          for (int j = 0; j < 4; ++j) x[hh * 4 + j] = c[j] + m[j] * (0.5f * (a[j] + d[j]) - c[j]); }
        u32x4 w;
        if (cb < 64) { w.x = pack2(tanh_fast(x[0]), tanh_fast(x[1])); w.y = pack2(tanh_fast(x[2]), tanh_fast(x[3])); w.z = pack2(tanh_fast(x[4]), tanh_fast(x[5])); w.w = pack2(tanh_fast(x[6]), tanh_fast(x[7]));
          *(LAS u32x4*)(txw + tl * 72 + cb) = w; }
        else { w.x = pack2(x[0], x[1]); w.y = pack2(x[2], x[3]); w.z = pack2(x[4], x[5]); w.w = pack2(x[6], x[7]); *(LAS u32x4*)(xab + tl * 72 + cb - 64) = w; } }
      __syncthreads();
      { const int mat = wid >> 2, mt = (wid >> 1) & 1, ntp = wid & 1;
        const LAS bf16_t* X = mat ? xab : txw; const LAS bf16_t* Y = mat ? a2s : w2s;
#pragma unroll
        for (int nn = 0; nn < 2; ++nn) { const int nt = ntp * 2 + nn; f32x4 a = (f32x4){0.f, 0.f, 0.f, 0.f};
#pragma unroll
          for (int ks = 0; ks < 2; ++ks) { const bf16x8 xf = *(const LAS bf16x8*)(X + (mt * 16 + fr) * 72 + ks * 32 + fq * 8); const bf16x8 yf = *(const LAS bf16x8*)(Y + (nt * 16 + fr) * 72 + ks * 32 + fq * 8); a = mfma16(xf, yf, a); }
#pragma unroll
          for (int r = 0; r < 4; ++r) pre[mat * 2048 + (mt * 16 + fq * 4 + r) * 64 + nt * 16 + fr] = a[r]; } }
      __syncthreads();
      { const int tl = tid >> 4, ri = tl + 1, t = ta + tl;
        const LAS bf16_t* q1 = raw + ri * 320 + k0;
        f32x4 xr, xk, xv;
        { const f32x4 a = ld_bf4(q1 - 320), c = ld_bf4(q1), d = ld_bf4(q1 + 320); xr = c + mur * (0.5f * (a + d) - c); }
        { const f32x4 a = ld_bf4(q1 - 320 + 64), c = ld_bf4(q1 + 64), d = ld_bf4(q1 + 320 + 64); xk = c + muk * (0.5f * (a + d) - c); }
        { const f32x4 a = ld_bf4(q1 - 320 + 128), c = ld_bf4(q1 + 128), d = ld_bf4(q1 + 320 + 128); xv = c + muv * (0.5f * (a + d) - c); }
        const f32x4 wp = *(const LAS f32x4*)(pre + tl * 64 + k0), ap = *(const LAS f32x4*)(pre + 2048 + tl * 64 + k0);
        f32x4 w, a, kk, kd, bb, wrr;
        float ss = 0.f;
#pragma unroll
        for (int j = 0; j < 4; ++j) {
          const float wl = w0c[j] + wp[j]; const float ew = 0.60653066f * rcpf_(1.0f + __expf(-wl)); w[j] = __expf(-ew);
          a[j] = rcpf_(1.0f + __expf(-(a0c[j] + ap[j])));
          kk[j] = xk[j] * kkc[j]; ss += kk[j] * kk[j];
          kd[j] = xk[j] * (1.0f + (a[j] - 1.0f) * kac[j]);
          wrr[j] = w[j] * xr[j];
        }
        ss = rowsum16(ss); const float inv = rsqrtf(fmaxf(ss, 1e-24f));
        float br = 0.f, kdr = 0.f, bon = 0.f;
#pragma unroll
        for (int j = 0; j < 4; ++j) { kk[j] *= inv; bb[j] = kk[j] * a[j]; br += bb[j] * xr[j]; kdr += kd[j] * xr[j]; bon += xr[j] * kd[j] * rkc[j]; }
        br = rowsum16(br); kdr = rowsum16(kdr); bon = rowsum16(bon);
        LAS float* s = st + tl * 320 + k0;
        *(LAS f32x4*)(s) = kk; *(LAS f32x4*)(s + 64) = wrr; *(LAS f32x4*)(s + 128) = w; *(LAS f32x4*)(s + 192) = bb; *(LAS f32x4*)(s + 256) = kd;
        *(LAS f32x4*)(vbuf + tl * 64 + k0) = xv;
        if (kq == 0) { sc[tl * 4] = br; sc[tl * 4 + 1] = kdr; if (rsplit == 0 && t >= 0 && t < L) bonus[(size_t)(sb + t) * 16 + dir * 8 + head] = bon; } }
      __syncthreads();
      if (sactive) {
        int tl = dir ? 31 : 0;
        const LAS float* sp = st + tl * 320 + fr * 4;
        f32x4 kk = *(const LAS f32x4*)(sp), wr4 = *(const LAS f32x4*)(sp + 64), w4 = *(const LAS f32x4*)(sp + 128), b4 = *(const LAS f32x4*)(sp + 192), kd4 = *(const LAS f32x4*)(sp + 256);
        float vv = vbuf[tl * 64 + rbase + srow], br = sc[tl * 4], kdr = sc[tl * 4 + 1];
        for (int s = 0; s < nst; ++s) {
          const int tln = s + 1 < nst ? (dir ? 30 - s : s + 1) : tl;
          const LAS float* spn = st + tln * 320 + fr * 4;
          const f32x4 kkn = *(const LAS f32x4*)(spn), wrn = *(const LAS f32x4*)(spn + 64), wn = *(const LAS f32x4*)(spn + 128), bn = *(const LAS f32x4*)(spn + 192), kdn = *(const LAS f32x4*)(spn + 256);
          const float vvn = vbuf[tln * 64 + rbase + srow], brn = sc[tln * 4], kdrn = sc[tln * 4 + 1];
          float skp = (S0 * kk[0] + S1 * kk[1]) + (S2 * kk[2] + S3 * kk[3]);
          float pp = (S0 * wr4[0] + S1 * wr4[1]) + (S2 * wr4[2] + S3 * wr4[3]);
          const float sk = rowsum16(skp), pt = rowsum16(pp);
          S0 = S0 * w4[0] - sk * b4[0] + vv * kd4[0]; S1 = S1 * w4[1] - sk * b4[1] + vv * kd4[1];
          S2 = S2 * w4[2] - sk * b4[2] + vv * kd4[2]; S3 = S3 * w4[3] - sk * b4[3] + vv * kd4[3];
          if (fr == 0) obuf[tl * 32 + srow] = pt - sk * br + vv * kdr;
          kk = kkn; wr4 = wrn; w4 = wn; b4 = bn; kd4 = kdn; vv = vvn; br = brn; kdr = kdrn; tl = tln;
        }
      }
      __syncthreads();
#pragma unroll
      for (int i = 0; i < 2; ++i) { const int e = tid + i * 512, tl = e >> 5, rw = e & 31, t = ta + tl;
        if (rw < NRW && t >= 0 && t < L) od[(size_t)(sb + t) * 512 + head * 64 + rbase + rw] = f2bf(obuf[tl * 32 + rw]); }
    }
  }
}

__device__ __forceinline__ float rowsum8p(float v) { v += dppf<0xB1>(v); v += dppf<0x4E>(v); v += dppf<0x141>(v); return v; }
__device__ __forceinline__ void unpack8p(const u32x4 v, float (&o)[8]) { o[0] = bflo(v.x); o[1] = bfhi(v.x); o[2] = bflo(v.y); o[3] = bfhi(v.y); o[4] = bflo(v.z); o[5] = bfhi(v.z); o[6] = bflo(v.w); o[7] = bfhi(v.w); }
__device__ __forceinline__ void rwkv_post_phase(const Params& p, LAS unsigned char* lds) {
  unsigned char* ws = p.ws + opq0_(); unsigned char* r2 = (unsigned char*)p.out + opq0_();
  const bf16_t* prw = (const bf16_t*)(r2 + R2_PRW);
  const bf16_t* of = (const bf16_t*)(ws + R1_OF); const bf16_t* ob = (const bf16_t*)(ws + R1_OB);
  const float* bonus = (const float*)(ws + T_BONUS); const bf16_t* g2t = (const bf16_t*)(ws + T_G2T);
  bf16_t* mix = (bf16_t*)(ws + R1_MIX);
  const float* mu = inp(ws, 10); const float* lnw = inp(ws, 19); const float* lnb = inp(ws, 20);
  LAS bf16_t* sg = (LAS bf16_t*)lds;
  LAS float* gbuf = (LAS float*)(lds + 34816);
  const int tid = tidx_(), wid = tid >> 6, lane = tid & 63, fr = lane & 15, fq = lane >> 4;
  const int G = gdim_();
  for (int wjob = bidx_(); wjob < 256 + 48; wjob += G) {
    const int tile = wjob < 256 ? wjob : 256 + ((wjob - 256) >> 3); const int hd0 = wjob < 256 ? 0 : ((wjob - 256) & 7), hd1 = wjob < 256 ? 8 : hd0 + 1;
    const int row0 = tile * 128;
    __syncthreads();
    { const int tr = tid >> 2, c0 = (tid & 3) * 32, row = row0 + tr; int seq, pos, L; row_info(row, seq, pos, L);
      const bool hasp = pos > 0, hasn = pos >= 0 && pos < L - 1;
      const bf16_t* pc = prw + (size_t)row * 1792 + 1664 + c0;
#pragma unroll
      for (int q = 0; q < 4; ++q) {
        const u32x4 c = *(const u32x4*)(pc + q * 8); u32x4 a = (u32x4){0u, 0u, 0u, 0u}, d = (u32x4){0u, 0u, 0u, 0u};
        if (hasp) a = *(const u32x4*)(pc - 1792 + q * 8);
        if (hasn) d = *(const u32x4*)(pc + 1792 + q * 8);
        float cv[8], av[8], dv[8]; unpack8p(c, cv); unpack8p(a, av); unpack8p(d, dv);
        const f32x4 m0 = *(const f32x4*)(mu + 1664 + c0 + q * 8), m1 = *(const f32x4*)(mu + 1664 + c0 + q * 8 + 4);
        float x[8];
#pragma unroll
        for (int j = 0; j < 8; ++j) { const float m = j < 4 ? m0[j & 3] : m1[j & 3]; x[j] = sigmoidf_(cv[j] + m * (0.5f * (av[j] + dv[j]) - cv[j])); }
        *(LAS u32x4*)(sg + tr * VT_LD + c0 + q * 8) = (u32x4){pack2(x[0], x[1]), pack2(x[2], x[3]), pack2(x[4], x[5]), pack2(x[6], x[7])};
      } }
    __syncthreads();
    bf16x8 xf[4];
#pragma unroll
    for (int ks = 0; ks < 4; ++ks) xf[ks] = *(const LAS bf16x8*)(sg + (wid * 16 + fr) * VT_LD + ks * 32 + fq * 8);
    const int ch = tid & 7;
#pragma unroll 1
    for (int hd = hd0; hd < hd1; ++hd) {
      LAS float* gb = gbuf + (hd & 1) * (128 * 68);
#pragma unroll
      for (int nt = 0; nt < 4; ++nt) { f32x4 g = (f32x4){0.f, 0.f, 0.f, 0.f};
#pragma unroll
        for (int ks = 0; ks < 4; ++ks) { const bf16x8 yf = *(const bf16x8*)(g2t + (size_t)(hd * 64 + nt * 16 + fr) * 128 + ks * 32 + fq * 8); g = mfma16(xf[ks], yf, g); }
#pragma unroll
        for (int r = 0; r < 4; ++r) gb[(wid * 16 + fq * 4 + r) * 68 + nt * 16 + fr] = g[r]; }
      __syncthreads();
      const int cg = hd * 64 + ch * 8;
      const f32x4 w0 = *(const f32x4*)(lnw + cg), w1 = *(const f32x4*)(lnw + cg + 4), b0 = *(const f32x4*)(lnb + cg), b1 = *(const f32x4*)(lnb + cg + 4);
      const f32x4 mv0 = *(const f32x4*)(mu + 1024 + cg), mv1 = *(const f32x4*)(mu + 1024 + cg + 4);
#pragma unroll
      for (int i = 0; i < 2; ++i) {
        const int tk = (tid >> 3) + i * 64, row = row0 + tk; int seq, pos, L; row_info(row, seq, pos, L);
        u32x4 res = (u32x4){0u, 0u, 0u, 0u};
        if (pos >= 0) {
          float o1[8], o2[8], o[8];
          unpack8p(*(const u32x4*)(of + (size_t)row * 512 + cg), o1); unpack8p(*(const u32x4*)(ob + (size_t)row * 512 + cg), o2);
          float sum = 0.f;
#pragma unroll
          for (int j = 0; j < 8; ++j) { o[j] = o1[j] + o2[j]; sum += o[j]; }
          sum = rowsum8p(sum); const float mean = sum * (1.0f / 64.0f);
          float vs = 0.f;
#pragma unroll
          for (int j = 0; j < 8; ++j) { const float d = o[j] - mean; vs += d * d; }
          vs = rowsum8p(vs); const float rstd = rsqrtf(vs * (1.0f / 64.0f) + 64e-5f);
          const float bsc = 0.5f * (bonus[(size_t)row * 16 + hd] + bonus[(size_t)row * 16 + 8 + hd]);
          const bf16_t* pv = prw + (size_t)row * 1792 + 1024 + cg;
          float vc[8], va[8], vd[8];
          unpack8p(*(const u32x4*)pv, vc);
          u32x4 ua = (u32x4){0u, 0u, 0u, 0u}, ud = (u32x4){0u, 0u, 0u, 0u};
          if (pos > 0) ua = *(const u32x4*)(pv - 1792);
          if (pos < L - 1) ud = *(const u32x4*)(pv + 1792);
          unpack8p(ua, va); unpack8p(ud, vd);
          const f32x4 g0 = *(const LAS f32x4*)(gb + tk * 68 + ch * 8), g1 = *(const LAS f32x4*)(gb + tk * 68 + ch * 8 + 4);
          float y[8];
#pragma unroll
          for (int j = 0; j < 8; ++j) { const float lw = j < 4 ? w0[j & 3] : w1[j & 3], lb = j < 4 ? b0[j & 3] : b1[j & 3], mm = j < 4 ? mv0[j & 3] : mv1[j & 3], gg = j < 4 ? g0[j & 3] : g1[j & 3];
            const float xv = vc[j] + mm * (0.5f * (va[j] + vd[j]) - vc[j]);
            y[j] = ((o[j] - mean) * rstd * lw + lb + bsc * xv) * gg; }
          res = (u32x4){pack2(y[0], y[1]), pack2(y[2], y[3]), pack2(y[4], y[5]), pack2(y[6], y[7])};
        }
        *(u32x4*)(mix + (size_t)row * 1024 + 512 + cg) = res;
      }
    }
  }
}
__device__ __forceinline__ f32x4 g_bf4(const bf16_t* p) { const u32x2 v = *(const u32x2*)p; return (f32x4){bflo(v.x), bfhi(v.x), bflo(v.y), bfhi(v.y)}; }
__device__ __forceinline__ void unpack8(const u32x4 v, float (&o)[8]) { o[0] = bflo(v.x); o[1] = bfhi(v.x); o[2] = bflo(v.y); o[3] = bfhi(v.y); o[4] = bflo(v.z); o[5] = bfhi(v.z); o[6] = bflo(v.w); o[7] = bfhi(v.w); }
__device__ __forceinline__ float rowsum8(float v) { v += dppf<0xB1>(v); v += dppf<0x4E>(v); v += dppf<0x141>(v); return v; }

constexpr size_t R2_XWA = (size_t)MROWS * 1792 * 2;
static_assert(R2_XWA + (size_t)MROWS * 128 * 2 <= SZ_OUT, "xwa");
__device__ __forceinline__ void xwa_phase(const Params& p) {
  unsigned char* ws = p.ws + opq0_(); unsigned char* r2 = (unsigned char*)p.out + opq0_();
  const bf16_t* prw = (const bf16_t*)(r2 + R2_PRW); bf16_t* xwa = (bf16_t*)(r2 + R2_XWA);
  const float* mu = inp(ws, 10);
  const int gt = bidx_() * 512 + tidx_(), ngt = gdim_() * 512;
  for (int it = gt; it < MROWS * 16; it += ngt) {
    const int row = it >> 4, cb = (it & 15) * 8; int seq, pos, L; row_info(row, seq, pos, L);
    u32x4 o = (u32x4){0u, 0u, 0u, 0u};
    if (pos >= 0) {
      const bf16_t* pc = prw + (size_t)row * 1792 + 1536 + cb;
      u32x4 ua = (u32x4){0u, 0u, 0u, 0u}, ud = (u32x4){0u, 0u, 0u, 0u}; const u32x4 uc = *(const u32x4*)pc;
      if (pos > 0) ua = *(const u32x4*)(pc - 1792);
      if (pos < L - 1) ud = *(const u32x4*)(pc + 1792);
      float a[8], c[8], d[8], x[8]; unpack8(ua, a); unpack8(uc, c); unpack8(ud, d);
      const f32x4 m0 = *(const f32x4*)(mu + 1536 + cb), m1 = *(const f32x4*)(mu + 1536 + cb + 4);
#pragma unroll
      for (int j = 0; j < 8; ++j) { const float m = j < 4 ? m0[j & 3] : m1[j & 3]; x[j] = c[j] + m * (0.5f * (a[j] + d[j]) - c[j]); if (cb < 64) x[j] = tanh_fast(x[j]); }
      o = (u32x4){pack2(x[0], x[1]), pack2(x[2], x[3]), pack2(x[4], x[5]), pack2(x[6], x[7])};
    }
    *(u32x4*)(xwa + (size_t)row * 128 + cb) = o;
  }
}

static_assert(LP % 32 == 16 && LS % 32 == 16, "scan half-blocks assume 16-step halves");
__device__ __forceinline__ void rwkv_scan2_phase(const Params& p, LAS unsigned char* lds) {
  unsigned char* ws = p.ws + opq0_(); unsigned char* r2 = (unsigned char*)p.out + opq0_();
  const bf16_t* prw = (const bf16_t*)(r2 + R2_PRW);
  float* bonus = (float*)(ws + T_BONUS);
  LAS bf16_t* w2s = (LAS bf16_t*)(lds + 0);
  LAS bf16_t* a2s = (LAS bf16_t*)(lds + 9216);
  LAS float* pre = (LAS float*)(lds + 18432);
  LAS float* cst = (LAS float*)(lds + 34816);
  LAS float* stb = (LAS float*)(lds + 36864);
  LAS float* vbb = (LAS float*)(lds + 118784);
  LAS float* scb = (LAS float*)(lds + 124928);
  LAS float* ppb = (LAS float*)(lds + 126464);
  LAS float* skb = (LAS float*)(lds + 142848);
  const int tid = tidx_(), wid = tid >> 6, lane = tid & 63, fr = lane & 15, fq = lane >> 4;
  const float* mu = inp(ws, 10);
  const bool producer = wid >= 4;
  const int pw = wid - 4, ptid = tid - 256;
  const int G = gdim_();
  for (int slot = bidx_(); slot < 256; slot += G) {
    const int nitems = slot < 128 ? 1 : 2;
    for (int itx = 0; itx < nitems; ++itx) {
      int dir, seq, head, rsplit, L;
      if (slot < 128) { const int chain = slot >> 2; rsplit = slot & 3; dir = chain >> 4; seq = (chain & 15) >> 3; head = chain & 7; L = LP; }
      else { const int v = (slot - 128) * 2 + itx; const int chain = v >> 2; rsplit = v & 3; dir = chain >> 5; seq = 2 + ((chain & 31) >> 3); head = chain & 7; L = LS; }
      const int rbase = rsplit * 16;
      const int sb = seq_base(seq) + PADR;
      bf16_t* od = (bf16_t*)(ws + (dir ? R1_OB : R1_OF));
      const int nblk = (L + 31) >> 5;
      __syncthreads();
      { const float* w2 = inp(ws, 12) + (size_t)dir * 64 * 512 + head * 64; const float* a2 = inp(ws, 14) + (size_t)dir * 64 * 512 + head * 64;
#pragma unroll
        for (int i = 0; i < 8; ++i) { const int e = tid + i * 512, k = e & 63, r = e >> 6; w2s[k * 72 + r] = f2bf(w2[(size_t)r * 512 + k]); a2s[k * 72 + r] = f2bf(a2[(size_t)r * 512 + k]); }
        { const int v = tid >> 6, k = tid & 63, c = head * 64 + k; float x;
          switch (v) { case 0: x = inp(ws, 11)[dir * 512 + c]; break; case 1: x = inp(ws, 13)[dir * 512 + c]; break; case 2: x = inp(ws, 16)[c]; break; case 3: x = inp(ws, 17)[c]; break;
                       case 4: x = inp(ws, 18)[c]; break; case 5: x = mu[c]; break; case 6: x = mu[512 + c]; break; default: x = mu[1024 + c]; break; }
          cst[v * 64 + k] = x; } }
      __syncthreads();
      u32x4 px[2][2], pd[3][3];
      const bf16_t* xwa = (const bf16_t*)(r2 + R2_XWA);
      const int dt = pw * 8 + (lane >> 3), dk0 = (lane & 7) * 8;
      auto issue_x = [&](int b) {
        const int ta = dir == 0 ? b * 32 : L - 32 - b * 32; const int t = ta + pw * 8 + (fr & 7);
#pragma unroll
        for (int mat = 0; mat < 2; ++mat)
#pragma unroll
          for (int ks = 0; ks < 2; ++ks) { px[mat][ks] = (u32x4){0u, 0u, 0u, 0u};
            if (t >= 0 && t < L) px[mat][ks] = *(const u32x4*)(xwa + (size_t)(sb + t) * 128 + mat * 64 + ks * 32 + fq * 8); }
      };
      auto issue_d = [&](int b) {
        const int ta = dir == 0 ? b * 32 : L - 32 - b * 32;
#pragma unroll
        for (int sg = 0; sg < 3; ++sg)
#pragma unroll
          for (int rr = 0; rr < 3; ++rr) { const int t = ta + dt - 1 + rr; pd[sg][rr] = (u32x4){0u, 0u, 0u, 0u};
            if (t >= 0 && t < L) pd[sg][rr] = *(const u32x4*)(prw + (size_t)(sb + t) * 1792 + sg * 512 + head * 64 + dk0); }
      };
      if (producer) { issue_x(0); issue_d(0); }
      const int srow = wid * 4 + fq;
      f32x2_t S01 = {0.f, 0.f}, S23 = {0.f, 0.f};
      for (int b = -1; b <= nblk; ++b) {
        const int cur = b & 1, nxt = cur ^ 1;
        const int nst = (b >= 0 && b < nblk) ? ((L - b * 32) < 32 ? (L - b * 32) : 32) : 0;
        if (!producer) {
          if (nst > 0) {
            const LAS float* st = stb + cur * 10240; const LAS float* vb = vbb + (b % 3) * 512;
            LAS float* ppw = ppb + cur * 2048 + srow * 4 + (fr >> 2); LAS float* skw = skb + cur * 512 + srow;
            f32x4 kkA, wrA, wA, bA, kdA, kkB, wrB, wB, bB, kdB; float vvA, vvB;
#define LOADR(X, s_) do { const int tl_ = dir ? 31 - (s_) : (s_); const LAS float* sp_ = st + tl_ * 320 + fr * 4; kk##X = *(const LAS f32x4*)(sp_); wr##X = *(const LAS f32x4*)(sp_ + 64); w##X = *(const LAS f32x4*)(sp_ + 128); \
                          b##X = *(const LAS f32x4*)(sp_ + 192); kd##X = *(const LAS f32x4*)(sp_ + 256); vv##X = vb[tl_ * 16 + srow]; } while (0)
#define STEPR(X, s_) do { const f32x2_t ts_ = __builtin_elementwise_fma(S23, kk##X.hi, S01 * kk##X.lo); const f32x2_t tp_ = __builtin_elementwise_fma(S23, wr##X.hi, S01 * wr##X.lo); \
                          const float sk_ = rowsum16(ts_.x + ts_.y); float pp_ = tp_.x + tp_.y; pp_ += dppf<0xB1>(pp_); pp_ += dppf<0x4E>(pp_); \
                          const f32x2_t nsk_ = {-sk_, -sk_}, vv2_ = {vv##X, vv##X}; \
                          S01 = __builtin_elementwise_fma(vv2_, kd##X.lo, __builtin_elementwise_fma(nsk_, b##X.lo, S01 * w##X.lo)); \
                          S23 = __builtin_elementwise_fma(vv2_, kd##X.hi, __builtin_elementwise_fma(nsk_, b##X.hi, S23 * w##X.hi)); \
                          ppw[(s_) * 64] = pp_; skw[(s_) * 16] = sk_; } while (0)
            const int np = nst >> 1;
            LOADR(A, 0);
            for (int i = 0; i < np; ++i) {
              const int s = 2 * i;
              LOADR(B, s + 1);
              STEPR(A, s);
              LOADR(A, i < np - 1 ? s + 2 : s + 1);
              STEPR(B, s + 1);
            }
#undef LOADR
#undef STEPR
          }
        } else {
          const int fb = b - 1;
          if (fb >= 0 && fb < nblk) {
            const int nstp = (L - fb * 32) < 32 ? (L - fb * 32) : 32; const int tap = dir == 0 ? fb * 32 : L - 32 - fb * 32; const int f3i = fb % 3;
#pragma unroll
            for (int i = 0; i < 2; ++i) { const int e = ptid + i * 256, sl = e >> 4, rw = e & 15;
              if (sl < nstp) {
                const int tl = dir ? 31 - sl : sl; const int t = tap + tl;
                const f32x4 q = *(const LAS f32x4*)(ppb + nxt * 2048 + (sl * 16 + rw) * 4); const float sk = skb[nxt * 512 + sl * 16 + rw];
                const float o = ((q[0] + q[1]) + (q[2] + q[3])) - sk * scb[f3i * 128 + tl * 4] + vbb[f3i * 512 + tl * 16 + rw] * scb[f3i * 128 + tl * 4 + 1];
                od[(size_t)(sb + t) * 512 + head * 64 + rbase + rw] = f2bf(o);
              } }
          }
          const int bn = b + 1;
          if (bn < nblk) {
            const int ta = dir == 0 ? bn * 32 : L - 32 - bn * 32; const int n3i = bn % 3;
            LAS float* prew = pre + pw * 1024;
            const int tloc = lane >> 3, tl = pw * 8 + tloc, t = ta + tl;
            LAS float* s = stb + nxt * 10240 + tl * 320 + dk0;
#pragma unroll
            for (int mat = 0; mat < 2; ++mat) { const LAS bf16_t* Y = mat ? a2s : w2s;
#pragma unroll
              for (int nt = 0; nt < 4; ++nt) { f32x4 a = (f32x4){0.f, 0.f, 0.f, 0.f};
#pragma unroll
                for (int ks = 0; ks < 2; ++ks) { const bf16x8 yf = *(const LAS bf16x8*)(Y + (nt * 16 + fr) * 72 + ks * 32 + fq * 8); a = mfma16(__builtin_bit_cast(bf16x8, px[mat][ks]), yf, a); }
                if (fq < 2) {
#pragma unroll
                  for (int r = 0; r < 4; ++r) prew[mat * 512 + (fq * 4 + r) * 64 + nt * 16 + fr] = a[r]; } } }
            float xk[8];
            { float a[8], c[8], d[8]; unpack8(pd[1][0], a); unpack8(pd[1][1], c); unpack8(pd[1][2], d);
#pragma unroll
              for (int j = 0; j < 8; ++j) xk[j] = c[j] + cst[6 * 64 + dk0 + j] * (0.5f * (a[j] + d[j]) - c[j]); }
            float ss = 0.f;
#pragma unroll
            for (int j = 0; j < 8; ++j) { const float q = xk[j] * cst[2 * 64 + dk0 + j]; ss += q * q; }
            ss = rowsum8(ss); const float inv = rsqrtf(fmaxf(ss, 1e-24f));
            float br = 0.f, kdr = 0.f, bon = 0.f;
#pragma unroll
            for (int hh = 0; hh < 2; ++hh) {
              asm volatile("" ::: "memory");
              f32x4 xr4;
              { const u32x4 ua = pd[0][0], uc = pd[0][1], ud = pd[0][2];
                const unsigned a0 = hh ? ua.z : ua.x, a1 = hh ? ua.w : ua.y, c0 = hh ? uc.z : uc.x, c1 = hh ? uc.w : uc.y, d0 = hh ? ud.z : ud.x, d1 = hh ? ud.w : ud.y;
                const float av[4] = {bflo(a0), bfhi(a0), bflo(a1), bfhi(a1)}, cv[4] = {bflo(c0), bfhi(c0), bflo(c1), bfhi(c1)}, dv[4] = {bflo(d0), bfhi(d0), bflo(d1), bfhi(d1)};
#pragma unroll
                for (int j = 0; j < 4; ++j) xr4[j] = cv[j] + cst[5 * 64 + dk0 + hh * 4 + j] * (0.5f * (av[j] + dv[j]) - cv[j]); }
              f32x4 w4, kk4, kd4, bb4, wr4;
#pragma unroll
              for (int j = 0; j < 4; ++j) { const int kx = dk0 + hh * 4 + j; const float xkj = xk[hh * 4 + j];
                const float wl = cst[0 * 64 + kx] + prew[tloc * 64 + kx]; const float ew = 0.60653066f * rcpf_(1.0f + __expf(-wl)); w4[j] = __expf(-ew);
                const float aj = rcpf_(1.0f + __expf(-(cst[1 * 64 + kx] + prew[512 + tloc * 64 + kx])));
                kk4[j] = xkj * cst[2 * 64 + kx] * inv; kd4[j] = xkj * (1.0f + (aj - 1.0f) * cst[3 * 64 + kx]); bb4[j] = kk4[j] * aj; wr4[j] = w4[j] * xr4[j];
                br += bb4[j] * xr4[j]; kdr += kd4[j] * xr4[j]; bon += xr4[j] * kd4[j] * cst[4 * 64 + kx]; }
              *(LAS f32x4*)(s + hh * 4) = kk4; *(LAS f32x4*)(s + 64 + hh * 4) = wr4; *(LAS f32x4*)(s + 128 + hh * 4) = w4; *(LAS f32x4*)(s + 192 + hh * 4) = bb4; *(LAS f32x4*)(s + 256 + hh * 4) = kd4;
            }
            br = rowsum8(br); kdr = rowsum8(kdr); bon = rowsum8(bon);
            float xv[8];
            { float a[8], c[8], d[8]; unpack8(pd[2][0], a); unpack8(pd[2][1], c); unpack8(pd[2][2], d);
#pragma unroll
              for (int j = 0; j < 8; ++j) xv[j] = c[j] + cst[7 * 64 + dk0 + j] * (0.5f * (a[j] + d[j]) - c[j]); }
            if (dk0 >= rbase && dk0 < rbase + 16) {
              LAS float* vd = vbb + n3i * 512 + tl * 16 + (dk0 - rbase);
              *(LAS f32x4*)(vd) = (f32x4){xv[0], xv[1], xv[2], xv[3]}; *(LAS f32x4*)(vd + 4) = (f32x4){xv[4], xv[5], xv[6], xv[7]};
            }
            if ((lane & 7) == 0) { LAS float* scn = scb + n3i * 128; scn[tl * 4] = br; scn[tl * 4 + 1] = kdr; if (rsplit == 0 && t >= 0 && t < L) bonus[(size_t)(sb + t) * 16 + dir * 8 + head] = bon; }
            if (b + 2 < nblk) { issue_x(b + 2); issue_d(b + 2); }
          }
        }
        __syncthreads();
      }
    }
  }
}
__device__ __forceinline__ void conv_phase(const Params& p) {
  unsigned char* ws = p.ws + opq0_();
  bf16_t* mix = (bf16_t*)(ws + R1_MIX); const bf16_t* ub = (const bf16_t*)(ws + R1_U); const float* cw = inp(ws, 32);
  const int gt = bidx_() * 512 + tidx_(), ngt = gridDim.x * 512;
  for (int it = gt; it < MROWS * 64; it += ngt) {
    const int row = it >> 6, c0 = (it & 63) * 8; int seq, pos, L; row_info(row, seq, pos, L);
    u32x4 o = (u32x4){0u, 0u, 0u, 0u};
    bf16_t* dst = mix + (size_t)row * 1024 + 512 + c0;
    if (pos >= 0) {
      const bf16_t* up = ub + (size_t)row * 512 + c0;
      const u32x4 pb = *(const u32x4*)dst, c = *(const u32x4*)up; u32x4 a = (u32x4){0u, 0u, 0u, 0u}, d = (u32x4){0u, 0u, 0u, 0u};
      if (pos > 0) a = *(const u32x4*)(up - 512);
      if (pos < L - 1) d = *(const u32x4*)(up + 512);
      const unsigned pw[4] = {pb.x, pb.y, pb.z, pb.w}, cw4[4] = {c.x, c.y, c.z, c.w}, aw[4] = {a.x, a.y, a.z, a.w}, dw[4] = {d.x, d.y, d.z, d.w}; unsigned ow[4];
#pragma unroll
      for (int t = 0; t < 4; ++t) { const int cc = c0 + t * 2;
        const float y0 = cw[cc] * bflo(aw[t]) + cw[512 + cc] * bflo(cw4[t]) + cw[1024 + cc] * bflo(dw[t]);
        const float y1 = cw[cc + 1] * bfhi(aw[t]) + cw[512 + cc + 1] * bfhi(cw4[t]) + cw[1024 + cc + 1] * bfhi(dw[t]);
        ow[t] = pack2(bflo(pw[t]) * y0, bfhi(pw[t]) * y1); }
      o = (u32x4){ow[0], ow[1], ow[2], ow[3]};
    }
    *(u32x4*)dst = o;
  }
}

__constant__ float C16[16] = {1.f, 0.92387953f, 0.70710678f, 0.38268343f, 0.f, -0.38268343f, -0.70710678f, -0.92387953f, -1.f, -0.92387953f, -0.70710678f, -0.38268343f, 0.f, 0.38268343f, 0.70710678f, 0.92387953f};
__constant__ float S16[16] = {0.f, 0.38268343f, 0.70710678f, 0.92387953f, 1.f, 0.92387953f, 0.70710678f, 0.38268343f, 0.f, -0.38268343f, -0.70710678f, -0.92387953f, -1.f, -0.92387953f, -0.70710678f, -0.38268343f};
__device__ __forceinline__ void f2_phase(const Params& p) {
  unsigned char* ws = p.ws + opq0_(); unsigned char* r2 = (unsigned char*)p.out + opq0_();
  const int gt = bidx_() * 512 + tidx_(), ngt = gridDim.x * 512;
  constexpr int NPI = 2 * 512 * 513, NSI = 4 * 512 * 257;
  for (int it = gt; it < NPI + NSI; it += ngt) {
    int grp, n2, c, sl, N2, L, NN;
    if (it < NPI) { grp = 0; N2 = 513; L = LP; NN = 1024; n2 = it % 513; const int q = it / 513; c = q & 511; sl = q >> 9; }
    else { const int v = it - NPI; grp = 1; N2 = 257; L = LS; NN = 2048; n2 = v % 257; const int q = v / 257; c = q & 511; sl = q >> 9; }
    const bf16_t* wt = (const bf16_t*)(r2 + (grp ? R2_WTS : R2_WT)) + (size_t)sl * 1024 * L;
    const bf16_t* pr = wt + (size_t)c * L + n2; const bf16_t* pi = wt + (size_t)(512 + c) * L + n2;
    float re[16], im[16];
#pragma unroll
    for (int n1 = 0; n1 < 16; ++n1) { re[n1] = bf2f(pr[n1 * N2]); im[n1] = bf2f(pi[n1 * N2]); }
    const float* tw = (const float*)(ws + (grp ? T_TWS : T_TWP));
    const int ni = sl * 512 + c; const int Kd = 2 * (N2 - 1);
    bf16_t* btf = grp ? (bf16_t*)(ws + R1_BTFS) : (bf16_t*)(r2 + R2_BTFP);
    float* tv = (float*)(ws + T_TAILV) + (grp ? 32768 : 0);
    float Ar[4][4], Ai[4][4];
#pragma unroll
    for (int b = 0; b < 4; ++b) {
      const float x0r = re[b], x0i = im[b], x1r = re[4 + b], x1i = im[4 + b], x2r = re[8 + b], x2i = im[8 + b], x3r = re[12 + b], x3i = im[12 + b];
      const float s02r = x0r + x2r, s02i = x0i + x2i, d02r = x0r - x2r, d02i = x0i - x2i, s13r = x1r + x3r, s13i = x1i + x3i, d13r = x1r - x3r, d13i = x1i - x3i;
      Ar[0][b] = s02r + s13r; Ai[0][b] = s02i + s13i;
      Ar[2][b] = s02r - s13r; Ai[2][b] = s02i - s13i;
      Ar[1][b] = d02r + d13i; Ai[1][b] = d02i - d13r;
      Ar[3][b] = d02r - d13i; Ai[3][b] = d02i + d13r;
    }
#pragma unroll
    for (int c = 1; c < 4; ++c)
#pragma unroll
      for (int b = 1; b < 4; ++b) { const float cc = C16[(c * b) & 15], ss = S16[(c * b) & 15]; const float xr = Ar[c][b], xi = Ai[c][b]; Ar[c][b] = xr * cc + xi * ss; Ai[c][b] = xi * cc - xr * ss; }
#pragma unroll
    for (int c = 0; c < 4; ++c) {
      const float x0r = Ar[c][0], x0i = Ai[c][0], x1r = Ar[c][1], x1i = Ai[c][1], x2r = Ar[c][2], x2i = Ai[c][2], x3r = Ar[c][3], x3i = Ai[c][3];
      const float s02r = x0r + x2r, s02i = x0i + x2i, d02r = x0r - x2r, d02i = x0i - x2i, s13r = x1r + x3r, s13i = x1i + x3i, d13r = x1r - x3r, d13i = x1i - x3i;
      float Or[4], Oi[4];
      Or[0] = s02r + s13r; Oi[0] = s02i + s13i; Or[2] = s02r - s13r; Oi[2] = s02i - s13i;
      Or[1] = d02r + d13i; Oi[1] = d02i - d13r; Or[3] = d02r - d13i; Oi[3] = d02i + d13r;
#pragma unroll
      for (int d = 0; d < 4; ++d) {
        const int k1 = c + 4 * d; const float orr = Or[d], oii = Oi[d];
        const float tc = tw[(k1 * N2 + n2) * 2], ts = tw[(k1 * N2 + n2) * 2 + 1];
        const float ar = tc * orr + ts * oii, ai = tc * oii - ts * orr;
        if (n2 < N2 - 1) { bf16_t* dd = btf + ((size_t)k1 * NN + ni) * Kd + n2; dd[0] = f2bf(ar); dd[N2 - 1] = f2bf(ai); }
        else { float* dd = tv + ((size_t)k1 * NN + ni) * 2; dd[0] = ar; dd[1] = ai; }
      }
    }
  }
}

__device__ __forceinline__ void f3_tail_phase(const Params& p) {
  unsigned char* ws = p.ws + opq0_(); unsigned char* r2 = (unsigned char*)p.out + opq0_();
  bf16_t* mix = (bf16_t*)(ws + R1_MIX); const float* tc = (const float*)(ws + T_TAILC);
  const int lane = tidx_() & 63, gw = bidx_() * 8 + (tidx_() >> 6), nw = gridDim.x * 8;
  for (int it = gw; it < 16 * 1024 + 16 * 2048; it += nw) {
    int grp, k1, ni, N2, NN; if (it < 16384) { grp = 0; k1 = it >> 10; ni = it & 1023; N2 = 513; NN = 1024; } else { const int v = it - 16384; grp = 1; k1 = v >> 11; ni = v & 2047; N2 = 257; NN = 2048; }
    const int H = N2 - 1, Kd = 2 * H;
    const bf16_t* b = (grp ? (const bf16_t*)(ws + R1_BTFS) : (const bf16_t*)(r2 + R2_BTFP)) + ((size_t)k1 * NN + ni) * Kd;
    const float* arc = tc + (grp ? TC_ARCS : TC_ARCP); const float* ars = tc + (grp ? TC_ARSS : TC_ARSP);
    float acc = 0.f;
    if (lane * 8 < H) {
      const u32x4 vr = *(const u32x4*)(b + lane * 8), vi = *(const u32x4*)(b + H + lane * 8);
      const unsigned rw[4] = {vr.x, vr.y, vr.z, vr.w}, iw[4] = {vi.x, vi.y, vi.z, vi.w};
#pragma unroll
      for (int t = 0; t < 4; ++t) { const int n2 = lane * 8 + t * 2;
        acc += arc[n2] * bflo(rw[t]) + arc[n2 + 1] * bfhi(rw[t]) + ars[n2] * bflo(iw[t]) + ars[n2 + 1] * bfhi(iw[t]); }
    }
#pragma unroll
    for (int o = 32; o >= 1; o >>= 1) acc += shx(acc, o, lane);
    if (lane == 0) {
      const float* tv = (const float*)(ws + T_TAILV) + (grp ? 32768 : 0) + ((size_t)k1 * NN + ni) * 2;
      acc += arc[H] * tv[0] + ars[H] * tv[1];
      const float scale = grp ? rsqrtf(128.0f * LS) : rsqrtf(128.0f * LP);
      const int sl = ni >> 9, c = ni & 511, pos = k1 + 16 * H;
      const int row = (grp ? 2 * LPP + sl * LPS : sl * LPP) + PADR + pos;
      mix[(size_t)row * 1024 + c] = f2bf(acc * scale);
    }
  }
}

__device__ __forceinline__ void final_phase(const Params& p) {
  unsigned char* ws = p.ws + opq0_(); const bf16_t* h = (const bf16_t*)(ws + OFF_H); const float* rowsq = (const float*)(ws + T_ROWSQ); const float* g = inp(ws, 37);
  const int lane = tidx_() & 63, gw = bidx_() * 8 + (tidx_() >> 6), nw = gridDim.x * 8;
  for (int row = gw; row < MROWS; row += nw) {
    int seq, pos, L; row_info(row, seq, pos, L); if (pos < 16) continue;
    const float rs = row_rstd(rowsq, row);
    float* dst = p.out + (seq < 2 ? ((size_t)seq * 8192 + (pos - 16)) : ((size_t)16384 + (size_t)(seq - 2) * 4096 + (pos - 16))) * 1024;
#pragma unroll
    for (int i = 0; i < 4; ++i) { const int c = i * 256 + lane * 4; const u32x2 v = *(const u32x2*)(h + tix(row, c, 16)); const f32x4 gg = *(const f32x4*)(g + c);
      f32x4 o; o[0] = bflo(v.x) * rs * gg[0]; o[1] = bfhi(v.x) * rs * gg[1]; o[2] = bflo(v.y) * rs * gg[2]; o[3] = bfhi(v.y) * rs * gg[3]; *(f32x4*)(dst + c) = o; }
  }
}

__global__ void __launch_bounds__(512) __attribute__((amdgpu_flat_work_group_size(512, 512))) mega(Params p) {
  extern __shared__ __attribute__((aligned(16))) unsigned char smem[];
  LAS unsigned char* lds = (LAS unsigned char*)smem;
  cg::grid_group grid = cg::this_grid();
  LAS unsigned* xst = (LAS unsigned*)(lds + LDS_CTL + 32);
  if (threadIdx.x == 0) { xst[0] = 0u; xst[1] = 0u; (void)xb_add(&((unsigned*)(p.ws + T_BAR))[XB_XCNT(xcc_id_())], 1u); }
  __syncthreads();
#define SYNC_ do { XcdBarrier xb_; xb_.bar = (unsigned*)(p.ws + T_BAR); xb_.x = xcc_id_(); xb_.st = xst; xcd_barrier(xb_); } while (0)
  if (threadIdx.x == 0) { const unsigned x = xcc_id_(); LAS int* ctl = (LAS int*)(lds + LDS_CTL);
    const unsigned slot = __hip_atomic_fetch_add((unsigned*)(p.ws + T_CNT) + x, 1u, __ATOMIC_RELAXED, __HIP_MEMORY_SCOPE_AGENT); ctl[0] = (int)x; ctl[1] = (int)slot; }
  prep_misc(p); prep_weights(p, 0, lds); grid.sync();
  if (threadIdx.x == 0) { LAS int* ctl = (LAS int*)(lds + LDS_CTL); int ok = 1, mine = 0;
    for (int i = 0; i < 8; ++i) { const int c = (int)__hip_atomic_load((unsigned*)(p.ws + T_CNT) + i, __ATOMIC_RELAXED, __HIP_MEMORY_SCOPE_AGENT); if (c == 0) ok = 0; if (i == ctl[0]) mine = c; }
    ctl[2] = mine; ctl[3] = ok; }
  __syncthreads();
  gemm_phase(K_UP, 0, p, lds, 1); SYNC_;
  gemm_phase(K_DN, 0, p, lds, 2); prep_weights(p, 2, lds); SYNC_;
  gemm_phase(K_WINA, 0, p, lds, 3); prep_weights(p, 3, lds); SYNC_;
  ret_kv_phase(p, lds); SYNC_;
  ret_scan_phase(p); SYNC_;
  ret_out_phase(p, lds); SYNC_;
  xwa_phase(p); SYNC_;
  rwkv_scan2_phase(p, lds); SYNC_;
  rwkv_post_phase(p, lds); SYNC_;
  gemm_phase(K_WOUT, 0, p, lds, 4); prep_weights(p, 1, lds); SYNC_;
  gemm_phase(K_UP, 1, p, lds, 5); gemm_phase(K_FOLD, 0, p, lds); SYNC_;
  gemm_phase(K_DN, 1, p, lds, 6); SYNC_;
  gemm_phase(K_UP, 2, p, lds, 7); SYNC_;
  gemm_phase(K_DN, 2, p, lds, 8); SYNC_;
  gemm_phase(K_WIN1, 0, p, lds, 9); SYNC_;
  conv_phase(p); SYNC_;
  f2_phase(p); SYNC_;
  gemm_phase(K_F3, 0, p, lds); f3_tail_phase(p); SYNC_;
  gemm_phase(K_WOUT, 1, p, lds, 10); SYNC_;
  gemm_phase(K_UP, 3, p, lds, 11); SYNC_;
  gemm_phase(K_DN, 3, p, lds, 12); SYNC_;
  final_phase(p);
}

extern "C" void kernel_launch(void* const* d_in, const int* in_sizes, int n_in, void* d_out, int out_size, void* d_ws, size_t ws_size, hipStream_t stream) {
  constexpr size_t kDynLds = 148224;
  static int grid_blocks = 0;
  if (!grid_blocks) {
    int dev = 0, cus = 0, per_cu = 0;
    (void)hipGetDevice(&dev);
    (void)hipDeviceGetAttribute(&cus, hipDeviceAttributeMultiprocessorCount, dev);
    (void)hipFuncSetAttribute((const void*)mega, hipFuncAttributeMaxDynamicSharedMemorySize, (int)kDynLds);
    (void)hipOccupancyMaxActiveBlocksPerMultiprocessor(&per_cu, mega, 512, kDynLds);
    if (per_cu < 1) per_cu = 1;
    grid_blocks = cus * 1;
  }
  Params p{};
  for (int i = 0; i < 38; ++i) p.in[i] = (const float*)d_in[i];
  p.out = (float*)d_out; p.ws = (unsigned char*)d_ws;
  (void)hipMemsetAsync((char*)d_ws + T_CNT, 0, 128 + 14336, stream);
  void* args[] = {&p};
  hipError_t e = hipLaunchCooperativeKernel((void*)mega, dim3(grid_blocks), dim3(512), args, kDynLds, stream);
  if (e != hipSuccess) fprintf(stderr, "cooperative launch failed: %s (grid %d)\n", hipGetErrorString(e), grid_blocks);
}
```

```cpp
#include <hip/hip_runtime.h>
#include <hip/hip_cooperative_groups.h>
#include <cstdio>
namespace cg = cooperative_groups;
#define LAS __attribute__((address_space(3)))
typedef unsigned short bf16_t;
typedef short bf16x8 __attribute__((ext_vector_type(8)));
typedef float f32x4 __attribute__((ext_vector_type(4)));
typedef unsigned u32x4 __attribute__((ext_vector_type(4)));
typedef unsigned u32x2 __attribute__((ext_vector_type(2)));

constexpr int DM = 1024, FF = 2816;
constexpr int LP = 8208, LS = 4112, LPP = 8320, LPS = 4224, PADR = 112;
constexpr int MROWS = 2 * LPP + 4 * LPS;
constexpr int MT = MROWS / 256;
constexpr int MT_A = 66;
static_assert(MROWS % 256 == 0, "rows");
constexpr size_t SZ_H = (size_t)MROWS * DM * 2;
constexpr size_t SZ_UP = (size_t)2 * FF * DM * 2, SZ_DN = (size_t)DM * FF * 2, SZ_SQ = (size_t)DM * DM * 2;
constexpr size_t OFF_H = 0;
constexpr size_t OFF_W0 = OFF_H + SZ_H;
constexpr size_t W0_F1UP = OFF_W0, W0_F1DN = W0_F1UP + SZ_UP, W0_INA = W0_F1DN + SZ_DN, W0_INB = W0_INA + (size_t)1536 * DM * 2,
                 W0_OUT = W0_INB + (size_t)1792 * DM * 2, W0_F2UP = W0_OUT + SZ_SQ, W0_F2DN = W0_F2UP + SZ_UP;
constexpr size_t OFF_TAB = W0_F2DN + SZ_DN;
constexpr size_t T_ROWSQ = OFF_TAB;
constexpr size_t T_ROPE = T_ROWSQ + (size_t)MROWS * 16 * 4;
constexpr size_t T_ADFTP = T_ROPE + (size_t)LP * 64 * 4;
constexpr size_t T_ADFTS = T_ADFTP + (size_t)512 * 1024 * 2;
constexpr size_t T_FT = T_ADFTS + (size_t)256 * 512 * 2;
constexpr size_t T_WTMP = T_FT + (size_t)1024 * 512 * 2;
constexpr size_t T_TWP = T_WTMP + (size_t)1024 * 512 * 2;
constexpr size_t T_TWS = T_TWP + 65792;
constexpr size_t T_TAILC = T_TWS + 33024;
constexpr size_t T_TAILV = T_TAILC + 16384;
constexpr size_t T_BONUS = T_TAILV + 131072 + 262144;
constexpr size_t T_G2T = T_BONUS + (size_t)MROWS * 16 * 4;
constexpr size_t T_PTR = T_G2T + 131072;
constexpr size_t T_CNT = T_PTR + 384;
constexpr size_t T_BAR = T_PTR + 512;
constexpr size_t OFF_R1 = T_BAR + 14336;
constexpr int LDS_RSTD = 146944 + 64;
constexpr int LDS_CTL = 146944;
constexpr size_t WS_MIN = 268435456;
constexpr size_t R1_MIX = OFF_R1;
constexpr size_t SZ_MIX = (size_t)MROWS * 1024 * 2;
constexpr size_t R1_OF = R1_MIX + SZ_MIX, R1_OB = R1_OF + (size_t)MROWS * 512 * 2;
constexpr size_t R1_U = R1_MIX + SZ_MIX;
constexpr size_t R1_BTFS = R1_U;
constexpr size_t R1_ACTA = OFF_R1;
constexpr size_t SZ_W1 = SZ_UP + SZ_DN + (size_t)2560 * DM * 2 + SZ_SQ + SZ_UP + SZ_DN;
constexpr size_t OFF_W1 = WS_MIN - SZ_W1;
constexpr size_t W1_F1UP = OFF_W1, W1_F1DN = W1_F1UP + SZ_UP, W1_IN = W1_F1DN + SZ_DN, W1_OUT = W1_IN + (size_t)2560 * DM * 2,
                 W1_F2UP = W1_OUT + SZ_SQ, W1_F2DN = W1_F2UP + SZ_UP;
static_assert(R1_OB + (size_t)MROWS * 512 * 2 <= WS_MIN, "L0 mixer region");
static_assert(R1_ACTA + (size_t)MT_A * 256 * FF * 2 <= OFF_W1, "actA vs W1");
static_assert(R1_U + (size_t)MROWS * 512 * 2 <= OFF_W1, "u vs W1");
static_assert(R1_BTFS + (size_t)16 * 2048 * 512 * 2 <= OFF_W1, "btfs vs W1");
constexpr size_t SZ_OUT = (size_t)32768 * 1024 * 4;
static_assert(((size_t)96 << 20) + (size_t)66 * 262144 <= SZ_OUT && ((size_t)96 << 20) >= (size_t)(MT - MT_A) * 256 * FF * 2, "split-K scratch");
constexpr size_t R2_SPLITK = (size_t)96 << 20;
constexpr size_t R1_QK = R1_OF;
constexpr size_t R1_KVF = R1_OB;
constexpr size_t R1_KVB = R1_KVF + (size_t)1048 * 8192 * 2;
static_assert(R1_KVB + (size_t)1048 * 8192 * 2 <= R1_OB + (size_t)MROWS * 512 * 2, "kv in o_b region");
constexpr size_t R2_PRW = 0;
constexpr size_t R2_ACTB = 0;
constexpr size_t R2_WT = 0;
constexpr size_t R2_WTS = (size_t)2 * 1024 * LP * 2;
constexpr size_t R2_BTFP = R2_WTS + (size_t)4 * 1024 * LS * 2;
static_assert(R2_PRW + (size_t)MROWS * 1792 * 2 <= SZ_OUT, "r2 b");
static_assert(R2_BTFP + (size_t)16 * 1024 * 1024 * 2 <= SZ_OUT, "r2 c");
static_assert((size_t)(MT - MT_A) * 256 * FF * 2 <= SZ_OUT, "r2 d");
constexpr int TC_CTP = 0, TC_STP = 512, TC_ARCP = 1024, TC_ARSP = 1024 + 520, TC_CTS = 2080, TC_STS = 2080 + 256, TC_ARCS = 2600, TC_ARSS = 2600 + 264;

struct Params { const float* in[38]; float* out; unsigned char* ws; };

__device__ __forceinline__ bf16_t f2bf(float f) { unsigned u = __float_as_uint(f); u += 0x7FFFu + ((u >> 16) & 1u); return (bf16_t)(u >> 16); }
__device__ __forceinline__ float bf2f(bf16_t b) { return __uint_as_float(((unsigned)b) << 16); }
typedef float f32x2_t __attribute__((ext_vector_type(2)));
typedef __bf16 bf16x2_t __attribute__((ext_vector_type(2)));
__device__ __forceinline__ unsigned pack2(float a, float b) { f32x2_t v = {a, b}; bf16x2_t r = __builtin_convertvector(v, bf16x2_t); return __builtin_bit_cast(unsigned, r); }
__device__ __forceinline__ float bflo(unsigned u) { return __uint_as_float(u << 16); }
__device__ __forceinline__ float bfhi(unsigned u) { return __uint_as_float(u & 0xffff0000u); }
__device__ __forceinline__ int seq_base(int s) { return s < 2 ? s * LPP : 2 * LPP + (s - 2) * LPS; }
__device__ __forceinline__ void row_info(int row, int& seq, int& pos, int& L) {
  if (row < 2 * LPP) { seq = row >= LPP ? 1 : 0; pos = row - seq * LPP - PADR; L = LP; }
  else { const int r = row - 2 * LPP; const int s = r / LPS; seq = 2 + s; pos = r - s * LPS - PADR; L = LS; }
}
template <int CTRL> __device__ __forceinline__ float dppf(float v) { return __int_as_float(__builtin_amdgcn_update_dpp(0, __float_as_int(v), CTRL, 0xF, 0xF, true)); }
__device__ __forceinline__ float rowsum16(float v) { v += dppf<0xB1>(v); v += dppf<0x4E>(v); v += dppf<0x141>(v); v += dppf<0x140>(v); return v; }
__device__ __forceinline__ float rcpf_(float x) { return __builtin_amdgcn_rcpf(x); }
__device__ __forceinline__ float sigmoidf_(float x) { return rcpf_(1.0f + __expf(-x)); }
__device__ __forceinline__ f32x4 mfma16(bf16x8 a, bf16x8 b, f32x4 c) { return __builtin_amdgcn_mfma_f32_16x16x32_bf16(a, b, c, 0, 0, 0); }
__device__ __forceinline__ const float* inp(const unsigned char* ws, int i) {
  const unsigned long long v = ((const unsigned long long*)(ws + T_PTR))[i];
  const unsigned lo = __builtin_amdgcn_readfirstlane((unsigned)v), hi = __builtin_amdgcn_readfirstlane((unsigned)(v >> 32));
  return (const float*)(((unsigned long long)hi << 32) | (unsigned long long)lo);
}
__device__ __forceinline__ int tidx_() { int t = threadIdx.x; asm volatile("" : "+v"(t)); return t; }
__device__ __forceinline__ int bidx_() { int b = blockIdx.x; asm volatile("" : "+s"(b)); return b; }
__device__ __forceinline__ int gdim_() { int g = __builtin_amdgcn_readfirstlane((int)gridDim.x); asm volatile("" : "+s"(g)); return g; }
__device__ __forceinline__ float shx(float v, int o, int lane) { return __int_as_float(__builtin_amdgcn_ds_bpermute(((lane ^ o) & 63) << 2, __float_as_int(v))); }
__device__ __forceinline__ unsigned xcc_id_() { return (unsigned)__builtin_amdgcn_s_getreg((3 << 11) | 20) & 0xFu; }
__device__ __forceinline__ size_t tix(int row, int col, int KB) { return ((size_t)((row >> 7) * KB + (col >> 6)) << 13) + (size_t)((row & 127) * 64 + (col & 63)); }

#define XB_TMO      128
#define XB_XCNT(j)  (256  + 64 * (j))
#define XB_XSUB(j)  (1280 + 64 * (j))
#define XB_XGEN(j)  (2304 + 64 * (j))
#define XB_TOP      3328
#define XB_TOPGEN   3392
#define XCD_BAR_WORDS 3456
#define XB_SPIN_CAP (1u << 22)
__device__ __forceinline__ unsigned xb_ld(unsigned* p)              { return __hip_atomic_load(p, __ATOMIC_RELAXED, __HIP_MEMORY_SCOPE_AGENT); }
__device__ __forceinline__ unsigned xb_add(unsigned* p, unsigned v) { return __hip_atomic_fetch_add(p, v, __ATOMIC_RELAXED, __HIP_MEMORY_SCOPE_AGENT); }
#define XB_SPIN(cond, bar) do { unsigned _sp = 0; while (cond) { __builtin_amdgcn_s_sleep(1); \
    if ((++_sp & 255u) == 0u) { if (xb_ld(&(bar)[XB_TMO])) break; if (_sp > XB_SPIN_CAP) { atomicAdd(&(bar)[XB_TMO], 1u); break; } } } } while (0)
struct XcdBarrier { unsigned* bar; unsigned x; volatile LAS unsigned* st; };
__device__ __forceinline__ void xcd_barrier_complete(unsigned* bar, unsigned x, unsigned& nloc, unsigned& nx) {
    const unsigned G = gridDim.x * gridDim.y * gridDim.z;
    unsigned sum, cnt, mine, sp = 0u;
    for (;;) {
        sum = 0u; cnt = 0u; mine = 0u;
#pragma unroll
        for (unsigned j = 0; j < 16; ++j) { const unsigned c = xb_ld(&bar[XB_XCNT(j)]); sum += c; cnt += (c > 0u) ? 1u : 0u; mine = (j == x) ? c : mine; }
        if (sum == G) break;
        __builtin_amdgcn_s_sleep(1);
        if ((++sp & 255u) == 0u) { if (xb_ld(&bar[XB_TMO])) break; if (sp > XB_SPIN_CAP) { atomicAdd(&bar[XB_TMO], 1u); break; } }
    }
    nloc = mine > 0u ? mine : 1u; nx = cnt > 0u ? cnt : 1u;
}
__device__ __forceinline__ void xcd_barrier(const XcdBarrier& b) {
    asm volatile("s_waitcnt vmcnt(0)" ::: "memory");
    __syncthreads();
    if (threadIdx.x == 0) {
        unsigned* bar = b.bar;
        __builtin_amdgcn_s_waitcnt(0);
        unsigned nloc = b.st[0], nx = b.st[1];
        if (nloc == 0u) { xcd_barrier_complete(bar, b.x, nloc, nx); b.st[0] = nloc; b.st[1] = nx; }
        const unsigned old = xb_add(&bar[XB_XSUB(b.x)], 1u);
        const unsigned gen = old / nloc;
        if (old + 1u == (gen + 1u) * nloc) {
            __builtin_amdgcn_fence(__ATOMIC_RELEASE, "agent");
            asm volatile("s_waitcnt vmcnt(0)" ::: "memory");
            const unsigned og = xb_add(&bar[XB_TOP], 1u);
            const unsigned tg = og / nx;
            if (og + 1u == (tg + 1u) * nx) xb_add(&bar[XB_TOPGEN], 1u);
            else XB_SPIN(xb_ld(&bar[XB_TOPGEN]) == tg, bar);
            __builtin_amdgcn_fence(__ATOMIC_ACQUIRE, "agent");
            xb_add(&bar[XB_XGEN(b.x)], 1u);
            asm volatile("s_waitcnt vmcnt(0)" ::: "memory");
        } else {
            XB_SPIN(xb_ld(&bar[XB_XGEN(b.x)]) == gen, bar);
            __builtin_amdgcn_fence(__ATOMIC_ACQUIRE, "agent");
            asm volatile("s_waitcnt vmcnt(0)" ::: "memory");
        }
    }
    __syncthreads();
}
__device__ __forceinline__ size_t opq0_() { size_t z = 0; asm volatile("" : "+s"(z)); return z; }
constexpr int HTB = 128 * 64 * 2;
__device__ __forceinline__ int lds_byte(int r, int c) { const int st = (r >> 4) * 2 + (c >> 5), rr = r & 15, cc = c & 31, ob = rr * 64 + cc * 2; return st * 1024 + (ob ^ (((ob >> 9) & 1) << 5)); }
__device__ __forceinline__ void stage_rc(int b, int& R, int& C) { const int st = b / 1024, sb = b % 1024, swz = sb ^ (((sb >> 9) & 1) << 5); R = (st >> 1) * 16 + swz / 64; C = (st & 1) * 32 + (swz % 64) / 2; }

__device__ __forceinline__ void gemm_core(const bf16_t* A, int lda, size_t kstepA, size_t hA, const bf16_t* Bt, int ldb, size_t kstepB, size_t hB, int K, LAS unsigned char* lds, f32x4 (&acc)[2][2][4][2]) {
  const int tid = tidx_(), wid = tid >> 6, lane = tid & 63, wr = wid >> 2, wc = wid & 3, fr = lane & 15, fq = lane >> 4;
  unsigned voffA[2], voffB[2];
#pragma unroll
  for (int i = 0; i < 2; ++i) { int R, C; stage_rc(tid * 16 + i * 8192, R, C); voffA[i] = (unsigned)(R * lda + C) * 2u; voffB[i] = (unsigned)(R * ldb + C) * 2u; }
  const unsigned ldsw = (unsigned)wid * 1024u;
  const int aoff = lds_byte(wr * 64 + fr, fq * 8), boff = lds_byte(wc * 32 + fr, fq * 8);
  const char* gA = (const char*)A; const char* gB = (const char*)Bt;
#define SA_(b, h) (((b) * 2 + (h)) * HTB)
#define SB_(b, h) ((4 + (b) * 2 + (h)) * HTB)
#define STAGE_(bufoff, gbase, voff) do { _Pragma("unroll") for (int _i = 0; _i < 2; ++_i) \
    __builtin_amdgcn_global_load_lds((const unsigned*)((gbase) + (voff)[_i]), (LAS unsigned*)(lds + (bufoff) + ldsw + _i * 8192), 16, 0, 0); } while (0)
#define STA_(b, h, kt) STAGE_(SA_(b, h), gA + (size_t)(h) * hA + (size_t)(kt) * kstepA, voffA)
#define STB_(b, h, kt) STAGE_(SB_(b, h), gB + (size_t)(h) * hB + (size_t)(kt) * kstepB, voffB)
#define LDA_(dst, b, h) do { _Pragma("unroll") for (int m = 0; m < 4; ++m) _Pragma("unroll") for (int k = 0; k < 2; ++k) dst[m][k] = *(const LAS bf16x8*)(lds + SA_(b, h) + aoff + m * 2048 + k * 1024); } while (0)
#define LDB_(dst, b, h) do { _Pragma("unroll") for (int n = 0; n < 2; ++n) _Pragma("unroll") for (int k = 0; k < 2; ++k) dst[n][k] = *(const LAS bf16x8*)(lds + SB_(b, h) + boff + n * 2048 + k * 1024); } while (0)
#define MMA_(ai, bj, At, Bx) do { __builtin_amdgcn_s_setprio(1); _Pragma("unroll") for (int m = 0; m < 4; ++m) _Pragma("unroll") for (int n = 0; n < 2; ++n) _Pragma("unroll") for (int k = 0; k < 2; ++k) \
    acc[ai][bj][m][n] = __builtin_amdgcn_mfma_f32_16x16x32_bf16(Bx[n][k], At[m][k], acc[ai][bj][m][n], 0, 0, 0); __builtin_amdgcn_s_setprio(0); } while (0)
#define WAIT_V(n) asm volatile("s_waitcnt vmcnt(" #n ")" ::: "memory")
#define WAIT_L(n) asm volatile("s_waitcnt lgkmcnt(" #n ")" ::: "memory")
#define BAR_ __builtin_amdgcn_s_barrier()
#define SCHED_ __builtin_amdgcn_sched_barrier(0)
#pragma unroll
  for (int a = 0; a < 2; ++a)
#pragma unroll
    for (int b = 0; b < 2; ++b)
#pragma unroll
      for (int m = 0; m < 4; ++m)
#pragma unroll
        for (int n = 0; n < 2; ++n) acc[a][b][m][n] = (f32x4){0.f, 0.f, 0.f, 0.f};
  bf16x8 At[4][2], B0[2][2], B1[2][2];
  const int nt = K / 64;
  STB_(0, 0, 0); STA_(0, 0, 0); STB_(0, 1, 0); STA_(0, 1, 0);
  if (wr == 1) BAR_;
  WAIT_V(4); BAR_;
  STB_(1, 0, 1); STA_(1, 0, 1); STB_(1, 1, 1);
  WAIT_V(6); BAR_;
  for (int t = 0; t < nt - 2; t += 2) {
    LDB_(B0, 0, 0); SCHED_; LDA_(At, 0, 0); STA_(1, 1, t + 1);
    WAIT_L(8); BAR_; WAIT_L(0); MMA_(0, 0, At, B0); BAR_; SCHED_;
    LDB_(B1, 0, 1); STB_(0, 0, t + 2);
    BAR_; WAIT_L(0); MMA_(0, 1, At, B1); BAR_;
    LDA_(At, 0, 1); STA_(0, 0, t + 2);
    BAR_; WAIT_L(0); MMA_(1, 0, At, B0); BAR_; SCHED_;
    STB_(0, 1, t + 2);
    WAIT_V(6); BAR_; MMA_(1, 1, At, B1); BAR_;
    LDB_(B0, 1, 0); SCHED_; LDA_(At, 1, 0); STA_(0, 1, t + 2);
    WAIT_L(8); BAR_; WAIT_L(0); MMA_(0, 0, At, B0); BAR_; SCHED_;
    LDB_(B1, 1, 1); STB_(1, 0, t + 3);
    BAR_; WAIT_L(0); MMA_(0, 1, At, B1); BAR_;
    LDA_(At, 1, 1); STA_(1, 0, t + 3);
    BAR_; WAIT_L(0); MMA_(1, 0, At, B0); BAR_; SCHED_;
    STB_(1, 1, t + 3);
    WAIT_V(6); BAR_; MMA_(1, 1, At, B1); BAR_;
  }
  { LDB_(B0, 0, 0); LDA_(At, 0, 0); STA_(1, 1, nt - 1);
    BAR_; WAIT_L(0); MMA_(0, 0, At, B0); BAR_;
    LDB_(B1, 0, 1); BAR_; WAIT_L(0); MMA_(0, 1, At, B1); BAR_;
    LDA_(At, 0, 1); WAIT_V(4); BAR_; WAIT_L(0); MMA_(1, 0, At, B0); MMA_(1, 1, At, B1); BAR_; }
  { LDB_(B0, 1, 0); LDA_(At, 1, 0); WAIT_V(2); BAR_; WAIT_L(0); MMA_(0, 0, At, B0); BAR_;
    LDB_(B1, 1, 1); WAIT_V(0); BAR_; WAIT_L(0); MMA_(0, 1, At, B1); BAR_;
    LDA_(At, 1, 1); BAR_; WAIT_L(0); MMA_(1, 0, At, B0); MMA_(1, 1, At, B1); BAR_; }
  if (wr == 0) BAR_;
}

__device__ __forceinline__ bool unit_for(int it, int U, int nM, int nN, int& pm, int& pn, LAS unsigned char* lds) {
  const LAS int* ctl = (const LAS int*)(lds + LDS_CTL);
  const int x = __builtin_amdgcn_readfirstlane(ctl[0]), slot = __builtin_amdgcn_readfirstlane(ctl[1]), nx = __builtin_amdgcn_readfirstlane(ctl[2]), ok = __builtin_amdgcn_readfirstlane(ctl[3]);
  int l;
  if (ok) {
    const int q = U >> 3, r = U & 7;
    const int cnt = x < r ? q + 1 : q, start = x < r ? x * (q + 1) : r * (q + 1) + (x - r) * q;
    const int li = it * nx + slot; if (li >= cnt) return false; l = start + li;
  } else { const int G = gridDim.x, b = bidx_(); l = it * G + b; if (l >= U) return false; }
  const int nig = 8 * nN, gid = l / nig, within = l % nig, fm = gid * 8, gsz = (nM - fm) < 8 ? (nM - fm) : 8;
  pm = fm + within % gsz; pn = within / gsz; return true;
}

enum { K_UP = 0, K_DN = 1, K_WINA = 2, K_WINB = 3, K_WOUT = 4, K_WIN1 = 5, K_F3 = 6, K_FOLD = 7 };

__device__ __forceinline__ float row_rstd(const float* rowsq, int row) {
  const f32x4* q = (const f32x4*)(rowsq + (size_t)row * 16);
  const f32x4 a = q[0], b = q[1], c = q[2], d = q[3];
  const float s = ((a[0] + a[1]) + (a[2] + a[3])) + ((b[0] + b[1]) + (b[2] + b[3])) + ((c[0] + c[1]) + (c[2] + c[3])) + ((d[0] + d[1]) + (d[2] + d[3]));
  return rsqrtf(s * (1.0f / 1024.0f) + 1e-6f);
}

struct F3Info { int grp, k1, mt, nt; };
__device__ __forceinline__ void gemm_epilogue(const int kind, const int pm, const int pn, const F3Info f3, f32x4 (&acc)[2][2][4][2], unsigned char* ws, unsigned char* r2, LAS unsigned char* lds, const float* partial = nullptr) {
  const LAS float* rst = (const LAS float*)(lds + LDS_RSTD);
#define ACC_(ai, bj, m, n) (partial ? acc[ai][bj][m][n] + *(const f32x4*)(partial + (size_t)(((((ai) * 2 + (bj)) * 4 + (m)) * 2 + (n)) * 512 + tid) * 4) : acc[ai][bj][m][n])
  const int f3_grp = f3.grp, f3_k1 = f3.k1, f3_mt = f3.mt, f3_nt = f3.nt;
  {
    ws += opq0_(); r2 += opq0_();
    const int tid = tidx_(), wid = tid >> 6, lane = tid & 63, wr = wid >> 2, wc = wid & 3, fr = lane & 15, fq = lane >> 4;
    bf16_t* h = (bf16_t*)(ws + OFF_H);
    float* rowsq = (float*)(ws + T_ROWSQ);
    const int brow = pm * 256 + wr * 64 + fr;
    const int ccol = wc * 32 + fq * 4;
    if (kind == K_UP) {
      bf16_t* act = pm < MT_A ? (bf16_t*)(ws + R1_ACTA) : (bf16_t*)(r2 + R2_ACTB); const int arow0 = pm < MT_A ? 0 : MT_A * 256;
      const int ccolw = (fq & 1) ? 16 + 4 * (fq - 1) : 4 * fq;
      bf16_t* actb = act + ((size_t)(((pm - (pm < MT_A ? 0 : MT_A)) * 2 * 44 + pn * 2 + (wc >> 1))) << 13) + (wr * 64 + fr) * 64 + (wc & 1) * 32 + ccolw;
#pragma unroll
      for (int ai = 0; ai < 2; ++ai)
#pragma unroll
        for (int m = 0; m < 4; ++m) { asm volatile("" ::: "memory");
          const int row = brow + ai * 128 + m * 16; const float rs = rst[row - pm * 256];
          u32x2 w[2];
#pragma unroll
          for (int n = 0; n < 2; ++n) {
            const f32x4 g = ACC_(ai, 0, m, n) * rs, u = ACC_(ai, 1, m, n) * rs; float o[4];
#pragma unroll
            for (int j = 0; j < 4; ++j) o[j] = g[j] * sigmoidf_(g[j]) * u[j];
            w[n].x = pack2(o[0], o[1]); w[n].y = pack2(o[2], o[3]);
          }
          const auto r0 = __builtin_amdgcn_permlane16_swap(w[0].x, w[1].x, false, false);
          const auto r1 = __builtin_amdgcn_permlane16_swap(w[0].y, w[1].y, false, false);
          *(u32x4*)(actb + ai * (44 << 13) + m * 1024) = (u32x4){(unsigned)r0[0], (unsigned)r1[0], (unsigned)r0[1], (unsigned)r1[1]};
        }
    } else if (kind == K_DN || kind == K_WOUT) {
      const float sc = kind == K_DN ? 0.5f : 1.0f;
      bf16_t* hb = h + ((size_t)((pm * 2 * 16 + pn * 4 + (wc >> 1))) << 13) + (wr * 64 + fr) * 64 + (wc & 1) * 32 + fq * 4;
#pragma unroll
      for (int ai = 0; ai < 2; ++ai)
#pragma unroll
        for (int m = 0; m < 4; ++m) { asm volatile("" ::: "memory");
          const int row = brow + ai * 128 + m * 16; int seq, pos, L; row_info(row, seq, pos, L);
          float ss = 0.f;
          if (pos >= 0) {
#pragma unroll
            for (int bj = 0; bj < 2; ++bj)
#pragma unroll
              for (int n = 0; n < 2; ++n) {
                bf16_t* hp = hb + ai * (16 << 13) + bj * (2 << 13) + m * 1024 + n * 16;
                const u32x2 old = *(const u32x2*)hp; const f32x4 a = ACC_(ai, bj, m, n);
                u32x2 w; w.x = pack2(bflo(old.x) + sc * a[0], bfhi(old.x) + sc * a[1]); w.y = pack2(bflo(old.y) + sc * a[2], bfhi(old.y) + sc * a[3]);
                *(u32x2*)hp = w;
                const float v0 = bflo(w.x), v1 = bfhi(w.x), v2 = bflo(w.y), v3 = bfhi(w.y);
                ss += (v0 * v0 + v1 * v1) + (v2 * v2 + v3 * v3);
              }
          }
          ss += shx(ss, 16, lane); ss += shx(ss, 32, lane);
          if (fq == 0) rowsq[(size_t)row * 16 + pn * 4 + wc] = ss;
        }
    } else if (kind == K_WINA) {
      if (pn < 2) {
        bf16_t* qk = (bf16_t*)(ws + R1_QK);
        const float* rc = (const float*)(ws + T_ROPE); const float* rsn = rc + (size_t)LP * 32;
        const float qs = pn == 0 ? 0.125f : 1.0f;
#pragma unroll
        for (int ai = 0; ai < 2; ++ai)
#pragma unroll
          for (int m = 0; m < 4; ++m) { asm volatile("" ::: "memory");
            const int row = brow + ai * 128 + m * 16; int seq, pos, L; row_info(row, seq, pos, L);
            const float rs = rst[row - pm * 256] * qs; const int pc = pos < 0 ? 0 : pos;
#pragma unroll
            for (int bj = 0; bj < 2; ++bj) {
              const int g = bj * 4 + wc, head = g >> 1, d1 = (g & 1) * 16 + fq * 4;
              const f32x4 x1 = ACC_(ai, bj, m, 0) * rs, x2 = ACC_(ai, bj, m, 1) * rs;
              const f32x4 c = *(const f32x4*)(rc + (size_t)pc * 32 + d1), s = *(const f32x4*)(rsn + (size_t)pc * 32 + d1);
              const f32x4 o1 = x1 * c - x2 * s, o2 = x1 * s + x2 * c;
              bf16_t* dst = qk + (size_t)row * 512 + pn * 256 + head * 64 + d1;
              u32x2 w; w.x = pack2(o1[0], o1[1]); w.y = pack2(o1[2], o1[3]); *(u32x2*)dst = w;
              w.x = pack2(o2[0], o2[1]); w.y = pack2(o2[2], o2[3]); *(u32x2*)(dst + 32) = w;
            }
          }
      } else if (pn >= 6) {
        bf16_t* dst = (bf16_t*)(r2 + R2_PRW);
#pragma unroll
        for (int ai = 0; ai < 2; ++ai)
#pragma unroll
          for (int m = 0; m < 4; ++m) { asm volatile("" ::: "memory");
            const int row = brow + ai * 128 + m * 16; const float rs = rst[row - pm * 256];
#pragma unroll
            for (int bj = 0; bj < 2; ++bj)
#pragma unroll
              for (int n = 0; n < 2; ++n) { const f32x4 a = ACC_(ai, bj, m, n) * rs; u32x2 w; w.x = pack2(a[0], a[1]); w.y = pack2(a[2], a[3]);
                *(u32x2*)(dst + (size_t)row * 1792 + (pn - 6) * 256 + bj * 128 + ccol + n * 16) = w; }
          }
      } else {
        bf16_t* mix = (bf16_t*)(ws + R1_MIX);
#pragma unroll
        for (int ai = 0; ai < 2; ++ai)
#pragma unroll
          for (int m = 0; m < 4; ++m) { asm volatile("" ::: "memory");
            const int row = brow + ai * 128 + m * 16; const float rs = rst[row - pm * 256];
#pragma unroll
            for (int bj = 0; bj < 2; ++bj)
#pragma unroll
              for (int n = 0; n < 2; ++n) { const f32x4 a = ACC_(ai, bj, m, n) * rs; u32x2 w; w.x = pack2(a[0], a[1]); w.y = pack2(a[2], a[3]);
                *(u32x2*)(mix + (size_t)row * 1024 + (pn - 2) * 256 + bj * 128 + ccol + n * 16) = w; }
          }
      }
    } else if (kind == K_WINB || kind == K_FOLD) {
      bf16_t* dst = kind == K_WINB ? (bf16_t*)(r2 + R2_PRW) : (bf16_t*)(ws + W1_IN);
      const int ldd = kind == K_WINB ? 1792 : 1024;
#pragma unroll
      for (int ai = 0; ai < 2; ++ai)
#pragma unroll
        for (int m = 0; m < 4; ++m) { asm volatile("" ::: "memory");
          const int row = brow + ai * 128 + m * 16; const float rs = kind == K_WINB ? rst[row - pm * 256] : 1.0f;
#pragma unroll
          for (int bj = 0; bj < 2; ++bj)
#pragma unroll
            for (int n = 0; n < 2; ++n) { const f32x4 a = ACC_(ai, bj, m, n) * rs; u32x2 w; w.x = pack2(a[0], a[1]); w.y = pack2(a[2], a[3]);
              const int col = pn * 256 + bj * 128 + ccol + n * 16; *(u32x2*)(dst + (kind == K_WINB ? (size_t)row * ldd + col : tix(row, col, 16))) = w; }
        }
    } else if (kind == K_WIN1) {
      bf16_t* mix = (bf16_t*)(ws + R1_MIX); bf16_t* ub = (bf16_t*)(ws + R1_U);
#pragma unroll
      for (int ai = 0; ai < 2; ++ai)
#pragma unroll
        for (int m = 0; m < 4; ++m) { asm volatile("" ::: "memory");
          const int row = brow + ai * 128 + m * 16; int seq, pos, L; row_info(row, seq, pos, L);
          const float rs = rst[row - pm * 256];
          if (pn < 4) {
            if (pos >= 0) {
              bf16_t* wt = (bf16_t*)(r2 + R2_WT) + (seq < 2 ? (size_t)seq * 1024 * LP : (size_t)2 * 1024 * LP + (size_t)(seq - 2) * 1024 * LS);
#pragma unroll
              for (int bj = 0; bj < 2; ++bj)
#pragma unroll
                for (int n = 0; n < 2; ++n) { const f32x4 a = ACC_(ai, bj, m, n) * rs; const int col = pn * 256 + bj * 128 + ccol + n * 16;
#pragma unroll
                  for (int j = 0; j < 4; ++j) wt[(size_t)(col + j) * L + pos] = f2bf(a[j]); }
            }
          } else if (pn < 6) {
#pragma unroll
            for (int bj = 0; bj < 2; ++bj)
#pragma unroll
              for (int n = 0; n < 2; ++n) { const f32x4 a = ACC_(ai, bj, m, n) * rs; u32x2 w; w.x = pack2(a[0], a[1]); w.y = pack2(a[2], a[3]);
                *(u32x2*)(mix + (size_t)row * 1024 + 512 + (pn - 4) * 256 + bj * 128 + ccol + n * 16) = w; }
          } else {
#pragma unroll
            for (int n = 0; n < 2; ++n) { const f32x4 a = (ACC_(ai, 0, m, n) * rs) * (ACC_(ai, 1, m, n) * rs); u32x2 w; w.x = pack2(a[0], a[1]); w.y = pack2(a[2], a[3]);
              *(u32x2*)(ub + (size_t)row * 512 + (pn - 6) * 128 + ccol + n * 16) = w; }
          }
        }
    } else {
      bf16_t* mix = (bf16_t*)(ws + R1_MIX);
      const float* tc = (const float*)(ws + T_TAILC);
      const float* ct = tc + (f3_grp ? TC_CTS : TC_CTP); const float* st = tc + (f3_grp ? TC_STS : TC_STP);
      const int NN = f3_grp ? 2048 : 1024;
      const float* tv = (const float*)(ws + T_TAILV) + (f3_grp ? 32768 : 0) + (size_t)f3_k1 * NN * 2;
      const float scale = f3_grp ? rsqrtf(128.0f * LS) : rsqrtf(128.0f * LP);
#pragma unroll
      for (int ai = 0; ai < 2; ++ai)
#pragma unroll
        for (int m = 0; m < 4; ++m) { asm volatile("" ::: "memory");
          const int k2 = f3_mt * 256 + wr * 64 + fr + ai * 128 + m * 16;
          const float c2 = ct[k2], s2 = st[k2]; const int pos = f3_k1 + 16 * k2;
#pragma unroll
          for (int bj = 0; bj < 2; ++bj)
#pragma unroll
            for (int n = 0; n < 2; ++n) {
              const int ni = f3_nt * 256 + bj * 128 + ccol + n * 16; const int sl = ni >> 9, c = ni & 511;
              const int row = (f3_grp ? 2 * LPP + sl * LPS : sl * LPP) + PADR + pos;
              const f32x4 t0 = *(const f32x4*)(tv + (size_t)ni * 2), t1 = *(const f32x4*)(tv + (size_t)ni * 2 + 4);
              const f32x4 a = acc[ai][bj][m][n];
              const float o0 = (a[0] + c2 * t0[0] + s2 * t0[1]) * scale, o1 = (a[1] + c2 * t0[2] + s2 * t0[3]) * scale,
                          o2 = (a[2] + c2 * t1[0] + s2 * t1[1]) * scale, o3 = (a[3] + c2 * t1[2] + s2 * t1[3]) * scale;
              u32x2 w; w.x = pack2(o0, o1); w.y = pack2(o2, o3);
              *(u32x2*)(mix + (size_t)row * 1024 + c) = w;
            }
        }
    }
  }
}

__device__ __forceinline__ void gemm_phase(const int kind, const int idx, const Params& p, LAS unsigned char* lds, const int seqid = 0) {
  unsigned char* ws = p.ws + opq0_(); unsigned char* r2 = (unsigned char*)p.out + opq0_();
  int nM = MT, nN = 4, K = 1024;
  const bf16_t* Wt = nullptr;
  switch (kind) {
    case K_UP: nN = 22; Wt = (const bf16_t*)(ws + (idx == 0 ? W0_F1UP : idx == 1 ? W0_F2UP : idx == 2 ? W1_F1UP : W1_F2UP)); break;
    case K_DN: nN = 4; K = FF; Wt = (const bf16_t*)(ws + (idx == 0 ? W0_F1DN : idx == 1 ? W0_F2DN : idx == 2 ? W1_F1DN : W1_F2DN)); break;
    case K_WINA: nN = 13; Wt = (const bf16_t*)(ws + W0_INA); break;
    case K_WINB: nN = 7; Wt = (const bf16_t*)(ws + W0_INB); break;
    case K_WOUT: nN = 4; Wt = (const bf16_t*)(ws + (idx == 0 ? W0_OUT : W1_OUT)); break;
    case K_WIN1: nN = 10; Wt = (const bf16_t*)(ws + W1_IN); break;
    case K_F3: nM = 1; nN = 256; break;
    default: nM = 4; nN = 4; K = 512; break;
  }
  const int U = nM * nN;
  for (int it = 0;; ++it) {
    int pm, pn;
    int khalf = -1;
    const bool split = kind == K_DN;
    if (split) {
      const LAS int* ctl = (const LAS int*)(lds + LDS_CTL);
      const int x = __builtin_amdgcn_readfirstlane(ctl[0]), slot = __builtin_amdgcn_readfirstlane(ctl[1]), nx = __builtin_amdgcn_readfirstlane(ctl[2]), ok = __builtin_amdgcn_readfirstlane(ctl[3]);
      int f = -1, hu = -1;
      if (ok) { const int li = it * nx + slot;
        if (li < 16 * nN) f = 16 * nN * x + li;
        else { const int hs = (6 * nN * x) >> 3, he = (6 * nN * (x + 1)) >> 3, j = li - 16 * nN; if (j < he - hs) hu = hs + j; else break; } }
      else { const int l = it * (int)gridDim.x + bidx_(); if (l < 128 * nN) f = l; else if (l < 134 * nN) hu = l - 128 * nN; else break; }
      if (f >= 0) { const int nig = 8 * nN, gid = f / nig, within = f % nig; pm = gid * 8 + (within & 7); pn = within >> 3; }
      else { const int u = hu >> 1; khalf = hu & 1; pm = 128 + u % 3; pn = u / 3; }
    } else if (!unit_for(it, U, nM, nN, pm, pn, lds)) break;
    const bf16_t* A; const bf16_t* Bt; int lda, ldb;
    int f3_k1 = 0, f3_mt = 0, f3_nt = 0, f3_grp = 0;
    if (kind == K_F3) {
      const int u = pn;
      if (u < 128) { f3_grp = 0; f3_k1 = u >> 3; f3_mt = (u >> 2) & 1; f3_nt = u & 3;
        A = (const bf16_t*)(ws + T_ADFTP) + (size_t)f3_mt * 256 * 1024; lda = 1024; Bt = (const bf16_t*)(r2 + R2_BTFP) + ((size_t)f3_k1 * 1024 + f3_nt * 256) * 1024; ldb = 1024; K = 1024; }
      else { const int v = u - 128; f3_grp = 1; f3_k1 = v >> 3; f3_mt = 0; f3_nt = v & 7;
        A = (const bf16_t*)(ws + T_ADFTS); lda = 512; Bt = (const bf16_t*)(ws + R1_BTFS) + ((size_t)f3_k1 * 2048 + f3_nt * 256) * 512; ldb = 512; K = 512; }
    } else if (kind == K_DN) {
      A = pm < MT_A ? (const bf16_t*)(ws + R1_ACTA) + (size_t)pm * 256 * FF : (const bf16_t*)(r2 + R2_ACTB) + (size_t)(pm - MT_A) * 256 * FF; lda = FF;
      Bt = Wt + (size_t)pn * 256 * FF; ldb = FF;
      K = FF;
    } else if (kind == K_WOUT) {
      A = (const bf16_t*)(ws + R1_MIX) + (size_t)pm * 256 * 1024; lda = 1024; Bt = Wt + (size_t)pn * 256 * 1024; ldb = 1024;
    } else if (kind == K_FOLD) {
      A = (const bf16_t*)(ws + T_FT) + (size_t)pm * 256 * 512; lda = 512; Bt = (const bf16_t*)(ws + T_WTMP) + (size_t)pn * 256 * 512; ldb = 512;
    } else {
      A = (const bf16_t*)(ws + OFF_H) + (size_t)pm * 256 * 1024; lda = 1024; Bt = Wt + (size_t)pn * 256 * 1024; ldb = 1024;
    }
    const bool tA = kind == K_UP || kind == K_DN || kind == K_WINA || kind == K_WINB || kind == K_WIN1;
    const bool tB = tA || kind == K_WOUT;
    const int KF = K;
    if (khalf >= 0) { const int hk = (K >> 7) * khalf; K >>= 1; A += tA ? (size_t)hk * 8192 : (size_t)hk * 64; Bt += (size_t)hk * 8192; }
    if (kind == K_UP || kind == K_WINA || kind == K_WINB || kind == K_WIN1) {
      const int t = tidx_(); if (t < 256) ((LAS float*)(lds + LDS_RSTD))[t] = row_rstd((const float*)(ws + T_ROWSQ), pm * 256 + t);
    }
    f32x4 acc[2][2][4][2];
    gemm_core(A, tA ? 64 : lda, tA ? (size_t)16384 : (size_t)128, tA ? (size_t)(KF >> 6) * 16384 : (size_t)128 * lda * 2,
              Bt, tB ? 64 : ldb, tB ? (size_t)16384 : (size_t)128, tB ? (size_t)(KF >> 6) * 16384 : (size_t)128 * ldb * 2, K, lds, acc);
    const float* partial = nullptr;
    if (khalf >= 0) {
      const int u = (pm - 128) + 3 * pn; const int t = tidx_();
      float* scr = (float*)(r2 + R2_SPLITK) + (size_t)u * 65536;
      unsigned* flag = (unsigned*)(ws + T_BAR + 13824) + u;
      if (khalf == 0) {
#pragma unroll
        for (int a = 0; a < 2; ++a)
#pragma unroll
          for (int b = 0; b < 2; ++b)
#pragma unroll
            for (int m = 0; m < 4; ++m)
#pragma unroll
              for (int n = 0; n < 2; ++n) *(f32x4*)(scr + (size_t)((((a * 2 + b) * 4 + m) * 2 + n) * 512 + t) * 4) = acc[a][b][m][n];
        asm volatile("s_waitcnt vmcnt(0)" ::: "memory");
        __syncthreads();
        if (t == 0) { __builtin_amdgcn_fence(__ATOMIC_RELEASE, "agent"); asm volatile("s_waitcnt vmcnt(0)" ::: "memory"); __hip_atomic_store(flag, (unsigned)seqid, __ATOMIC_RELAXED, __HIP_MEMORY_SCOPE_AGENT); }
        __syncthreads();
        continue;
      } else {
        if (t == 0) { unsigned sp = 0; while (__hip_atomic_load(flag, __ATOMIC_RELAXED, __HIP_MEMORY_SCOPE_AGENT) < (unsigned)seqid) { __builtin_amdgcn_s_sleep(2); if (++sp > (1u << 24)) break; }
          __builtin_amdgcn_fence(__ATOMIC_ACQUIRE, "agent"); asm volatile("s_waitcnt vmcnt(0)" ::: "memory"); }
        __syncthreads();
        partial = scr;
      }
    }
    { F3Info f3; f3.grp = f3_grp; f3.k1 = f3_k1; f3.mt = f3_mt; f3.nt = f3_nt; gemm_epilogue(kind, pm, pn, f3, acc, ws, r2, lds, partial); }
    WAIT_V(0);
    __syncthreads();
  }
}

__device__ __forceinline__ void gemm_phase_stream(const int kind, const int idx, const Params& p, LAS unsigned char* lds) {
  unsigned char* ws = p.ws + opq0_(); unsigned char* r2 = (unsigned char*)p.out + opq0_();
  int nM = MT, nN = 4, K = 1024, lda = 1024, ldb = 1024;
  const bf16_t* Wt = nullptr;
  switch (kind) {
    case K_UP: nN = 22; Wt = (const bf16_t*)(ws + (idx == 0 ? W0_F1UP : idx == 1 ? W0_F2UP : idx == 2 ? W1_F1UP : W1_F2UP)); break;
    case K_DN: nN = 4; K = FF; lda = FF; ldb = FF; Wt = (const bf16_t*)(ws + (idx == 0 ? W0_F1DN : idx == 1 ? W0_F2DN : idx == 2 ? W1_F1DN : W1_F2DN)); break;
    case K_WINA: nN = 13; Wt = (const bf16_t*)(ws + W0_INA); break;
    case K_WINB: nN = 7; Wt = (const bf16_t*)(ws + W0_INB); break;
    case K_WOUT: nN = 4; Wt = (const bf16_t*)(ws + (idx == 0 ? W0_OUT : W1_OUT)); break;
    default: nN = 10; Wt = (const bf16_t*)(ws + W1_IN); break;
  }
  const int U = nM * nN;
  int pm, pn;
  if (!unit_for(0, U, nM, nN, pm, pn, lds)) return;
  const int KB = K >> 6;
  const bool tiledA = kind != K_WOUT;
  auto ptrA = [&](int m) -> const char* {
    if (kind == K_DN) return (const char*)(m < MT_A ? (const bf16_t*)(ws + R1_ACTA) + (size_t)m * 256 * FF : (const bf16_t*)(r2 + R2_ACTB) + (size_t)(m - MT_A) * 256 * FF);
    if (kind == K_WOUT) return (const char*)((const bf16_t*)(ws + R1_MIX) + (size_t)m * 256 * 1024);
    return (const char*)((const bf16_t*)(ws + OFF_H) + (size_t)m * 256 * 1024); };
  auto ptrB = [&](int n) -> const char* { return (const char*)(Wt + (size_t)n * 256 * ldb); };
  const int tid = tidx_(), wid = tid >> 6, lane = tid & 63, wr = wid >> 2, wc = wid & 3, fr = lane & 15, fq = lane >> 4;
  unsigned voffA[2], voffB[2];
#pragma unroll
  for (int i = 0; i < 2; ++i) { int R, C; stage_rc(tid * 16 + i * 8192, R, C); voffA[i] = (unsigned)(R * (tiledA ? 64 : lda) + C) * 2u; voffB[i] = (unsigned)(R * 64 + C) * 2u; }
  const unsigned ldsw = (unsigned)wid * 1024u;
  const int aoff = lds_byte(wr * 64 + fr, fq * 8), boff = lds_byte(wc * 32 + fr, fq * 8);
  const size_t hA = tiledA ? (size_t)KB * 16384 : (size_t)128 * lda * 2, hB = (size_t)KB * 16384, kstepA = tiledA ? 16384 : 128, kstepB = 16384;
  const int nt = K / 64;
  const char* cA = ptrA(pm); const char* cB = ptrB(pn);
  f32x4 acc[2][2][4][2];
#pragma unroll
  for (int a = 0; a < 2; ++a)
#pragma unroll
    for (int b = 0; b < 2; ++b)
#pragma unroll
      for (int m = 0; m < 4; ++m)
#pragma unroll
        for (int n = 0; n < 2; ++n) acc[a][b][m][n] = (f32x4){0.f, 0.f, 0.f, 0.f};
  bf16x8 At[4][2], B0[2][2], B1[2][2];
  STAGE_(SB_(0, 0), cB, voffB); STAGE_(SA_(0, 0), cA, voffA); STAGE_(SB_(0, 1), cB + hB, voffB); STAGE_(SA_(0, 1), cA + hA, voffA);
  if (wr == 1) BAR_;
  WAIT_V(4); BAR_;
  STAGE_(SB_(1, 0), cB + kstepB, voffB); STAGE_(SA_(1, 0), cA + kstepA, voffA); STAGE_(SB_(1, 1), cB + hB + kstepB, voffB);
  WAIT_V(6); BAR_;
  int it = 0;
  for (;;) {
    int pm2 = 0, pn2 = 0;
    const bool has_next = unit_for(it + 1, U, nM, nN, pm2, pn2, lds);
    const char* nA = has_next ? ptrA(pm2) : cA; const char* nB = has_next ? ptrB(pn2) : cB;
    for (int t = 0; t < nt; t += 2) {
      const bool last = (t == nt - 2);
      const char* a1 = cA + (size_t)(t + 1) * kstepA;
      const char* a2 = last ? nA : cA + (size_t)(t + 2) * kstepA; const char* b2 = last ? nB : cB + (size_t)(t + 2) * kstepB;
      const char* a3 = a2 + kstepA; const char* b3 = b2 + kstepB;
      LDB_(B0, 0, 0); SCHED_; LDA_(At, 0, 0); STAGE_(SA_(1, 1), a1 + hA, voffA);
      WAIT_L(8); BAR_; WAIT_L(0); MMA_(0, 0, At, B0); BAR_; SCHED_;
      LDB_(B1, 0, 1); STAGE_(SB_(0, 0), b2, voffB);
      BAR_; WAIT_L(0); MMA_(0, 1, At, B1); BAR_;
      LDA_(At, 0, 1); STAGE_(SA_(0, 0), a2, voffA);
      BAR_; WAIT_L(0); MMA_(1, 0, At, B0); BAR_; SCHED_;
      STAGE_(SB_(0, 1), b2 + hB, voffB);
      WAIT_V(6); BAR_; MMA_(1, 1, At, B1); BAR_;
      LDB_(B0, 1, 0); SCHED_; LDA_(At, 1, 0); STAGE_(SA_(0, 1), a2 + hA, voffA);
      WAIT_L(8); BAR_; WAIT_L(0); MMA_(0, 0, At, B0); BAR_; SCHED_;
      LDB_(B1, 1, 1); STAGE_(SB_(1, 0), b3, voffB);
      BAR_; WAIT_L(0); MMA_(0, 1, At, B1); BAR_;
      LDA_(At, 1, 1); STAGE_(SA_(1, 0), a3, voffA);
      BAR_; WAIT_L(0); MMA_(1, 0, At, B0); BAR_; SCHED_;
      STAGE_(SB_(1, 1), b3 + hB, voffB);
      WAIT_V(6); BAR_; MMA_(1, 1, At, B1); BAR_;
    }
    { unsigned char* ws2 = ws + opq0_(); unsigned char* r22 = r2 + opq0_();
      F3Info f3; f3.grp = 0; f3.k1 = 0; f3.mt = 0; f3.nt = 0; gemm_epilogue(kind, pm, pn, f3, acc, ws2, r22, lds); }
    if (!has_next) break;
#pragma unroll
    for (int a = 0; a < 2; ++a)
#pragma unroll
      for (int b = 0; b < 2; ++b)
#pragma unroll
        for (int m = 0; m < 4; ++m)
#pragma unroll
          for (int n = 0; n < 2; ++n) acc[a][b][m][n] = (f32x4){0.f, 0.f, 0.f, 0.f};
    pm = pm2; pn = pn2; cA = nA; cB = nB; ++it;
  }
  WAIT_V(0);
  if (wr == 0) BAR_;
  BAR_;
  __syncthreads();
}
enum { CM_ID = 0, CM_ROPE = 1 };
struct Job { const float* src; const float* src2; const float* gain; bf16_t* dst; int ldw, K, Np, cm, off, half2; };
__device__ __forceinline__ void conv_tile(const Job& jb, int tn, int tk, LAS unsigned char* lds) {
  LAS float* tile = (LAS float*)lds;
  const int tid = tidx_();
  const int nn = tid & 63, n = tn * 64 + nn;
  const float* src = jb.src; int c;
  if (jb.half2 & 1) { const int t = n >> 8, r = n & 255; if (r >= 128) { src = jb.src2; c = (jb.half2 >> 1) + t * 128 + (r - 128); } else c = jb.off + t * 128 + r; }
  else if (jb.cm == CM_ROPE) { const int pnq = n >> 8, r = n & 255, bj = r >> 7, wc = (r >> 5) & 3, nq = (r >> 4) & 1, i = r & 15, g = bj * 4 + wc;
    c = jb.off + pnq * 256 + (g >> 1) * 64 + nq * 32 + (g & 1) * 16 + i; }
  else c = jb.off + n;
#pragma unroll
  for (int i = 0; i < 8; ++i) { const int kk = i * 8 + (tid >> 6), k = tk * 64 + kk;
    float v = src[(size_t)k * jb.ldw + c]; if (jb.gain) v *= jb.gain[k]; tile[nn * 65 + kk] = v; }
  __syncthreads();
  { const int r = tid >> 3, kc = (tid & 7) * 8; u32x4 w;
    w.x = pack2(tile[r * 65 + kc + 0], tile[r * 65 + kc + 1]); w.y = pack2(tile[r * 65 + kc + 2], tile[r * 65 + kc + 3]);
    w.z = pack2(tile[r * 65 + kc + 4], tile[r * 65 + kc + 5]); w.w = pack2(tile[r * 65 + kc + 6], tile[r * 65 + kc + 7]);
    *(u32x4*)(jb.dst + tix(tn * 64 + r, tk * 64 + kc, jb.K >> 6)) = w; }
  __syncthreads();
}
__device__ __forceinline__ Job mkjob(const float* s, const float* s2, const float* g, bf16_t* d, int ldw, int K, int Np, int cm, int off, int half2) {
  Job j; j.src = s; j.src2 = s2; j.gain = g; j.dst = d; j.ldw = ldw; j.K = K; j.Np = Np; j.cm = cm; j.off = off; j.half2 = half2; return j; }
__device__ __forceinline__ Job get_job(const Params& p, int set, int j, bool tab) {
  unsigned char* ws = p.ws + opq0_();
#define IN0(i) (tab ? inp(ws, i) : p.in[i])
  if (set == 0) {
    switch (j) {
      case 0: return mkjob(IN0(4), IN0(5), IN0(3), (bf16_t*)(ws + W0_F1UP), FF, 1024, 5632, 0, 0, 1);
      case 1: return mkjob(IN0(6), nullptr, nullptr, (bf16_t*)(ws + W0_F1DN), 1024, FF, 1024, 0, 0, 0);
      case 2: return mkjob(IN0(8), nullptr, IN0(7), (bf16_t*)(ws + W0_INA), 3328, 1024, 512, CM_ROPE, 0, 0);
      case 3: return mkjob(IN0(8), nullptr, IN0(7), (bf16_t*)(ws + W0_INA) + (size_t)512 * 1024, 3328, 1024, 1024, 0, 512, 0);
      case 4: return mkjob(IN0(8), nullptr, IN0(7), (bf16_t*)(ws + W0_INB), 3328, 1024, 1792, 0, 1536, 0);
      case 5: return mkjob(IN0(9), nullptr, nullptr, (bf16_t*)(ws + W0_OUT), 1024, 1024, 1024, 0, 0, 0);
      case 6: return mkjob(IN0(22), IN0(23), IN0(21), (bf16_t*)(ws + W0_F2UP), FF, 1024, 5632, 0, 0, 1);
      default: return mkjob(IN0(24), nullptr, nullptr, (bf16_t*)(ws + W0_F2DN), 1024, FF, 1024, 0, 0, 0);
    }
  } else {
    switch (j) {
      case 0: return mkjob(inp(ws, 26), inp(ws, 27), inp(ws, 25), (bf16_t*)(ws + W1_F1UP), FF, 1024, 5632, 0, 0, 1);
      case 1: return mkjob(inp(ws, 28), nullptr, nullptr, (bf16_t*)(ws + W1_F1DN), 1024, FF, 1024, 0, 0, 0);
      case 2: return mkjob(inp(ws, 30), nullptr, inp(ws, 29), (bf16_t*)(ws + W1_IN) + (size_t)1024 * 1024, 2048, 1024, 512, 0, 512, 0);
      case 3: return mkjob(inp(ws, 30), inp(ws, 30), inp(ws, 29), (bf16_t*)(ws + W1_IN) + (size_t)1536 * 1024, 2048, 1024, 1024, 0, 1024, 1 | (1536 << 1));
      case 4: return mkjob(inp(ws, 31), nullptr, nullptr, (bf16_t*)(ws + W1_OUT), 1024, 1024, 1024, 0, 0, 0);
      case 5: return mkjob(inp(ws, 34), inp(ws, 35), inp(ws, 33), (bf16_t*)(ws + W1_F2UP), FF, 1024, 5632, 0, 0, 1);
      case 6: return mkjob(inp(ws, 36), nullptr, nullptr, (bf16_t*)(ws + W1_F2DN), 1024, FF, 1024, 0, 0, 0);
      default: return mkjob(inp(ws, 32), nullptr, nullptr, nullptr, 0, 0, 0, 0, 0, 0);
    }
  }
}
__device__ __forceinline__ void prep_weights(const Params& p, int set, LAS unsigned char* lds) {
  const int j0 = set == 2 ? 4 : set == 3 ? 5 : 0, j1 = set == 0 ? 4 : set == 2 ? 5 : set == 3 ? 8 : 7;
  int base = 0;
  for (int j = j0; j < j1; ++j) {
    const Job jb = get_job(p, set == 1 ? 1 : 0, j, set != 0);
    const int tn = jb.Np / 64, tk = jb.K / 64, nt = tn * tk;
    const int G = gdim_();
    int t0 = (bidx_() - base % G + G) % G;
    for (int t = t0; t < nt; t += G) conv_tile(jb, t / tk, t % tk, lds);
    base += nt;
  }
}

__device__ __forceinline__ void prep_misc(const Params& p) {
  unsigned char* ws = p.ws + opq0_();
  const int tid = tidx_(), lane = tid & 63, gw = bidx_() * 8 + (tid >> 6), nw = gridDim.x * 8;
  bf16_t* h = (bf16_t*)(ws + OFF_H); float* rowsq = (float*)(ws + T_ROWSQ);
  for (int row = gw; row < MROWS; row += nw) {
    int seq, pos, L; row_info(row, seq, pos, L);
    const float* src = nullptr;
    if (pos >= 16) src = (seq < 2 ? p.in[0] + ((size_t)seq * 8192 + (pos - 16)) * 1024 : p.in[1] + ((size_t)(seq - 2) * 4096 + (pos - 16)) * 1024);
    else if (pos >= 0) src = p.in[2] + (size_t)pos * 1024;
    float ss = 0.f;
#pragma unroll
    for (int i = 0; i < 4; ++i) {
      const int c = i * 256 + lane * 4;
      f32x4 v = (f32x4){0.f, 0.f, 0.f, 0.f}; if (src) v = *(const f32x4*)(src + c);
      u32x2 w; w.x = pack2(v[0], v[1]); w.y = pack2(v[2], v[3]);
      *(u32x2*)(h + tix(row, c, 16)) = w;
      const float a = bflo(w.x), b = bfhi(w.x), cc = bflo(w.y), d = bfhi(w.y); ss += (a * a + b * b) + (cc * cc + d * d);
    }
#pragma unroll
    for (int o = 32; o >= 1; o >>= 1) ss += shx(ss, o, lane);
    if (lane < 16) rowsq[(size_t)row * 16 + lane] = lane == 0 ? ss : 0.f;
  }
  const int gt = bidx_() * 512 + tid, ngt = gridDim.x * 512;
  if (gt == 0) {
#pragma unroll
    for (int i = 0; i < 38; ++i) ((unsigned long long*)(ws + T_PTR))[i] = (unsigned long long)p.in[i];
  }
  { float* rc = (float*)(ws + T_ROPE); float* rs = rc + (size_t)LP * 32;
    for (int i = gt; i < LP * 32; i += ngt) { const int pos = i >> 5, d = i & 31; const float inv = powf(10000.0f, -(float)d / 32.0f); const float ang = (float)pos * inv; rc[i] = cosf(ang); rs[i] = sinf(ang); } }
  { bf16_t* a = (bf16_t*)(ws + T_ADFTP);
    for (int i = gt; i < 512 * 1024; i += ngt) { const int k2 = i >> 10, kk = i & 1023, n2 = kk & 511; const int mm = (k2 * n2) % 513; const float x = 2.0f * (float)mm / 513.0f; a[i] = f2bf(kk < 512 ? cospif(x) : sinpif(x)); }
    bf16_t* b = (bf16_t*)(ws + T_ADFTS);
    for (int i = gt; i < 256 * 512; i += ngt) { const int k2 = i >> 9, kk = i & 511, n2 = kk & 255; const int mm = (k2 * n2) % 257; const float x = 2.0f * (float)mm / 257.0f; b[i] = f2bf(kk < 256 ? cospif(x) : sinpif(x)); } }
  { bf16_t* f = (bf16_t*)(ws + T_FT);
    for (int i = gt; i < 1024 * 512; i += ngt) { const int np = i >> 9, kc = i & 511, part = np >> 9, g = (np >> 7) & 3, cp = np & 127, g2 = kc >> 7, c = kc & 127;
      float v = 0.f; if (g2 == g) { const float x = 2.0f * (float)((c * cp) & 127) / 128.0f; v = part == 0 ? cospif(x) : -sinpif(x); } f[i] = f2bf(v); } }
  { bf16_t* w = (bf16_t*)(ws + T_WTMP); const float* src = p.in[30]; const float* g = p.in[29];
    for (int i = gt; i < 1024 * 512; i += ngt) { const int k = i >> 9, c = i & 511; w[i] = f2bf(g[k] * src[(size_t)k * 2048 + c]); } }
  { float* tp = (float*)(ws + T_TWP); for (int i = gt; i < 16 * 513; i += ngt) { const int k1 = i / 513, n2 = i % 513; const float x = 2.0f * (float)(k1 * n2) / (float)LP; tp[2 * i] = cospif(x); tp[2 * i + 1] = sinpif(x); }
    float* ts = (float*)(ws + T_TWS); for (int i = gt; i < 16 * 257; i += ngt) { const int k1 = i / 257, n2 = i % 257; const float x = 2.0f * (float)(k1 * n2) / (float)LS; ts[2 * i] = cospif(x); ts[2 * i + 1] = sinpif(x); } }
  { float* tc = (float*)(ws + T_TAILC);
    for (int i = gt; i < 513; i += ngt) { const float x = 2.0f * (float)((i * 512) % 513) / 513.0f; const float c = cospif(x), s = sinpif(x);
      if (i < 512) { tc[TC_CTP + i] = c; tc[TC_STP + i] = s; } tc[TC_ARCP + i] = c; tc[TC_ARSP + i] = s; }
    for (int i = gt; i < 257; i += ngt) { const float x = 2.0f * (float)((i * 256) % 257) / 257.0f; const float c = cospif(x), s = sinpif(x);
      if (i < 256) { tc[TC_CTS + i] = c; tc[TC_STS + i] = s; } tc[TC_ARCS + i] = c; tc[TC_ARSS + i] = s; } }
  { bf16_t* g2t = (bf16_t*)(ws + T_G2T); const float* g2 = p.in[15]; for (int i = gt; i < 512 * 128; i += ngt) { const int c = i >> 7, r = i & 127; g2t[i] = f2bf(g2[(size_t)r * 512 + c]); } }
}
__device__ __forceinline__ void ret_unit(int uid, int& seq, int& chunk, int& head, int& cidx) {
  if (uid < 520) { seq = uid / 260; const int rem = uid % 260; chunk = rem >> 2; head = rem & 3; cidx = seq * 65 + chunk; }
  else { const int v = uid - 520; const int s = v / 132; seq = 2 + s; const int rem = v % 132; chunk = rem >> 2; head = rem & 3; cidx = 130 + s * 33 + chunk; }
}
__device__ __forceinline__ float ret_lg(int head) { return log1pf(-exp2f(-5.0f - (float)head)); }
constexpr int VT_LD = 136;

__device__ __forceinline__ void load_vT(const bf16_t* mix, int row0, int head, LAS bf16_t* vT) {
  const int tid = tidx_(), j = tid >> 2, e0 = (tid & 3) * 32;
  const u32x4* src = (const u32x4*)(mix + (size_t)(row0 + j) * 1024 + head * 128 + e0);
#pragma unroll
  for (int q = 0; q < 4; ++q) { const u32x4 v = src[q]; const unsigned w[4] = {v.x, v.y, v.z, v.w};
#pragma unroll
    for (int t = 0; t < 4; ++t) { vT[(e0 + q * 8 + t * 2) * VT_LD + j] = (bf16_t)(w[t] & 0xffff); vT[(e0 + q * 8 + t * 2 + 1) * VT_LD + j] = (bf16_t)(w[t] >> 16); } }
}

__device__ __forceinline__ void ret_kv_phase(const Params& p, LAS unsigned char* lds) {
  unsigned char* ws = p.ws + opq0_(); unsigned char* r2 = (unsigned char*)p.out + opq0_();
  const bf16_t* mix = (const bf16_t*)(ws + R1_MIX); const bf16_t* qk = (const bf16_t*)(ws + R1_QK);
  bf16_t* kvf = (bf16_t*)(ws + R1_KVF); bf16_t* kvb = (bf16_t*)(ws + R1_KVB);
  LAS bf16_t* vT = (LAS bf16_t*)lds; LAS bf16_t* kTf = vT + 128 * VT_LD; LAS bf16_t* kTb = kTf + 64 * VT_LD;
  const int tid = tidx_(), wid = tid >> 6, lane = tid & 63, fr = lane & 15, fq = lane >> 4;
  for (int uid = bidx_(); uid < 1048; uid += gridDim.x) {
    int seq, chunk, head, cidx; ret_unit(uid, seq, chunk, head, cidx);
    const int row0 = cidx * 128; const float lg = ret_lg(head);
    __syncthreads();
    load_vT(mix, row0, head, vT);
    { const int j = tid >> 2, d0 = (tid & 3) * 16;
      const float df = __expf(lg * (float)(127 - j)), db = __expf(lg * (float)j);
      const u32x4* src = (const u32x4*)(qk + (size_t)(row0 + j) * 512 + 256 + head * 64 + d0);
#pragma unroll
      for (int q = 0; q < 2; ++q) { const u32x4 v = src[q]; const unsigned w[4] = {v.x, v.y, v.z, v.w};
#pragma unroll
        for (int t = 0; t < 4; ++t) { const float lo = bflo(w[t]), hi = bfhi(w[t]); const int d = d0 + q * 8 + t * 2;
          kTf[d * VT_LD + j] = f2bf(lo * df); kTf[(d + 1) * VT_LD + j] = f2bf(hi * df);
          kTb[d * VT_LD + j] = f2bf(lo * db); kTb[(d + 1) * VT_LD + j] = f2bf(hi * db); } } }
    __syncthreads();
    f32x4 af[4], ab[4];
#pragma unroll
    for (int m = 0; m < 4; ++m) { af[m] = (f32x4){0.f, 0.f, 0.f, 0.f}; ab[m] = (f32x4){0.f, 0.f, 0.f, 0.f}; }
#pragma unroll
    for (int ks = 0; ks < 4; ++ks) {
      const bf16x8 y = *(const LAS bf16x8*)(vT + (wid * 16 + fr) * VT_LD + ks * 32 + fq * 8);
#pragma unroll
      for (int m = 0; m < 4; ++m) {
        const bf16x8 xf = *(const LAS bf16x8*)(kTf + (m * 16 + fr) * VT_LD + ks * 32 + fq * 8);
        const bf16x8 xb = *(const LAS bf16x8*)(kTb + (m * 16 + fr) * VT_LD + ks * 32 + fq * 8);
        af[m] = mfma16(xf, y, af[m]); ab[m] = mfma16(xb, y, ab[m]);
      }
    }
    const size_t o = ((size_t)(cidx * 4 + head) * 128 + wid * 16 + fr) * 64;
#pragma unroll
    for (int m = 0; m < 4; ++m) { u32x2 w; w.x = pack2(af[m][0], af[m][1]); w.y = pack2(af[m][2], af[m][3]); *(u32x2*)(kvf + o + m * 16 + fq * 4) = w;
      w.x = pack2(ab[m][0], ab[m][1]); w.y = pack2(ab[m][2], ab[m][3]); *(u32x2*)(kvb + o + m * 16 + fq * 4) = w; }
  }
}

__device__ __forceinline__ void ret_scan_phase(const Params& p) {
  unsigned char* ws = p.ws + opq0_();
  const int gt = bidx_() * 512 + tidx_(), ngt = gridDim.x * 512;
  for (int w = gt; w < 2 * 24 * 2048; w += ngt) {
    const int dir = w / (24 * 2048), rem = w % (24 * 2048), sh = rem >> 11, eg = rem & 2047, seq = sh >> 2, head = sh & 3;
    const int n = seq < 2 ? 65 : 33, cb = seq < 2 ? seq * 65 : 130 + (seq - 2) * 33;
    bf16_t* base = (bf16_t*)(ws + (dir ? R1_KVB : R1_KVF)) + (size_t)head * 8192 + eg * 4;
    const float gc = __expf(128.0f * ret_lg(head));
    float s0 = 0.f, s1 = 0.f, s2 = 0.f, s3 = 0.f;
    for (int i = 0; i < n; ++i) {
      const int c = dir ? n - 1 - i : i;
      u32x2* ptr = (u32x2*)(base + (size_t)(cb + c) * 4 * 8192);
      const u32x2 x = *ptr;
      u32x2 o; o.x = pack2(s0, s1); o.y = pack2(s2, s3); *ptr = o;
      s0 = gc * s0 + bflo(x.x); s1 = gc * s1 + bfhi(x.x); s2 = gc * s2 + bflo(x.y); s3 = gc * s3 + bfhi(x.y);
    }
  }
}

__device__ __forceinline__ bf16x8 scale_frag(bf16x8 v, float s) {
  bf16x8 o;
#pragma unroll
  for (int i = 0; i < 8; ++i) o[i] = (short)f2bf(bf2f((bf16_t)v[i]) * s);
  return o;
}

__device__ __forceinline__ void ret_out_phase(const Params& p, LAS unsigned char* lds) {
  unsigned char* ws = p.ws + opq0_(); unsigned char* r2 = (unsigned char*)p.out + opq0_();
  bf16_t* mix = (bf16_t*)(ws + R1_MIX); const bf16_t* qk = (const bf16_t*)(ws + R1_QK);
  const bf16_t* kvf = (const bf16_t*)(ws + R1_KVF); const bf16_t* kvb = (const bf16_t*)(ws + R1_KVB);
  LAS bf16_t* vT = (LAS bf16_t*)lds; LAS bf16_t* Pm = vT + 128 * VT_LD;
  const int tid = tidx_(), wid = tid >> 6, lane = tid & 63, fr = lane & 15, fq = lane >> 4;
  for (int uid = bidx_(); uid < 1048; uid += gridDim.x) {
    int seq, chunk, head, cidx; ret_unit(uid, seq, chunk, head, cidx);
    const int row0 = cidx * 128; const float lg = ret_lg(head);
    __syncthreads();
    load_vT(mix, row0, head, vT);
    bf16x8 qf[2];
#pragma unroll
    for (int ks = 0; ks < 2; ++ks) qf[ks] = *(const bf16x8*)(qk + (size_t)(row0 + wid * 16 + fr) * 512 + head * 64 + ks * 32 + fq * 8);
    f32x4 acc[8];
#pragma unroll
    for (int nt = 0; nt < 8; ++nt) {
      acc[nt] = (f32x4){0.f, 0.f, 0.f, 0.f};
#pragma unroll
      for (int ks = 0; ks < 2; ++ks) { const bf16x8 kf = *(const bf16x8*)(qk + (size_t)(row0 + nt * 16 + fr) * 512 + 256 + head * 64 + ks * 32 + fq * 8); acc[nt] = mfma16(qf[ks], kf, acc[nt]); }
    }
#pragma unroll
    for (int nt = 0; nt < 8; ++nt)
#pragma unroll
      for (int r = 0; r < 4; ++r) { const int i = wid * 16 + fq * 4 + r, j = nt * 16 + fr; const int dd = i > j ? i - j : j - i;
        Pm[i * VT_LD + j] = f2bf(acc[nt][r] * __expf(lg * (float)dd)); }
    __syncthreads();
    const int irow = wid * 16 + fr;
    const float g1 = __expf(lg * (float)(irow + 1)), g2 = __expf(lg * (float)(128 - irow));
    bf16x8 q1[2], q2[2];
#pragma unroll
    for (int ks = 0; ks < 2; ++ks) { q1[ks] = scale_frag(qf[ks], g1); q2[ks] = scale_frag(qf[ks], g2); }
    bf16x8 pf[4];
#pragma unroll
    for (int ks = 0; ks < 4; ++ks) pf[ks] = *(const LAS bf16x8*)(Pm + irow * VT_LD + ks * 32 + fq * 8);
    const bf16_t* sp = kvf + (size_t)(cidx * 4 + head) * 8192; const bf16_t* sn = kvb + (size_t)(cidx * 4 + head) * 8192;
    float ssq[4] = {0.f, 0.f, 0.f, 0.f};
#pragma unroll
    for (int nt = 0; nt < 8; ++nt) {
      f32x4 a = (f32x4){0.f, 0.f, 0.f, 0.f};
#pragma unroll
      for (int ks = 0; ks < 4; ++ks) { const bf16x8 y = *(const LAS bf16x8*)(vT + (nt * 16 + fr) * VT_LD + ks * 32 + fq * 8); a = mfma16(pf[ks], y, a); }
#pragma unroll
      for (int ks = 0; ks < 2; ++ks) { const bf16x8 y1 = *(const bf16x8*)(sp + (size_t)(nt * 16 + fr) * 64 + ks * 32 + fq * 8); a = mfma16(q1[ks], y1, a);
        const bf16x8 y2 = *(const bf16x8*)(sn + (size_t)(nt * 16 + fr) * 64 + ks * 32 + fq * 8); a = mfma16(q2[ks], y2, a); }
      acc[nt] = a;
#pragma unroll
      for (int r = 0; r < 4; ++r) ssq[r] += a[r] * a[r];
    }
#pragma unroll
    for (int r = 0; r < 4; ++r) { ssq[r] = rowsum16(ssq[r]); ssq[r] = rsqrtf(ssq[r] * (1.0f / 128.0f) + 1e-5f); }
    __syncthreads();
#pragma unroll
    for (int nt = 0; nt < 8; ++nt)
#pragma unroll
      for (int r = 0; r < 4; ++r) {
        const int i = wid * 16 + fq * 4 + r, e = nt * 16 + fr;
        bf16_t* dst = mix + (size_t)(row0 + i) * 1024 + head * 128 + e;
        const float gr = bf2f(dst[512]);
        *dst = f2bf(acc[nt][r] * ssq[r] * gr * sigmoidf_(gr));
      }
  }
}
__device__ __forceinline__ float tanh_fast(float x) { x = fminf(fmaxf(x, -15.f), 15.f); const float e = __expf(2.0f * x); return (e - 1.0f) * rcpf_(e + 1.0f); }
__device__ __forceinline__ f32x4 ld_bf4(const LAS bf16_t* p) { const u32x2 v = *(const LAS u32x2*)p; return (f32x4){bflo(v.x), bfhi(v.x), bflo(v.y), bfhi(v.y)}; }

__device__ __forceinline__ void rwkv_scan_phase(const Params& p, LAS unsigned char* lds) {
  unsigned char* ws = p.ws + opq0_(); unsigned char* r2 = (unsigned char*)p.out + opq0_();
  const bf16_t* prw = (const bf16_t*)(r2 + R2_PRW);
  float* bonus = (float*)(ws + T_BONUS);
  LAS bf16_t* raw = (LAS bf16_t*)lds;
  LAS bf16_t* txw = (LAS bf16_t*)(lds + 21760);
  LAS bf16_t* xab = (LAS bf16_t*)(lds + 26368);
  LAS bf16_t* w2s = (LAS bf16_t*)(lds + 30976);
  LAS bf16_t* a2s = (LAS bf16_t*)(lds + 40192);
  LAS float* pre = (LAS float*)(lds + 49408);
  LAS float* st = (LAS float*)(lds + 65792);
  LAS float* vbuf = (LAS float*)(lds + 106752);
  LAS float* sc = (LAS float*)(lds + 114944);
  LAS float* obuf = (LAS float*)(lds + 115456);
  const int tid = tidx_(), wid = tid >> 6, lane = tid & 63, fr = lane & 15, fq = lane >> 4;
  const float* mu = inp(ws, 10);
  for (int wi = bidx_(); wi < 256; wi += gridDim.x) {
    int dir, seq, head, rbase, NRW, L, rsplit;
    if (wi < 128) { const int chain = wi >> 2; rsplit = wi & 3; dir = chain >> 4; seq = (chain & 15) >> 3; head = chain & 7; NRW = 16; rbase = rsplit * 16; L = LP; }
    else { const int v = wi - 128; const int chain = v >> 1; rsplit = v & 1; dir = chain >> 5; seq = 2 + ((chain & 31) >> 3); head = chain & 7; NRW = 32; rbase = rsplit * 32; L = LS; }
    const int sb = seq_base(seq) + PADR;
    bf16_t* od = (bf16_t*)(ws + (dir ? R1_OB : R1_OF));
    const int nblk = (L + 31) >> 5;
    __syncthreads();
    { const float* w2 = inp(ws, 12) + (size_t)dir * 64 * 512 + head * 64; const float* a2 = inp(ws, 14) + (size_t)dir * 64 * 512 + head * 64;
#pragma unroll
      for (int i = 0; i < 8; ++i) { const int e = tid + i * 512, k = e & 63, r = e >> 6; w2s[k * 72 + r] = f2bf(w2[(size_t)r * 512 + k]); a2s[k * 72 + r] = f2bf(a2[(size_t)r * 512 + k]); } }
    const int kq = tid & 15, k0 = kq * 4, ch0 = head * 64 + k0;
    const f32x4 w0c = *(const f32x4*)(inp(ws, 11) + dir * 512 + ch0), a0c = *(const f32x4*)(inp(ws, 13) + dir * 512 + ch0);
    const f32x4 kkc = *(const f32x4*)(inp(ws, 16) + ch0), kac = *(const f32x4*)(inp(ws, 17) + ch0), rkc = *(const f32x4*)(inp(ws, 18) + ch0);
    const f32x4 mur = *(const f32x4*)(mu + ch0), muk = *(const f32x4*)(mu + 512 + ch0), muv = *(const f32x4*)(mu + 1024 + ch0);
    const int cb = (tid & 15) * 8;
    const f32x4 mub0 = *(const f32x4*)(mu + 1536 + cb), mub1 = *(const f32x4*)(mu + 1536 + cb + 4);
    u32x4 pf[3];
    auto issue = [&](int b) {
      const int ta = dir == 0 ? b * 32 : L - 32 - b * 32;
#pragma unroll
      for (int i = 0; i < 3; ++i) { const int li = tid + i * 512; pf[i] = (u32x4){0u, 0u, 0u, 0u};
        if (li < 1360) { const int ri = li / 40, rem = li % 40, seg = rem >> 3, chk = rem & 7; const int t = ta - 1 + ri;
          const int col = seg < 3 ? seg * 512 + head * 64 : 1536 + (seg - 3) * 64;
          if (t >= 0 && t < L) pf[i] = *(const u32x4*)(prw + (size_t)(sb + t) * 1792 + col + chk * 8); } }
    };
    issue(0);
    const int srow = wid * 4 + fq;
    const bool sactive = wid * 4 < NRW;
    float S0 = 0.f, S1 = 0.f, S2 = 0.f, S3 = 0.f;
    for (int b = 0; b < nblk; ++b) {
      const int ta = dir == 0 ? b * 32 : L - 32 - b * 32;
      const int nst = (L - b * 32) < 32 ? (L - b * 32) : 32;
#pragma unroll
      for (int i = 0; i < 3; ++i) { const int li = tid + i * 512; if (li < 1360) { const int ri = li / 40, rem = li % 40; *(LAS u32x4*)(raw + ri * 320 + rem * 8) = pf[i]; } }
      if (b + 1 < nblk) issue(b + 1);
      __syncthreads();
      { const int tl = tid >> 4, ri = tl + 1;
        const LAS bf16_t* q0 = raw + (ri - 1) * 320 + 192 + cb; const LAS bf16_t* q1 = q0 + 320; const LAS bf16_t* q2 = q1 + 320;
        float x[8];
#pragma unroll
        for (int hh = 0; hh < 2; ++hh) { const f32x4 a = ld_bf4(q0 + hh * 4), c = ld_bf4(q1 + hh * 4), d = ld_bf4(q2 + hh * 4); const f32x4 m = hh ? mub1 : mub0;
#pragma unroll
          for (int j = 0; j < 4; ++j) x[hh * 4 + j] = c[j] + m[j] * (0.5f * (a[j] + d[j]) - c[j]); }
        u32x4 w;
        if (cb < 64) { w.x = pack2(tanh_fast(x[0]), tanh_fast(x[1])); w.y = pack2(tanh_fast(x[2]), tanh_fast(x[3])); w.z = pack2(tanh_fast(x[4]), tanh_fast(x[5])); w.w = pack2(tanh_fast(x[6]), tanh_fast(x[7]));
          *(LAS u32x4*)(txw + tl * 72 + cb) = w; }
        else { w.x = pack2(x[0], x[1]); w.y = pack2(x[2], x[3]); w.z = pack2(x[4], x[5]); w.w = pack2(x[6], x[7]); *(LAS u32x4*)(xab + tl * 72 + cb - 64) = w; } }
      __syncthreads();
      { const int mat = wid >> 2, mt = (wid >> 1) & 1, ntp = wid & 1;
        const LAS bf16_t* X = mat ? xab : txw; const LAS bf16_t* Y = mat ? a2s : w2s;
#pragma unroll
        for (int nn = 0; nn < 2; ++nn) { const int nt = ntp * 2 + nn; f32x4 a = (f32x4){0.f, 0.f, 0.f, 0.f};
#pragma unroll
          for (int ks = 0; ks < 2; ++ks) { const bf16x8 xf = *(const LAS bf16x8*)(X + (mt * 16 + fr) * 72 + ks * 32 + fq * 8); const bf16x8 yf = *(const LAS bf16x8*)(Y + (nt * 16 + fr) * 72 + ks * 32 + fq * 8); a = mfma16(xf, yf, a); }
#pragma unroll
          for (int r = 0; r < 4; ++r) pre[mat * 2048 + (mt * 16 + fq * 4 + r) * 64 + nt * 16 + fr] = a[r]; } }
      __syncthreads();
      { const int tl = tid >> 4, ri = tl + 1, t = ta + tl;
        const LAS bf16_t* q1 = raw + ri * 320 + k0;
        f32x4 xr, xk, xv;
        { const f32x4 a = ld_bf4(q1 - 320), c = ld_bf4(q1), d = ld_bf4(q1 + 320); xr = c + mur * (0.5f * (a + d) - c); }
        { const f32x4 a = ld_bf4(q1 - 320 + 64), c = ld_bf4(q1 + 64), d = ld_bf4(q1 + 320 + 64); xk = c + muk * (0.5f * (a + d) - c); }
        { const f32x4 a = ld_bf4(q1 - 320 + 128), c = ld_bf4(q1 + 128), d = ld_bf4(q1 + 320 + 128); xv = c + muv * (0.5f * (a + d) - c); }
        const f32x4 wp = *(const LAS f32x4*)(pre + tl * 64 + k0), ap = *(const LAS f32x4*)(pre + 2048 + tl * 64 + k0);
        f32x4 w, a, kk, kd, bb, wrr;
        float ss = 0.f;
#pragma unroll
        for (int j = 0; j < 4; ++j) {
          const float wl = w0c[j] + wp[j]; const float ew = 0.60653066f * rcpf_(1.0f + __expf(-wl)); w[j] = __expf(-ew);
          a[j] = rcpf_(1.0f + __expf(-(a0c[j] + ap[j])));
          kk[j] = xk[j] * kkc[j]; ss += kk[j] * kk[j];
          kd[j] = xk[j] * (1.0f + (a[j] - 1.0f) * kac[j]);
          wrr[j] = w[j] * xr[j];
        }
        ss = rowsum16(ss); const float inv = rsqrtf(fmaxf(ss, 1e-24f));
        float br = 0.f, kdr = 0.f, bon = 0.f;
#pragma unroll
        for (int j = 0; j < 4; ++j) { kk[j] *= inv; bb[j] = kk[j] * a[j]; br += bb[j] * xr[j]; kdr += kd[j] * xr[j]; bon += xr[j] * kd[j] * rkc[j]; }
        br = rowsum16(br); kdr = rowsum16(kdr); bon = rowsum16(bon);
        LAS float* s = st + tl * 320 + k0;
        *(LAS f32x4*)(s) = kk; *(LAS f32x4*)(s + 64) = wrr; *(LAS f32x4*)(s + 128) = w; *(LAS f32x4*)(s + 192) = bb; *(LAS f32x4*)(s + 256) = kd;
        *(LAS f32x4*)(vbuf + tl * 64 + k0) = xv;
        if (kq == 0) { sc[tl * 4] = br; sc[tl * 4 + 1] = kdr; if (rsplit == 0 && t >= 0 && t < L) bonus[(size_t)(sb + t) * 16 + dir * 8 + head] = bon; } }
      __syncthreads();
      if (sactive) {
        int tl = dir ? 31 : 0;
        const LAS float* sp = st + tl * 320 + fr * 4;
        f32x4 kk = *(const LAS f32x4*)(sp), wr4 = *(const LAS f32x4*)(sp + 64), w4 = *(const LAS f32x4*)(sp + 128), b4 = *(const LAS f32x4*)(sp + 192), kd4 = *(const LAS f32x4*)(sp + 256);
        float vv = vbuf[tl * 64 + rbase + srow], br = sc[tl * 4], kdr = sc[tl * 4 + 1];
        for (int s = 0; s < nst; ++s) {
          const int tln = s + 1 < nst ? (dir ? 30 - s : s + 1) : tl;
          const LAS float* spn = st + tln * 320 + fr * 4;
          const f32x4 kkn = *(const LAS f32x4*)(spn), wrn = *(const LAS f32x4*)(spn + 64), wn = *(const LAS f32x4*)(spn + 128), bn = *(const LAS f32x4*)(spn + 192), kdn = *(const LAS f32x4*)(spn + 256);
          const float vvn = vbuf[tln * 64 + rbase + srow], brn = sc[tln * 4], kdrn = sc[tln * 4 + 1];
          float skp = (S0 * kk[0] + S1 * kk[1]) + (S2 * kk[2] + S3 * kk[3]);
          float pp = (S0 * wr4[0] + S1 * wr4[1]) + (S2 * wr4[2] + S3 * wr4[3]);
          const float sk = rowsum16(skp), pt = rowsum16(pp);
          S0 = S0 * w4[0] - sk * b4[0] + vv * kd4[0]; S1 = S1 * w4[1] - sk * b4[1] + vv * kd4[1];
          S2 = S2 * w4[2] - sk * b4[2] + vv * kd4[2]; S3 = S3 * w4[3] - sk * b4[3] + vv * kd4[3];
          if (fr == 0) obuf[tl * 32 + srow] = pt - sk * br + vv * kdr;
          kk = kkn; wr4 = wrn; w4 = wn; b4 = bn; kd4 = kdn; vv = vvn; br = brn; kdr = kdrn; tl = tln;
        }
      }
      __syncthreads();
#pragma unroll
      for (int i = 0; i < 2; ++i) { const int e = tid + i * 512, tl = e >> 5, rw = e & 31, t = ta + tl;
        if (rw < NRW && t >= 0 && t < L) od[(size_t)(sb + t) * 512 + head * 64 + rbase + rw] = f2bf(obuf[tl * 32 + rw]); }
    }
  }
}

__device__ __forceinline__ float rowsum8p(float v) { v += dppf<0xB1>(v); v += dppf<0x4E>(v); v += dppf<0x141>(v); return v; }
__device__ __forceinline__ void unpack8p(const u32x4 v, float (&o)[8]) { o[0] = bflo(v.x); o[1] = bfhi(v.x); o[2] = bflo(v.y); o[3] = bfhi(v.y); o[4] = bflo(v.z); o[5] = bfhi(v.z); o[6] = bflo(v.w); o[7] = bfhi(v.w); }
__device__ __forceinline__ void rwkv_post_phase(const Params& p, LAS unsigned char* lds) {
  unsigned char* ws = p.ws + opq0_(); unsigned char* r2 = (unsigned char*)p.out + opq0_();
  const bf16_t* prw = (const bf16_t*)(r2 + R2_PRW);
  const bf16_t* of = (const bf16_t*)(ws + R1_OF); const bf16_t* ob = (const bf16_t*)(ws + R1_OB);
  const float* bonus = (const float*)(ws + T_BONUS); const bf16_t* g2t = (const bf16_t*)(ws + T_G2T);
  bf16_t* mix = (bf16_t*)(ws + R1_MIX);
  const float* mu = inp(ws, 10); const float* lnw = inp(ws, 19); const float* lnb = inp(ws, 20);
  LAS bf16_t* sg = (LAS bf16_t*)lds;
  LAS float* gbuf = (LAS float*)(lds + 34816);
  const int tid = tidx_(), wid = tid >> 6, lane = tid & 63, fr = lane & 15, fq = lane >> 4;
  const int G = gdim_();
  for (int wjob = bidx_(); wjob < 256 + 48; wjob += G) {
    const int tile = wjob < 256 ? wjob : 256 + ((wjob - 256) >> 3); const int hd0 = wjob < 256 ? 0 : ((wjob - 256) & 7), hd1 = wjob < 256 ? 8 : hd0 + 1;
    const int row0 = tile * 128;
    __syncthreads();
    { const int tr = tid >> 2, c0 = (tid & 3) * 32, row = row0 + tr; int seq, pos, L; row_info(row, seq, pos, L);
      const bool hasp = pos > 0, hasn = pos >= 0 && pos < L - 1;
      const bf16_t* pc = prw + (size_t)row * 1792 + 1664 + c0;
#pragma unroll
      for (int q = 0; q < 4; ++q) {
        const u32x4 c = *(const u32x4*)(pc + q * 8); u32x4 a = (u32x4){0u, 0u, 0u, 0u}, d = (u32x4){0u, 0u, 0u, 0u};
        if (hasp) a = *(const u32x4*)(pc - 1792 + q * 8);
        if (hasn) d = *(const u32x4*)(pc + 1792 + q * 8);
        float cv[8], av[8], dv[8]; unpack8p(c, cv); unpack8p(a, av); unpack8p(d, dv);
        const f32x4 m0 = *(const f32x4*)(mu + 1664 + c0 + q * 8), m1 = *(const f32x4*)(mu + 1664 + c0 + q * 8 + 4);
        float x[8];
#pragma unroll
        for (int j = 0; j < 8; ++j) { const float m = j < 4 ? m0[j & 3] : m1[j & 3]; x[j] = sigmoidf_(cv[j] + m * (0.5f * (av[j] + dv[j]) - cv[j])); }
        *(LAS u32x4*)(sg + tr * VT_LD + c0 + q * 8) = (u32x4){pack2(x[0], x[1]), pack2(x[2], x[3]), pack2(x[4], x[5]), pack2(x[6], x[7])};
      } }
    __syncthreads();
    bf16x8 xf[4];
#pragma unroll
    for (int ks = 0; ks < 4; ++ks) xf[ks] = *(const LAS bf16x8*)(sg + (wid * 16 + fr) * VT_LD + ks * 32 + fq * 8);
    const int ch = tid & 7;
#pragma unroll 1
    for (int hd = hd0; hd < hd1; ++hd) {
      LAS float* gb = gbuf + (hd & 1) * (128 * 68);
#pragma unroll
      for (int nt = 0; nt < 4; ++nt) { f32x4 g = (f32x4){0.f, 0.f, 0.f, 0.f};
#pragma unroll
        for (int ks = 0; ks < 4; ++ks) { const bf16x8 yf = *(const bf16x8*)(g2t + (size_t)(hd * 64 + nt * 16 + fr) * 128 + ks * 32 + fq * 8); g = mfma16(xf[ks], yf, g); }
#pragma unroll
        for (int r = 0; r < 4; ++r) gb[(wid * 16 + fq * 4 + r) * 68 + nt * 16 + fr] = g[r]; }
      __syncthreads();
      const int cg = hd * 64 + ch * 8;
      const f32x4 w0 = *(const f32x4*)(lnw + cg), w1 = *(const f32x4*)(lnw + cg + 4), b0 = *(const f32x4*)(lnb + cg), b1 = *(const f32x4*)(lnb + cg + 4);
      const f32x4 mv0 = *(const f32x4*)(mu + 1024 + cg), mv1 = *(const f32x4*)(mu + 1024 + cg + 4);
#pragma unroll
      for (int i = 0; i < 2; ++i) {
        const int tk = (tid >> 3) + i * 64, row = row0 + tk; int seq, pos, L; row_info(row, seq, pos, L);
        u32x4 res = (u32x4){0u, 0u, 0u, 0u};
        if (pos >= 0) {
          float o1[8], o2[8], o[8];
          unpack8p(*(const u32x4*)(of + (size_t)row * 512 + cg), o1); unpack8p(*(const u32x4*)(ob + (size_t)row * 512 + cg), o2);
          float sum = 0.f;
#pragma unroll
          for (int j = 0; j < 8; ++j) { o[j] = o1[j] + o2[j]; sum += o[j]; }
          sum = rowsum8p(sum); const float mean = sum * (1.0f / 64.0f);
          float vs = 0.f;
#pragma unroll
          for (int j = 0; j < 8; ++j) { const float d = o[j] - mean; vs += d * d; }
          vs = rowsum8p(vs); const float rstd = rsqrtf(vs * (1.0f / 64.0f) + 64e-5f);
          const float bsc = 0.5f * (bonus[(size_t)row * 16 + hd] + bonus[(size_t)row * 16 + 8 + hd]);
          const bf16_t* pv = prw + (size_t)row * 1792 + 1024 + cg;
          float vc[8], va[8], vd[8];
          unpack8p(*(const u32x4*)pv, vc);
          u32x4 ua = (u32x4){0u, 0u, 0u, 0u}, ud = (u32x4){0u, 0u, 0u, 0u};
          if (pos > 0) ua = *(const u32x4*)(pv - 1792);
          if (pos < L - 1) ud = *(const u32x4*)(pv + 1792);
          unpack8p(ua, va); unpack8p(ud, vd);
          const f32x4 g0 = *(const LAS f32x4*)(gb + tk * 68 + ch * 8), g1 = *(const LAS f32x4*)(gb + tk * 68 + ch * 8 + 4);
          float y[8];
#pragma unroll
          for (int j = 0; j < 8; ++j) { const float lw = j < 4 ? w0[j & 3] : w1[j & 3], lb = j < 4 ? b0[j & 3] : b1[j & 3], mm = j < 4 ? mv0[j & 3] : mv1[j & 3], gg = j < 4 ? g0[j & 3] : g1[j & 3];
            const float xv = vc[j] + mm * (0.5f * (va[j] + vd[j]) - vc[j]);
            y[j] = ((o[j] - mean) * rstd * lw + lb + bsc * xv) * gg; }
          res = (u32x4){pack2(y[0], y[1]), pack2(y[2], y[3]), pack2(y[4], y[5]), pack2(y[6], y[7])};
        }
        *(u32x4*)(mix + (size_t)row * 1024 + 512 + cg) = res;
      }
    }
  }
}
__device__ __forceinline__ f32x4 g_bf4(const bf16_t* p) { const u32x2 v = *(const u32x2*)p; return (f32x4){bflo(v.x), bfhi(v.x), bflo(v.y), bfhi(v.y)}; }
__device__ __forceinline__ void unpack8(const u32x4 v, float (&o)[8]) { o[0] = bflo(v.x); o[1] = bfhi(v.x); o[2] = bflo(v.y); o[3] = bfhi(v.y); o[4] = bflo(v.z); o[5] = bfhi(v.z); o[6] = bflo(v.w); o[7] = bfhi(v.w); }
__device__ __forceinline__ float rowsum8(float v) { v += dppf<0xB1>(v); v += dppf<0x4E>(v); v += dppf<0x141>(v); return v; }

constexpr size_t R2_XWA = (size_t)MROWS * 1792 * 2;
static_assert(R2_XWA + (size_t)MROWS * 128 * 2 <= SZ_OUT, "xwa");
__device__ __forceinline__ void xwa_phase(const Params& p) {
  unsigned char* ws = p.ws + opq0_(); unsigned char* r2 = (unsigned char*)p.out + opq0_();
  const bf16_t* prw = (const bf16_t*)(r2 + R2_PRW); bf16_t* xwa = (bf16_t*)(r2 + R2_XWA);
  const float* mu = inp(ws, 10);
  const int gt = bidx_() * 512 + tidx_(), ngt = gdim_() * 512;
  for (int it = gt; it < MROWS * 16; it += ngt) {
    const int row = it >> 4, cb = (it & 15) * 8; int seq, pos, L; row_info(row, seq, pos, L);
    u32x4 o = (u32x4){0u, 0u, 0u, 0u};
    if (pos >= 0) {
      const bf16_t* pc = prw + (size_t)row * 1792 + 1536 + cb;
      u32x4 ua = (u32x4){0u, 0u, 0u, 0u}, ud = (u32x4){0u, 0u, 0u, 0u}; const u32x4 uc = *(const u32x4*)pc;
      if (pos > 0) ua = *(const u32x4*)(pc - 1792);
      if (pos < L - 1) ud = *(const u32x4*)(pc + 1792);
      float a[8], c[8], d[8], x[8]; unpack8(ua, a); unpack8(uc, c); unpack8(ud, d);
      const f32x4 m0 = *(const f32x4*)(mu + 1536 + cb), m1 = *(const f32x4*)(mu + 1536 + cb + 4);
#pragma unroll
      for (int j = 0; j < 8; ++j) { const float m = j < 4 ? m0[j & 3] : m1[j & 3]; x[j] = c[j] + m * (0.5f * (a[j] + d[j]) - c[j]); if (cb < 64) x[j] = tanh_fast(x[j]); }
      o = (u32x4){pack2(x[0], x[1]), pack2(x[2], x[3]), pack2(x[4], x[5]), pack2(x[6], x[7])};
    }
    *(u32x4*)(xwa + (size_t)row * 128 + cb) = o;
  }
}

static_assert(LP % 32 == 16 && LS % 32 == 16, "scan half-blocks assume 16-step halves");
__device__ __forceinline__ void rwkv_scan2_phase(const Params& p, LAS unsigned char* lds) {
  unsigned char* ws = p.ws + opq0_(); unsigned char* r2 = (unsigned char*)p.out + opq0_();
  const bf16_t* prw = (const bf16_t*)(r2 + R2_PRW);
  float* bonus = (float*)(ws + T_BONUS);
  LAS bf16_t* w2s = (LAS bf16_t*)(lds + 0);
  LAS bf16_t* a2s = (LAS bf16_t*)(lds + 9216);
  LAS float* pre = (LAS float*)(lds + 18432);
  LAS float* cst = (LAS float*)(lds + 34816);
  LAS float* stb = (LAS float*)(lds + 36864);
  LAS float* vbb = (LAS float*)(lds + 118784);
  LAS float* scb = (LAS float*)(lds + 124928);
  LAS float* ppb = (LAS float*)(lds + 126464);
  LAS float* skb = (LAS float*)(lds + 142848);
  const int tid = tidx_(), wid = tid >> 6, lane = tid & 63, fr = lane & 15, fq = lane >> 4;
  const float* mu = inp(ws, 10);
  const bool producer = wid >= 4;
  const int pw = wid - 4, ptid = tid - 256;
  const int G = gdim_();
  for (int slot = bidx_(); slot < 256; slot += G) {
    const int nitems = slot < 128 ? 1 : 2;
    for (int itx = 0; itx < nitems; ++itx) {
      int dir, seq, head, rsplit, L;
      if (slot < 128) { const int chain = slot >> 2; rsplit = slot & 3; dir = chain >> 4; seq = (chain & 15) >> 3; head = chain & 7; L = LP; }
      else { const int v = (slot - 128) * 2 + itx; const int chain = v >> 2; rsplit = v & 3; dir = chain >> 5; seq = 2 + ((chain & 31) >> 3); head = chain & 7; L = LS; }
      const int rbase = rsplit * 16;
      const int sb = seq_base(seq) + PADR;
      bf16_t* od = (bf16_t*)(ws + (dir ? R1_OB : R1_OF));
      const int nblk = (L + 31) >> 5;
      __syncthreads();
      { const float* w2 = inp(ws, 12) + (size_t)dir * 64 * 512 + head * 64; const float* a2 = inp(ws, 14) + (size_t)dir * 64 * 512 + head * 64;
#pragma unroll
        for (int i = 0; i < 8; ++i) { const int e = tid + i * 512, k = e & 63, r = e >> 6; w2s[k * 72 + r] = f2bf(w2[(size_t)r * 512 + k]); a2s[k * 72 + r] = f2bf(a2[(size_t)r * 512 + k]); }
        { const int v = tid >> 6, k = tid & 63, c = head * 64 + k; float x;
          switch (v) { case 0: x = inp(ws, 11)[dir * 512 + c]; break; case 1: x = inp(ws, 13)[dir * 512 + c]; break; case 2: x = inp(ws, 16)[c]; break; case 3: x = inp(ws, 17)[c]; break;
                       case 4: x = inp(ws, 18)[c]; break; case 5: x = mu[c]; break; case 6: x = mu[512 + c]; break; default: x = mu[1024 + c]; break; }
          cst[v * 64 + k] = x; } }
      __syncthreads();
      u32x4 px[2][2], pd[3][3];
      const bf16_t* xwa = (const bf16_t*)(r2 + R2_XWA);
      const int dt = pw * 8 + (lane >> 3), dk0 = (lane & 7) * 8;
      auto issue_x = [&](int b) {
        const int ta = dir == 0 ? b * 32 : L - 32 - b * 32; const int t = ta + pw * 8 + (fr & 7);
#pragma unroll
        for (int mat = 0; mat < 2; ++mat)
#pragma unroll
          for (int ks = 0; ks < 2; ++ks) { px[mat][ks] = (u32x4){0u, 0u, 0u, 0u};
            if (t >= 0 && t < L) px[mat][ks] = *(const u32x4*)(xwa + (size_t)(sb + t) * 128 + mat * 64 + ks * 32 + fq * 8); }
      };
      auto issue_d = [&](int b) {
        const int ta = dir == 0 ? b * 32 : L - 32 - b * 32;
#pragma unroll
        for (int sg = 0; sg < 3; ++sg)
#pragma unroll
          for (int rr = 0; rr < 3; ++rr) { const int t = ta + dt - 1 + rr; pd[sg][rr] = (u32x4){0u, 0u, 0u, 0u};
            if (t >= 0 && t < L) pd[sg][rr] = *(const u32x4*)(prw + (size_t)(sb + t) * 1792 + sg * 512 + head * 64 + dk0); }
      };
      if (producer) { issue_x(0); issue_d(0); }
      const int srow = wid * 4 + fq;
      f32x2_t S01 = {0.f, 0.f}, S23 = {0.f, 0.f};
      for (int b = -1; b <= nblk; ++b) {
        const int cur = b & 1, nxt = cur ^ 1;
        const int nst = (b >= 0 && b < nblk) ? ((L - b * 32) < 32 ? (L - b * 32) : 32) : 0;
        if (!producer) {
          if (nst > 0) {
            const LAS float* st = stb + cur * 10240; const LAS float* vb = vbb + (b % 3) * 512;
            LAS float* ppw = ppb + cur * 2048 + srow * 4 + (fr >> 2); LAS float* skw = skb + cur * 512 + srow;
            f32x4 kkA, wrA, wA, bA, kdA, kkB, wrB, wB, bB, kdB; float vvA, vvB;
#define LOADR(X, s_) do { const int tl_ = dir ? 31 - (s_) : (s_); const LAS float* sp_ = st + tl_ * 320 + fr * 4; kk##X = *(const LAS f32x4*)(sp_); wr##X = *(const LAS f32x4*)(sp_ + 64); w##X = *(const LAS f32x4*)(sp_ + 128); \
                          b##X = *(const LAS f32x4*)(sp_ + 192); kd##X = *(const LAS f32x4*)(sp_ + 256); vv##X = vb[tl_ * 16 + srow]; } while (0)
#define STEPR(X, s_) do { const f32x2_t ts_ = __builtin_elementwise_fma(S23, kk##X.hi, S01 * kk##X.lo); const f32x2_t tp_ = __builtin_elementwise_fma(S23, wr##X.hi, S01 * wr##X.lo); \
                          const float sk_ = rowsum16(ts_.x + ts_.y); float pp_ = tp_.x + tp_.y; pp_ += dppf<0xB1>(pp_); pp_ += dppf<0x4E>(pp_); \
                          const f32x2_t nsk_ = {-sk_, -sk_}, vv2_ = {vv##X, vv##X}; \
                          S01 = __builtin_elementwise_fma(vv2_, kd##X.lo, __builtin_elementwise_fma(nsk_, b##X.lo, S01 * w##X.lo)); \
                          S23 = __builtin_elementwise_fma(vv2_, kd##X.hi, __builtin_elementwise_fma(nsk_, b##X.hi, S23 * w##X.hi)); \
                          ppw[(s_) * 64] = pp_; skw[(s_) * 16] = sk_; } while (0)
            const int np = nst >> 1;
            LOADR(A, 0);
            for (int i = 0; i < np; ++i) {
              const int s = 2 * i;
              LOADR(B, s + 1);
              STEPR(A, s);
              LOADR(A, i < np - 1 ? s + 2 : s + 1);
              STEPR(B, s + 1);
            }
#undef LOADR
#undef STEPR
          }
        } else {
          const int fb = b - 1;
          if (fb >= 0 && fb < nblk) {
            const int nstp = (L - fb * 32) < 32 ? (L - fb * 32) : 32; const int tap = dir == 0 ? fb * 32 : L - 32 - fb * 32; const int f3i = fb % 3;
#pragma unroll
            for (int i = 0; i < 2; ++i) { const int e = ptid + i * 256, sl = e >> 4, rw = e & 15;
              if (sl < nstp) {
                const int tl = dir ? 31 - sl : sl; const int t = tap + tl;
                const f32x4 q = *(const LAS f32x4*)(ppb + nxt * 2048 + (sl * 16 + rw) * 4); const float sk = skb[nxt * 512 + sl * 16 + rw];
                const float o = ((q[0] + q[1]) + (q[2] + q[3])) - sk * scb[f3i * 128 + tl * 4] + vbb[f3i * 512 + tl * 16 + rw] * scb[f3i * 128 + tl * 4 + 1];
                od[(size_t)(sb + t) * 512 + head * 64 + rbase + rw] = f2bf(o);
              } }
          }
          const int bn = b + 1;
          if (bn < nblk) {
            const int ta = dir == 0 ? bn * 32 : L - 32 - bn * 32; const int n3i = bn % 3;
            LAS float* prew = pre + pw * 1024;
            const int tloc = lane >> 3, tl = pw * 8 + tloc, t = ta + tl;
            LAS float* s = stb + nxt * 10240 + tl * 320 + dk0;
#pragma unroll
            for (int mat = 0; mat < 2; ++mat) { const LAS bf16_t* Y = mat ? a2s : w2s;
#pragma unroll
              for (int nt = 0; nt < 4; ++nt) { f32x4 a = (f32x4){0.f, 0.f, 0.f, 0.f};
#pragma unroll
                for (int ks = 0; ks < 2; ++ks) { const bf16x8 yf = *(const LAS bf16x8*)(Y + (nt * 16 + fr) * 72 + ks * 32 + fq * 8); a = mfma16(__builtin_bit_cast(bf16x8, px[mat][ks]), yf, a); }
                if (fq < 2) {
#pragma unroll
                  for (int r = 0; r < 4; ++r) prew[mat * 512 + (fq * 4 + r) * 64 + nt * 16 + fr] = a[r]; } } }
            float xk[8];
            { float a[8], c[8], d[8]; unpack8(pd[1][0], a); unpack8(pd[1][1], c); unpack8(pd[1][2], d);
#pragma unroll
              for (int j = 0; j < 8; ++j) xk[j] = c[j] + cst[6 * 64 + dk0 + j] * (0.5f * (a[j] + d[j]) - c[j]); }
            float ss = 0.f;
#pragma unroll
            for (int j = 0; j < 8; ++j) { const float q = xk[j] * cst[2 * 64 + dk0 + j]; ss += q * q; }
            ss = rowsum8(ss); const float inv = rsqrtf(fmaxf(ss, 1e-24f));
            float br = 0.f, kdr = 0.f, bon = 0.f;
#pragma unroll
            for (int hh = 0; hh < 2; ++hh) {
              asm volatile("" ::: "memory");
              f32x4 xr4;
              { const u32x4 ua = pd[0][0], uc = pd[0][1], ud = pd[0][2];
                const unsigned a0 = hh ? ua.z : ua.x, a1 = hh ? ua.w : ua.y, c0 = hh ? uc.z : uc.x, c1 = hh ? uc.w : uc.y, d0 = hh ? ud.z : ud.x, d1 = hh ? ud.w : ud.y;
                const float av[4] = {bflo(a0), bfhi(a0), bflo(a1), bfhi(a1)}, cv[4] = {bflo(c0), bfhi(c0), bflo(c1), bfhi(c1)}, dv[4] = {bflo(d0), bfhi(d0), bflo(d1), bfhi(d1)};
#pragma unroll
                for (int j = 0; j < 4; ++j) xr4[j] = cv[j] + cst[5 * 64 + dk0 + hh * 4 + j] * (0.5f * (av[j] + dv[j]) - cv[j]); }
              f32x4 w4, kk4, kd4, bb4, wr4;
#pragma unroll
              for (int j = 0; j < 4; ++j) { const int kx = dk0 + hh * 4 + j; const float xkj = xk[hh * 4 + j];
                const float wl = cst[0 * 64 + kx] + prew[tloc * 64 + kx]; const float ew = 0.60653066f * rcpf_(1.0f + __expf(-wl)); w4[j] = __expf(-ew);
                const float aj = rcpf_(1.0f + __expf(-(cst[1 * 64 + kx] + prew[512 + tloc * 64 + kx])));
                kk4[j] = xkj * cst[2 * 64 + kx] * inv; kd4[j] = xkj * (1.0f + (aj - 1.0f) * cst[3 * 64 + kx]); bb4[j] = kk4[j] * aj; wr4[j] = w4[j] * xr4[j];
                br += bb4[j] * xr4[j]; kdr += kd4[j] * xr4[j]; bon += xr4[j] * kd4[j] * cst[4 * 64 + kx]; }
              *(LAS f32x4*)(s + hh * 4) = kk4; *(LAS f32x4*)(s + 64 + hh * 4) = wr4; *(LAS f32x4*)(s + 128 + hh * 4) = w4; *(LAS f32x4*)(s + 192 + hh * 4) = bb4; *(LAS f32x4*)(s + 256 + hh * 4) = kd4;
            }
            br = rowsum8(br); kdr = rowsum8(kdr); bon = rowsum8(bon);
            float xv[8];
            { float a[8], c[8], d[8]; unpack8(pd[2][0], a); unpack8(pd[2][1], c); unpack8(pd[2][2], d);
#pragma unroll
              for (int j = 0; j < 8; ++j) xv[j] = c[j] + cst[7 * 64 + dk0 + j] * (0.5f * (a[j] + d[j]) - c[j]); }
            if (dk0 >= rbase && dk0 < rbase + 16) {
              LAS float* vd = vbb + n3i * 512 + tl * 16 + (dk0 - rbase);
              *(LAS f32x4*)(vd) = (f32x4){xv[0], xv[1], xv[2], xv[3]}; *(LAS f32x4*)(vd + 4) = (f32x4){xv[4], xv[5], xv[6], xv[7]};
            }
            if ((lane & 7) == 0) { LAS float* scn = scb + n3i * 128; scn[tl * 4] = br; scn[tl * 4 + 1] = kdr; if (rsplit == 0 && t >= 0 && t < L) bonus[(size_t)(sb + t) * 16 + dir * 8 + head] = bon; }
            if (b + 2 < nblk) { issue_x(b + 2); issue_d(b + 2); }
          }
        }
        __syncthreads();
      }
    }
  }
}
__device__ __forceinline__ void conv_phase(const Params& p) {
  unsigned char* ws = p.ws + opq0_();
  bf16_t* mix = (bf16_t*)(ws + R1_MIX); const bf16_t* ub = (const bf16_t*)(ws + R1_U); const float* cw = inp(ws, 32);
  const int gt = bidx_() * 512 + tidx_(), ngt = gridDim.x * 512;
  for (int it = gt; it < MROWS * 64; it += ngt) {
    const int row = it >> 6, c0 = (it & 63) * 8; int seq, pos, L; row_info(row, seq, pos, L);
    u32x4 o = (u32x4){0u, 0u, 0u, 0u};
    bf16_t* dst = mix + (size_t)row * 1024 + 512 + c0;
    if (pos >= 0) {
      const bf16_t* up = ub + (size_t)row * 512 + c0;
      const u32x4 pb = *(const u32x4*)dst, c = *(const u32x4*)up; u32x4 a = (u32x4){0u, 0u, 0u, 0u}, d = (u32x4){0u, 0u, 0u, 0u};
      if (pos > 0) a = *(const u32x4*)(up - 512);
      if (pos < L - 1) d = *(const u32x4*)(up + 512);
      const unsigned pw[4] = {pb.x, pb.y, pb.z, pb.w}, cw4[4] = {c.x, c.y, c.z, c.w}, aw[4] = {a.x, a.y, a.z, a.w}, dw[4] = {d.x, d.y, d.z, d.w}; unsigned ow[4];
#pragma unroll
      for (int t = 0; t < 4; ++t) { const int cc = c0 + t * 2;
        const float y0 = cw[cc] * bflo(aw[t]) + cw[512 + cc] * bflo(cw4[t]) + cw[1024 + cc] * bflo(dw[t]);
        const float y1 = cw[cc + 1] * bfhi(aw[t]) + cw[512 + cc + 1] * bfhi(cw4[t]) + cw[1024 + cc + 1] * bfhi(dw[t]);
        ow[t] = pack2(bflo(pw[t]) * y0, bfhi(pw[t]) * y1); }
      o = (u32x4){ow[0], ow[1], ow[2], ow[3]};
    }
    *(u32x4*)dst = o;
  }
}

__constant__ float C16[16] = {1.f, 0.92387953f, 0.70710678f, 0.38268343f, 0.f, -0.38268343f, -0.70710678f, -0.92387953f, -1.f, -0.92387953f, -0.70710678f, -0.38268343f, 0.f, 0.38268343f, 0.70710678f, 0.92387953f};
__constant__ float S16[16] = {0.f, 0.38268343f, 0.70710678f, 0.92387953f, 1.f, 0.92387953f, 0.70710678f, 0.38268343f, 0.f, -0.38268343f, -0.70710678f, -0.92387953f, -1.f, -0.92387953f, -0.70710678f, -0.38268343f};
__device__ __forceinline__ void f2_phase(const Params& p) {
  unsigned char* ws = p.ws + opq0_(); unsigned char* r2 = (unsigned char*)p.out + opq0_();
  const int gt = bidx_() * 512 + tidx_(), ngt = gridDim.x * 512;
  constexpr int NPI = 2 * 512 * 513, NSI = 4 * 512 * 257;
  for (int it = gt; it < NPI + NSI; it += ngt) {
    int grp, n2, c, sl, N2, L, NN;
    if (it < NPI) { grp = 0; N2 = 513; L = LP; NN = 1024; n2 = it % 513; const int q = it / 513; c = q & 511; sl = q >> 9; }
    else { const int v = it - NPI; grp = 1; N2 = 257; L = LS; NN = 2048; n2 = v % 257; const int q = v / 257; c = q & 511; sl = q >> 9; }
    const bf16_t* wt = (const bf16_t*)(r2 + (grp ? R2_WTS : R2_WT)) + (size_t)sl * 1024 * L;
    const bf16_t* pr = wt + (size_t)c * L + n2; const bf16_t* pi = wt + (size_t)(512 + c) * L + n2;
    float re[16], im[16];
#pragma unroll
    for (int n1 = 0; n1 < 16; ++n1) { re[n1] = bf2f(pr[n1 * N2]); im[n1] = bf2f(pi[n1 * N2]); }
    const float* tw = (const float*)(ws + (grp ? T_TWS : T_TWP));
    const int ni = sl * 512 + c; const int Kd = 2 * (N2 - 1);
    bf16_t* btf = grp ? (bf16_t*)(ws + R1_BTFS) : (bf16_t*)(r2 + R2_BTFP);
    float* tv = (float*)(ws + T_TAILV) + (grp ? 32768 : 0);
    float Ar[4][4], Ai[4][4];
#pragma unroll
    for (int b = 0; b < 4; ++b) {
      const float x0r = re[b], x0i = im[b], x1r = re[4 + b], x1i = im[4 + b], x2r = re[8 + b], x2i = im[8 + b], x3r = re[12 + b], x3i = im[12 + b];
      const float s02r = x0r + x2r, s02i = x0i + x2i, d02r = x0r - x2r, d02i = x0i - x2i, s13r = x1r + x3r, s13i = x1i + x3i, d13r = x1r - x3r, d13i = x1i - x3i;
      Ar[0][b] = s02r + s13r; Ai[0][b] = s02i + s13i;
      Ar[2][b] = s02r - s13r; Ai[2][b] = s02i - s13i;
      Ar[1][b] = d02r + d13i; Ai[1][b] = d02i - d13r;
      Ar[3][b] = d02r - d13i; Ai[3][b] = d02i + d13r;
    }
#pragma unroll
    for (int c = 1; c < 4; ++c)
#pragma unroll
      for (int b = 1; b < 4; ++b) { const float cc = C16[(c * b) & 15], ss = S16[(c * b) & 15]; const float xr = Ar[c][b], xi = Ai[c][b]; Ar[c][b] = xr * cc + xi * ss; Ai[c][b] = xi * cc - xr * ss; }
#pragma unroll
    for (int c = 0; c < 4; ++c) {
      const float x0r = Ar[c][0], x0i = Ai[c][0], x1r = Ar[c][1], x1i = Ai[c][1], x2r = Ar[c][2], x2i = Ai[c][2], x3r = Ar[c][3], x3i = Ai[c][3];
      const float s02r = x0r + x2r, s02i = x0i + x2i, d02r = x0r - x2r, d02i = x0i - x2i, s13r = x1r + x3r, s13i = x1i + x3i, d13r = x1r - x3r, d13i = x1i - x3i;
      float Or[4], Oi[4];
      Or[0] = s02r + s13r; Oi[0] = s02i + s13i; Or[2] = s02r - s13r; Oi[2] = s02i - s13i;
      Or[1] = d02r + d13i; Oi[1] = d02i - d13r; Or[3] = d02r - d13i; Oi[3] = d02i + d13r;
#pragma unroll
      for (int d = 0; d < 4; ++d) {
        const int k1 = c + 4 * d; const float orr = Or[d], oii = Oi[d];
        const float tc = tw[(k1 * N2 + n2) * 2], ts = tw[(k1 * N2 + n2) * 2 + 1];
        const float ar = tc * orr + ts * oii, ai = tc * oii - ts * orr;
        if (n2 < N2 - 1) { bf16_t* dd = btf + ((size_t)k1 * NN + ni) * Kd + n2; dd[0] = f2bf(ar); dd[N2 - 1] = f2bf(ai); }
        else { float* dd = tv + ((size_t)k1 * NN + ni) * 2; dd[0] = ar; dd[1] = ai; }
      }
    }
  }
}

__device__ __forceinline__ void f3_tail_phase(const Params& p) {
  unsigned char* ws = p.ws + opq0_(); unsigned char* r2 = (unsigned char*)p.out + opq0_();
  bf16_t* mix = (bf16_t*)(ws + R1_MIX); const float* tc = (const float*)(ws + T_TAILC);
  const int lane = tidx_() & 63, gw = bidx_() * 8 + (tidx_() >> 6), nw = gridDim.x * 8;
  for (int it = gw; it < 16 * 1024 + 16 * 2048; it += nw) {
    int grp, k1, ni, N2, NN; if (it < 16384) { grp = 0; k1 = it >> 10; ni = it & 1023; N2 = 513; NN = 1024; } else { const int v = it - 16384; grp = 1; k1 = v >> 11; ni = v & 2047; N2 = 257; NN = 2048; }
    const int H = N2 - 1, Kd = 2 * H;
    const bf16_t* b = (grp ? (const bf16_t*)(ws + R1_BTFS) : (const bf16_t*)(r2 + R2_BTFP)) + ((size_t)k1 * NN + ni) * Kd;
    const float* arc = tc + (grp ? TC_ARCS : TC_ARCP); const float* ars = tc + (grp ? TC_ARSS : TC_ARSP);
    float acc = 0.f;
    if (lane * 8 < H) {
      const u32x4 vr = *(const u32x4*)(b + lane * 8), vi = *(const u32x4*)(b + H + lane * 8);
      const unsigned rw[4] = {vr.x, vr.y, vr.z, vr.w}, iw[4] = {vi.x, vi.y, vi.z, vi.w};
#pragma unroll
      for (int t = 0; t < 4; ++t) { const int n2 = lane * 8 + t * 2;
        acc += arc[n2] * bflo(rw[t]) + arc[n2 + 1] * bfhi(rw[t]) + ars[n2] * bflo(iw[t]) + ars[n2 + 1] * bfhi(iw[t]); }
    }
#pragma unroll
    for (int o = 32; o >= 1; o >>= 1) acc += shx(acc, o, lane);
    if (lane == 0) {
      const float* tv = (const float*)(ws + T_TAILV) + (grp ? 32768 : 0) + ((size_t)k1 * NN + ni) * 2;
      acc += arc[H] * tv[0] + ars[H] * tv[1];
      const float scale = grp ? rsqrtf(128.0f * LS) : rsqrtf(128.0f * LP);
      const int sl = ni >> 9, c = ni & 511, pos = k1 + 16 * H;
      const int row = (grp ? 2 * LPP + sl * LPS : sl * LPP) + PADR + pos;
      mix[(size_t)row * 1024 + c] = f2bf(acc * scale);
    }
  }
}

__device__ __forceinline__ void final_phase(const Params& p) {
  unsigned char* ws = p.ws + opq0_(); const bf16_t* h = (const bf16_t*)(ws + OFF_H); const float* rowsq = (const float*)(ws + T_ROWSQ); const float* g = inp(ws, 37);
  const int lane = tidx_() & 63, gw = bidx_() * 8 + (tidx_() >> 6), nw = gridDim.x * 8;
  for (int row = gw; row < MROWS; row += nw) {
    int seq, pos, L; row_info(row, seq, pos, L); if (pos < 16) continue;
    const float rs = row_rstd(rowsq, row);
    float* dst = p.out + (seq < 2 ? ((size_t)seq * 8192 + (pos - 16)) : ((size_t)16384 + (size_t)(seq - 2) * 4096 + (pos - 16))) * 1024;
#pragma unroll
    for (int i = 0; i < 4; ++i) { const int c = i * 256 + lane * 4; const u32x2 v = *(const u32x2*)(h + tix(row, c, 16)); const f32x4 gg = *(const f32x4*)(g + c);
      f32x4 o; o[0] = bflo(v.x) * rs * gg[0]; o[1] = bfhi(v.x) * rs * gg[1]; o[2] = bflo(v.y) * rs * gg[2]; o[3] = bfhi(v.y) * rs * gg[3]; *(f32x4*)(dst + c) = o; }
  }
}

__global__ void __launch_bounds__(512) __attribute__((amdgpu_flat_work_group_size(512, 512))) mega(Params p) {
  extern __shared__ __attribute__((aligned(16))) unsigned char smem[];
  LAS unsigned char* lds = (LAS unsigned char*)smem;
  cg::grid_group grid = cg::this_grid();
  LAS unsigned* xst = (LAS unsigned*)(lds + LDS_CTL + 32);
  if (threadIdx.x == 0) { xst[0] = 0u; xst[1] = 0u; (void)xb_add(&((unsigned*)(p.ws + T_BAR))[XB_XCNT(xcc_id_())], 1u); }
  __syncthreads();
#define SYNC_ do { XcdBarrier xb_; xb_.bar = (unsigned*)(p.ws + T_BAR); xb_.x = xcc_id_(); xb_.st = xst; xcd_barrier(xb_); } while (0)
  if (threadIdx.x == 0) { const unsigned x = xcc_id_(); LAS int* ctl = (LAS int*)(lds + LDS_CTL);
    const unsigned slot = __hip_atomic_fetch_add((unsigned*)(p.ws + T_CNT) + x, 1u, __ATOMIC_RELAXED, __HIP_MEMORY_SCOPE_AGENT); ctl[0] = (int)x; ctl[1] = (int)slot; }
  prep_misc(p); prep_weights(p, 0, lds); grid.sync();
  if (threadIdx.x == 0) { LAS int* ctl = (LAS int*)(lds + LDS_CTL); int ok = 1, mine = 0;
    for (int i = 0; i < 8; ++i) { const int c = (int)__hip_atomic_load((unsigned*)(p.ws + T_CNT) + i, __ATOMIC_RELAXED, __HIP_MEMORY_SCOPE_AGENT); if (c == 0) ok = 0; if (i == ctl[0]) mine = c; }
    ctl[2] = mine; ctl[3] = ok; }
  __syncthreads();
  gemm_phase(K_UP, 0, p, lds, 1); SYNC_;
  gemm_phase(K_DN, 0, p, lds, 2); prep_weights(p, 2, lds); SYNC_;
  gemm_phase(K_WINA, 0, p, lds, 3); prep_weights(p, 3, lds); SYNC_;
  ret_kv_phase(p, lds); SYNC_;
  ret_scan_phase(p); SYNC_;
  ret_out_phase(p, lds); SYNC_;
  xwa_phase(p); SYNC_;
  rwkv_scan2_phase(p, lds); SYNC_;
  rwkv_post_phase(p, lds); SYNC_;
  gemm_phase(K_WOUT, 0, p, lds, 4); prep_weights(p, 1, lds); SYNC_;
  gemm_phase(K_UP, 1, p, lds, 5); gemm_phase(K_FOLD, 0, p, lds); SYNC_;
  gemm_phase(K_DN, 1, p, lds, 6); SYNC_;
  gemm_phase(K_UP, 2, p, lds, 7); SYNC_;
  gemm_phase(K_DN, 2, p, lds, 8); SYNC_;
  gemm_phase(K_WIN1, 0, p, lds, 9); SYNC_;
  conv_phase(p); SYNC_;
  f2_phase(p); SYNC_;
  gemm_phase(K_F3, 0, p, lds); f3_tail_phase(p); SYNC_;
  gemm_phase(K_WOUT, 1, p, lds, 10); SYNC_;
  gemm_phase(K_UP, 3, p, lds, 11); SYNC_;
  gemm_phase(K_DN, 3, p, lds, 12); SYNC_;
  final_phase(p);
}

extern "C" void kernel_launch(void* const* d_in, const int* in_sizes, int n_in, void* d_out, int out_size, void* d_ws, size_t ws_size, hipStream_t stream) {
  constexpr size_t kDynLds = 148224;
  static int grid_blocks = 0;
  if (!grid_blocks) {
    int dev = 0, cus = 0, per_cu = 0;
    (void)hipGetDevice(&dev);
    (void)hipDeviceGetAttribute(&cus, hipDeviceAttributeMultiprocessorCount, dev);
    (void)hipFuncSetAttribute((const void*)mega, hipFuncAttributeMaxDynamicSharedMemorySize, (int)kDynLds);
    (void)hipOccupancyMaxActiveBlocksPerMultiprocessor(&per_cu, mega, 512, kDynLds);
    if (per_cu < 1) per_cu = 1;
    grid_blocks = cus * 1;
  }
  Params p{};
  for (int i = 0; i < 38; ++i) p.in[i] = (const float*)d_in[i];
  p.out = (float*)d_out; p.ws = (unsigned char*)d_ws;
  (void)hipMemsetAsync((char*)d_ws + T_CNT, 0, 128 + 14336, stream);
  void* args[] = {&p};
  hipError_t e = hipLaunchCooperativeKernel((void*)mega, dim3(grid_blocks), dim3(512), args, kDynLds, stream);
  if (e != hipSuccess) fprintf(stderr, "cooperative launch failed: %s (grid %d)\n", hipGetErrorString(e), grid_blocks);
}
```

```cpp
#include <hip/hip_runtime.h>
#include <hip/hip_cooperative_groups.h>
#include <cstdio>
namespace cg = cooperative_groups;
#define LAS __attribute__((address_space(3)))
typedef unsigned short bf16_t;
typedef short bf16x8 __attribute__((ext_vector_type(8)));
typedef float f32x4 __attribute__((ext_vector_type(4)));
typedef unsigned u32x4 __attribute__((ext_vector_type(4)));
typedef unsigned u32x2 __attribute__((ext_vector_type(2)));

constexpr int DM = 1024, FF = 2816;
constexpr int LP = 8208, LS = 4112, LPP = 8320, LPS = 4224, PADR = 112;
constexpr int MROWS = 2 * LPP + 4 * LPS;
constexpr int MT = MROWS / 256;
constexpr int MT_A = 66;
static_assert(MROWS % 256 == 0, "rows");
constexpr size_t SZ_H = (size_t)MROWS * DM * 2;
constexpr size_t SZ_UP = (size_t)2 * FF * DM * 2, SZ_DN = (size_t)DM * FF * 2, SZ_SQ = (size_t)DM * DM * 2;
constexpr size_t OFF_H = 0;
constexpr size_t OFF_W0 = OFF_H + SZ_H;
constexpr size_t W0_F1UP = OFF_W0, W0_F1DN = W0_F1UP + SZ_UP, W0_INA = W0_F1DN + SZ_DN, W0_INB = W0_INA + (size_t)1536 * DM * 2,
                 W0_OUT = W0_INB + (size_t)1792 * DM * 2, W0_F2UP = W0_OUT + SZ_SQ, W0_F2DN = W0_F2UP + SZ_UP;
constexpr size_t OFF_TAB = W0_F2DN + SZ_DN;
constexpr size_t T_ROWSQ = OFF_TAB;
constexpr size_t T_ROPE = T_ROWSQ + (size_t)MROWS * 16 * 4;
constexpr size_t T_ADFTP = T_ROPE + (size_t)LP * 64 * 4;
constexpr size_t T_ADFTS = T_ADFTP + (size_t)512 * 1024 * 2;
constexpr size_t T_FT = T_ADFTS + (size_t)256 * 512 * 2;
constexpr size_t T_WTMP = T_FT + (size_t)1024 * 512 * 2;
constexpr size_t T_TWP = T_WTMP + (size_t)1024 * 512 * 2;
constexpr size_t T_TWS = T_TWP + 65792;
constexpr size_t T_TAILC = T_TWS + 33024;
constexpr size_t T_TAILV = T_TAILC + 16384;
constexpr size_t T_BONUS = T_TAILV + 131072 + 262144;
constexpr size_t T_G2T = T_BONUS + (size_t)MROWS * 16 * 4;
constexpr size_t T_PTR = T_G2T + 131072;
constexpr size_t T_CNT = T_PTR + 384;
constexpr size_t T_BAR = T_PTR + 512;
constexpr size_t OFF_R1 = T_BAR + 14336;
constexpr int LDS_RSTD = 146944 + 64;
constexpr int LDS_CTL = 146944;
constexpr size_t WS_MIN = 268435456;
constexpr size_t R1_MIX = OFF_R1;
constexpr size_t SZ_MIX = (size_t)MROWS * 1024 * 2;
constexpr size_t R1_OF = R1_MIX + SZ_MIX, R1_OB = R1_OF + (size_t)MROWS * 512 * 2;
constexpr size_t R1_U = R1_MIX + SZ_MIX;
constexpr size_t R1_BTFS = R1_U;
constexpr size_t R1_ACTA = OFF_R1;
constexpr size_t SZ_W1 = SZ_UP + SZ_DN + (size_t)2560 * DM * 2 + SZ_SQ + SZ_UP + SZ_DN;
constexpr size_t OFF_W1 = WS_MIN - SZ_W1;
constexpr size_t W1_F1UP = OFF_W1, W1_F1DN = W1_F1UP + SZ_UP, W1_IN = W1_F1DN + SZ_DN, W1_OUT = W1_IN + (size_t)2560 * DM * 2,
                 W1_F2UP = W1_OUT + SZ_SQ, W1_F2DN = W1_F2UP + SZ_UP;
static_assert(R1_OB + (size_t)MROWS * 512 * 2 <= WS_MIN, "L0 mixer region");
static_assert(R1_ACTA + (size_t)MT_A * 256 * FF * 2 <= OFF_W1, "actA vs W1");
static_assert(R1_U + (size_t)MROWS * 512 * 2 <= OFF_W1, "u vs W1");
static_assert(R1_BTFS + (size_t)16 * 2048 * 512 * 2 <= OFF_W1, "btfs vs W1");
constexpr size_t SZ_OUT = (size_t)32768 * 1024 * 4;
static_assert(((size_t)96 << 20) + (size_t)66 * 262144 <= SZ_OUT && ((size_t)96 << 20) >= (size_t)(MT - MT_A) * 256 * FF * 2, "split-K scratch");
constexpr size_t R2_SPLITK = (size_t)96 << 20;
constexpr size_t R1_QK = R1_OF;
constexpr size_t R1_KVF = R1_OB;
constexpr size_t R1_KVB = R1_KVF + (size_t)1048 * 8192 * 2;
static_assert(R1_KVB + (size_t)1048 * 8192 * 2 <= R1_OB + (size_t)MROWS * 512 * 2, "kv in o_b region");
constexpr size_t R2_PRW = 0;
constexpr size_t R2_ACTB = 0;
constexpr size_t R2_WT = 0;
constexpr size_t R2_WTS = (size_t)2 * 1024 * LP * 2;
constexpr size_t R2_BTFP = R2_WTS + (size_t)4 * 1024 * LS * 2;
static_assert(R2_PRW + (size_t)MROWS * 1792 * 2 <= SZ_OUT, "r2 b");
static_assert(R2_BTFP + (size_t)16 * 1024 * 1024 * 2 <= SZ_OUT, "r2 c");
static_assert((size_t)(MT - MT_A) * 256 * FF * 2 <= SZ_OUT, "r2 d");
constexpr int TC_CTP = 0, TC_STP = 512, TC_ARCP = 1024, TC_ARSP = 1024 + 520, TC_CTS = 2080, TC_STS = 2080 + 256, TC_ARCS = 2600, TC_ARSS = 2600 + 264;

struct Params { const float* in[38]; float* out; unsigned char* ws; };

__device__ __forceinline__ bf16_t f2bf(float f) { unsigned u = __float_as_uint(f); u += 0x7FFFu + ((u >> 16) & 1u); return (bf16_t)(u >> 16); }
__device__ __forceinline__ float bf2f(bf16_t b) { return __uint_as_float(((unsigned)b) << 16); }
typedef float f32x2_t __attribute__((ext_vector_type(2)));
typedef __bf16 bf16x2_t __attribute__((ext_vector_type(2)));
__device__ __forceinline__ unsigned pack2(float a, float b) { f32x2_t v = {a, b}; bf16x2_t r = __builtin_convertvector(v, bf16x2_t); return __builtin_bit_cast(unsigned, r); }
__device__ __forceinline__ float bflo(unsigned u) { return __uint_as_float(u << 16); }
__device__ __forceinline__ float bfhi(unsigned u) { return __uint_as_float(u & 0xffff0000u); }
__device__ __forceinline__ int seq_base(int s) { return s < 2 ? s * LPP : 2 * LPP + (s - 2) * LPS; }
__device__ __forceinline__ void row_info(int row, int& seq, int& pos, int& L) {
  if (row < 2 * LPP) { seq = row >= LPP ? 1 : 0; pos = row - seq * LPP - PADR; L = LP; }
  else { const int r = row - 2 * LPP; const int s = r / LPS; seq = 2 + s; pos = r - s * LPS - PADR; L = LS; }
}
template <int CTRL> __device__ __forceinline__ float dppf(float v) { return __int_as_float(__builtin_amdgcn_update_dpp(0, __float_as_int(v), CTRL, 0xF, 0xF, true)); }
__device__ __forceinline__ float rowsum16(float v) { v += dppf<0xB1>(v); v += dppf<0x4E>(v); v += dppf<0x141>(v); v += dppf<0x140>(v); return v; }
__device__ __forceinline__ float rcpf_(float x) { return __builtin_amdgcn_rcpf(x); }
__device__ __forceinline__ float sigmoidf_(float x) { return rcpf_(1.0f + __expf(-x)); }
__device__ __forceinline__ f32x4 mfma16(bf16x8 a, bf16x8 b, f32x4 c) { return __builtin_amdgcn_mfma_f32_16x16x32_bf16(a, b, c, 0, 0, 0); }
__device__ __forceinline__ const float* inp(const unsigned char* ws, int i) {
  const unsigned long long v = ((const unsigned long long*)(ws + T_PTR))[i];
  const unsigned lo = __builtin_amdgcn_readfirstlane((unsigned)v), hi = __builtin_amdgcn_readfirstlane((unsigned)(v >> 32));
  return (const float*)(((unsigned long long)hi << 32) | (unsigned long long)lo);
}
__device__ __forceinline__ int tidx_() { int t = threadIdx.x; asm volatile("" : "+v"(t)); return t; }
__device__ __forceinline__ int bidx_() { int b = blockIdx.x; asm volatile("" : "+s"(b)); return b; }
__device__ __forceinline__ int gdim_() { int g = __builtin_amdgcn_readfirstlane((int)gridDim.x); asm volatile("" : "+s"(g)); return g; }
__device__ __forceinline__ float shx(float v, int o, int lane) { return __int_as_float(__builtin_amdgcn_ds_bpermute(((lane ^ o) & 63) << 2, __float_as_int(v))); }
__device__ __forceinline__ unsigned xcc_id_() { return (unsigned)__builtin_amdgcn_s_getreg((3 << 11) | 20) & 0xFu; }
__device__ __forceinline__ size_t tix(int row, int col, int KB) { return ((size_t)((row >> 7) * KB + (col >> 6)) << 13) + (size_t)((row & 127) * 64 + (col & 63)); }

#define XB_TMO      128
#define XB_XCNT(j)  (256  + 64 * (j))
#define XB_XSUB(j)  (1280 + 64 * (j))
#define XB_XGEN(j)  (2304 + 64 * (j))
#define XB_TOP      3328
#define XB_TOPGEN   3392
#define XCD_BAR_WORDS 3456
#define XB_SPIN_CAP (1u << 22)
__device__ __forceinline__ unsigned xb_ld(unsigned* p)              { return __hip_atomic_load(p, __ATOMIC_RELAXED, __HIP_MEMORY_SCOPE_AGENT); }
__device__ __forceinline__ unsigned xb_add(unsigned* p, unsigned v) { return __hip_atomic_fetch_add(p, v, __ATOMIC_RELAXED, __HIP_MEMORY_SCOPE_AGENT); }
#define XB_SPIN(cond, bar) do { unsigned _sp = 0; while (cond) { __builtin_amdgcn_s_sleep(1); \
    if ((++_sp & 255u) == 0u) { if (xb_ld(&(bar)[XB_TMO])) break; if (_sp > XB_SPIN_CAP) { atomicAdd(&(bar)[XB_TMO], 1u); break; } } } } while (0)
struct XcdBarrier { unsigned* bar; unsigned x; volatile LAS unsigned* st; };
__device__ __forceinline__ void xcd_barrier_complete(unsigned* bar, unsigned x, unsigned& nloc, unsigned& nx) {
    const unsigned G = gridDim.x * gridDim.y * gridDim.z;
    unsigned sum, cnt, mine, sp = 0u;
    for (;;) {
        sum = 0u; cnt = 0u; mine = 0u;
#pragma unroll
        for (unsigned j = 0; j < 16; ++j) { const unsigned c = xb_ld(&bar[XB_XCNT(j)]); sum += c; cnt += (c > 0u) ? 1u : 0u; mine = (j == x) ? c : mine; }
        if (sum == G) break;
        __builtin_amdgcn_s_sleep(1);
        if ((++sp & 255u) == 0u) { if (xb_ld(&bar[XB_TMO])) break; if (sp > XB_SPIN_CAP) { atomicAdd(&bar[XB_TMO], 1u); break; } }
    }
    nloc = mine > 0u ? mine : 1u; nx = cnt > 0u ? cnt : 1u;
}
__device__ __forceinline__ void xcd_barrier(const XcdBarrier& b) {
    asm volatile("s_waitcnt vmcnt(0)" ::: "memory");
    __syncthreads();
    if (threadIdx.x == 0) {
        unsigned* bar = b.bar;
        __builtin_amdgcn_s_waitcnt(0);
        unsigned nloc = b.st[0], nx = b.st[1];
        if (nloc == 0u) { xcd_barrier_complete(bar, b.x, nloc, nx); b.st[0] = nloc; b.st[1] = nx; }
        const unsigned old = xb_add(&bar[XB_XSUB(b.x)], 1u);
        const unsigned gen = old / nloc;
        if (old + 1u == (gen + 1u) * nloc) {
            __builtin_amdgcn_fence(__ATOMIC_RELEASE, "agent");
            asm volatile("s_waitcnt vmcnt(0)" ::: "memory");
            const unsigned og = xb_add(&bar[XB_TOP], 1u);
            const unsigned tg = og / nx;
            if (og + 1u == (tg + 1u) * nx) xb_add(&bar[XB_TOPGEN], 1u);
            else XB_SPIN(xb_ld(&bar[XB_TOPGEN]) == tg, bar);
            __builtin_amdgcn_fence(__ATOMIC_ACQUIRE, "agent");
            xb_add(&bar[XB_XGEN(b.x)], 1u);
            asm volatile("s_waitcnt vmcnt(0)" ::: "memory");
        } else {
            XB_SPIN(xb_ld(&bar[XB_XGEN(b.x)]) == gen, bar);
            __builtin_amdgcn_fence(__ATOMIC_ACQUIRE, "agent");
            asm volatile("s_waitcnt vmcnt(0)" ::: "memory");
        }
    }
    __syncthreads();
}
__device__ __forceinline__ size_t opq0_() { size_t z = 0; asm volatile("" : "+s"(z)); return z; }
constexpr int HTB = 128 * 64 * 2;
__device__ __forceinline__ int lds_byte(int r, int c) { const int st = (r >> 4) * 2 + (c >> 5), rr = r & 15, cc = c & 31, ob = rr * 64 + cc * 2; return st * 1024 + (ob ^ (((ob >> 9) & 1) << 5)); }
__device__ __forceinline__ void stage_rc(int b, int& R, int& C) { const int st = b / 1024, sb = b % 1024, swz = sb ^ (((sb >> 9) & 1) << 5); R = (st >> 1) * 16 + swz / 64; C = (st & 1) * 32 + (swz % 64) / 2; }

__device__ __forceinline__ void gemm_core(const bf16_t* A, int lda, size_t kstepA, size_t hA, const bf16_t* Bt, int ldb, size_t kstepB, size_t hB, int K, LAS unsigned char* lds, f32x4 (&acc)[2][2][4][2]) {
  const int tid = tidx_(), wid = tid >> 6, lane = tid & 63, wr = wid >> 2, wc = wid & 3, fr = lane & 15, fq = lane >> 4;
  unsigned voffA[2], voffB[2];
#pragma unroll
  for (int i = 0; i < 2; ++i) { int R, C; stage_rc(tid * 16 + i * 8192, R, C); voffA[i] = (unsigned)(R * lda + C) * 2u; voffB[i] = (unsigned)(R * ldb + C) * 2u; }
  const unsigned ldsw = (unsigned)wid * 1024u;
  const int aoff = lds_byte(wr * 64 + fr, fq * 8), boff = lds_byte(wc * 32 + fr, fq * 8);
  const char* gA = (const char*)A; const char* gB = (const char*)Bt;
#define SA_(b, h) (((b) * 2 + (h)) * HTB)
#define SB_(b, h) ((4 + (b) * 2 + (h)) * HTB)
#define STAGE_(bufoff, gbase, voff) do { _Pragma("unroll") for (int _i = 0; _i < 2; ++_i) \
    __builtin_amdgcn_global_load_lds((const unsigned*)((gbase) + (voff)[_i]), (LAS unsigned*)(lds + (bufoff) + ldsw + _i * 8192), 16, 0, 0); } while (0)
#define STA_(b, h, kt) STAGE_(SA_(b, h), gA + (size_t)(h) * hA + (size_t)(kt) * kstepA, voffA)
#define STB_(b, h, kt) STAGE_(SB_(b, h), gB + (size_t)(h) * hB + (size_t)(kt) * kstepB, voffB)
#define LDA_(dst, b, h) do { _Pragma("unroll") for (int m = 0; m < 4; ++m) _Pragma("unroll") for (int k = 0; k < 2; ++k) dst[m][k] = *(const LAS bf16x8*)(lds + SA_(b, h) + aoff + m * 2048 + k * 1024); } while (0)
#define LDB_(dst, b, h) do { _Pragma("unroll") for (int n = 0; n < 2; ++n) _Pragma("unroll") for (int k = 0; k < 2; ++k) dst[n][k] = *(const LAS bf16x8*)(lds + SB_(b, h) + boff + n * 2048 + k * 1024); } while (0)
#define MMA_(ai, bj, At, Bx) do { __builtin_amdgcn_s_setprio(1); _Pragma("unroll") for (int m = 0; m < 4; ++m) _Pragma("unroll") for (int n = 0; n < 2; ++n) _Pragma("unroll") for (int k = 0; k < 2; ++k) \
    acc[ai][bj][m][n] = __builtin_amdgcn_mfma_f32_16x16x32_bf16(Bx[n][k], At[m][k], acc[ai][bj][m][n], 0, 0, 0); __builtin_amdgcn_s_setprio(0); } while (0)
#define WAIT_V(n) asm volatile("s_waitcnt vmcnt(" #n ")" ::: "memory")
#define WAIT_L(n) asm volatile("s_waitcnt lgkmcnt(" #n ")" ::: "memory")
#define BAR_ __builtin_amdgcn_s_barrier()
#define SCHED_ __builtin_amdgcn_sched_barrier(0)
#pragma unroll
  for (int a = 0; a < 2; ++a)
#pragma unroll
    for (int b = 0; b < 2; ++b)
#pragma unroll
      for (int m = 0; m < 4; ++m)
#pragma unroll
        for (int n = 0; n < 2; ++n) acc[a][b][m][n] = (f32x4){0.f, 0.f, 0.f, 0.f};
  bf16x8 At[4][2], B0[2][2], B1[2][2];
  const int nt = K / 64;
  STB_(0, 0, 0); STA_(0, 0, 0); STB_(0, 1, 0); STA_(0, 1, 0);
  if (wr == 1) BAR_;
  WAIT_V(4); BAR_;
  STB_(1, 0, 1); STA_(1, 0, 1); STB_(1, 1, 1);
  WAIT_V(6); BAR_;
  for (int t = 0; t < nt - 2; t += 2) {
    LDB_(B0, 0, 0); SCHED_; LDA_(At, 0, 0); STA_(1, 1, t + 1);
    WAIT_L(8); BAR_; WAIT_L(0); MMA_(0, 0, At, B0); BAR_; SCHED_;
    LDB_(B1, 0, 1); STB_(0, 0, t + 2);
    BAR_; WAIT_L(0); MMA_(0, 1, At, B1); BAR_;
    LDA_(At, 0, 1); STA_(0, 0, t + 2);
    BAR_; WAIT_L(0); MMA_(1, 0, At, B0); BAR_; SCHED_;
    STB_(0, 1, t + 2);
    WAIT_V(6); BAR_; MMA_(1, 1, At, B1); BAR_;
    LDB_(B0, 1, 0); SCHED_; LDA_(At, 1, 0); STA_(0, 1, t + 2);
    WAIT_L(8); BAR_; WAIT_L(0); MMA_(0, 0, At, B0); BAR_; SCHED_;
    LDB_(B1, 1, 1); STB_(1, 0, t + 3);
    BAR_; WAIT_L(0); MMA_(0, 1, At, B1); BAR_;
    LDA_(At, 1, 1); STA_(1, 0, t + 3);
    BAR_; WAIT_L(0); MMA_(1, 0, At, B0); BAR_; SCHED_;
    STB_(1, 1, t + 3);
    WAIT_V(6); BAR_; MMA_(1, 1, At, B1); BAR_;
  }
  { LDB_(B0, 0, 0); LDA_(At, 0, 0); STA_(1, 1, nt - 1);
    BAR_; WAIT_L(0); MMA_(0, 0, At, B0); BAR_;
    LDB_(B1, 0, 1); BAR_; WAIT_L(0); MMA_(0, 1, At, B1); BAR_;
    LDA_(At, 0, 1); WAIT_V(4); BAR_; WAIT_L(0); MMA_(1, 0, At, B0); MMA_(1, 1, At, B1); BAR_; }
  { LDB_(B0, 1, 0); LDA_(At, 1, 0); WAIT_V(2); BAR_; WAIT_L(0); MMA_(0, 0, At, B0); BAR_;
    LDB_(B1, 1, 1); WAIT_V(0); BAR_; WAIT_L(0); MMA_(0, 1, At, B1); BAR_;
    LDA_(At, 1, 1); BAR_; WAIT_L(0); MMA_(1, 0, At, B0); MMA_(1, 1, At, B1); BAR_; }
  if (wr == 0) BAR_;
}

__device__ __forceinline__ bool unit_for(int it, int U, int nM, int nN, int& pm, int& pn, LAS unsigned char* lds) {
  const LAS int* ctl = (const LAS int*)(lds + LDS_CTL);
  const int x = __builtin_amdgcn_readfirstlane(ctl[0]), slot = __builtin_amdgcn_readfirstlane(ctl[1]), nx = __builtin_amdgcn_readfirstlane(ctl[2]), ok = __builtin_amdgcn_readfirstlane(ctl[3]);
  int l;
  if (ok) {
    const int q = U >> 3, r = U & 7;
    const int cnt = x < r ? q + 1 : q, start = x < r ? x * (q + 1) : r * (q + 1) + (x - r) * q;
    const int li = it * nx + slot; if (li >= cnt) return false; l = start + li;
  } else { const int G = gridDim.x, b = bidx_(); l = it * G + b; if (l >= U) return false; }
  const int nig = 8 * nN, gid = l / nig, within = l % nig, fm = gid * 8, gsz = (nM - fm) < 8 ? (nM - fm) : 8;
  pm = fm + within % gsz; pn = within / gsz; return true;
}

enum { K_UP = 0, K_DN = 1, K_WINA = 2, K_WINB = 3, K_WOUT = 4, K_WIN1 = 5, K_F3 = 6, K_FOLD = 7 };

__device__ __forceinline__ float row_rstd(const float* rowsq, int row) {
  const f32x4* q = (const f32x4*)(rowsq + (size_t)row * 16);
  const f32x4 a = q[0], b = q[1], c = q[2], d = q[3];
  const float s = ((a[0] + a[1]) + (a[2] + a[3])) + ((b[0] + b[1]) + (b[2] + b[3])) + ((c[0] + c[1]) + (c[2] + c[3])) + ((d[0] + d[1]) + (d[2] + d[3]));
  return rsqrtf(s * (1.0f / 1024.0f) + 1e-6f);
}

struct F3Info { int grp, k1, mt, nt; };
__device__ __forceinline__ void gemm_epilogue(const int kind, const int pm, const int pn, const F3Info f3, f32x4 (&acc)[2][2][4][2], unsigned char* ws, unsigned char* r2, LAS unsigned char* lds, const float* partial = nullptr) {
  const LAS float* rst = (const LAS float*)(lds + LDS_RSTD);
#define ACC_(ai, bj, m, n) (partial ? acc[ai][bj][m][n] + *(const f32x4*)(partial + (size_t)(((((ai) * 2 + (bj)) * 4 + (m)) * 2 + (n)) * 512 + tid) * 4) : acc[ai][bj][m][n])
  const int f3_grp = f3.grp, f3_k1 = f3.k1, f3_mt = f3.mt, f3_nt = f3.nt;
  {
    ws += opq0_(); r2 += opq0_();
    const int tid = tidx_(), wid = tid >> 6, lane = tid & 63, wr = wid >> 2, wc = wid & 3, fr = lane & 15, fq = lane >> 4;
    bf16_t* h = (bf16_t*)(ws + OFF_H);
    float* rowsq = (float*)(ws + T_ROWSQ);
    const int brow = pm * 256 + wr * 64 + fr;
    const int ccol = wc * 32 + fq * 4;
    const int ccw = wc * 32 + ((fq & 1) ? 16 + 4 * (fq - 1) : 4 * fq);
#define ST16_(ptr, w0, w1) do { const auto r0_ = __builtin_amdgcn_permlane16_swap((w0).x, (w1).x, false, false); const auto r1_ = __builtin_amdgcn_permlane16_swap((w0).y, (w1).y, false, false); \
    *(u32x4*)(ptr) = (u32x4){(unsigned)r0_[0], (unsigned)r1_[0], (unsigned)r0_[1], (unsigned)r1_[1]}; } while (0)
    if (kind == K_UP) {
      bf16_t* act = pm < MT_A ? (bf16_t*)(ws + R1_ACTA) : (bf16_t*)(r2 + R2_ACTB); const int arow0 = pm < MT_A ? 0 : MT_A * 256;
      const int ccolw = ccw - wc * 32;
      bf16_t* actb = act + ((size_t)(((pm - (pm < MT_A ? 0 : MT_A)) * 2 * 44 + pn * 2 + (wc >> 1))) << 13) + (wr * 64 + fr) * 64 + (wc & 1) * 32 + ccolw;
#pragma unroll
      for (int ai = 0; ai < 2; ++ai)
#pragma unroll
        for (int m = 0; m < 4; ++m) { asm volatile("" ::: "memory");
          const int row = brow + ai * 128 + m * 16; const float rs = rst[row - pm * 256];
          u32x2 w[2];
#pragma unroll
          for (int n = 0; n < 2; ++n) {
            const f32x4 g = ACC_(ai, 0, m, n) * rs, u = ACC_(ai, 1, m, n) * rs; float o[4];
#pragma unroll
            for (int j = 0; j < 4; ++j) o[j] = g[j] * sigmoidf_(g[j]) * u[j];
            w[n].x = pack2(o[0], o[1]); w[n].y = pack2(o[2], o[3]);
          }
          const auto r0 = __builtin_amdgcn_permlane16_swap(w[0].x, w[1].x, false, false);
          const auto r1 = __builtin_amdgcn_permlane16_swap(w[0].y, w[1].y, false, false);
          *(u32x4*)(actb + ai * (44 << 13) + m * 1024) = (u32x4){(unsigned)r0[0], (unsigned)r1[0], (unsigned)r0[1], (unsigned)r1[1]};
        }
    } else if (kind == K_DN || kind == K_WOUT) {
      const float sc = kind == K_DN ? 0.5f : 1.0f;
      bf16_t* hb = h + ((size_t)((pm * 2 * 16 + pn * 4 + (wc >> 1))) << 13) + (wr * 64 + fr) * 64 + (ccw - (wc & 2) * 32);
#pragma unroll
      for (int ai = 0; ai < 2; ++ai)
#pragma unroll
        for (int m = 0; m < 4; ++m) { asm volatile("" ::: "memory");
          const int row = brow + ai * 128 + m * 16; int seq, pos, L; row_info(row, seq, pos, L);
          float ss = 0.f;
          if (pos >= 0) {
#pragma unroll
            for (int bj = 0; bj < 2; ++bj) {
              bf16_t* hp = hb + ai * (16 << 13) + bj * (2 << 13) + m * 1024;
              const u32x4 ld = *(const u32x4*)hp;
              const auto s0 = __builtin_amdgcn_permlane16_swap(ld.x, ld.z, false, false); const auto s1 = __builtin_amdgcn_permlane16_swap(ld.y, ld.w, false, false);
              u32x2 w[2];
#pragma unroll
              for (int n = 0; n < 2; ++n) {
                const unsigned ox = (unsigned)s0[n], oy = (unsigned)s1[n]; const f32x4 a = ACC_(ai, bj, m, n);
                w[n].x = pack2(bflo(ox) + sc * a[0], bfhi(ox) + sc * a[1]); w[n].y = pack2(bflo(oy) + sc * a[2], bfhi(oy) + sc * a[3]);
                const float v0 = bflo(w[n].x), v1 = bfhi(w[n].x), v2 = bflo(w[n].y), v3 = bfhi(w[n].y);
                ss += (v0 * v0 + v1 * v1) + (v2 * v2 + v3 * v3);
              }
              ST16_(hp, w[0], w[1]);
            }
          }
          ss += shx(ss, 16, lane); ss += shx(ss, 32, lane);
          if (fq == 0) rowsq[(size_t)row * 16 + pn * 4 + wc] = ss;
        }
    } else if (kind == K_WINA) {
      if (pn < 2) {
        bf16_t* qk = (bf16_t*)(ws + R1_QK);
        const float* rc = (const float*)(ws + T_ROPE); const float* rsn = rc + (size_t)LP * 32;
        const float qs = pn == 0 ? 0.125f : 1.0f;
#pragma unroll
        for (int ai = 0; ai < 2; ++ai)
#pragma unroll
          for (int m = 0; m < 4; ++m) { asm volatile("" ::: "memory");
            const int row = brow + ai * 128 + m * 16; int seq, pos, L; row_info(row, seq, pos, L);
            const float rs = rst[row - pm * 256] * qs; const int pc = pos < 0 ? 0 : pos;
#pragma unroll
            for (int bj = 0; bj < 2; ++bj) {
              const int g = bj * 4 + wc, head = g >> 1, d1 = (g & 1) * 16 + fq * 4;
              const f32x4 x1 = ACC_(ai, bj, m, 0) * rs, x2 = ACC_(ai, bj, m, 1) * rs;
              const f32x4 c = *(const f32x4*)(rc + (size_t)pc * 32 + d1), s = *(const f32x4*)(rsn + (size_t)pc * 32 + d1);
              const f32x4 o1 = x1 * c - x2 * s, o2 = x1 * s + x2 * c;
              bf16_t* dst = qk + (size_t)row * 512 + pn * 256 + head * 64 + d1;
              u32x2 w; w.x = pack2(o1[0], o1[1]); w.y = pack2(o1[2], o1[3]); *(u32x2*)dst = w;
              w.x = pack2(o2[0], o2[1]); w.y = pack2(o2[2], o2[3]); *(u32x2*)(dst + 32) = w;
            }
          }
      } else if (pn >= 6) {
        bf16_t* dst = (bf16_t*)(r2 + R2_PRW);
#pragma unroll
        for (int ai = 0; ai < 2; ++ai)
#pragma unroll
          for (int m = 0; m < 4; ++m) { asm volatile("" ::: "memory");
            const int row = brow + ai * 128 + m * 16; const float rs = rst[row - pm * 256];
#pragma unroll
            for (int bj = 0; bj < 2; ++bj)
              { u32x2 w[2];
#pragma unroll
                for (int n = 0; n < 2; ++n) { const f32x4 a = ACC_(ai, bj, m, n) * rs; w[n].x = pack2(a[0], a[1]); w[n].y = pack2(a[2], a[3]); }
                ST16_(dst + (size_t)row * 1792 + (pn - 6) * 256 + bj * 128 + ccw, w[0], w[1]); }
          }
      } else {
        bf16_t* mix = (bf16_t*)(ws + R1_MIX);
#pragma unroll
        for (int ai = 0; ai < 2; ++ai)
#pragma unroll
          for (int m = 0; m < 4; ++m) { asm volatile("" ::: "memory");
            const int row = brow + ai * 128 + m * 16; const float rs = rst[row - pm * 256];
#pragma unroll
            for (int bj = 0; bj < 2; ++bj)
              { u32x2 w[2];
#pragma unroll
                for (int n = 0; n < 2; ++n) { const f32x4 a = ACC_(ai, bj, m, n) * rs; w[n].x = pack2(a[0], a[1]); w[n].y = pack2(a[2], a[3]); }
                ST16_(mix + (size_t)row * 1024 + (pn - 2) * 256 + bj * 128 + ccw, w[0], w[1]); }
          }
      }
    } else if (kind == K_WINB || kind == K_FOLD) {
      bf16_t* dst = kind == K_WINB ? (bf16_t*)(r2 + R2_PRW) : (bf16_t*)(ws + W1_IN);
      const int ldd = kind == K_WINB ? 1792 : 1024;
#pragma unroll
      for (int ai = 0; ai < 2; ++ai)
#pragma unroll
        for (int m = 0; m < 4; ++m) { asm volatile("" ::: "memory");
          const int row = brow + ai * 128 + m * 16; const float rs = kind == K_WINB ? rst[row - pm * 256] : 1.0f;
#pragma unroll
          for (int bj = 0; bj < 2; ++bj)
#pragma unroll
            for (int n = 0; n < 2; ++n) { const f32x4 a = ACC_(ai, bj, m, n) * rs; u32x2 w; w.x = pack2(a[0], a[1]); w.y = pack2(a[2], a[3]);
              const int col = pn * 256 + bj * 128 + ccol + n * 16; *(u32x2*)(dst + (kind == K_WINB ? (size_t)row * ldd + col : tix(row, col, 16))) = w; }
        }
    } else if (kind == K_WIN1) {
      bf16_t* mix = (bf16_t*)(ws + R1_MIX); bf16_t* ub = (bf16_t*)(ws + R1_U);
#pragma unroll
      for (int ai = 0; ai < 2; ++ai)
#pragma unroll
        for (int m = 0; m < 4; ++m) { asm volatile("" ::: "memory");
          const int row = brow + ai * 128 + m * 16; int seq, pos, L; row_info(row, seq, pos, L);
          const float rs = rst[row - pm * 256];
          if (pn < 4) {
            if (pos >= 0) {
              bf16_t* wt = (bf16_t*)(r2 + R2_WT) + (seq < 2 ? (size_t)seq * 1024 * LP : (size_t)2 * 1024 * LP + (size_t)(seq - 2) * 1024 * LS);
#pragma unroll
              for (int bj = 0; bj < 2; ++bj)
#pragma unroll
                for (int n = 0; n < 2; ++n) { const f32x4 a = ACC_(ai, bj, m, n) * rs; const int col = pn * 256 + bj * 128 + ccol + n * 16;
#pragma unroll
                  for (int j = 0; j < 4; ++j) wt[(size_t)(col + j) * L + pos] = f2bf(a[j]); }
            }
          } else if (pn < 6) {
#pragma unroll
            for (int bj = 0; bj < 2; ++bj)
              { u32x2 w[2];
#pragma unroll
                for (int n = 0; n < 2; ++n) { const f32x4 a = ACC_(ai, bj, m, n) * rs; w[n].x = pack2(a[0], a[1]); w[n].y = pack2(a[2], a[3]); }
                ST16_(mix + (size_t)row * 1024 + 512 + (pn - 4) * 256 + bj * 128 + ccw, w[0], w[1]); }
          } else {
            { u32x2 w[2];
#pragma unroll
              for (int n = 0; n < 2; ++n) { const f32x4 a = (ACC_(ai, 0, m, n) * rs) * (ACC_(ai, 1, m, n) * rs); w[n].x = pack2(a[0], a[1]); w[n].y = pack2(a[2], a[3]); }
              ST16_(ub + (size_t)row * 512 + (pn - 6) * 128 + ccw, w[0], w[1]); }
          }
        }
    } else {
      bf16_t* mix = (bf16_t*)(ws + R1_MIX);
      const float* tc = (const float*)(ws + T_TAILC);
      const float* ct = tc + (f3_grp ? TC_CTS : TC_CTP); const float* st = tc + (f3_grp ? TC_STS : TC_STP);
      const int NN = f3_grp ? 2048 : 1024;
      const float* tv = (const float*)(ws + T_TAILV) + (f3_grp ? 32768 : 0) + (size_t)f3_k1 * NN * 2;
      const float scale = f3_grp ? rsqrtf(128.0f * LS) : rsqrtf(128.0f * LP);
#pragma unroll
      for (int ai = 0; ai < 2; ++ai)
#pragma unroll
        for (int m = 0; m < 4; ++m) { asm volatile("" ::: "memory");
          const int k2 = f3_mt * 256 + wr * 64 + fr + ai * 128 + m * 16;
          const float c2 = ct[k2], s2 = st[k2]; const int pos = f3_k1 + 16 * k2;
#pragma unroll
          for (int bj = 0; bj < 2; ++bj)
#pragma unroll
            for (int n = 0; n < 2; ++n) {
              const int ni = f3_nt * 256 + bj * 128 + ccol + n * 16; const int sl = ni >> 9, c = ni & 511;
              const int row = (f3_grp ? 2 * LPP + sl * LPS : sl * LPP) + PADR + pos;
              const f32x4 t0 = *(const f32x4*)(tv + (size_t)ni * 2), t1 = *(const f32x4*)(tv + (size_t)ni * 2 + 4);
              const f32x4 a = acc[ai][bj][m][n];
              const float o0 = (a[0] + c2 * t0[0] + s2 * t0[1]) * scale, o1 = (a[1] + c2 * t0[2] + s2 * t0[3]) * scale,
                          o2 = (a[2] + c2 * t1[0] + s2 * t1[1]) * scale, o3 = (a[3] + c2 * t1[2] + s2 * t1[3]) * scale;
              u32x2 w; w.x = pack2(o0, o1); w.y = pack2(o2, o3);
              *(u32x2*)(mix + (size_t)row * 1024 + c) = w;
            }
        }
    }
  }
}

__device__ __forceinline__ void gemm_phase(const int kind, const int idx, const Params& p, LAS unsigned char* lds, const int seqid = 0) {
  unsigned char* ws = p.ws + opq0_(); unsigned char* r2 = (unsigned char*)p.out + opq0_();
  int nM = MT, nN = 4, K = 1024;
  const bf16_t* Wt = nullptr;
  switch (kind) {
    case K_UP: nN = 22; Wt = (const bf16_t*)(ws + (idx == 0 ? W0_F1UP : idx == 1 ? W0_F2UP : idx == 2 ? W1_F1UP : W1_F2UP)); break;
    case K_DN: nN = 4; K = FF; Wt = (const bf16_t*)(ws + (idx == 0 ? W0_F1DN : idx == 1 ? W0_F2DN : idx == 2 ? W1_F1DN : W1_F2DN)); break;
    case K_WINA: nN = 13; Wt = (const bf16_t*)(ws + W0_INA); break;
    case K_WINB: nN = 7; Wt = (const bf16_t*)(ws + W0_INB); break;
    case K_WOUT: nN = 4; Wt = (const bf16_t*)(ws + (idx == 0 ? W0_OUT : W1_OUT)); break;
    case K_WIN1: nN = 10; Wt = (const bf16_t*)(ws + W1_IN); break;
    case K_F3: nM = 1; nN = 256; break;
    default: nM = 4; nN = 4; K = 512; break;
  }
  const int U = nM * nN;
  for (int it = 0;; ++it) {
    int pm, pn;
    int khalf = -1;
    const bool split = kind == K_DN;
    if (split) {
      const LAS int* ctl = (const LAS int*)(lds + LDS_CTL);
      const int x = __builtin_amdgcn_readfirstlane(ctl[0]), slot = __builtin_amdgcn_readfirstlane(ctl[1]), nx = __builtin_amdgcn_readfirstlane(ctl[2]), ok = __builtin_amdgcn_readfirstlane(ctl[3]);
      int f = -1, hu = -1;
      if (ok) { const int li = it * nx + slot;
        if (li < 16 * nN) f = 16 * nN * x + li;
        else { const int hs = (6 * nN * x) >> 3, he = (6 * nN * (x + 1)) >> 3, j = li - 16 * nN; if (j < he - hs) hu = hs + j; else break; } }
      else { const int l = it * (int)gridDim.x + bidx_(); if (l < 128 * nN) f = l; else if (l < 134 * nN) hu = l - 128 * nN; else break; }
      if (f >= 0) { const int nig = 8 * nN, gid = f / nig, within = f % nig; pm = gid * 8 + (within & 7); pn = within >> 3; }
      else { const int u = hu >> 1; khalf = hu & 1; pm = 128 + u % 3; pn = u / 3; }
    } else if (!unit_for(it, U, nM, nN, pm, pn, lds)) break;
    const bf16_t* A; const bf16_t* Bt; int lda, ldb;
    int f3_k1 = 0, f3_mt = 0, f3_nt = 0, f3_grp = 0;
    if (kind == K_F3) {
      const int u = pn;
      if (u < 128) { f3_grp = 0; f3_k1 = u >> 3; f3_mt = (u >> 2) & 1; f3_nt = u & 3;
        A = (const bf16_t*)(ws + T_ADFTP) + (size_t)f3_mt * 256 * 1024; lda = 1024; Bt = (const bf16_t*)(r2 + R2_BTFP) + ((size_t)f3_k1 * 1024 + f3_nt * 256) * 1024; ldb = 1024; K = 1024; }
      else { const int v = u - 128; f3_grp = 1; f3_k1 = v >> 3; f3_mt = 0; f3_nt = v & 7;
        A = (const bf16_t*)(ws + T_ADFTS); lda = 512; Bt = (const bf16_t*)(ws + R1_BTFS) + ((size_t)f3_k1 * 2048 + f3_nt * 256) * 512; ldb = 512; K = 512; }
    } else if (kind == K_DN) {
      A = pm < MT_A ? (const bf16_t*)(ws + R1_ACTA) + (size_t)pm * 256 * FF : (const bf16_t*)(r2 + R2_ACTB) + (size_t)(pm - MT_A) * 256 * FF; lda = FF;
      Bt = Wt + (size_t)pn * 256 * FF; ldb = FF;
      K = FF;
    } else if (kind == K_WOUT) {
      A = (const bf16_t*)(ws + R1_MIX) + (size_t)pm * 256 * 1024; lda = 1024; Bt = Wt + (size_t)pn * 256 * 1024; ldb = 1024;
    } else if (kind == K_FOLD) {
      A = (const bf16_t*)(ws + T_FT) + (size_t)pm * 256 * 512; lda = 512; Bt = (const bf16_t*)(ws + T_WTMP) + (size_t)pn * 256 * 512; ldb = 512;
    } else {
      A = (const bf16_t*)(ws + OFF_H) + (size_t)pm * 256 * 1024; lda = 1024; Bt = Wt + (size_t)pn * 256 * 1024; ldb = 1024;
    }
    const bool tA = kind == K_UP || kind == K_DN || kind == K_WINA || kind == K_WINB || kind == K_WIN1;
    const bool tB = tA || kind == K_WOUT;
    const int KF = K;
    if (khalf >= 0) { const int hk = (K >> 7) * khalf; K >>= 1; A += tA ? (size_t)hk * 8192 : (size_t)hk * 64; Bt += (size_t)hk * 8192; }
    if (kind == K_UP || kind == K_WINA || kind == K_WINB || kind == K_WIN1) {
      const int t = tidx_(); if (t < 256) ((LAS float*)(lds + LDS_RSTD))[t] = row_rstd((const float*)(ws + T_ROWSQ), pm * 256 + t);
    }
    f32x4 acc[2][2][4][2];
    gemm_core(A, tA ? 64 : lda, tA ? (size_t)16384 : (size_t)128, tA ? (size_t)(KF >> 6) * 16384 : (size_t)128 * lda * 2,
              Bt, tB ? 64 : ldb, tB ? (size_t)16384 : (size_t)128, tB ? (size_t)(KF >> 6) * 16384 : (size_t)128 * ldb * 2, K, lds, acc);
    const float* partial = nullptr;
    if (khalf >= 0) {
      const int u = (pm - 128) + 3 * pn; const int t = tidx_();
      float* scr = (float*)(r2 + R2_SPLITK) + (size_t)u * 65536;
      unsigned* flag = (unsigned*)(ws + T_BAR + 13824) + u;
      if (khalf == 0) {
#pragma unroll
        for (int a = 0; a < 2; ++a)
#pragma unroll
          for (int b = 0; b < 2; ++b)
#pragma unroll
            for (int m = 0; m < 4; ++m)
#pragma unroll
              for (int n = 0; n < 2; ++n) *(f32x4*)(scr + (size_t)((((a * 2 + b) * 4 + m) * 2 + n) * 512 + t) * 4) = acc[a][b][m][n];
        asm volatile("s_waitcnt vmcnt(0)" ::: "memory");
        __syncthreads();
        if (t == 0) { __builtin_amdgcn_fence(__ATOMIC_RELEASE, "agent"); asm volatile("s_waitcnt vmcnt(0)" ::: "memory"); __hip_atomic_store(flag, (unsigned)seqid, __ATOMIC_RELAXED, __HIP_MEMORY_SCOPE_AGENT); }
        __syncthreads();
        continue;
      } else {
        if (t == 0) { unsigned sp = 0; while (__hip_atomic_load(flag, __ATOMIC_RELAXED, __HIP_MEMORY_SCOPE_AGENT) < (unsigned)seqid) { __builtin_amdgcn_s_sleep(2); if (++sp > (1u << 24)) break; }
          __builtin_amdgcn_fence(__ATOMIC_ACQUIRE, "agent"); asm volatile("s_waitcnt vmcnt(0)" ::: "memory"); }
        __syncthreads();
        partial = scr;
      }
    }
    { F3Info f3; f3.grp = f3_grp; f3.k1 = f3_k1; f3.mt = f3_mt; f3.nt = f3_nt; gemm_epilogue(kind, pm, pn, f3, acc, ws, r2, lds, partial); }
    WAIT_V(0);
    __syncthreads();
  }
}

__device__ __forceinline__ void gemm_phase_stream(const int kind, const int idx, const Params& p, LAS unsigned char* lds) {
  unsigned char* ws = p.ws + opq0_(); unsigned char* r2 = (unsigned char*)p.out + opq0_();
  int nM = MT, nN = 4, K = 1024, lda = 1024, ldb = 1024;
  const bf16_t* Wt = nullptr;
  switch (kind) {
    case K_UP: nN = 22; Wt = (const bf16_t*)(ws + (idx == 0 ? W0_F1UP : idx == 1 ? W0_F2UP : idx == 2 ? W1_F1UP : W1_F2UP)); break;
    case K_DN: nN = 4; K = FF; lda = FF; ldb = FF; Wt = (const bf16_t*)(ws + (idx == 0 ? W0_F1DN : idx == 1 ? W0_F2DN : idx == 2 ? W1_F1DN : W1_F2DN)); break;
    case K_WINA: nN = 13; Wt = (const bf16_t*)(ws + W0_INA); break;
    case K_WINB: nN = 7; Wt = (const bf16_t*)(ws + W0_INB); break;
    case K_WOUT: nN = 4; Wt = (const bf16_t*)(ws + (idx == 0 ? W0_OUT : W1_OUT)); break;
    default: nN = 10; Wt = (const bf16_t*)(ws + W1_IN); break;
  }
  const int U = nM * nN;
  int pm, pn;
  if (!unit_for(0, U, nM, nN, pm, pn, lds)) return;
  const int KB = K >> 6;
  const bool tiledA = kind != K_WOUT;
  auto ptrA = [&](int m) -> const char* {
    if (kind == K_DN) return (const char*)(m < MT_A ? (const bf16_t*)(ws + R1_ACTA) + (size_t)m * 256 * FF : (const bf16_t*)(r2 + R2_ACTB) + (size_t)(m - MT_A) * 256 * FF);
    if (kind == K_WOUT) return (const char*)((const bf16_t*)(ws + R1_MIX) + (size_t)m * 256 * 1024);
    return (const char*)((const bf16_t*)(ws + OFF_H) + (size_t)m * 256 * 1024); };
  auto ptrB = [&](int n) -> const char* { return (const char*)(Wt + (size_t)n * 256 * ldb); };
  const int tid = tidx_(), wid = tid >> 6, lane = tid & 63, wr = wid >> 2, wc = wid & 3, fr = lane & 15, fq = lane >> 4;
  unsigned voffA[2], voffB[2];
#pragma unroll
  for (int i = 0; i < 2; ++i) { int R, C; stage_rc(tid * 16 + i * 8192, R, C); voffA[i] = (unsigned)(R * (tiledA ? 64 : lda) + C) * 2u; voffB[i] = (unsigned)(R * 64 + C) * 2u; }
  const unsigned ldsw = (unsigned)wid * 1024u;
  const int aoff = lds_byte(wr * 64 + fr, fq * 8), boff = lds_byte(wc * 32 + fr, fq * 8);
  const size_t hA = tiledA ? (size_t)KB * 16384 : (size_t)128 * lda * 2, hB = (size_t)KB * 16384, kstepA = tiledA ? 16384 : 128, kstepB = 16384;
  const int nt = K / 64;
  const char* cA = ptrA(pm); const char* cB = ptrB(pn);
  f32x4 acc[2][2][4][2];
#pragma unroll
  for (int a = 0; a < 2; ++a)
#pragma unroll
    for (int b = 0; b < 2; ++b)
#pragma unroll
      for (int m = 0; m < 4; ++m)
#pragma unroll
        for (int n = 0; n < 2; ++n) acc[a][b][m][n] = (f32x4){0.f, 0.f, 0.f, 0.f};
  bf16x8 At[4][2], B0[2][2], B1[2][2];
  STAGE_(SB_(0, 0), cB, voffB); STAGE_(SA_(0, 0), cA, voffA); STAGE_(SB_(0, 1), cB + hB, voffB); STAGE_(SA_(0, 1), cA + hA, voffA);
  if (wr == 1) BAR_;
  WAIT_V(4); BAR_;
  STAGE_(SB_(1, 0), cB + kstepB, voffB); STAGE_(SA_(1, 0), cA + kstepA, voffA); STAGE_(SB_(1, 1), cB + hB + kstepB, voffB);
  WAIT_V(6); BAR_;
  int it = 0;
  for (;;) {
    int pm2 = 0, pn2 = 0;
    const bool has_next = unit_for(it + 1, U, nM, nN, pm2, pn2, lds);
    const char* nA = has_next ? ptrA(pm2) : cA; const char* nB = has_next ? ptrB(pn2) : cB;
    for (int t = 0; t < nt; t += 2) {
      const bool last = (t == nt - 2);
      const char* a1 = cA + (size_t)(t + 1) * kstepA;
      const char* a2 = last ? nA : cA + (size_t)(t + 2) * kstepA; const char* b2 = last ? nB : cB + (size_t)(t + 2) * kstepB;
      const char* a3 = a2 + kstepA; const char* b3 = b2 + kstepB;
      LDB_(B0, 0, 0); SCHED_; LDA_(At, 0, 0); STAGE_(SA_(1, 1), a1 + hA, voffA);
      WAIT_L(8); BAR_; WAIT_L(0); MMA_(0, 0, At, B0); BAR_; SCHED_;
      LDB_(B1, 0, 1); STAGE_(SB_(0, 0), b2, voffB);
      BAR_; WAIT_L(0); MMA_(0, 1, At, B1); BAR_;
      LDA_(At, 0, 1); STAGE_(SA_(0, 0), a2, voffA);
      BAR_; WAIT_L(0); MMA_(1, 0, At, B0); BAR_; SCHED_;
      STAGE_(SB_(0, 1), b2 + hB, voffB);
      WAIT_V(6); BAR_; MMA_(1, 1, At, B1); BAR_;
      LDB_(B0, 1, 0); SCHED_; LDA_(At, 1, 0); STAGE_(SA_(0, 1), a2 + hA, voffA);
      WAIT_L(8); BAR_; WAIT_L(0); MMA_(0, 0, At, B0); BAR_; SCHED_;
      LDB_(B1, 1, 1); STAGE_(SB_(1, 0), b3, voffB);
      BAR_; WAIT_L(0); MMA_(0, 1, At, B1); BAR_;
      LDA_(At, 1, 1); STAGE_(SA_(1, 0), a3, voffA);
      BAR_; WAIT_L(0); MMA_(1, 0, At, B0); BAR_; SCHED_;
      STAGE_(SB_(1, 1), b3 + hB, voffB);
      WAIT_V(6); BAR_; MMA_(1, 1, At, B1); BAR_;
    }
    { unsigned char* ws2 = ws + opq0_(); unsigned char* r22 = r2 + opq0_();
      F3Info f3; f3.grp = 0; f3.k1 = 0; f3.mt = 0; f3.nt = 0; gemm_epilogue(kind, pm, pn, f3, acc, ws2, r22, lds); }
    if (!has_next) break;
#pragma unroll
    for (int a = 0; a < 2; ++a)
#pragma unroll
      for (int b = 0; b < 2; ++b)
#pragma unroll
        for (int m = 0; m < 4; ++m)
#pragma unroll
          for (int n = 0; n < 2; ++n) acc[a][b][m][n] = (f32x4){0.f, 0.f, 0.f, 0.f};
    pm = pm2; pn = pn2; cA = nA; cB = nB; ++it;
  }
  WAIT_V(0);
  if (wr == 0) BAR_;
  BAR_;
  __syncthreads();
}
enum { CM_ID = 0, CM_ROPE = 1 };
struct Job { const float* src; const float* src2; const float* gain; bf16_t* dst; int ldw, K, Np, cm, off, half2; };
__device__ __forceinline__ void conv_tile(const Job& jb, int tn, int tk, LAS unsigned char* lds) {
  LAS float* tile = (LAS float*)lds;
  const int tid = tidx_();
  const int nn = tid & 63, n = tn * 64 + nn;
  const float* src = jb.src; int c;
  if (jb.half2 & 1) { const int t = n >> 8, r = n & 255; if (r >= 128) { src = jb.src2; c = (jb.half2 >> 1) + t * 128 + (r - 128); } else c = jb.off + t * 128 + r; }
  else if (jb.cm == CM_ROPE) { const int pnq = n >> 8, r = n & 255, bj = r >> 7, wc = (r >> 5) & 3, nq = (r >> 4) & 1, i = r & 15, g = bj * 4 + wc;
    c = jb.off + pnq * 256 + (g >> 1) * 64 + nq * 32 + (g & 1) * 16 + i; }
  else c = jb.off + n;
#pragma unroll
  for (int i = 0; i < 8; ++i) { const int kk = i * 8 + (tid >> 6), k = tk * 64 + kk;
    float v = src[(size_t)k * jb.ldw + c]; if (jb.gain) v *= jb.gain[k]; tile[nn * 65 + kk] = v; }
  __syncthreads();
  { const int r = tid >> 3, kc = (tid & 7) * 8; u32x4 w;
    w.x = pack2(tile[r * 65 + kc + 0], tile[r * 65 + kc + 1]); w.y = pack2(tile[r * 65 + kc + 2], tile[r * 65 + kc + 3]);
    w.z = pack2(tile[r * 65 + kc + 4], tile[r * 65 + kc + 5]); w.w = pack2(tile[r * 65 + kc + 6], tile[r * 65 + kc + 7]);
    *(u32x4*)(jb.dst + tix(tn * 64 + r, tk * 64 + kc, jb.K >> 6)) = w; }
  __syncthreads();
}
__device__ __forceinline__ Job mkjob(const float* s, const float* s2, const float* g, bf16_t* d, int ldw, int K, int Np, int cm, int off, int half2) {
  Job j; j.src = s; j.src2 = s2; j.gain = g; j.dst = d; j.ldw = ldw; j.K = K; j.Np = Np; j.cm = cm; j.off = off; j.half2 = half2; return j; }
__device__ __forceinline__ Job get_job(const Params& p, int set, int j, bool tab) {
  unsigned char* ws = p.ws + opq0_();
#define IN0(i) (tab ? inp(ws, i) : p.in[i])
  if (set == 0) {
    switch (j) {
      case 0: return mkjob(IN0(4), IN0(5), IN0(3), (bf16_t*)(ws + W0_F1UP), FF, 1024, 5632, 0, 0, 1);
      case 1: return mkjob(IN0(6), nullptr, nullptr, (bf16_t*)(ws + W0_F1DN), 1024, FF, 1024, 0, 0, 0);
      case 2: return mkjob(IN0(8), nullptr, IN0(7), (bf16_t*)(ws + W0_INA), 3328, 1024, 512, CM_ROPE, 0, 0);
      case 3: return mkjob(IN0(8), nullptr, IN0(7), (bf16_t*)(ws + W0_INA) + (size_t)512 * 1024, 3328, 1024, 1024, 0, 512, 0);
      case 4: return mkjob(IN0(8), nullptr, IN0(7), (bf16_t*)(ws + W0_INB), 3328, 1024, 1792, 0, 1536, 0);
      case 5: return mkjob(IN0(9), nullptr, nullptr, (bf16_t*)(ws + W0_OUT), 1024, 1024, 1024, 0, 0, 0);
      case 6: return mkjob(IN0(22), IN0(23), IN0(21), (bf16_t*)(ws + W0_F2UP), FF, 1024, 5632, 0, 0, 1);
      default: return mkjob(IN0(24), nullptr, nullptr, (bf16_t*)(ws + W0_F2DN), 1024, FF, 1024, 0, 0, 0);
    }
  } else {
    switch (j) {
      case 0: return mkjob(inp(ws, 26), inp(ws, 27), inp(ws, 25), (bf16_t*)(ws + W1_F1UP), FF, 1024, 5632, 0, 0, 1);
      case 1: return mkjob(inp(ws, 28), nullptr, nullptr, (bf16_t*)(ws + W1_F1DN), 1024, FF, 1024, 0, 0, 0);
      case 2: return mkjob(inp(ws, 30), nullptr, inp(ws, 29), (bf16_t*)(ws + W1_IN) + (size_t)1024 * 1024, 2048, 1024, 512, 0, 512, 0);
      case 3: return mkjob(inp(ws, 30), inp(ws, 30), inp(ws, 29), (bf16_t*)(ws + W1_IN) + (size_t)1536 * 1024, 2048, 1024, 1024, 0, 1024, 1 | (1536 << 1));
      case 4: return mkjob(inp(ws, 31), nullptr, nullptr, (bf16_t*)(ws + W1_OUT), 1024, 1024, 1024, 0, 0, 0);
      case 5: return mkjob(inp(ws, 34), inp(ws, 35), inp(ws, 33), (bf16_t*)(ws + W1_F2UP), FF, 1024, 5632, 0, 0, 1);
      case 6: return mkjob(inp(ws, 36), nullptr, nullptr, (bf16_t*)(ws + W1_F2DN), 1024, FF, 1024, 0, 0, 0);
      default: return mkjob(inp(ws, 32), nullptr, nullptr, nullptr, 0, 0, 0, 0, 0, 0);
    }
  }
}
__device__ __forceinline__ void prep_weights(const Params& p, int set, LAS unsigned char* lds) {
  const int j0 = set == 2 ? 4 : set == 3 ? 5 : 0, j1 = set == 0 ? 4 : set == 2 ? 5 : set == 3 ? 8 : 7;
  int base = 0;
  for (int j = j0; j < j1; ++j) {
    const Job jb = get_job(p, set == 1 ? 1 : 0, j, set != 0);
    const int tn = jb.Np / 64, tk = jb.K / 64, nt = tn * tk;
    const int G = gdim_();
    int t0 = (bidx_() - base % G + G) % G;
    for (int t = t0; t < nt; t += G) conv_tile(jb, t / tk, t % tk, lds);
    base += nt;
  }
}

__device__ __forceinline__ void prep_misc(const Params& p) {
  unsigned char* ws = p.ws + opq0_();
  const int tid = tidx_(), lane = tid & 63, gw = bidx_() * 8 + (tid >> 6), nw = gridDim.x * 8;
  bf16_t* h = (bf16_t*)(ws + OFF_H); float* rowsq = (float*)(ws + T_ROWSQ);
  for (int row = gw; row < MROWS; row += nw) {
    int seq, pos, L; row_info(row, seq, pos, L);
    const float* src = nullptr;
    if (pos >= 16) src = (seq < 2 ? p.in[0] + ((size_t)seq * 8192 + (pos - 16)) * 1024 : p.in[1] + ((size_t)(seq - 2) * 4096 + (pos - 16)) * 1024);
    else if (pos >= 0) src = p.in[2] + (size_t)pos * 1024;
    float ss = 0.f;
#pragma unroll
    for (int i = 0; i < 4; ++i) {
      const int c = i * 256 + lane * 4;
      f32x4 v = (f32x4){0.f, 0.f, 0.f, 0.f}; if (src) v = *(const f32x4*)(src + c);
      u32x2 w; w.x = pack2(v[0], v[1]); w.y = pack2(v[2], v[3]);
      *(u32x2*)(h + tix(row, c, 16)) = w;
      const float a = bflo(w.x), b = bfhi(w.x), cc = bflo(w.y), d = bfhi(w.y); ss += (a * a + b * b) + (cc * cc + d * d);
    }
#pragma unroll
    for (int o = 32; o >= 1; o >>= 1) ss += shx(ss, o, lane);
    if (lane < 16) rowsq[(size_t)row * 16 + lane] = lane == 0 ? ss : 0.f;
  }
  const int gt = bidx_() * 512 + tid, ngt = gridDim.x * 512;
  if (gt == 0) {
#pragma unroll
    for (int i = 0; i < 38; ++i) ((unsigned long long*)(ws + T_PTR))[i] = (unsigned long long)p.in[i];
  }
  { float* rc = (float*)(ws + T_ROPE); float* rs = rc + (size_t)LP * 32;
    for (int i = gt; i < LP * 32; i += ngt) { const int pos = i >> 5, d = i & 31; const float inv = powf(10000.0f, -(float)d / 32.0f); const float ang = (float)pos * inv; rc[i] = cosf(ang); rs[i] = sinf(ang); } }
  { bf16_t* a = (bf16_t*)(ws + T_ADFTP);
    for (int i = gt; i < 512 * 1024; i += ngt) { const int k2 = i >> 10, kk = i & 1023, n2 = kk & 511; const int mm = (k2 * n2) % 513; const float x = 2.0f * (float)mm / 513.0f; a[i] = f2bf(kk < 512 ? cospif(x) : sinpif(x)); }
    bf16_t* b = (bf16_t*)(ws + T_ADFTS);
    for (int i = gt; i < 256 * 512; i += ngt) { const int k2 = i >> 9, kk = i & 511, n2 = kk & 255; const int mm = (k2 * n2) % 257; const float x = 2.0f * (float)mm / 257.0f; b[i] = f2bf(kk < 256 ? cospif(x) : sinpif(x)); } }
  { bf16_t* f = (bf16_t*)(ws + T_FT);
    for (int i = gt; i < 1024 * 512; i += ngt) { const int np = i >> 9, kc = i & 511, part = np >> 9, g = (np >> 7) & 3, cp = np & 127, g2 = kc >> 7, c = kc & 127;
      float v = 0.f; if (g2 == g) { const float x = 2.0f * (float)((c * cp) & 127) / 128.0f; v = part == 0 ? cospif(x) : -sinpif(x); } f[i] = f2bf(v); } }
  { bf16_t* w = (bf16_t*)(ws + T_WTMP); const float* src = p.in[30]; const float* g = p.in[29];
    for (int i = gt; i < 1024 * 512; i += ngt) { const int k = i >> 9, c = i & 511; w[i] = f2bf(g[k] * src[(size_t)k * 2048 + c]); } }
  { float* tp = (float*)(ws + T_TWP); for (int i = gt; i < 16 * 513; i += ngt) { const int k1 = i / 513, n2 = i % 513; const float x = 2.0f * (float)(k1 * n2) / (float)LP; tp[2 * i] = cospif(x); tp[2 * i + 1] = sinpif(x); }
    float* ts = (float*)(ws + T_TWS); for (int i = gt; i < 16 * 257; i += ngt) { const int k1 = i / 257, n2 = i % 257; const float x = 2.0f * (float)(k1 * n2) / (float)LS; ts[2 * i] = cospif(x); ts[2 * i + 1] = sinpif(x); } }
  { float* tc = (float*)(ws + T_TAILC);
    for (int i = gt; i < 513; i += ngt) { const float x = 2.0f * (float)((i * 512) % 513) / 513.0f; const float c = cospif(x), s = sinpif(x);
      if (i < 512) { tc[TC_CTP + i] = c; tc[TC_STP + i] = s; } tc[TC_ARCP + i] = c; tc[TC_ARSP + i] = s; }
    for (int i = gt; i < 257; i += ngt) { const float x = 2.0f * (float)((i * 256) % 257) / 257.0f; const float c = cospif(x), s = sinpif(x);
      if (i < 256) { tc[TC_CTS + i] = c; tc[TC_STS + i] = s; } tc[TC_ARCS + i] = c; tc[TC_ARSS + i] = s; } }
  { bf16_t* g2t = (bf16_t*)(ws + T_G2T); const float* g2 = p.in[15]; for (int i = gt; i < 512 * 128; i += ngt) { const int c = i >> 7, r = i & 127; g2t[i] = f2bf(g2[(size_t)r * 512 + c]); } }
}
__device__ __forceinline__ void ret_unit(int uid, int& seq, int& chunk, int& head, int& cidx) {
  if (uid < 520) { seq = uid / 260; const int rem = uid % 260; chunk = rem >> 2; head = rem & 3; cidx = seq * 65 + chunk; }
  else { const int v = uid - 520; const int s = v / 132; seq = 2 + s; const int rem = v % 132; chunk = rem >> 2; head = rem & 3; cidx = 130 + s * 33 + chunk; }
}
__device__ __forceinline__ float ret_lg(int head) { return log1pf(-exp2f(-5.0f - (float)head)); }
constexpr int VT_LD = 136;

__device__ __forceinline__ void load_vT(const bf16_t* mix, int row0, int head, LAS bf16_t* vT) {
  const int tid = tidx_(), j = tid >> 2, e0 = (tid & 3) * 32;
  const u32x4* src = (const u32x4*)(mix + (size_t)(row0 + j) * 1024 + head * 128 + e0);
#pragma unroll
  for (int q = 0; q < 4; ++q) { const u32x4 v = src[q]; const unsigned w[4] = {v.x, v.y, v.z, v.w};
#pragma unroll
    for (int t = 0; t < 4; ++t) { vT[(e0 + q * 8 + t * 2) * VT_LD + j] = (bf16_t)(w[t] & 0xffff); vT[(e0 + q * 8 + t * 2 + 1) * VT_LD + j] = (bf16_t)(w[t] >> 16); } }
}

__device__ __forceinline__ void ret_kv_phase(const Params& p, LAS unsigned char* lds) {
  unsigned char* ws = p.ws + opq0_(); unsigned char* r2 = (unsigned char*)p.out + opq0_();
  const bf16_t* mix = (const bf16_t*)(ws + R1_MIX); const bf16_t* qk = (const bf16_t*)(ws + R1_QK);
  bf16_t* kvf = (bf16_t*)(ws + R1_KVF); bf16_t* kvb = (bf16_t*)(ws + R1_KVB);
  LAS bf16_t* vT = (LAS bf16_t*)lds; LAS bf16_t* kTf = vT + 128 * VT_LD; LAS bf16_t* kTb = kTf + 64 * VT_LD;
  const int tid = tidx_(), wid = tid >> 6, lane = tid & 63, fr = lane & 15, fq = lane >> 4;
  for (int uid = bidx_(); uid < 1048; uid += gridDim.x) {
    int seq, chunk, head, cidx; ret_unit(uid, seq, chunk, head, cidx);
    const int row0 = cidx * 128; const float lg = ret_lg(head);
    __syncthreads();
    load_vT(mix, row0, head, vT);
    { const int j = tid >> 2, d0 = (tid & 3) * 16;
      const float df = __expf(lg * (float)(127 - j)), db = __expf(lg * (float)j);
      const u32x4* src = (const u32x4*)(qk + (size_t)(row0 + j) * 512 + 256 + head * 64 + d0);
#pragma unroll
      for (int q = 0; q < 2; ++q) { const u32x4 v = src[q]; const unsigned w[4] = {v.x, v.y, v.z, v.w};
#pragma unroll
        for (int t = 0; t < 4; ++t) { const float lo = bflo(w[t]), hi = bfhi(w[t]); const int d = d0 + q * 8 + t * 2;
          kTf[d * VT_LD + j] = f2bf(lo * df); kTf[(d + 1) * VT_LD + j] = f2bf(hi * df);
          kTb[d * VT_LD + j] = f2bf(lo * db); kTb[(d + 1) * VT_LD + j] = f2bf(hi * db); } } }
    __syncthreads();
    f32x4 af[4], ab[4];
#pragma unroll
    for (int m = 0; m < 4; ++m) { af[m] = (f32x4){0.f, 0.f, 0.f, 0.f}; ab[m] = (f32x4){0.f, 0.f, 0.f, 0.f}; }
#pragma unroll
    for (int ks = 0; ks < 4; ++ks) {
      const bf16x8 y = *(const LAS bf16x8*)(vT + (wid * 16 + fr) * VT_LD + ks * 32 + fq * 8);
#pragma unroll
      for (int m = 0; m < 4; ++m) {
        const bf16x8 xf = *(const LAS bf16x8*)(kTf + (m * 16 + fr) * VT_LD + ks * 32 + fq * 8);
        const bf16x8 xb = *(const LAS bf16x8*)(kTb + (m * 16 + fr) * VT_LD + ks * 32 + fq * 8);
        af[m] = mfma16(xf, y, af[m]); ab[m] = mfma16(xb, y, ab[m]);
      }
    }
    const size_t o = ((size_t)(cidx * 4 + head) * 128 + wid * 16 + fr) * 64;
#pragma unroll
    for (int m = 0; m < 4; ++m) { u32x2 w; w.x = pack2(af[m][0], af[m][1]); w.y = pack2(af[m][2], af[m][3]); *(u32x2*)(kvf + o + m * 16 + fq * 4) = w;
      w.x = pack2(ab[m][0], ab[m][1]); w.y = pack2(ab[m][2], ab[m][3]); *(u32x2*)(kvb + o + m * 16 + fq * 4) = w; }
  }
}

__device__ __forceinline__ void ret_scan_phase(const Params& p) {
  unsigned char* ws = p.ws + opq0_();
  const int gt = bidx_() * 512 + tidx_(), ngt = gridDim.x * 512;
  for (int w = gt; w < 2 * 24 * 2048; w += ngt) {
    const int dir = w / (24 * 2048), rem = w % (24 * 2048), sh = rem >> 11, eg = rem & 2047, seq = sh >> 2, head = sh & 3;
    const int n = seq < 2 ? 65 : 33, cb = seq < 2 ? seq * 65 : 130 + (seq - 2) * 33;
    bf16_t* base = (bf16_t*)(ws + (dir ? R1_KVB : R1_KVF)) + (size_t)head * 8192 + eg * 4;
    const float gc = __expf(128.0f * ret_lg(head));
    float s0 = 0.f, s1 = 0.f, s2 = 0.f, s3 = 0.f;
    for (int i = 0; i < n; ++i) {
      const int c = dir ? n - 1 - i : i;
      u32x2* ptr = (u32x2*)(base + (size_t)(cb + c) * 4 * 8192);
      const u32x2 x = *ptr;
      u32x2 o; o.x = pack2(s0, s1); o.y = pack2(s2, s3); *ptr = o;
      s0 = gc * s0 + bflo(x.x); s1 = gc * s1 + bfhi(x.x); s2 = gc * s2 + bflo(x.y); s3 = gc * s3 + bfhi(x.y);
    }
  }
}

__device__ __forceinline__ bf16x8 scale_frag(bf16x8 v, float s) {
  bf16x8 o;
#pragma unroll
  for (int i = 0; i < 8; ++i) o[i] = (short)f2bf(bf2f((bf16_t)v[i]) * s);
  return o;
}

__device__ __forceinline__ void ret_out_phase(const Params& p, LAS unsigned char* lds) {
  unsigned char* ws = p.ws + opq0_(); unsigned char* r2 = (unsigned char*)p.out + opq0_();
  bf16_t* mix = (bf16_t*)(ws + R1_MIX); const bf16_t* qk = (const bf16_t*)(ws + R1_QK);
  const bf16_t* kvf = (const bf16_t*)(ws + R1_KVF); const bf16_t* kvb = (const bf16_t*)(ws + R1_KVB);
  LAS bf16_t* vT = (LAS bf16_t*)lds; LAS bf16_t* Pm = vT + 128 * VT_LD;
  const int tid = tidx_(), wid = tid >> 6, lane = tid & 63, fr = lane & 15, fq = lane >> 4;
  for (int uid = bidx_(); uid < 1048; uid += gridDim.x) {
    int seq, chunk, head, cidx; ret_unit(uid, seq, chunk, head, cidx);
    const int row0 = cidx * 128; const float lg = ret_lg(head);
    __syncthreads();
    load_vT(mix, row0, head, vT);
    bf16x8 qf[2];
#pragma unroll
    for (int ks = 0; ks < 2; ++ks) qf[ks] = *(const bf16x8*)(qk + (size_t)(row0 + wid * 16 + fr) * 512 + head * 64 + ks * 32 + fq * 8);
    f32x4 acc[8];
#pragma unroll
    for (int nt = 0; nt < 8; ++nt) {
      acc[nt] = (f32x4){0.f, 0.f, 0.f, 0.f};
#pragma unroll
      for (int ks = 0; ks < 2; ++ks) { const bf16x8 kf = *(const bf16x8*)(qk + (size_t)(row0 + nt * 16 + fr) * 512 + 256 + head * 64 + ks * 32 + fq * 8); acc[nt] = mfma16(qf[ks], kf, acc[nt]); }
    }
#pragma unroll
    for (int nt = 0; nt < 8; ++nt)
#pragma unroll
      for (int r = 0; r < 4; ++r) { const int i = wid * 16 + fq * 4 + r, j = nt * 16 + fr; const int dd = i > j ? i - j : j - i;
        Pm[i * VT_LD + j] = f2bf(acc[nt][r] * __expf(lg * (float)dd)); }
    __syncthreads();
    const int irow = wid * 16 + fr;
    const float g1 = __expf(lg * (float)(irow + 1)), g2 = __expf(lg * (float)(128 - irow));
    bf16x8 q1[2], q2[2];
#pragma unroll
    for (int ks = 0; ks < 2; ++ks) { q1[ks] = scale_frag(qf[ks], g1); q2[ks] = scale_frag(qf[ks], g2); }
    bf16x8 pf[4];
#pragma unroll
    for (int ks = 0; ks < 4; ++ks) pf[ks] = *(const LAS bf16x8*)(Pm + irow * VT_LD + ks * 32 + fq * 8);
    const bf16_t* sp = kvf + (size_t)(cidx * 4 + head) * 8192; const bf16_t* sn = kvb + (size_t)(cidx * 4 + head) * 8192;
    float ssq[4] = {0.f, 0.f, 0.f, 0.f};
#pragma unroll
    for (int nt = 0; nt < 8; ++nt) {
      f32x4 a = (f32x4){0.f, 0.f, 0.f, 0.f};
#pragma unroll
      for (int ks = 0; ks < 4; ++ks) { const bf16x8 y = *(const LAS bf16x8*)(vT + (nt * 16 + fr) * VT_LD + ks * 32 + fq * 8); a = mfma16(pf[ks], y, a); }
#pragma unroll
      for (int ks = 0; ks < 2; ++ks) { const bf16x8 y1 = *(const bf16x8*)(sp + (size_t)(nt * 16 + fr) * 64 + ks * 32 + fq * 8); a = mfma16(q1[ks], y1, a);
        const bf16x8 y2 = *(const bf16x8*)(sn + (size_t)(nt * 16 + fr) * 64 + ks * 32 + fq * 8); a = mfma16(q2[ks], y2, a); }
      acc[nt] = a;
#pragma unroll
      for (int r = 0; r < 4; ++r) ssq[r] += a[r] * a[r];
    }
#pragma unroll
    for (int r = 0; r < 4; ++r) { ssq[r] = rowsum16(ssq[r]); ssq[r] = rsqrtf(ssq[r] * (1.0f / 128.0f) + 1e-5f); }
    __syncthreads();
#pragma unroll
    for (int nt = 0; nt < 8; ++nt)
#pragma unroll
      for (int r = 0; r < 4; ++r) {
        const int i = wid * 16 + fq * 4 + r, e = nt * 16 + fr;
        bf16_t* dst = mix + (size_t)(row0 + i) * 1024 + head * 128 + e;
        const float gr = bf2f(dst[512]);
        *dst = f2bf(acc[nt][r] * ssq[r] * gr * sigmoidf_(gr));
      }
  }
}
__device__ __forceinline__ float tanh_fast(float x) { x = fminf(fmaxf(x, -15.f), 15.f); const float e = __expf(2.0f * x); return (e - 1.0f) * rcpf_(e + 1.0f); }
__device__ __forceinline__ f32x4 ld_bf4(const LAS bf16_t* p) { const u32x2 v = *(const LAS u32x2*)p; return (f32x4){bflo(v.x), bfhi(v.x), bflo(v.y), bfhi(v.y)}; }

__device__ __forceinline__ void rwkv_scan_phase(const Params& p, LAS unsigned char* lds) {
  unsigned char* ws = p.ws + opq0_(); unsigned char* r2 = (unsigned char*)p.out + opq0_();
  const bf16_t* prw = (const bf16_t*)(r2 + R2_PRW);
  float* bonus = (float*)(ws + T_BONUS);
  LAS bf16_t* raw = (LAS bf16_t*)lds;
  LAS bf16_t* txw = (LAS bf16_t*)(lds + 21760);
  LAS bf16_t* xab = (LAS bf16_t*)(lds + 26368);
  LAS bf16_t* w2s = (LAS bf16_t*)(lds + 30976);
  LAS bf16_t* a2s = (LAS bf16_t*)(lds + 40192);
  LAS float* pre = (LAS float*)(lds + 49408);
  LAS float* st = (LAS float*)(lds + 65792);
  LAS float* vbuf = (LAS float*)(lds + 106752);
  LAS float* sc = (LAS float*)(lds + 114944);
  LAS float* obuf = (LAS float*)(lds + 115456);
  const int tid = tidx_(), wid = tid >> 6, lane = tid & 63, fr = lane & 15, fq = lane >> 4;
  const float* mu = inp(ws, 10);
  for (int wi = bidx_(); wi < 256; wi += gridDim.x) {
    int dir, seq, head, rbase, NRW, L, rsplit;
    if (wi < 128) { const int chain = wi >> 2; rsplit = wi & 3; dir = chain >> 4; seq = (chain & 15) >> 3; head = chain & 7; NRW = 16; rbase = rsplit * 16; L = LP; }
    else { const int v = wi - 128; const int chain = v >> 1; rsplit = v & 1; dir = chain >> 5; seq = 2 + ((chain & 31) >> 3); head = chain & 7; NRW = 32; rbase = rsplit * 32; L = LS; }
    const int sb = seq_base(seq) + PADR;
    bf16_t* od = (bf16_t*)(ws + (dir ? R1_OB : R1_OF));
    const int nblk = (L + 31) >> 5;
    __syncthreads();
    { const float* w2 = inp(ws, 12) + (size_t)dir * 64 * 512 + head * 64; const float* a2 = inp(ws, 14) + (size_t)dir * 64 * 512 + head * 64;
#pragma unroll
      for (int i = 0; i < 8; ++i) { const int e = tid + i * 512, k = e & 63, r = e >> 6; w2s[k * 72 + r] = f2bf(w2[(size_t)r * 512 + k]); a2s[k * 72 + r] = f2bf(a2[(size_t)r * 512 + k]); } }
    const int kq = tid & 15, k0 = kq * 4, ch0 = head * 64 + k0;
    const f32x4 w0c = *(const f32x4*)(inp(ws, 11) + dir * 512 + ch0), a0c = *(const f32x4*)(inp(ws, 13) + dir * 512 + ch0);
    const f32x4 kkc = *(const f32x4*)(inp(ws, 16) + ch0), kac = *(const f32x4*)(inp(ws, 17) + ch0), rkc = *(const f32x4*)(inp(ws, 18) + ch0);
    const f32x4 mur = *(const f32x4*)(mu + ch0), muk = *(const f32x4*)(mu + 512 + ch0), muv = *(const f32x4*)(mu + 1024 + ch0);
    const int cb = (tid & 15) * 8;
    const f32x4 mub0 = *(const f32x4*)(mu + 1536 + cb), mub1 = *(const f32x4*)(mu + 1536 + cb + 4);
    u32x4 pf[3];
    auto issue = [&](int b) {
      const int ta = dir == 0 ? b * 32 : L - 32 - b * 32;
#pragma unroll
      for (int i = 0; i < 3; ++i) { const int li = tid + i * 512; pf[i] = (u32x4){0u, 0u, 0u, 0u};
        if (li < 1360) { const int ri = li / 40, rem = li % 40, seg = rem >> 3, chk = rem & 7; const int t = ta - 1 + ri;
          const int col = seg < 3 ? seg * 512 + head * 64 : 1536 + (seg - 3) * 64;
          if (t >= 0 && t < L) pf[i] = *(const u32x4*)(prw + (size_t)(sb + t) * 1792 + col + chk * 8); } }
    };
    issue(0);
    const int srow = wid * 4 + fq;
    const bool sactive = wid * 4 < NRW;
    float S0 = 0.f, S1 = 0.f, S2 = 0.f, S3 = 0.f;
    for (int b = 0; b < nblk; ++b) {
      const int ta = dir == 0 ? b * 32 : L - 32 - b * 32;
      const int nst = (L - b * 32) < 32 ? (L - b * 32) : 32;
#pragma unroll
      for (int i = 0; i < 3; ++i) { const int li = tid + i * 512; if (li < 1360) { const int ri = li / 40, rem = li % 40; *(LAS u32x4*)(raw + ri * 320 + rem * 8) = pf[i]; } }
      if (b + 1 < nblk) issue(b + 1);
      __syncthreads();
      { const int tl = tid >> 4, ri = tl + 1;
        const LAS bf16_t* q0 = raw + (ri - 1) * 320 + 192 + cb; const LAS bf16_t* q1 = q0 + 320; const LAS bf16_t* q2 = q1 + 320;
        float x[8];
#pragma unroll
        for (int hh = 0; hh < 2; ++hh) { const f32x4 a = ld_bf4(q0 + hh * 4), c = ld_bf4(q1 + hh * 4), d = ld_bf4(q2 + hh * 4); const f32x4 m = hh ? mub1 : mub0;
#pragma unroll
          for (int j = 0; j < 4; ++j) x[hh * 4 + j] = c[j] + m[j] * (0.5f * (a[j] + d[j]) - c[j]); }
        u32x4 w;
        if (cb < 64) { w.x = pack2(tanh_fast(x[0]), tanh_fast(x[1])); w.y = pack2(tanh_fast(x[2]), tanh_fast(x[3])); w.z = pack2(tanh_fast(x[4]), tanh_fast(x[5])); w.w = pack2(tanh_fast(x[6]), tanh_fast(x[7]));
          *(LAS u32x4*)(txw + tl * 72 + cb) = w; }
        else { w.x = pack2(x[0], x[1]); w.y = pack2(x[2], x[3]); w.z = pack2(x[4], x[5]); w.w = pack2(x[6], x[7]); *(LAS u32x4*)(xab + tl * 72 + cb - 64) = w; } }
      __syncthreads();
      { const int mat = wid >> 2, mt = (wid >> 1) & 1, ntp = wid & 1;
        const LAS bf16_t* X = mat ? xab : txw; const LAS bf16_t* Y = mat ? a2s : w2s;
#pragma unroll
        for (int nn = 0; nn < 2; ++nn) { const int nt = ntp * 2 + nn; f32x4 a = (f32x4){0.f, 0.f, 0.f, 0.f};
#pragma unroll
          for (int ks = 0; ks < 2; ++ks) { const bf16x8 xf = *(const LAS bf16x8*)(X + (mt * 16 + fr) * 72 + ks * 32 + fq * 8); const bf16x8 yf = *(const LAS bf16x8*)(Y + (nt * 16 + fr) * 72 + ks * 32 + fq * 8); a = mfma16(xf, yf, a); }
#pragma unroll
          for (int r = 0; r < 4; ++r) pre[mat * 2048 + (mt * 16 + fq * 4 + r) * 64 + nt * 16 + fr] = a[r]; } }
      __syncthreads();
      { const int tl = tid >> 4, ri = tl + 1, t = ta + tl;
        const LAS bf16_t* q1 = raw + ri * 320 + k0;
        f32x4 xr, xk, xv;
        { const f32x4 a = ld_bf4(q1 - 320), c = ld_bf4(q1), d = ld_bf4(q1 + 320); xr = c + mur * (0.5f * (a + d) - c); }
        { const f32x4 a = ld_bf4(q1 - 320 + 64), c = ld_bf4(q1 + 64), d = ld_bf4(q1 + 320 + 64); xk = c + muk * (0.5f * (a + d) - c); }
        { const f32x4 a = ld_bf4(q1 - 320 + 128), c = ld_bf4(q1 + 128), d = ld_bf4(q1 + 320 + 128); xv = c + muv * (0.5f * (a + d) - c); }
        const f32x4 wp = *(const LAS f32x4*)(pre + tl * 64 + k0), ap = *(const LAS f32x4*)(pre + 2048 + tl * 64 + k0);
        f32x4 w, a, kk, kd, bb, wrr;
        float ss = 0.f;
#pragma unroll
        for (int j = 0; j < 4; ++j) {
          const float wl = w0c[j] + wp[j]; const float ew = 0.60653066f * rcpf_(1.0f + __expf(-wl)); w[j] = __expf(-ew);
          a[j] = rcpf_(1.0f + __expf(-(a0c[j] + ap[j])));
          kk[j] = xk[j] * kkc[j]; ss += kk[j] * kk[j];
          kd[j] = xk[j] * (1.0f + (a[j] - 1.0f) * kac[j]);
          wrr[j] = w[j] * xr[j];
        }
        ss = rowsum16(ss); const float inv = rsqrtf(fmaxf(ss, 1e-24f));
        float br = 0.f, kdr = 0.f, bon = 0.f;
#pragma unroll
        for (int j = 0; j < 4; ++j) { kk[j] *= inv; bb[j] = kk[j] * a[j]; br += bb[j] * xr[j]; kdr += kd[j] * xr[j]; bon += xr[j] * kd[j] * rkc[j]; }
        br = rowsum16(br); kdr = rowsum16(kdr); bon = rowsum16(bon);
        LAS float* s = st + tl * 320 + k0;
        *(LAS f32x4*)(s) = kk; *(LAS f32x4*)(s + 64) = wrr; *(LAS f32x4*)(s + 128) = w; *(LAS f32x4*)(s + 192) = bb; *(LAS f32x4*)(s + 256) = kd;
        *(LAS f32x4*)(vbuf + tl * 64 + k0) = xv;
        if (kq == 0) { sc[tl * 4] = br; sc[tl * 4 + 1] = kdr; if (rsplit == 0 && t >= 0 && t < L) bonus[(size_t)(sb + t) * 16 + dir * 8 + head] = bon; } }
      __syncthreads();
      if (sactive) {
        int tl = dir ? 31 : 0;
        const LAS float* sp = st + tl * 320 + fr * 4;
        f32x4 kk = *(const LAS f32x4*)(sp), wr4 = *(const LAS f32x4*)(sp + 64), w4 = *(const LAS f32x4*)(sp + 128), b4 = *(const LAS f32x4*)(sp + 192), kd4 = *(const LAS f32x4*)(sp + 256);
        float vv = vbuf[tl * 64 + rbase + srow], br = sc[tl * 4], kdr = sc[tl * 4 + 1];
        for (int s = 0; s < nst; ++s) {
          const int tln = s + 1 < nst ? (dir ? 30 - s : s + 1) : tl;
          const LAS float* spn = st + tln * 320 + fr * 4;
          const f32x4 kkn = *(const LAS f32x4*)(spn), wrn = *(const LAS f32x4*)(spn + 64), wn = *(const LAS f32x4*)(spn + 128), bn = *(const LAS f32x4*)(spn + 192), kdn = *(const LAS f32x4*)(spn + 256);
          const float vvn = vbuf[tln * 64 + rbase + srow], brn = sc[tln * 4], kdrn = sc[tln * 4 + 1];
          float skp = (S0 * kk[0] + S1 * kk[1]) + (S2 * kk[2] + S3 * kk[3]);
          float pp = (S0 * wr4[0] + S1 * wr4[1]) + (S2 * wr4[2] + S3 * wr4[3]);
          const float sk = rowsum16(skp), pt = rowsum16(pp);
          S0 = S0 * w4[0] - sk * b4[0] + vv * kd4[0]; S1 = S1 * w4[1] - sk * b4[1] + vv * kd4[1];
          S2 = S2 * w4[2] - sk * b4[2] + vv * kd4[2]; S3 = S3 * w4[3] - sk * b4[3] + vv * kd4[3];
          if (fr == 0) obuf[tl * 32 + srow] = pt - sk * br + vv * kdr;
          kk = kkn; wr4 = wrn; w4 = wn; b4 = bn; kd4 = kdn; vv = vvn; br = brn; kdr = kdrn; tl = tln;
        }
      }
      __syncthreads();
#pragma unroll
      for (int i = 0; i < 2; ++i) { const int e = tid + i * 512, tl = e >> 5, rw = e & 31, t = ta + tl;
        if (rw < NRW && t >= 0 && t < L) od[(size_t)(sb + t) * 512 + head * 64 + rbase + rw] = f2bf(obuf[tl * 32 + rw]); }
    }
  }
}

__device__ __forceinline__ float rowsum8p(float v) { v += dppf<0xB1>(v); v += dppf<0x4E>(v); v += dppf<0x141>(v); return v; }
__device__ __forceinline__ void unpack8p(const u32x4 v, float (&o)[8]) { o[0] = bflo(v.x); o[1] = bfhi(v.x); o[2] = bflo(v.y); o[3] = bfhi(v.y); o[4] = bflo(v.z); o[5] = bfhi(v.z); o[6] = bflo(v.w); o[7] = bfhi(v.w); }
__device__ __forceinline__ void rwkv_post_phase(const Params& p, LAS unsigned char* lds) {
  unsigned char* ws = p.ws + opq0_(); unsigned char* r2 = (unsigned char*)p.out + opq0_();
  const bf16_t* prw = (const bf16_t*)(r2 + R2_PRW);
  const bf16_t* of = (const bf16_t*)(ws + R1_OF); const bf16_t* ob = (const bf16_t*)(ws + R1_OB);
  const float* bonus = (const float*)(ws + T_BONUS); const bf16_t* g2t = (const bf16_t*)(ws + T_G2T);
  bf16_t* mix = (bf16_t*)(ws + R1_MIX);
  const float* mu = inp(ws, 10); const float* lnw = inp(ws, 19); const float* lnb = inp(ws, 20);
  LAS bf16_t* sg = (LAS bf16_t*)lds;
  LAS float* gbuf = (LAS float*)(lds + 34816);
  const int tid = tidx_(), wid = tid >> 6, lane = tid & 63, fr = lane & 15, fq = lane >> 4;
  const int G = gdim_();
  for (int wjob = bidx_(); wjob < 256 + 48; wjob += G) {
    const int tile = wjob < 256 ? wjob : 256 + ((wjob - 256) >> 3); const int hd0 = wjob < 256 ? 0 : ((wjob - 256) & 7), hd1 = wjob < 256 ? 8 : hd0 + 1;
    const int row0 = tile * 128;
    __syncthreads();
    { const int tr = tid >> 2, c0 = (tid & 3) * 32, row = row0 + tr; int seq, pos, L; row_info(row, seq, pos, L);
      const bool hasp = pos > 0, hasn = pos >= 0 && pos < L - 1;
      const bf16_t* pc = prw + (size_t)row * 1792 + 1664 + c0;
#pragma unroll
      for (int q = 0; q < 4; ++q) {
        const u32x4 c = *(const u32x4*)(pc + q * 8); u32x4 a = (u32x4){0u, 0u, 0u, 0u}, d = (u32x4){0u, 0u, 0u, 0u};
        if (hasp) a = *(const u32x4*)(pc - 1792 + q * 8);
        if (hasn) d = *(const u32x4*)(pc + 1792 + q * 8);
        float cv[8], av[8], dv[8]; unpack8p(c, cv); unpack8p(a, av); unpack8p(d, dv);
        const f32x4 m0 = *(const f32x4*)(mu + 1664 + c0 + q * 8), m1 = *(const f32x4*)(mu + 1664 + c0 + q * 8 + 4);
        float x[8];
#pragma unroll
        for (int j = 0; j < 8; ++j) { const float m = j < 4 ? m0[j & 3] : m1[j & 3]; x[j] = sigmoidf_(cv[j] + m * (0.5f * (av[j] + dv[j]) - cv[j])); }
        *(LAS u32x4*)(sg + tr * VT_LD + c0 + q * 8) = (u32x4){pack2(x[0], x[1]), pack2(x[2], x[3]), pack2(x[4], x[5]), pack2(x[6], x[7])};
      } }
    __syncthreads();
    bf16x8 xf[4];
#pragma unroll
    for (int ks = 0; ks < 4; ++ks) xf[ks] = *(const LAS bf16x8*)(sg + (wid * 16 + fr) * VT_LD + ks * 32 + fq * 8);
    const int ch = tid & 7;
#pragma unroll 1
    for (int hd = hd0; hd < hd1; ++hd) {
      LAS float* gb = gbuf + (hd & 1) * (128 * 68);
#pragma unroll
      for (int nt = 0; nt < 4; ++nt) { f32x4 g = (f32x4){0.f, 0.f, 0.f, 0.f};
#pragma unroll
        for (int ks = 0; ks < 4; ++ks) { const bf16x8 yf = *(const bf16x8*)(g2t + (size_t)(hd * 64 + nt * 16 + fr) * 128 + ks * 32 + fq * 8); g = mfma16(xf[ks], yf, g); }
#pragma unroll
        for (int r = 0; r < 4; ++r) gb[(wid * 16 + fq * 4 + r) * 68 + nt * 16 + fr] = g[r]; }
      __syncthreads();
      const int cg = hd * 64 + ch * 8;
      const f32x4 w0 = *(const f32x4*)(lnw + cg), w1 = *(const f32x4*)(lnw + cg + 4), b0 = *(const f32x4*)(lnb + cg), b1 = *(const f32x4*)(lnb + cg + 4);
      const f32x4 mv0 = *(const f32x4*)(mu + 1024 + cg), mv1 = *(const f32x4*)(mu + 1024 + cg + 4);
#pragma unroll
      for (int i = 0; i < 2; ++i) {
        const int tk = (tid >> 3) + i * 64, row = row0 + tk; int seq, pos, L; row_info(row, seq, pos, L);
        u32x4 res = (u32x4){0u, 0u, 0u, 0u};
        if (pos >= 0) {
          float o1[8], o2[8], o[8];
          unpack8p(*(const u32x4*)(of + (size_t)row * 512 + cg), o1); unpack8p(*(const u32x4*)(ob + (size_t)row * 512 + cg), o2);
          float sum = 0.f;
#pragma unroll
          for (int j = 0; j < 8; ++j) { o[j] = o1[j] + o2[j]; sum += o[j]; }
          sum = rowsum8p(sum); const float mean = sum * (1.0f / 64.0f);
          float vs = 0.f;
#pragma unroll
          for (int j = 0; j < 8; ++j) { const float d = o[j] - mean; vs += d * d; }
          vs = rowsum8p(vs); const float rstd = rsqrtf(vs * (1.0f / 64.0f) + 64e-5f);
          const float bsc = 0.5f * (bonus[(size_t)row * 16 + hd] + bonus[(size_t)row * 16 + 8 + hd]);
          const bf16_t* pv = prw + (size_t)row * 1792 + 1024 + cg;
          float vc[8], va[8], vd[8];
          unpack8p(*(const u32x4*)pv, vc);
          u32x4 ua = (u32x4){0u, 0u, 0u, 0u}, ud = (u32x4){0u, 0u, 0u, 0u};
          if (pos > 0) ua = *(const u32x4*)(pv - 1792);
          if (pos < L - 1) ud = *(const u32x4*)(pv + 1792);
          unpack8p(ua, va); unpack8p(ud, vd);
          const f32x4 g0 = *(const LAS f32x4*)(gb + tk * 68 + ch * 8), g1 = *(const LAS f32x4*)(gb + tk * 68 + ch * 8 + 4);
          float y[8];
#pragma unroll
          for (int j = 0; j < 8; ++j) { const float lw = j < 4 ? w0[j & 3] : w1[j & 3], lb = j < 4 ? b0[j & 3] : b1[j & 3], mm = j < 4 ? mv0[j & 3] : mv1[j & 3], gg = j < 4 ? g0[j & 3] : g1[j & 3];
            const float xv = vc[j] + mm * (0.5f * (va[j] + vd[j]) - vc[j]);
            y[j] = ((o[j] - mean) * rstd * lw + lb + bsc * xv) * gg; }
          res = (u32x4){pack2(y[0], y[1]), pack2(y[2], y[3]), pack2(y[4], y[5]), pack2(y[6], y[7])};
        }
        *(u32x4*)(mix + (size_t)row * 1024 + 512 + cg) = res;
      }
    }
  }
}
__device__ __forceinline__ f32x4 g_bf4(const bf16_t* p) { const u32x2 v = *(const u32x2*)p; return (f32x4){bflo(v.x), bfhi(v.x), bflo(v.y), bfhi(v.y)}; }
__device__ __forceinline__ void unpack8(const u32x4 v, float (&o)[8]) { o[0] = bflo(v.x); o[1] = bfhi(v.x); o[2] = bflo(v.y); o[3] = bfhi(v.y); o[4] = bflo(v.z); o[5] = bfhi(v.z); o[6] = bflo(v.w); o[7] = bfhi(v.w); }
__device__ __forceinline__ float rowsum8(float v) { v += dppf<0xB1>(v); v += dppf<0x4E>(v); v += dppf<0x141>(v); return v; }

constexpr size_t R2_XWA = (size_t)MROWS * 1792 * 2;
static_assert(R2_XWA + (size_t)MROWS * 128 * 2 <= SZ_OUT, "xwa");
__device__ __forceinline__ void xwa_phase(const Params& p) {
  unsigned char* ws = p.ws + opq0_(); unsigned char* r2 = (unsigned char*)p.out + opq0_();
  const bf16_t* prw = (const bf16_t*)(r2 + R2_PRW); bf16_t* xwa = (bf16_t*)(r2 + R2_XWA);
  const float* mu = inp(ws, 10);
  const int gt = bidx_() * 512 + tidx_(), ngt = gdim_() * 512;
  for (int it = gt; it < MROWS * 16; it += ngt) {
    const int row = it >> 4, cb = (it & 15) * 8; int seq, pos, L; row_info(row, seq, pos, L);
    u32x4 o = (u32x4){0u, 0u, 0u, 0u};
    if (pos >= 0) {
      const bf16_t* pc = prw + (size_t)row * 1792 + 1536 + cb;
      u32x4 ua = (u32x4){0u, 0u, 0u, 0u}, ud = (u32x4){0u, 0u, 0u, 0u}; const u32x4 uc = *(const u32x4*)pc;
      if (pos > 0) ua = *(const u32x4*)(pc - 1792);
      if (pos < L - 1) ud = *(const u32x4*)(pc + 1792);
      float a[8], c[8], d[8], x[8]; unpack8(ua, a); unpack8(uc, c); unpack8(ud, d);
      const f32x4 m0 = *(const f32x4*)(mu + 1536 + cb), m1 = *(const f32x4*)(mu + 1536 + cb + 4);
#pragma unroll
      for (int j = 0; j < 8; ++j) { const float m = j < 4 ? m0[j & 3] : m1[j & 3]; x[j] = c[j] + m * (0.5f * (a[j] + d[j]) - c[j]); if (cb < 64) x[j] = tanh_fast(x[j]); }
      o = (u32x4){pack2(x[0], x[1]), pack2(x[2], x[3]), pack2(x[4], x[5]), pack2(x[6], x[7])};
    }
    *(u32x4*)(xwa + (size_t)row * 128 + cb) = o;
  }
}

static_assert(LP % 32 == 16 && LS % 32 == 16, "scan half-blocks assume 16-step halves");
__device__ __forceinline__ void rwkv_scan2_phase(const Params& p, LAS unsigned char* lds) {
  unsigned char* ws = p.ws + opq0_(); unsigned char* r2 = (unsigned char*)p.out + opq0_();
  const bf16_t* prw = (const bf16_t*)(r2 + R2_PRW);
  float* bonus = (float*)(ws + T_BONUS);
  LAS bf16_t* w2s = (LAS bf16_t*)(lds + 0);
  LAS bf16_t* a2s = (LAS bf16_t*)(lds + 9216);
  LAS float* pre = (LAS float*)(lds + 18432);
  LAS float* cst = (LAS float*)(lds + 34816);
  LAS float* stb = (LAS float*)(lds + 36864);
  LAS float* vbb = (LAS float*)(lds + 118784);
  LAS float* scb = (LAS float*)(lds + 124928);
  LAS float* ppb = (LAS float*)(lds + 126464);
  LAS float* skb = (LAS float*)(lds + 142848);
  const int tid = tidx_(), wid = tid >> 6, lane = tid & 63, fr = lane & 15, fq = lane >> 4;
  const float* mu = inp(ws, 10);
  const bool producer = wid >= 4;
  const int pw = wid - 4, ptid = tid - 256;
  const int G = gdim_();
  for (int slot = bidx_(); slot < 256; slot += G) {
    const int nitems = slot < 128 ? 1 : 2;
    for (int itx = 0; itx < nitems; ++itx) {
      int dir, seq, head, rsplit, L;
      if (slot < 128) { const int chain = slot >> 2; rsplit = slot & 3; dir = chain >> 4; seq = (chain & 15) >> 3; head = chain & 7; L = LP; }
      else { const int v = (slot - 128) * 2 + itx; const int chain = v >> 2; rsplit = v & 3; dir = chain >> 5; seq = 2 + ((chain & 31) >> 3); head = chain & 7; L = LS; }
      const int rbase = rsplit * 16;
      const int sb = seq_base(seq) + PADR;
      bf16_t* od = (bf16_t*)(ws + (dir ? R1_OB : R1_OF));
      const int nblk = (L + 31) >> 5;
      __syncthreads();
      { const float* w2 = inp(ws, 12) + (size_t)dir * 64 * 512 + head * 64; const float* a2 = inp(ws, 14) + (size_t)dir * 64 * 512 + head * 64;
#pragma unroll
        for (int i = 0; i < 8; ++i) { const int e = tid + i * 512, k = e & 63, r = e >> 6; w2s[k * 72 + r] = f2bf(w2[(size_t)r * 512 + k]); a2s[k * 72 + r] = f2bf(a2[(size_t)r * 512 + k]); }
        { const int v = tid >> 6, k = tid & 63, c = head * 64 + k; float x;
          switch (v) { case 0: x = inp(ws, 11)[dir * 512 + c]; break; case 1: x = inp(ws, 13)[dir * 512 + c]; break; case 2: x = inp(ws, 16)[c]; break; case 3: x = inp(ws, 17)[c]; break;
                       case 4: x = inp(ws, 18)[c]; break; case 5: x = mu[c]; break; case 6: x = mu[512 + c]; break; default: x = mu[1024 + c]; break; }
          cst[v * 64 + k] = x; } }
      __syncthreads();
      u32x4 px[2][2], pd[3][3];
      const bf16_t* xwa = (const bf16_t*)(r2 + R2_XWA);
      const int dt = pw * 8 + (lane >> 3), dk0 = (lane & 7) * 8;
      auto issue_x = [&](int b) {
        const int ta = dir == 0 ? b * 32 : L - 32 - b * 32; const int t = ta + pw * 8 + (fr & 7);
#pragma unroll
        for (int mat = 0; mat < 2; ++mat)
#pragma unroll
          for (int ks = 0; ks < 2; ++ks) { px[mat][ks] = (u32x4){0u, 0u, 0u, 0u};
            if (t >= 0 && t < L) px[mat][ks] = *(const u32x4*)(xwa + (size_t)(sb + t) * 128 + mat * 64 + ks * 32 + fq * 8); }
      };
      auto issue_d = [&](int b) {
        const int ta = dir == 0 ? b * 32 : L - 32 - b * 32;
#pragma unroll
        for (int sg = 0; sg < 3; ++sg)
#pragma unroll
          for (int rr = 0; rr < 3; ++rr) { const int t = ta + dt - 1 + rr; pd[sg][rr] = (u32x4){0u, 0u, 0u, 0u};
            if (t >= 0 && t < L) pd[sg][rr] = *(const u32x4*)(prw + (size_t)(sb + t) * 1792 + sg * 512 + head * 64 + dk0); }
      };
      if (producer) { issue_x(0); issue_d(0); }
      const int srow = wid * 4 + fq;
      f32x2_t S01 = {0.f, 0.f}, S23 = {0.f, 0.f};
      for (int b = -1; b <= nblk; ++b) {
        const int cur = b & 1, nxt = cur ^ 1;
        const int nst = (b >= 0 && b < nblk) ? ((L - b * 32) < 32 ? (L - b * 32) : 32) : 0;
        if (!producer) {
          if (nst > 0) {
            const LAS float* st = stb + cur * 10240; const LAS float* vb = vbb + (b % 3) * 512;
            LAS float* ppw = ppb + cur * 2048 + srow * 4 + (fr >> 2); LAS float* skw = skb + cur * 512 + srow;
            f32x4 kkA, wrA, wA, bA, kdA, kkB, wrB, wB, bB, kdB; float vvA, vvB;
#define LOADR(X, s_) do { const int tl_ = dir ? 31 - (s_) : (s_); const LAS float* sp_ = st + tl_ * 320 + fr * 4; kk##X = *(const LAS f32x4*)(sp_); wr##X = *(const LAS f32x4*)(sp_ + 64); w##X = *(const LAS f32x4*)(sp_ + 128); \
                          b##X = *(const LAS f32x4*)(sp_ + 192); kd##X = *(const LAS f32x4*)(sp_ + 256); vv##X = vb[tl_ * 16 + srow]; } while (0)
#define STEPR(X, s_) do { const f32x2_t ts_ = __builtin_elementwise_fma(S23, kk##X.hi, S01 * kk##X.lo); const f32x2_t tp_ = __builtin_elementwise_fma(S23, wr##X.hi, S01 * wr##X.lo); \
                          const float sk_ = rowsum16(ts_.x + ts_.y); float pp_ = tp_.x + tp_.y; pp_ += dppf<0xB1>(pp_); pp_ += dppf<0x4E>(pp_); \
                          const f32x2_t nsk_ = {-sk_, -sk_}, vv2_ = {vv##X, vv##X}; \
                          S01 = __builtin_elementwise_fma(vv2_, kd##X.lo, __builtin_elementwise_fma(nsk_, b##X.lo, S01 * w##X.lo)); \
                          S23 = __builtin_elementwise_fma(vv2_, kd##X.hi, __builtin_elementwise_fma(nsk_, b##X.hi, S23 * w##X.hi)); \
                          ppw[(s_) * 64] = pp_; skw[(s_) * 16] = sk_; } while (0)
            const int np = nst >> 1;
            LOADR(A, 0);
            for (int i = 0; i < np; ++i) {
              const int s = 2 * i;
              LOADR(B, s + 1);
              STEPR(A, s);
              LOADR(A, i < np - 1 ? s + 2 : s + 1);
              STEPR(B, s + 1);
            }
#undef LOADR
#undef STEPR
          }
        } else {
          const int fb = b - 1;
          if (fb >= 0 && fb < nblk) {
            const int nstp = (L - fb * 32) < 32 ? (L - fb * 32) : 32; const int tap = dir == 0 ? fb * 32 : L - 32 - fb * 32; const int f3i = fb % 3;
#pragma unroll
            for (int i = 0; i < 2; ++i) { const int e = ptid + i * 256, sl = e >> 4, rw = e & 15;
              if (sl < nstp) {
                const int tl = dir ? 31 - sl : sl; const int t = tap + tl;
                const f32x4 q = *(const LAS f32x4*)(ppb + nxt * 2048 + (sl * 16 + rw) * 4); const float sk = skb[nxt * 512 + sl * 16 + rw];
                const float o = ((q[0] + q[1]) + (q[2] + q[3])) - sk * scb[f3i * 128 + tl * 4] + vbb[f3i * 512 + tl * 16 + rw] * scb[f3i * 128 + tl * 4 + 1];
                od[(size_t)(sb + t) * 512 + head * 64 + rbase + rw] = f2bf(o);
              } }
          }
          const int bn = b + 1;
          if (bn < nblk) {
            const int ta = dir == 0 ? bn * 32 : L - 32 - bn * 32; const int n3i = bn % 3;
            LAS float* prew = pre + pw * 1024;
            const int tloc = lane >> 3, tl = pw * 8 + tloc, t = ta + tl;
            LAS float* s = stb + nxt * 10240 + tl * 320 + dk0;
#pragma unroll
            for (int mat = 0; mat < 2; ++mat) { const LAS bf16_t* Y = mat ? a2s : w2s;
#pragma unroll
              for (int nt = 0; nt < 4; ++nt) { f32x4 a = (f32x4){0.f, 0.f, 0.f, 0.f};
#pragma unroll
                for (int ks = 0; ks < 2; ++ks) { const bf16x8 yf = *(const LAS bf16x8*)(Y + (nt * 16 + fr) * 72 + ks * 32 + fq * 8); a = mfma16(__builtin_bit_cast(bf16x8, px[mat][ks]), yf, a); }
                if (fq < 2) {
#pragma unroll
                  for (int r = 0; r < 4; ++r) prew[mat * 512 + (fq * 4 + r) * 64 + nt * 16 + fr] = a[r]; } } }
            float xk[8];
            { float a[8], c[8], d[8]; unpack8(pd[1][0], a); unpack8(pd[1][1], c); unpack8(pd[1][2], d);
#pragma unroll
              for (int j = 0; j < 8; ++j) xk[j] = c[j] + cst[6 * 64 + dk0 + j] * (0.5f * (a[j] + d[j]) - c[j]); }
            float ss = 0.f;
#pragma unroll
            for (int j = 0; j < 8; ++j) { const float q = xk[j] * cst[2 * 64 + dk0 + j]; ss += q * q; }
            ss = rowsum8(ss); const float inv = rsqrtf(fmaxf(ss, 1e-24f));
            float br = 0.f, kdr = 0.f, bon = 0.f;
#pragma unroll
            for (int hh = 0; hh < 2; ++hh) {
              asm volatile("" ::: "memory");
              f32x4 xr4;
              { const u32x4 ua = pd[0][0], uc = pd[0][1], ud = pd[0][2];
                const unsigned a0 = hh ? ua.z : ua.x, a1 = hh ? ua.w : ua.y, c0 = hh ? uc.z : uc.x, c1 = hh ? uc.w : uc.y, d0 = hh ? ud.z : ud.x, d1 = hh ? ud.w : ud.y;
                const float av[4] = {bflo(a0), bfhi(a0), bflo(a1), bfhi(a1)}, cv[4] = {bflo(c0), bfhi(c0), bflo(c1), bfhi(c1)}, dv[4] = {bflo(d0), bfhi(d0), bflo(d1), bfhi(d1)};
#pragma unroll
                for (int j = 0; j < 4; ++j) xr4[j] = cv[j] + cst[5 * 64 + dk0 + hh * 4 + j] * (0.5f * (av[j] + dv[j]) - cv[j]); }
              f32x4 w4, kk4, kd4, bb4, wr4;
#pragma unroll
              for (int j = 0; j < 4; ++j) { const int kx = dk0 + hh * 4 + j; const float xkj = xk[hh * 4 + j];
                const float wl = cst[0 * 64 + kx] + prew[tloc * 64 + kx]; const float ew = 0.60653066f * rcpf_(1.0f + __expf(-wl)); w4[j] = __expf(-ew);
                const float aj = rcpf_(1.0f + __expf(-(cst[1 * 64 + kx] + prew[512 + tloc * 64 + kx])));
                kk4[j] = xkj * cst[2 * 64 + kx] * inv; kd4[j] = xkj * (1.0f + (aj - 1.0f) * cst[3 * 64 + kx]); bb4[j] = kk4[j] * aj; wr4[j] = w4[j] * xr4[j];
                br += bb4[j] * xr4[j]; kdr += kd4[j] * xr4[j]; bon += xr4[j] * kd4[j] * cst[4 * 64 + kx]; }
              *(LAS f32x4*)(s + hh * 4) = kk4; *(LAS f32x4*)(s + 64 + hh * 4) = wr4; *(LAS f32x4*)(s + 128 + hh * 4) = w4; *(LAS f32x4*)(s + 192 + hh * 4) = bb4; *(LAS f32x4*)(s + 256 + hh * 4) = kd4;
            }
            br = rowsum8(br); kdr = rowsum8(kdr); bon = rowsum8(bon);
            float xv[8];
            { float a[8], c[8], d[8]; unpack8(pd[2][0], a); unpack8(pd[2][1], c); unpack8(pd[2][2], d);
#pragma unroll
              for (int j = 0; j < 8; ++j) xv[j] = c[j] + cst[7 * 64 + dk0 + j] * (0.5f * (a[j] + d[j]) - c[j]); }
            if (dk0 >= rbase && dk0 < rbase + 16) {
              LAS float* vd = vbb + n3i * 512 + tl * 16 + (dk0 - rbase);
              *(LAS f32x4*)(vd) = (f32x4){xv[0], xv[1], xv[2], xv[3]}; *(LAS f32x4*)(vd + 4) = (f32x4){xv[4], xv[5], xv[6], xv[7]};
            }
            if ((lane & 7) == 0) { LAS float* scn = scb + n3i * 128; scn[tl * 4] = br; scn[tl * 4 + 1] = kdr; if (rsplit == 0 && t >= 0 && t < L) bonus[(size_t)(sb + t) * 16 + dir * 8 + head] = bon; }
            if (b + 2 < nblk) { issue_x(b + 2); issue_d(b + 2); }
          }
        }
        __syncthreads();
      }
    }
  }
}
__device__ __forceinline__ void conv_phase(const Params& p) {
  unsigned char* ws = p.ws + opq0_();
  bf16_t* mix = (bf16_t*)(ws + R1_MIX); const bf16_t* ub = (const bf16_t*)(ws + R1_U); const float* cw = inp(ws, 32);
  const int gt = bidx_() * 512 + tidx_(), ngt = gridDim.x * 512;
  for (int it = gt; it < MROWS * 64; it += ngt) {
    const int row = it >> 6, c0 = (it & 63) * 8; int seq, pos, L; row_info(row, seq, pos, L);
    u32x4 o = (u32x4){0u, 0u, 0u, 0u};
    bf16_t* dst = mix + (size_t)row * 1024 + 512 + c0;
    if (pos >= 0) {
      const bf16_t* up = ub + (size_t)row * 512 + c0;
      const u32x4 pb = *(const u32x4*)dst, c = *(const u32x4*)up; u32x4 a = (u32x4){0u, 0u, 0u, 0u}, d = (u32x4){0u, 0u, 0u, 0u};
      if (pos > 0) a = *(const u32x4*)(up - 512);
      if (pos < L - 1) d = *(const u32x4*)(up + 512);
      const unsigned pw[4] = {pb.x, pb.y, pb.z, pb.w}, cw4[4] = {c.x, c.y, c.z, c.w}, aw[4] = {a.x, a.y, a.z, a.w}, dw[4] = {d.x, d.y, d.z, d.w}; unsigned ow[4];
#pragma unroll
      for (int t = 0; t < 4; ++t) { const int cc = c0 + t * 2;
        const float y0 = cw[cc] * bflo(aw[t]) + cw[512 + cc] * bflo(cw4[t]) + cw[1024 + cc] * bflo(dw[t]);
        const float y1 = cw[cc + 1] * bfhi(aw[t]) + cw[512 + cc + 1] * bfhi(cw4[t]) + cw[1024 + cc + 1] * bfhi(dw[t]);
        ow[t] = pack2(bflo(pw[t]) * y0, bfhi(pw[t]) * y1); }
      o = (u32x4){ow[0], ow[1], ow[2], ow[3]};
    }
    *(u32x4*)dst = o;
  }
}

__constant__ float C16[16] = {1.f, 0.92387953f, 0.70710678f, 0.38268343f, 0.f, -0.38268343f, -0.70710678f, -0.92387953f, -1.f, -0.92387953f, -0.70710678f, -0.38268343f, 0.f, 0.38268343f, 0.70710678f, 0.92387953f};
__constant__ float S16[16] = {0.f, 0.38268343f, 0.70710678f, 0.92387953f, 1.f, 0.92387953f, 0.70710678f, 0.38268343f, 0.f, -0.38268343f, -0.70710678f, -0.92387953f, -1.f, -0.92387953f, -0.70710678f, -0.38268343f};
__device__ __forceinline__ void f2_phase(const Params& p) {
  unsigned char* ws = p.ws + opq0_(); unsigned char* r2 = (unsigned char*)p.out + opq0_();
  const int gt = bidx_() * 512 + tidx_(), ngt = gridDim.x * 512;
  constexpr int NPI = 2 * 512 * 513, NSI = 4 * 512 * 257;
  for (int it = gt; it < NPI + NSI; it += ngt) {
    int grp, n2, c, sl, N2, L, NN;
    if (it < NPI) { grp = 0; N2 = 513; L = LP; NN = 1024; n2 = it % 513; const int q = it / 513; c = q & 511; sl = q >> 9; }
    else { const int v = it - NPI; grp = 1; N2 = 257; L = LS; NN = 2048; n2 = v % 257; const int q = v / 257; c = q & 511; sl = q >> 9; }
    const bf16_t* wt = (const bf16_t*)(r2 + (grp ? R2_WTS : R2_WT)) + (size_t)sl * 1024 * L;
    const bf16_t* pr = wt + (size_t)c * L + n2; const bf16_t* pi = wt + (size_t)(512 + c) * L + n2;
    float re[16], im[16];
#pragma unroll
    for (int n1 = 0; n1 < 16; ++n1) { re[n1] = bf2f(pr[n1 * N2]); im[n1] = bf2f(pi[n1 * N2]); }
    const float* tw = (const float*)(ws + (grp ? T_TWS : T_TWP));
    const int ni = sl * 512 + c; const int Kd = 2 * (N2 - 1);
    bf16_t* btf = grp ? (bf16_t*)(ws + R1_BTFS) : (bf16_t*)(r2 + R2_BTFP);
    float* tv = (float*)(ws + T_TAILV) + (grp ? 32768 : 0);
    float Ar[4][4], Ai[4][4];
#pragma unroll
    for (int b = 0; b < 4; ++b) {
      const float x0r = re[b], x0i = im[b], x1r = re[4 + b], x1i = im[4 + b], x2r = re[8 + b], x2i = im[8 + b], x3r = re[12 + b], x3i = im[12 + b];
      const float s02r = x0r + x2r, s02i = x0i + x2i, d02r = x0r - x2r, d02i = x0i - x2i, s13r = x1r + x3r, s13i = x1i + x3i, d13r = x1r - x3r, d13i = x1i - x3i;
      Ar[0][b] = s02r + s13r; Ai[0][b] = s02i + s13i;
      Ar[2][b] = s02r - s13r; Ai[2][b] = s02i - s13i;
      Ar[1][b] = d02r + d13i; Ai[1][b] = d02i - d13r;
      Ar[3][b] = d02r - d13i; Ai[3][b] = d02i + d13r;
    }
#pragma unroll
    for (int c = 1; c < 4; ++c)
#pragma unroll
      for (int b = 1; b < 4; ++b) { const float cc = C16[(c * b) & 15], ss = S16[(c * b) & 15]; const float xr = Ar[c][b], xi = Ai[c][b]; Ar[c][b] = xr * cc + xi * ss; Ai[c][b] = xi * cc - xr * ss; }
#pragma unroll
    for (int c = 0; c < 4; ++c) {
      const float x0r = Ar[c][0], x0i = Ai[c][0], x1r = Ar[c][1], x1i = Ai[c][1], x2r = Ar[c][2], x2i = Ai[c][2], x3r = Ar[c][3], x3i = Ai[c][3];
      const float s02r = x0r + x2r, s02i = x0i + x2i, d02r = x0r - x2r, d02i = x0i - x2i, s13r = x1r + x3r, s13i = x1i + x3i, d13r = x1r - x3r, d13i = x1i - x3i;
      float Or[4], Oi[4];
      Or[0] = s02r + s13r; Oi[0] = s02i + s13i; Or[2] = s02r - s13r; Oi[2] = s02i - s13i;
      Or[1] = d02r + d13i; Oi[1] = d02i - d13r; Or[3] = d02r - d13i; Oi[3] = d02i + d13r;
#pragma unroll
      for (int d = 0; d < 4; ++d) {
        const int k1 = c + 4 * d; const float orr = Or[d], oii = Oi[d];
        const float tc = tw[(k1 * N2 + n2) * 2], ts = tw[(k1 * N2 + n2) * 2 + 1];
        const float ar = tc * orr + ts * oii, ai = tc * oii - ts * orr;
        if (n2 < N2 - 1) { bf16_t* dd = btf + ((size_t)k1 * NN + ni) * Kd + n2; dd[0] = f2bf(ar); dd[N2 - 1] = f2bf(ai); }
        else { float* dd = tv + ((size_t)k1 * NN + ni) * 2; dd[0] = ar; dd[1] = ai; }
      }
    }
  }
}

__device__ __forceinline__ void f3_tail_phase(const Params& p) {
  unsigned char* ws = p.ws + opq0_(); unsigned char* r2 = (unsigned char*)p.out + opq0_();
  bf16_t* mix = (bf16_t*)(ws + R1_MIX); const float* tc = (const float*)(ws + T_TAILC);
  const int lane = tidx_() & 63, gw = bidx_() * 8 + (tidx_() >> 6), nw = gridDim.x * 8;
  for (int it = gw; it < 16 * 1024 + 16 * 2048; it += nw) {
    int grp, k1, ni, N2, NN; if (it < 16384) { grp = 0; k1 = it >> 10; ni = it & 1023; N2 = 513; NN = 1024; } else { const int v = it - 16384; grp = 1; k1 = v >> 11; ni = v & 2047; N2 = 257; NN = 2048; }
    const int H = N2 - 1, Kd = 2 * H;
    const bf16_t* b = (grp ? (const bf16_t*)(ws + R1_BTFS) : (const bf16_t*)(r2 + R2_BTFP)) + ((size_t)k1 * NN + ni) * Kd;
    const float* arc = tc + (grp ? TC_ARCS : TC_ARCP); const float* ars = tc + (grp ? TC_ARSS : TC_ARSP);
    float acc = 0.f;
    if (lane * 8 < H) {
      const u32x4 vr = *(const u32x4*)(b + lane * 8), vi = *(const u32x4*)(b + H + lane * 8);
      const unsigned rw[4] = {vr.x, vr.y, vr.z, vr.w}, iw[4] = {vi.x, vi.y, vi.z, vi.w};
#pragma unroll
      for (int t = 0; t < 4; ++t) { const int n2 = lane * 8 + t * 2;
        acc += arc[n2] * bflo(rw[t]) + arc[n2 + 1] * bfhi(rw[t]) + ars[n2] * bflo(iw[t]) + ars[n2 + 1] * bfhi(iw[t]); }
    }
#pragma unroll
    for (int o = 32; o >= 1; o >>= 1) acc += shx(acc, o, lane);
    if (lane == 0) {
      const float* tv = (const float*)(ws + T_TAILV) + (grp ? 32768 : 0) + ((size_t)k1 * NN + ni) * 2;
      acc += arc[H] * tv[0] + ars[H] * tv[1];
      const float scale = grp ? rsqrtf(128.0f * LS) : rsqrtf(128.0f * LP);
      const int sl = ni >> 9, c = ni & 511, pos = k1 + 16 * H;
      const int row = (grp ? 2 * LPP + sl * LPS : sl * LPP) + PADR + pos;
      mix[(size_t)row * 1024 + c] = f2bf(acc * scale);
    }
  }
}

__device__ __forceinline__ void final_phase(const Params& p) {
  unsigned char* ws = p.ws + opq0_(); const bf16_t* h = (const bf16_t*)(ws + OFF_H); const float* rowsq = (const float*)(ws + T_ROWSQ); const float* g = inp(ws, 37);
  const int lane = tidx_() & 63, gw = bidx_() * 8 + (tidx_() >> 6), nw = gridDim.x * 8;
  for (int row = gw; row < MROWS; row += nw) {
    int seq, pos, L; row_info(row, seq, pos, L); if (pos < 16) continue;
    const float rs = row_rstd(rowsq, row);
    float* dst = p.out + (seq < 2 ? ((size_t)seq * 8192 + (pos - 16)) : ((size_t)16384 + (size_t)(seq - 2) * 4096 + (pos - 16))) * 1024;
#pragma unroll
    for (int i = 0; i < 4; ++i) { const int c = i * 256 + lane * 4; const u32x2 v = *(const u32x2*)(h + tix(row, c, 16)); const f32x4 gg = *(const f32x4*)(g + c);
      f32x4 o; o[0] = bflo(v.x) * rs * gg[0]; o[1] = bfhi(v.x) * rs * gg[1]; o[2] = bflo(v.y) * rs * gg[2]; o[3] = bfhi(v.y) * rs * gg[3]; *(f32x4*)(dst + c) = o; }
  }
}

__global__ void __launch_bounds__(512) __attribute__((amdgpu_flat_work_group_size(512, 512))) mega(Params p) {
  extern __shared__ __attribute__((aligned(16))) unsigned char smem[];
  LAS unsigned char* lds = (LAS unsigned char*)smem;
  cg::grid_group grid = cg::this_grid();
  LAS unsigned* xst = (LAS unsigned*)(lds + LDS_CTL + 32);
  if (threadIdx.x == 0) { xst[0] = 0u; xst[1] = 0u; (void)xb_add(&((unsigned*)(p.ws + T_BAR))[XB_XCNT(xcc_id_())], 1u); }
  __syncthreads();
#define SYNC_ do { XcdBarrier xb_; xb_.bar = (unsigned*)(p.ws + T_BAR); xb_.x = xcc_id_(); xb_.st = xst; xcd_barrier(xb_); } while (0)
  if (threadIdx.x == 0) { const unsigned x = xcc_id_(); LAS int* ctl = (LAS int*)(lds + LDS_CTL);
    const unsigned slot = __hip_atomic_fetch_add((unsigned*)(p.ws + T_CNT) + x, 1u, __ATOMIC_RELAXED, __HIP_MEMORY_SCOPE_AGENT); ctl[0] = (int)x; ctl[1] = (int)slot; }
  prep_misc(p); prep_weights(p, 0, lds); grid.sync();
  if (threadIdx.x == 0) { LAS int* ctl = (LAS int*)(lds + LDS_CTL); int ok = 1, mine = 0;
    for (int i = 0; i < 8; ++i) { const int c = (int)__hip_atomic_load((unsigned*)(p.ws + T_CNT) + i, __ATOMIC_RELAXED, __HIP_MEMORY_SCOPE_AGENT); if (c == 0) ok = 0; if (i == ctl[0]) mine = c; }
    ctl[2] = mine; ctl[3] = ok; }
  __syncthreads();
  gemm_phase(K_UP, 0, p, lds, 1); SYNC_;
  gemm_phase(K_DN, 0, p, lds, 2); prep_weights(p, 2, lds); SYNC_;
  gemm_phase(K_WINA, 0, p, lds, 3); prep_weights(p, 3, lds); SYNC_;
  ret_kv_phase(p, lds); SYNC_;
  ret_scan_phase(p); SYNC_;
  ret_out_phase(p, lds); SYNC_;
  xwa_phase(p); SYNC_;
  rwkv_scan2_phase(p, lds); SYNC_;
  rwkv_post_phase(p, lds); SYNC_;
  gemm_phase(K_WOUT, 0, p, lds, 4); prep_weights(p, 1, lds); SYNC_;
  gemm_phase(K_UP, 1, p, lds, 5); gemm_phase(K_FOLD, 0, p, lds); SYNC_;
  gemm_phase(K_DN, 1, p, lds, 6); SYNC_;
  gemm_phase(K_UP, 2, p, lds, 7); SYNC_;
  gemm_phase(K_DN, 2, p, lds, 8); SYNC_;
  gemm_phase(K_WIN1, 0, p, lds, 9); SYNC_;
  conv_phase(p); SYNC_;
  f2_phase(p); SYNC_;
  gemm_phase(K_F3, 0, p, lds); f3_tail_phase(p); SYNC_;
  gemm_phase(K_WOUT, 1, p, lds, 10); SYNC_;
  gemm_phase(K_UP, 3, p, lds, 11); SYNC_;
  gemm_phase(K_DN, 3, p, lds, 12); SYNC_;
  final_phase(p);
}

extern "C" void kernel_launch(void* const* d_in, const int* in_sizes, int n_in, void* d_out, int out_size, void* d_ws, size_t ws_size, hipStream_t stream) {
  constexpr size_t kDynLds = 148224;
  static int grid_blocks = 0;
  if (!grid_blocks) {
    int dev = 0, cus = 0, per_cu = 0;
    (void)hipGetDevice(&dev);
    (void)hipDeviceGetAttribute(&cus, hipDeviceAttributeMultiprocessorCount, dev);
    (void)hipFuncSetAttribute((const void*)mega, hipFuncAttributeMaxDynamicSharedMemorySize, (int)kDynLds);
    (void)hipOccupancyMaxActiveBlocksPerMultiprocessor(&per_cu, mega, 512, kDynLds);
    if (per_cu < 1) per_cu = 1;
    grid_blocks = cus * 1;
  }
  Params p{};
  for (int i = 0; i < 38; ++i) p.in[i] = (const float*)d_in[i];
  p.out = (float*)d_out; p.ws = (unsigned char*)d_ws;
  (void)hipMemsetAsync((char*)d_ws + T_CNT, 0, 128 + 14336, stream);
  void* args[] = {&p};
  hipError_t e = hipLaunchCooperativeKernel((void*)mega, dim3(grid_blocks), dim3(512), args, kDynLds, stream);
  if (e != hipSuccess) fprintf(stderr, "cooperative launch failed: %s (grid %d)\n", hipGetErrorString(e), grid_blocks);
}
```
